# Optimizing an MI355X kernel written in HIP

```python
import math
import jax, jax.numpy as jnp
from jax import lax
import numpy as np

D_MODEL = 1024
BATCH = 16
SEQ = 2048
DEPTH = 1
DEC_BATCH = 16
DEC_SEQ = 4096
PAST_LEN = 128

N_HEADS = 8
QK_NOPE_DIM = 64
QK_ROPE_DIM = 32
QK_DIM = QK_NOPE_DIM + QK_ROPE_DIM
V_HEAD_DIM = 64
Q_LORA_RANK = 256
KV_LORA_RANK = 128
ATTN_WIDTH = N_HEADS * V_HEAD_DIM
ROPE_THETA = 10000.0
Q_BLOCK = 128
LRU_WIDTH = D_MODEL
LRU_BLOCKS = 8
LRU_BLOCK_DIM = LRU_WIDTH // LRU_BLOCKS
CONV_WIDTH = 4
LRU_C = 8.0
N_DIRECTIONS = 2
D_FF = 2816
FFN_RESIDUAL = 0.5
N_SUBLAYERS = 3
EPS = 1e-6
SPLIT_POINTS = (
    Q_LORA_RANK,
    Q_LORA_RANK + KV_LORA_RANK,
    Q_LORA_RANK + KV_LORA_RANK + QK_ROPE_DIM,
    Q_LORA_RANK + KV_LORA_RANK + QK_ROPE_DIM + LRU_WIDTH,
    Q_LORA_RANK + KV_LORA_RANK + QK_ROPE_DIM + 2 * LRU_WIDTH,
    Q_LORA_RANK + KV_LORA_RANK + QK_ROPE_DIM + 2 * LRU_WIDTH + D_MODEL,
)
COMBINED_WIDTH = Q_LORA_RANK + KV_LORA_RANK + QK_ROPE_DIM + 2 * LRU_WIDTH + 2 * D_MODEL

kernel_name = "hybrid_mla_rglru_macaron_encoder"


def rmsnorm(x, g):
    xf = x.astype(jnp.float32)
    y = xf * lax.rsqrt(jnp.mean(xf * xf, axis=-1, keepdims=True) + EPS)
    return (y * g.astype(jnp.float32)).astype(x.dtype)


def rope_tables(seq_len):
    inv = 1.0 / (ROPE_THETA ** (jnp.arange(0, QK_ROPE_DIM, 2, dtype=jnp.float32) / QK_ROPE_DIM))
    ang = jnp.arange(seq_len, dtype=jnp.float32)[:, None] * inv[None, :]
    return jnp.cos(ang), jnp.sin(ang)


def apply_rope(x, cos, sin):
    x1, x2 = jnp.split(x.astype(jnp.float32), 2, axis=-1)
    c = cos[None, :, None, :]
    s = sin[None, :, None, :]
    return jnp.concatenate([x1 * c - x2 * s, x2 * c + x1 * s], axis=-1).astype(x.dtype)


def swiglu(h, w_gu, w_down):
    g, u = jnp.split(h @ w_gu, 2, axis=-1)
    return (jax.nn.silu(g) * u) @ w_down


def bidir_attention(q, k, v):
    b, s = q.shape[0], q.shape[1]
    nb = s // Q_BLOCK
    qb = q.reshape(b, nb, Q_BLOCK, N_HEADS, QK_DIM).transpose(1, 0, 2, 3, 4)
    scale = QK_DIM ** -0.5

    def one_block(qblk):
        sc = jnp.einsum("bqhd,bkhd->bhqk", qblk, k, preferred_element_type=jnp.float32) * scale
        p = jax.nn.softmax(sc, axis=-1)
        return jnp.einsum("bhqk,bkhd->bqhd", p.astype(v.dtype), v)

    o = lax.map(one_block, qb)
    return o.transpose(1, 0, 2, 3, 4).reshape(b, s, ATTN_WIDTH)


def mla_branch(c_q, c_kv, k_rope, cos, sin, g_q_norm, g_kv_norm, w_q_b, w_kv_b, w_attn_o):
    b, s = c_q.shape[0], c_q.shape[1]
    q = (rmsnorm(c_q, g_q_norm) @ w_q_b).reshape(b, s, N_HEADS, QK_DIM)
    q = jnp.concatenate([q[..., :QK_NOPE_DIM], apply_rope(q[..., QK_NOPE_DIM:], cos, sin)], axis=-1)
    kv = (rmsnorm(c_kv, g_kv_norm) @ w_kv_b).reshape(b, s, N_HEADS, QK_NOPE_DIM + V_HEAD_DIM)
    k_nope, v = kv[..., :QK_NOPE_DIM], kv[..., QK_NOPE_DIM:]
    k_r = apply_rope(k_rope[:, :, None, :], cos, sin)
    k = jnp.concatenate([k_nope, jnp.broadcast_to(k_r, (b, s, N_HEADS, QK_ROPE_DIM))], axis=-1)
    return bidir_attention(q, k, v) @ w_attn_o


def centred_depthwise_conv(x, w, bias):
    s = x.shape[1]
    left = (CONV_WIDTH - 1) // 2
    right = CONV_WIDTH - 1 - left
    xp = jnp.pad(x, ((0, 0), (left, right), (0, 0)))
    out = bias + xp[:, 0:s, :] * w[0]
    for j in range(1, CONV_WIDTH):
        out = out + xp[:, j:j + s, :] * w[j]
    return out


def block_diag_linear(x, w, bias):
    b, s = x.shape[0], x.shape[1]
    xb = x.reshape(b, s, LRU_BLOCKS, LRU_BLOCK_DIM)
    return jnp.einsum("bsnd,nde->bsne", xb, w).reshape(b, s, LRU_WIDTH) + bias


def rglru_direction(x, w_a, b_a, w_i, b_i, lam, reverse):
    r = jax.nn.sigmoid(block_diag_linear(x, w_a, b_a).astype(jnp.float32))
    i = jax.nn.sigmoid(block_diag_linear(x, w_i, b_i).astype(jnp.float32))
    log_a = -LRU_C * r * jax.nn.softplus(-lam.astype(jnp.float32))
    a = jnp.exp(log_a)
    u = jnp.sqrt(-jnp.expm1(2.0 * log_a)) * (i * x.astype(jnp.float32))

    def combine(e1, e2):
        a1, b1 = e1
        a2, b2 = e2
        return a1 * a2, a2 * b1 + b2

    _, h = lax.associative_scan(combine, (a, u), axis=1, reverse=reverse)
    return h


def encoder_layer(x, c, cos, sin, w_ada, b_ada, g_pre, g_post, w_ffn1_gu, w_ffn1_down, w_in,
                  g_q_norm, g_kv_norm, w_q_b, w_kv_b, w_attn_o, conv_w, conv_b,
                  lru_w_a, lru_b_a, lru_w_i, lru_b_i, lru_lambda, w_lru_o, w_out,
                  w_ffn2_gu, w_ffn2_down):
    b = x.shape[0]
    mod = (jax.nn.silu(c) @ w_ada + b_ada).reshape(b, N_SUBLAYERS, 3, D_MODEL)
    shift = mod[:, :, 0, None, :]
    scl = mod[:, :, 1, None, :]
    gate = mod[:, :, 2, None, :]

    h = rmsnorm(x, g_pre[0]) * (1.0 + scl[:, 0]) + shift[:, 0]
    f = rmsnorm(swiglu(h, w_ffn1_gu, w_ffn1_down), g_post[0])
    x = x + FFN_RESIDUAL * gate[:, 0] * f

    h = rmsnorm(x, g_pre[1]) * (1.0 + scl[:, 1]) + shift[:, 1]
    z = h @ w_in
    c_q, c_kv, k_rope, x_lru, y_lru, g_att, g_lru = jnp.split(z, SPLIT_POINTS, axis=-1)
    o_att = mla_branch(c_q, c_kv, k_rope, cos, sin, g_q_norm, g_kv_norm, w_q_b, w_kv_b, w_attn_o)
    xc = centred_depthwise_conv(x_lru, conv_w, conv_b)
    h_lru = (rglru_direction(xc, lru_w_a[0], lru_b_a[0], lru_w_i[0], lru_b_i[0], lru_lambda[0], False)
             + rglru_direction(xc, lru_w_a[1], lru_b_a[1], lru_w_i[1], lru_b_i[1], lru_lambda[1], True))
    o_lru = (h_lru.astype(x.dtype) * jax.nn.gelu(y_lru)) @ w_lru_o
    merged = jax.nn.sigmoid(g_att) * o_att + jax.nn.sigmoid(g_lru) * o_lru
    m = rmsnorm(merged @ w_out, g_post[1])
    x = x + gate[:, 1] * m

    h = rmsnorm(x, g_pre[2]) * (1.0 + scl[:, 2]) + shift[:, 2]
    f = rmsnorm(swiglu(h, w_ffn2_gu, w_ffn2_down), g_post[2])
    return x + FFN_RESIDUAL * gate[:, 2] * f


def setup_inputs(seed: int = 0) -> dict:
    key = jax.random.key(seed)
    ks = jax.random.split(key, 32)
    f32 = jnp.float32

    def normal(k, shape, scale):
        return jax.random.normal(k, shape, f32) * scale

    u = jax.random.uniform(ks[24], (DEPTH, N_DIRECTIONS, LRU_WIDTH), f32, minval=0.9, maxval=0.999)
    a_base = u ** (1.0 / LRU_C)
    lru_lambda = jnp.log(a_base) - jnp.log1p(-a_base)
    return {
        "x_prompt": normal(ks[0], (BATCH, SEQ, D_MODEL), 1.0),
        "x_sample": normal(ks[1], (DEC_BATCH, DEC_SEQ, D_MODEL), 1.0),
        "c_prompt": normal(ks[2], (BATCH, D_MODEL), 1.0),
        "c_sample": normal(ks[3], (DEC_BATCH, D_MODEL), 1.0),
        "w_ada": normal(ks[4], (DEPTH, D_MODEL, N_SUBLAYERS * 3 * D_MODEL), 0.5 * D_MODEL ** -0.5),
        "b_ada": normal(ks[5], (DEPTH, N_SUBLAYERS * 3 * D_MODEL), 0.02),
        "g_pre": 1.0 + normal(ks[6], (DEPTH, N_SUBLAYERS, D_MODEL), 0.05),
        "g_post": 1.0 + normal(ks[7], (DEPTH, N_SUBLAYERS, D_MODEL), 0.05),
        "w_ffn1_gu": normal(ks[8], (DEPTH, D_MODEL, 2 * D_FF), D_MODEL ** -0.5),
        "w_ffn1_down": normal(ks[9], (DEPTH, D_FF, D_MODEL), D_FF ** -0.5),
        "w_in": normal(ks[10], (DEPTH, D_MODEL, COMBINED_WIDTH), D_MODEL ** -0.5),
        "g_q_norm": 1.0 + normal(ks[11], (DEPTH, Q_LORA_RANK), 0.05),
        "g_kv_norm": 1.0 + normal(ks[12], (DEPTH, KV_LORA_RANK), 0.05),
        "w_q_b": normal(ks[13], (DEPTH, Q_LORA_RANK, N_HEADS * QK_DIM), Q_LORA_RANK ** -0.5),
        "w_kv_b": normal(ks[14], (DEPTH, KV_LORA_RANK, N_HEADS * (QK_NOPE_DIM + V_HEAD_DIM)), KV_LORA_RANK ** -0.5),
        "w_attn_o": normal(ks[15], (DEPTH, ATTN_WIDTH, D_MODEL), ATTN_WIDTH ** -0.5),
        "conv_w": normal(ks[16], (DEPTH, CONV_WIDTH, LRU_WIDTH), CONV_WIDTH ** -0.5),
        "conv_b": normal(ks[17], (DEPTH, LRU_WIDTH), 0.02),
        "lru_w_a": normal(ks[18], (DEPTH, N_DIRECTIONS, LRU_BLOCKS, LRU_BLOCK_DIM, LRU_BLOCK_DIM), LRU_BLOCK_DIM ** -0.5),
        "lru_b_a": normal(ks[19], (DEPTH, N_DIRECTIONS, LRU_WIDTH), 0.1),
        "lru_w_i": normal(ks[20], (DEPTH, N_DIRECTIONS, LRU_BLOCKS, LRU_BLOCK_DIM, LRU_BLOCK_DIM), LRU_BLOCK_DIM ** -0.5),
        "lru_b_i": normal(ks[21], (DEPTH, N_DIRECTIONS, LRU_WIDTH), 0.1),
        "lru_lambda": lru_lambda,
        "w_lru_o": normal(ks[22], (DEPTH, LRU_WIDTH, D_MODEL), LRU_WIDTH ** -0.5),
        "w_out": normal(ks[23], (DEPTH, D_MODEL, D_MODEL), D_MODEL ** -0.5),
        "w_ffn2_gu": normal(ks[25], (DEPTH, D_MODEL, 2 * D_FF), D_MODEL ** -0.5),
        "w_ffn2_down": normal(ks[26], (DEPTH, D_FF, D_MODEL), D_FF ** -0.5),
    }


def reference(x_prompt, x_sample, c_prompt, c_sample, w_ada, b_ada, g_pre, g_post, w_ffn1_gu,
              w_ffn1_down, w_in, g_q_norm, g_kv_norm, w_q_b, w_kv_b, w_attn_o, conv_w, conv_b,
              lru_w_a, lru_b_a, lru_w_i, lru_b_i, lru_lambda, w_lru_o, w_out, w_ffn2_gu, w_ffn2_down):
    cos_p, sin_p = rope_tables(x_prompt.shape[1])
    cos_s, sin_s = rope_tables(x_sample.shape[1])
    y_prompt = x_prompt
    y_sample = x_sample
    for l in range(DEPTH):
        layer_params = (w_ada[l], b_ada[l], g_pre[l], g_post[l], w_ffn1_gu[l], w_ffn1_down[l], w_in[l],
                        g_q_norm[l], g_kv_norm[l], w_q_b[l], w_kv_b[l], w_attn_o[l], conv_w[l], conv_b[l],
                        lru_w_a[l], lru_b_a[l], lru_w_i[l], lru_b_i[l], lru_lambda[l], w_lru_o[l], w_out[l],
                        w_ffn2_gu[l], w_ffn2_down[l])
        y_prompt = encoder_layer(y_prompt, c_prompt, cos_p, sin_p, *layer_params)
        y_sample = encoder_layer(y_sample, c_sample, cos_s, sin_s, *layer_params)
    return (y_prompt, y_sample)
```

```cpp
#include <hip/hip_runtime.h>
#include <hip/hip_cooperative_groups.h>
#include <cstdio>
#include <cstdint>
namespace cg = cooperative_groups;

#define LAS __attribute__((address_space(3)))
typedef unsigned short bf16_t;
typedef short bf16x8 __attribute__((ext_vector_type(8)));
typedef short v4i16_t __attribute__((ext_vector_type(4)));
typedef float f32x4 __attribute__((ext_vector_type(4)));
typedef float f32x2 __attribute__((ext_vector_type(2)));
typedef unsigned u32x4 __attribute__((ext_vector_type(4)));
typedef unsigned u32x2 __attribute__((ext_vector_type(2)));

constexpr int D = 1024, DFF = 2816, TP = 32768, TS = 65536, T = TP + TS, SP = 2048, SS = 4096;
constexpr int NQ = 768, NKV = 512;
constexpr float EPS = 1e-6f;
constexpr int NTHREADS = 512, NWAVES = 8;

constexpr size_t KiB = 1024, MiB = 1024 * 1024;
constexpr size_t WS_WGU1 = 0, WS_WDN1 = 11 * MiB, WS_WINA = 16 * MiB + 512 * KiB, WS_WINB = 21 * MiB + 512 * KiB, WS_WQKV = 25 * MiB + 512 * KiB,
                 WS_WAO = 27 * MiB, WS_WLO = 28 * MiB, WS_WOUT = 30 * MiB, WS_WGU2 = 32 * MiB, WS_WDN2 = 43 * MiB, WS_WG = 48 * MiB + 512 * KiB,
                 WS_MOD = 49 * MiB + 512 * KiB, WS_ROPE = 50 * MiB + 768 * KiB, WS_STATS = 51 * MiB + 256 * KiB, WS_KR = 52 * MiB;
constexpr size_t WS_H = 64 * MiB, WS_F = 256 * MiB, WS_BIG = 448 * MiB;
constexpr size_t WS_ZQ = WS_BIG, WS_XL = WS_BIG + 96 * MiB, WS_GY = WS_BIG + 288 * MiB, WS_ACT = WS_BIG, WS_END = 976 * MiB;
constexpr int LDS_BYTES = 139264;

struct Params { const float* in[27]; float* out; unsigned char* ws; int ph_lo, ph_hi; };

typedef __bf16 bf16x2_t __attribute__((ext_vector_type(2)));
__device__ __forceinline__ unsigned pk_bf16(float lo, float hi) { const f32x2 v = {lo, hi}; const bf16x2_t b = __builtin_convertvector(v, bf16x2_t); return __builtin_bit_cast(unsigned, b); }
__device__ __forceinline__ float lo_bf(unsigned w) { return __uint_as_float(w << 16); }
__device__ __forceinline__ float hi_bf(unsigned w) { return __uint_as_float(w & 0xffff0000u); }
__device__ __forceinline__ float bf2f(bf16_t h) { return __uint_as_float((unsigned)h << 16); }
__device__ __forceinline__ float fexp(float x) { return __builtin_amdgcn_exp2f(x * 1.4426950408889634f); }
__device__ __forceinline__ float fsigmoid(float x) { return __builtin_amdgcn_rcpf(1.0f + fexp(-x)); }
__device__ __forceinline__ float fsilu(float x) { return x * fsigmoid(x); }
__device__ __forceinline__ float fgelu(float x) { return x * fsigmoid(1.5957691216057308f * (x + 0.044715f * x * x * x)); }
__device__ __forceinline__ float wave_sum(float v) {
#pragma unroll
    for (int o = 1; o < 64; o <<= 1) v += __shfl_xor(v, o);
    return v;
}
__device__ __forceinline__ int row_batch(int row) { return row < TP ? (row >> 11) : 16 + ((row - TP) >> 12); }
__device__ __forceinline__ int row_pos(int row) { return row < TP ? (row & (SP - 1)) : ((row - TP) & (SS - 1)); }

namespace pg8 {
constexpr int BM = 256, BK = 64, HALF = 128, HTB = HALF * BK * 2, STAGE_BYTES = 8 * HTB, NXCD = 8, WGM = 8;
__host__ __device__ __forceinline__ int lds_byte(int r, int c) { const int st = (r >> 4) * 2 + (c >> 5), rr = r & 15, cc = c & 31, ob = rr * 64 + cc * 2; return st * 1024 + (ob ^ (((ob >> 9) & 1) << 5)); }
__host__ __device__ __forceinline__ void stage_rc(int b, int& R, int& C) { const int st = b / 1024, sb = b % 1024, swz = sb ^ (((sb >> 9) & 1) << 5); R = (st >> 1) * 16 + swz / 64; C = (st & 1) * 32 + (swz % 64) / 2; }
__host__ __device__ __forceinline__ int perm32(int rho) { const int n = rho >> 4, i = rho & 15; return 8 * (i >> 2) + 4 * n + (i & 3); }

struct Unit { int pm, pn; };
struct Gemm { const bf16_t* A; const bf16_t* Bt; int lda, K; };

struct StaticOrder {
    int nM, nN, nwg, G, c;
    __device__ void init(int M, int N, int G_, int c_) { nM = M / BM; nN = N / BM; nwg = nM * nN; G = G_; c = c_; }
    __device__ bool next(int i, Unit& u) const {
        const long L = (long)i * G + c; if (L >= nwg) return false;
        int wgid = (int)L; { const int q = nwg / NXCD, r = nwg % NXCD, xcd = wgid % NXCD, off = wgid / NXCD; wgid = (xcd < r ? xcd * (q + 1) : r * (q + 1) + (xcd - r) * q) + off; }
        const int nig = WGM * nN, gid = wgid / nig, fm = gid * WGM, gsz = (nM - fm) < WGM ? (nM - fm) : WGM;
        u.pm = fm + ((wgid % nig) % gsz); u.pn = (wgid % nig) / gsz; return true;
    }
};

template <class Epi>
__device__ __forceinline__ void gemm_phase(LAS unsigned char* lds, const Gemm g, const StaticOrder& S, const Epi& E) {
    const int tid = threadIdx.x, wid = __builtin_amdgcn_readfirstlane(tid >> 6), lane = tid & 63, wr = wid >> 2, wc = wid & 3, fr = lane & 15, fq = lane >> 4;
    const int K = g.K, nt = K / BK, lda = g.lda;
    unsigned voffA[2], voffB[2];
#pragma unroll
    for (int i = 0; i < 2; ++i) { int R, C; stage_rc(tid * 16 + i * 8192, R, C); const int Rb = Epi::PERM ? ((R & ~31) + perm32(R & 31)) : R;
        voffA[i] = (unsigned)(R * lda + C) * 2u; voffB[i] = (unsigned)(Rb * K + C) * 2u; }
    const size_t kstep = (size_t)(BK * 2);
    const size_t hstepA = (size_t)HALF * lda * 2, hstepB = (size_t)HALF * K * 2;
    const size_t tstepA = 2 * hstepA, tstepB = 2 * hstepB;
    const unsigned ldsw = (unsigned)wid * 1024u;
    const int aoff = lds_byte(wr * 64 + fr, fq * 8), boff = lds_byte(wc * 32 + fr, fq * 8);
#define PG8_SA(b, h) (((b) * 2 + (h)) * HTB)
#define PG8_SB(b, h) ((4 + (b) * 2 + (h)) * HTB)
#define PG8_STAGE(bufoff, gbase, voff) do { _Pragma("unroll") for (int _i = 0; _i < 2; ++_i) \
        __builtin_amdgcn_global_load_lds((const unsigned*)((const char*)(gbase) + (voff)[_i]), (LAS unsigned*)(lds + (bufoff) + ldsw + _i * 8192), 16, 0, 0); } while (0)
#define PG8_LDA(dst, b, h) do { _Pragma("unroll") for (int m = 0; m < 4; ++m) _Pragma("unroll") for (int k = 0; k < 2; ++k) dst[m][k] = *(const LAS bf16x8*)(lds + PG8_SA(b, h) + aoff + m * 2048 + k * 1024); } while (0)
#define PG8_LDB(dst, b, h) do { _Pragma("unroll") for (int n = 0; n < 2; ++n) _Pragma("unroll") for (int k = 0; k < 2; ++k) dst[n][k] = *(const LAS bf16x8*)(lds + PG8_SB(b, h) + boff + n * 2048 + k * 1024); } while (0)
#define PG8_MMA(ai, bj, At, Bt) do { __builtin_amdgcn_s_setprio(1); _Pragma("unroll") for (int m = 0; m < 4; ++m) _Pragma("unroll") for (int n = 0; n < 2; ++n) _Pragma("unroll") for (int k = 0; k < 2; ++k) \
        acc[ai][bj][m][n] = __builtin_amdgcn_mfma_f32_16x16x32_bf16(Bt[n][k], At[m][k], acc[ai][bj][m][n], 0, 0, 0); __builtin_amdgcn_s_setprio(0); } while (0)
#define PG8_WAIT_V(n) asm volatile("s_waitcnt vmcnt(" #n ")" ::: "memory")
#define PG8_WAIT_L(n) asm volatile("s_waitcnt lgkmcnt(" #n ")" ::: "memory")
#define PG8_BAR __builtin_amdgcn_s_barrier()
#define PG8_SCHED __builtin_amdgcn_sched_barrier(0)
    Unit cur, nxt; int ui = 0;
    if (!S.next(0, cur)) return;
    f32x4 acc[2][2][4][2];
#pragma unroll
    for (int a = 0; a < 2; ++a)
#pragma unroll
        for (int b = 0; b < 2; ++b)
#pragma unroll
            for (int m = 0; m < 4; ++m)
#pragma unroll
                for (int n = 0; n < 2; ++n) acc[a][b][m][n] = (f32x4){0.f, 0.f, 0.f, 0.f};
    bf16x8 At[4][2], B0[2][2], B1[2][2];
    const char* cA = (const char*)g.A + (size_t)cur.pm * tstepA; const char* cB = (const char*)g.Bt + (size_t)cur.pn * tstepB;
    PG8_STAGE(PG8_SB(0, 0), cB, voffB); PG8_STAGE(PG8_SA(0, 0), cA, voffA); PG8_STAGE(PG8_SB(0, 1), cB + hstepB, voffB); PG8_STAGE(PG8_SA(0, 1), cA + hstepA, voffA);
    if (wr == 1) PG8_BAR;
    PG8_WAIT_V(4); PG8_BAR;
    PG8_STAGE(PG8_SB(1, 0), cB + kstep, voffB); PG8_STAGE(PG8_SA(1, 0), cA + kstep, voffA); PG8_STAGE(PG8_SB(1, 1), cB + hstepB + kstep, voffB);
    PG8_WAIT_V(6); PG8_BAR;
    for (;;) {
        const bool has_next = S.next(ui + 1, nxt);
        const char* nA = has_next ? (const char*)g.A + (size_t)nxt.pm * tstepA : cA; const char* nB = has_next ? (const char*)g.Bt + (size_t)nxt.pn * tstepB : cB;
        for (int t = 0; t < nt; t += 2) {
            const bool last = (t == nt - 2);
            const char* a1 = cA + (size_t)(t + 1) * kstep;
            const char* a2 = last ? nA : cA + (size_t)(t + 2) * kstep; const char* b2 = last ? nB : cB + (size_t)(t + 2) * kstep;
            const char* a3 = a2 + kstep; const char* b3 = b2 + kstep;
            PG8_LDB(B0, 0, 0); PG8_SCHED; PG8_LDA(At, 0, 0); PG8_STAGE(PG8_SA(1, 1), a1 + hstepA, voffA);
            PG8_WAIT_L(8); PG8_BAR; PG8_WAIT_L(0); PG8_MMA(0, 0, At, B0); PG8_BAR; PG8_SCHED;
            PG8_LDB(B1, 0, 1); PG8_STAGE(PG8_SB(0, 0), b2, voffB);
            PG8_BAR; PG8_WAIT_L(0); PG8_MMA(0, 1, At, B1); PG8_BAR;
            PG8_LDA(At, 0, 1); PG8_STAGE(PG8_SA(0, 0), a2, voffA);
            PG8_BAR; PG8_WAIT_L(0); PG8_MMA(1, 0, At, B0); PG8_BAR; PG8_SCHED;
            PG8_STAGE(PG8_SB(0, 1), b2 + hstepB, voffB);
            PG8_WAIT_V(6); PG8_BAR; PG8_MMA(1, 1, At, B1); PG8_BAR;
            PG8_LDB(B0, 1, 0); PG8_SCHED; PG8_LDA(At, 1, 0); PG8_STAGE(PG8_SA(0, 1), a2 + hstepA, voffA);
            PG8_WAIT_L(8); PG8_BAR; PG8_WAIT_L(0); PG8_MMA(0, 0, At, B0); PG8_BAR; PG8_SCHED;
            PG8_LDB(B1, 1, 1); PG8_STAGE(PG8_SB(1, 0), b3, voffB);
            PG8_BAR; PG8_WAIT_L(0); PG8_MMA(0, 1, At, B1); PG8_BAR;
            PG8_LDA(At, 1, 1); PG8_STAGE(PG8_SA(1, 0), a3, voffA);
            PG8_BAR; PG8_WAIT_L(0); PG8_MMA(1, 0, At, B0); PG8_BAR; PG8_SCHED;
            PG8_STAGE(PG8_SB(1, 1), b3 + hstepB, voffB);
            PG8_WAIT_V(6); PG8_BAR; PG8_MMA(1, 1, At, B1); PG8_BAR;
        }
        { int el; asm volatile("v_mbcnt_lo_u32_b32 %0, -1, 0\n\tv_mbcnt_hi_u32_b32 %0, -1, %0" : "=v"(el)); E(acc, cur, wr, wc, el & 15, el >> 4); }
        if (!has_next) break;
#pragma unroll
        for (int a = 0; a < 2; ++a)
#pragma unroll
            for (int b = 0; b < 2; ++b)
#pragma unroll
                for (int m = 0; m < 4; ++m)
#pragma unroll
                    for (int n = 0; n < 2; ++n) acc[a][b][m][n] = (f32x4){0.f, 0.f, 0.f, 0.f};
        cur = nxt; cA = nA; cB = nB; ++ui;
    }
    PG8_WAIT_V(0);
    if (wr == 0) PG8_BAR;
    PG8_BAR;
#undef PG8_SA
#undef PG8_SB
#undef PG8_STAGE
#undef PG8_LDA
#undef PG8_LDB
#undef PG8_MMA
#undef PG8_WAIT_V
#undef PG8_WAIT_L
#undef PG8_BAR
#undef PG8_SCHED
}

#if defined(MK_SIMPLE_GEMM)
template <class Epi>
__device__ __forceinline__ void gemm_phase_simple(const Gemm g, const StaticOrder& S, const Epi& E) {
    const int tid = threadIdx.x, wid = __builtin_amdgcn_readfirstlane(tid >> 6), lane = tid & 63, wr = wid >> 2, wc = wid & 3, fr = lane & 15, fq = lane >> 4;
    Unit cur;
    for (int ui = 0; S.next(ui, cur); ++ui) {
        f32x4 acc[2][2][4][2];
#pragma unroll
        for (int a = 0; a < 2; ++a)
#pragma unroll
            for (int b = 0; b < 2; ++b)
#pragma unroll
                for (int m = 0; m < 4; ++m)
#pragma unroll
                    for (int n = 0; n < 2; ++n) acc[a][b][m][n] = (f32x4){0.f, 0.f, 0.f, 0.f};
        for (int k0 = 0; k0 < g.K; k0 += 32) {
            bf16x8 bf[2][2];
#pragma unroll
            for (int bj = 0; bj < 2; ++bj)
#pragma unroll
                for (int n = 0; n < 2; ++n) { const int slot = 16 * n + fr; const int wrow = cur.pn * BM + bj * HALF + wc * 32 + (Epi::PERM ? perm32(slot) : slot);
                    bf[bj][n] = *(const bf16x8*)(g.Bt + (size_t)wrow * g.K + k0 + 8 * fq); }
#pragma unroll
            for (int ai = 0; ai < 2; ++ai)
#pragma unroll
                for (int m = 0; m < 4; ++m) { const int arow = cur.pm * BM + ai * HALF + wr * 64 + m * 16 + fr;
                    const bf16x8 af = *(const bf16x8*)(g.A + (size_t)arow * g.lda + k0 + 8 * fq);
#pragma unroll
                    for (int bj = 0; bj < 2; ++bj)
#pragma unroll
                        for (int n = 0; n < 2; ++n) acc[ai][bj][m][n] = __builtin_amdgcn_mfma_f32_16x16x32_bf16(bf[bj][n], af, acc[ai][bj][m][n], 0, 0, 0); }
        }
        E(acc, cur, wr, wc, fr, fq);
    }
}
#define GEMM_PHASE(EPI, lds, g, S, E) pg8::gemm_phase_simple<EPI>(g, S, E)
#else
#define GEMM_PHASE(EPI, lds, g, S, E) pg8::gemm_phase<EPI>(lds, g, S, E)
#endif
struct EpiSwiglu {
    static constexpr bool PERM = true;
    bf16_t* O; int ldc;
    __device__ __forceinline__ void operator()(const f32x4 (&acc)[2][2][4][2], const Unit& u, int wr, int wc, int fr, int fq) const {
        const int row0 = u.pm * BM + wr * 64 + fr, col0 = u.pn * 128 + wc * 32 + 8 * fq;
#pragma unroll
        for (int ai = 0; ai < 2; ++ai)
#pragma unroll
            for (int m = 0; m < 4; ++m) {
                bf16_t* rowp = O + (size_t)(row0 + ai * HALF + m * 16) * ldc + col0;
                const f32x4 g0 = acc[ai][0][m][0], g1 = acc[ai][0][m][1], u0 = acc[ai][1][m][0], u1 = acc[ai][1][m][1];
                float v[8];
#pragma unroll
                for (int j = 0; j < 4; ++j) { v[j] = fsilu(g0[j]) * u0[j]; v[4 + j] = fsilu(g1[j]) * u1[j]; }
                u32x4 w; w.x = pk_bf16(v[0], v[1]); w.y = pk_bf16(v[2], v[3]); w.z = pk_bf16(v[4], v[5]); w.w = pk_bf16(v[6], v[7]);
                *(u32x4*)rowp = w;
                asm volatile("" ::: "memory");
            }
    }
};
__device__ __forceinline__ void store_tile_bf16(const f32x4 (&acc)[2][2][4][2], bf16_t* base, int ld, int row0, int col0, int act) {
#pragma unroll
    for (int ai = 0; ai < 2; ++ai)
#pragma unroll
        for (int m = 0; m < 4; ++m) {
            bf16_t* rowp = base + (size_t)(row0 + ai * HALF + m * 16) * ld + col0;
#pragma unroll
            for (int bj = 0; bj < 2; ++bj) {
                f32x4 v0 = acc[ai][bj][m][0], v1 = acc[ai][bj][m][1];
                if (act == 1) {
#pragma unroll
                    for (int j = 0; j < 4; ++j) { v0[j] = fgelu(v0[j]); v1[j] = fgelu(v1[j]); }
                } else if (act == 2) {
#pragma unroll
                    for (int j = 0; j < 4; ++j) { v0[j] = fsigmoid(v0[j]); v1[j] = fsigmoid(v1[j]); }
                }
                u32x4 w; w.x = pk_bf16(v0[0], v0[1]); w.y = pk_bf16(v0[2], v0[3]); w.z = pk_bf16(v1[0], v1[1]); w.w = pk_bf16(v1[2], v1[3]);
                *(u32x4*)(rowp + bj * HALF) = w;
            }
            asm volatile("" ::: "memory");
        }
}
template <int ACT> struct EpiAct {
    static constexpr bool PERM = true;
    bf16_t* p; int ld, pn0;
    __device__ __forceinline__ void operator()(const f32x4 (&acc)[2][2][4][2], const Unit& u, int wr, int wc, int fr, int fq) const {
        store_tile_bf16(acc, p, ld, u.pm * BM + wr * 64 + fr, (u.pn - pn0) * BM + wc * 32 + 8 * fq, ACT);
    }
};
struct EpiWinA {
    static constexpr bool PERM = true;
    bf16_t* zq; bf16_t* xl; bf16_t* gy;
    __device__ __forceinline__ void operator()(const f32x4 (&acc)[2][2][4][2], const Unit& u, int wr, int wc, int fr, int fq) const {
        size_t boff = 0; if (u.pn >= 2) boff += (size_t)((const char*)xl - (const char*)zq); if (u.pn >= 6) boff += (size_t)((const char*)gy - (const char*)xl);
        bf16_t* base = (bf16_t*)((char*)zq + boff);
        int ld = 512, pn0 = 0; if (u.pn >= 2) { ld = D; pn0 = 2; } if (u.pn >= 6) pn0 = 6;
        store_tile_bf16(acc, base, ld, u.pm * BM + wr * 64 + fr, (u.pn - pn0) * BM + wc * 32 + 8 * fq, u.pn < 6 ? 0 : 1);
    }
};
struct EpiWinB {
    static constexpr bool PERM = true;
    bf16_t* ga; bf16_t* gl;
    __device__ __forceinline__ void operator()(const f32x4 (&acc)[2][2][4][2], const Unit& u, int wr, int wc, int fr, int fq) const {
        store_tile_bf16(acc, u.pn < 4 ? ga : gl, D, u.pm * BM + wr * 64 + fr, (u.pn & 3) * BM + wc * 32 + 8 * fq, 2);
    }
};
template <bool ADD> struct EpiGate {
    static constexpr bool PERM = true;
    const bf16_t* gate; const bf16_t* add; bf16_t* out;
    __device__ __forceinline__ void operator()(const f32x4 (&acc)[2][2][4][2], const Unit& u, int wr, int wc, int fr, int fq) const {
        const int row0 = u.pm * BM + wr * 64 + fr, col0 = u.pn * BM + wc * 32 + 8 * fq;
#pragma unroll
        for (int ai = 0; ai < 2; ++ai)
#pragma unroll
            for (int m = 0; m < 4; ++m) {
                const size_t off = (size_t)(row0 + ai * HALF + m * 16) * D + col0;
#pragma unroll
                for (int bj = 0; bj < 2; ++bj) {
                    const u32x4 gw = *(const u32x4*)(gate + off + bj * HALF);
                    const f32x4 v0 = acc[ai][bj][m][0], v1 = acc[ai][bj][m][1];
                    float r[8];
                    r[0] = lo_bf(gw.x) * v0[0]; r[1] = hi_bf(gw.x) * v0[1]; r[2] = lo_bf(gw.y) * v0[2]; r[3] = hi_bf(gw.y) * v0[3];
                    r[4] = lo_bf(gw.z) * v1[0]; r[5] = hi_bf(gw.z) * v1[1]; r[6] = lo_bf(gw.w) * v1[2]; r[7] = hi_bf(gw.w) * v1[3];
                    if (ADD) {
                        const u32x4 aw = *(const u32x4*)(add + off + bj * HALF);
                        r[0] += lo_bf(aw.x); r[1] += hi_bf(aw.x); r[2] += lo_bf(aw.y); r[3] += hi_bf(aw.y);
                        r[4] += lo_bf(aw.z); r[5] += hi_bf(aw.z); r[6] += lo_bf(aw.w); r[7] += hi_bf(aw.w);
                    }
                    u32x4 w; w.x = pk_bf16(r[0], r[1]); w.y = pk_bf16(r[2], r[3]); w.z = pk_bf16(r[4], r[5]); w.w = pk_bf16(r[6], r[7]);
                    *(u32x4*)(out + off + bj * HALF) = w;
                }
                asm volatile("" ::: "memory");
            }
    }
};
struct EpiQKV {
    static constexpr bool PERM = true;
    bf16_t* Q; bf16_t* Kn; const float* stats;
    __device__ __forceinline__ void operator()(const f32x4 (&acc)[2][2][4][2], const Unit& u, int wr, int wc, int fr, int fq) const {
        const int row0 = u.pm * BM + wr * 64 + fr;
        const int sel = u.pn < 3 ? 0 : 1;
        bf16_t* dst = Q; int ld = NQ, ctile = u.pn * BM;
        if (u.pn >= 3) { dst = Kn; ld = NKV; ctile = ((u.pn - 3) & 1) * BM; if (u.pn >= 5) dst += (size_t)T * NKV; }
        const int col0 = ctile + wc * 32 + 8 * fq;
#pragma unroll
        for (int ai = 0; ai < 2; ++ai)
#pragma unroll
            for (int m = 0; m < 4; ++m) {
                const int row = row0 + ai * HALF + m * 16;
                const float rs = stats[2 * row + sel];
                bf16_t* rowp = dst + (size_t)row * ld + col0;
#pragma unroll
                for (int bj = 0; bj < 2; ++bj) {
                    const f32x4 v0 = acc[ai][bj][m][0] * rs, v1 = acc[ai][bj][m][1] * rs;
                    u32x4 w; w.x = pk_bf16(v0[0], v0[1]); w.y = pk_bf16(v0[2], v0[3]); w.z = pk_bf16(v1[0], v1[1]); w.w = pk_bf16(v1[2], v1[3]);
                    *(u32x4*)(rowp + bj * HALF) = w;
                }
                asm volatile("" ::: "memory");
            }
    }
};
}

struct TJob { const float* src; const float* scale; bf16_t* dst; int ldsrc, K, lddst, dstk0, nrb, map, nbatch, sbs, dbs; };
__device__ __forceinline__ int srccol(int map, int rb) {
    const int r = rb * 32;
    switch (map) {
        case 1: { const int pn = r >> 8, w = r & 255; return w < 128 ? 128 * pn + w : DFF + 128 * pn + (w - 128); }
        case 2: { if (r < 416) return r; if (r < 512) return -1; return r - 96; }
        case 3: return 2464 + r;
        case 4: { const int v = r >= 512 ? 1 : 0; const int rr = r & 511; return (rr >> 6) * 128 + (rr & 63) + 64 * v; }
        default: return r;
    }
}
constexpr int NJOBS = 15;
__device__ __forceinline__ TJob get_job(const Params& p, int j) {
    TJob t; t.scale = nullptr; t.dstk0 = 0; t.map = 0; t.nbatch = 1; t.sbs = 0; t.dbs = 0;
    unsigned char* ws = p.ws;
    switch (j) {
        case 0:  t.src = p.in[8];  t.dst = (bf16_t*)(ws + WS_WGU1); t.ldsrc = 2 * DFF; t.K = D; t.lddst = D; t.nrb = 176; t.map = 1; break;
        case 1:  t.src = p.in[9];  t.dst = (bf16_t*)(ws + WS_WDN1); t.ldsrc = D; t.K = DFF; t.lddst = DFF; t.nrb = 32; break;
        case 2:  t.src = p.in[10]; t.dst = (bf16_t*)(ws + WS_WINA); t.ldsrc = 4512; t.K = D; t.lddst = D; t.nrb = 80; t.map = 2; break;
        case 3:  t.src = p.in[10]; t.dst = (bf16_t*)(ws + WS_WINB); t.ldsrc = 4512; t.K = D; t.lddst = D; t.nrb = 64; t.map = 3; break;
        case 4:  t.src = p.in[13]; t.scale = p.in[11]; t.dst = (bf16_t*)(ws + WS_WQKV); t.ldsrc = 768; t.K = 256; t.lddst = 384; t.nrb = 24; break;
        case 5:  t.src = nullptr;  t.dst = (bf16_t*)(ws + WS_WQKV); t.ldsrc = 0; t.K = 128; t.lddst = 384; t.dstk0 = 256; t.nrb = 24; break;
        case 6:  t.src = p.in[14]; t.scale = p.in[12]; t.dst = (bf16_t*)(ws + WS_WQKV) + 768 * 384; t.ldsrc = 1024; t.K = 128; t.lddst = 384; t.dstk0 = 256; t.nrb = 32; t.map = 4; break;
        case 7:  t.src = nullptr;  t.dst = (bf16_t*)(ws + WS_WQKV) + 768 * 384; t.ldsrc = 0; t.K = 256; t.lddst = 384; t.nrb = 32; break;
        case 8:  t.src = p.in[15]; t.dst = (bf16_t*)(ws + WS_WAO); t.ldsrc = D; t.K = 512; t.lddst = 512; t.nrb = 32; break;
        case 9:  t.src = p.in[23]; t.dst = (bf16_t*)(ws + WS_WLO); t.ldsrc = D; t.K = D; t.lddst = D; t.nrb = 32; break;
        case 10: t.src = p.in[24]; t.dst = (bf16_t*)(ws + WS_WOUT); t.ldsrc = D; t.K = D; t.lddst = D; t.nrb = 32; break;
        case 11: t.src = p.in[25]; t.dst = (bf16_t*)(ws + WS_WGU2); t.ldsrc = 2 * DFF; t.K = D; t.lddst = D; t.nrb = 176; t.map = 1; break;
        case 12: t.src = p.in[26]; t.dst = (bf16_t*)(ws + WS_WDN2); t.ldsrc = D; t.K = DFF; t.lddst = DFF; t.nrb = 32; break;
        case 13: t.src = p.in[18]; t.dst = (bf16_t*)(ws + WS_WG); t.ldsrc = 128; t.K = 128; t.lddst = 128; t.nrb = 4; t.nbatch = 16; t.sbs = 16384; t.dbs = 32768; break;
        default: t.src = p.in[20]; t.dst = (bf16_t*)(ws + WS_WG) + 16384; t.ldsrc = 128; t.K = 128; t.lddst = 128; t.nrb = 4; t.nbatch = 16; t.sbs = 16384; t.dbs = 32768; break;
    }
    return t;
}
__device__ __forceinline__ int job_items(const TJob& t) { return t.nbatch * t.nrb * (t.K >> 6); }

__device__ __forceinline__ void tr_item(const TJob& jb, int item, LAS float* scr, int lane) {
    const int nkb = jb.K >> 6, per_batch = jb.nrb * nkb;
    const int bt = item / per_batch, r = item - bt * per_batch, rb = r / nkb, kb = r - rb * nkb;
    const int sc = srccol(jb.map, rb), k0 = 64 * kb;
    if (jb.src != nullptr && sc >= 0) {
        const float* src = jb.src + (size_t)bt * jb.sbs;
#pragma unroll 8
        for (int i = 0; i < 32; ++i) { const int kk = 2 * i + (lane >> 5);
            float v = src[(size_t)(k0 + kk) * jb.ldsrc + sc + (lane & 31)];
            if (jb.scale) v *= jb.scale[k0 + kk];
            scr[kk * 33 + (lane & 31)] = v; }
    } else {
#pragma unroll 8
        for (int i = 0; i < 32; ++i) { const int kk = 2 * i + (lane >> 5); scr[kk * 33 + (lane & 31)] = 0.f; }
    }
    asm volatile("s_waitcnt lgkmcnt(0)" ::: "memory");
    bf16_t* dst = jb.dst + (size_t)bt * jb.dbs;
    const int c = lane & 7;
#pragma unroll
    for (int j = 0; j < 4; ++j) { const int n = (lane >> 3) + 8 * j; const LAS float* s = scr + (8 * c) * 33 + n;
        u32x4 o; o.x = pk_bf16(s[0 * 33], s[1 * 33]); o.y = pk_bf16(s[2 * 33], s[3 * 33]); o.z = pk_bf16(s[4 * 33], s[5 * 33]); o.w = pk_bf16(s[6 * 33], s[7 * 33]);
        *(u32x4*)(dst + (size_t)(32 * rb + n) * jb.lddst + jb.dstk0 + k0 + 8 * c) = o; }
    asm volatile("s_waitcnt lgkmcnt(0)" ::: "memory");
}

__device__ __forceinline__ void phase_prep(const Params& p, LAS unsigned char* lds) {
    const int tid = threadIdx.x, lane = tid & 63, wave = tid >> 6;
    const int gw = blockIdx.x * NWAVES + wave, NGW = gridDim.x * NWAVES;
    {
        LAS float* scr = (LAS float*)(lds + wave * 8704);
        int base = 0;
        for (int j = 0; j < NJOBS; ++j) {
            const TJob jb = get_job(p, j); const int n = job_items(jb);
            int first = gw - (base % NGW); if (first < 0) first += NGW;
            for (int i = first; i < n; i += NGW) tr_item(jb, i, scr, lane);
            base += n;
        }
    }
    {
        const int gt = blockIdx.x * NTHREADS + tid;
        if (gt < SS * 16) {
            const int pos = gt >> 4, i = gt & 15;
            double inv = 1.0; for (int q = 0; q < i; ++q) inv *= 0.5623413251903491;
            const float ang = (float)pos * (float)inv;
            const double rev = (double)ang * 0.15915494309189535; const float fr = (float)(rev - rint(rev));
            ((float*)(p.ws + WS_ROPE))[gt] = __builtin_amdgcn_cosf(fr);
            ((float*)(p.ws + WS_ROPE))[SS * 16 + gt] = __builtin_amdgcn_sinf(fr);
        }
    }
    __syncthreads();
    for (int item = blockIdx.x; item < 144; item += gridDim.x) {
        LAS float* sc = (LAS float*)(lds) + wave * (128 * 33);
        for (int i = 0; i < 64; ++i) { const int idx = lane + 64 * i, kl = idx & 127, b = idx >> 7;
            const float cv = (b < 16 ? p.in[2] : p.in[3])[(b & 15) * D + 128 * wave + kl];
            sc[kl * 33 + b] = fsilu(cv); }
        asm volatile("s_waitcnt lgkmcnt(0)" ::: "memory");
        float acc[32];
#pragma unroll
        for (int b = 0; b < 32; ++b) acc[b] = 0.f;
        const float* W = p.in[4] + (size_t)(128 * wave) * 9216 + item * 64 + lane;
        for (int k = 0; k < 128; ++k) { const float wv = W[(size_t)k * 9216];
#pragma unroll
            for (int b = 0; b < 32; ++b) acc[b] += sc[k * 33 + b] * wv; }
        __syncthreads();
        LAS float* red = (LAS float*)(lds);
#pragma unroll
        for (int b = 0; b < 32; ++b) red[(wave * 32 + b) * 64 + lane] = acc[b];
        __syncthreads();
        for (int o = tid; o < 2048; o += NTHREADS) { const int b = o >> 6, col = o & 63; float s = 0.f;
#pragma unroll
            for (int w = 0; w < 8; ++w) s += red[(w * 32 + b) * 64 + col];
            const int j = item * 64 + col;
            ((float*)(p.ws + WS_MOD))[b * 9216 + j] = s + p.in[5][j]; }
        __syncthreads();
    }
}

template <bool HAS_F, bool HAS_H>
__device__ __forceinline__ void phase_rows(const Params& p, int sp, int sn, float resw, bool from_input) {
    const int tid = threadIdx.x, lane = tid & 63, wave = tid >> 6;
    const int gw = blockIdx.x * NWAVES + wave, NGW = gridDim.x * NWAVES;
    const float* mod = (const float*)(p.ws + WS_MOD);
    const bf16_t* F = (const bf16_t*)(p.ws + WS_F);
    bf16_t* H = (bf16_t*)(p.ws + WS_H);
    for (int row = gw; row < T; row += NGW) {
        const int b = row_batch(row);
        const float* xin = !from_input ? p.out + (size_t)row * D : (row < TP ? p.in[0] + (size_t)row * D : p.in[1] + (size_t)(row - TP) * D);
        f32x4 v[4];
#pragma unroll
        for (int j = 0; j < 4; ++j) v[j] = *(const f32x4*)(xin + 4 * lane + 256 * j);
        if (HAS_F) {
            f32x4 f[4]; float ss = 0.f;
#pragma unroll
            for (int j = 0; j < 4; ++j) { const u32x2 w = *(const u32x2*)(F + (size_t)row * D + 4 * lane + 256 * j);
                f[j] = (f32x4){lo_bf(w.x), hi_bf(w.x), lo_bf(w.y), hi_bf(w.y)}; ss += (f[j].x * f[j].x + f[j].y * f[j].y) + (f[j].z * f[j].z + f[j].w * f[j].w); }
            const float rs = 1.0f / sqrtf(wave_sum(ss) * (1.0f / D) + EPS) * resw;
            const float* gate = mod + b * 9216 + sp * 3072 + 2048; const float* gp = p.in[7] + sp * D;
#pragma unroll
            for (int j = 0; j < 4; ++j) { const f32x4 g = *(const f32x4*)(gate + 4 * lane + 256 * j), q = *(const f32x4*)(gp + 4 * lane + 256 * j);
                v[j] = v[j] + g * (f[j] * rs * q);
                *(f32x4*)(p.out + (size_t)row * D + 4 * lane + 256 * j) = v[j]; }
        }
        if (HAS_H) {
            float ss = 0.f;
#pragma unroll
            for (int j = 0; j < 4; ++j) ss += (v[j].x * v[j].x + v[j].y * v[j].y) + (v[j].z * v[j].z + v[j].w * v[j].w);
            const float rs = 1.0f / sqrtf(wave_sum(ss) * (1.0f / D) + EPS);
            const float* sh = mod + b * 9216 + sn * 3072; const float* scl = sh + 1024; const float* gq = p.in[6] + sn * D;
#pragma unroll
            for (int j = 0; j < 4; ++j) { const f32x4 a = *(const f32x4*)(sh + 4 * lane + 256 * j), s = *(const f32x4*)(scl + 4 * lane + 256 * j), q = *(const f32x4*)(gq + 4 * lane + 256 * j);
                const f32x4 h = (v[j] * rs * q) * (s + 1.0f) + a;
                u32x2 w; w.x = pk_bf16(h.x, h.y); w.y = pk_bf16(h.z, h.w);
                *(u32x2*)(H + (size_t)row * D + 4 * lane + 256 * j) = w; }
        }
    }
}

__device__ __forceinline__ void phase_stats(const Params& p) {
    const int tid = threadIdx.x, lane = tid & 63, wave = tid >> 6;
    const int gw = blockIdx.x * NWAVES + wave, NGW = gridDim.x * NWAVES;
    const bf16_t* ZQ = (const bf16_t*)(p.ws + WS_ZQ);
    float* stats = (float*)(p.ws + WS_STATS); bf16_t* KR = (bf16_t*)(p.ws + WS_KR);
    const float* rc = (const float*)(p.ws + WS_ROPE); const float* rsn = rc + SS * 16;
    for (int row = gw; row < T; row += NGW) {
        const u32x4 w = *(const u32x4*)(ZQ + (size_t)row * 512 + 8 * lane);
        float x[8] = {lo_bf(w.x), hi_bf(w.x), lo_bf(w.y), hi_bf(w.y), lo_bf(w.z), hi_bf(w.z), lo_bf(w.w), hi_bf(w.w)};
        float ss = 0.f;
#pragma unroll
        for (int e = 0; e < 8; ++e) ss += x[e] * x[e];
        const float sq = wave_sum(lane < 32 ? ss : 0.f), skv = wave_sum((lane >= 32 && lane < 48) ? ss : 0.f);
        if (lane == 0) { f32x2 st; st.x = 1.0f / sqrtf(sq * (1.0f / 256.0f) + EPS); st.y = 1.0f / sqrtf(skv * (1.0f / 128.0f) + EPS); *(f32x2*)(stats + 2 * row) = st; }
        float y[8];
#pragma unroll
        for (int e = 0; e < 8; ++e) y[e] = __shfl_xor(x[e], 2);
        if (lane >= 48 && lane < 52) {
            const int pos = row_pos(row), i0 = 8 * (lane & 1);
            const f32x4 c0 = *(const f32x4*)(rc + pos * 16 + i0), c1 = *(const f32x4*)(rc + pos * 16 + i0 + 4);
            const f32x4 s0 = *(const f32x4*)(rsn + pos * 16 + i0), s1 = *(const f32x4*)(rsn + pos * 16 + i0 + 4);
            const float c[8] = {c0.x, c0.y, c0.z, c0.w, c1.x, c1.y, c1.z, c1.w}, s[8] = {s0.x, s0.y, s0.z, s0.w, s1.x, s1.y, s1.z, s1.w};
            float o[8];
            const bool first = lane < 50;
#pragma unroll
            for (int e = 0; e < 8; ++e) o[e] = first ? (x[e] * c[e] - y[e] * s[e]) : (x[e] * c[e] + y[e] * s[e]);
            u32x4 ow; ow.x = pk_bf16(o[0], o[1]); ow.y = pk_bf16(o[2], o[3]); ow.z = pk_bf16(o[4], o[5]); ow.w = pk_bf16(o[6], o[7]);
            *(u32x4*)(KR + (size_t)row * 32 + 8 * (lane - 48)) = ow;
        }
    }
}

constexpr int XC_PITCH = 272;
__device__ __forceinline__ void phase_lru(const Params& p, LAS unsigned char* lds) {
    const int tid = threadIdx.x, lane = tid & 63, wave = __builtin_amdgcn_readfirstlane(tid >> 6), g = lane >> 4, lc = lane & 15;
    const bf16_t* XL = (const bf16_t*)(p.ws + WS_XL); bf16_t* GY = (bf16_t*)(p.ws + WS_GY); bf16_t* HF = (bf16_t*)(p.ws + WS_F);
    const bf16_t* WG = (const bf16_t*)(p.ws + WS_WG);
    for (int item = blockIdx.x; item < 256; item += gridDim.x) {
        int gb, n;
        if (item < 128) { gb = 16 + (item >> 3); n = item & 7; } else { gb = (item - 128) >> 3; n = item & 7; }
        const int S = gb < 16 ? SP : SS; const int row0 = gb < 16 ? gb * SP : TP + (gb - 16) * SS;
        const int nch = S >> 6;
        const int tr = tid >> 4, cgp = (tid & 15) * 8, c0 = 128 * n + cgp;
        float cw[4][8], cb[8];
#pragma unroll
        for (int j = 0; j < 4; ++j) { const f32x4 a = *(const f32x4*)(p.in[16] + j * D + c0), b = *(const f32x4*)(p.in[16] + j * D + c0 + 4);
            cw[j][0] = a.x; cw[j][1] = a.y; cw[j][2] = a.z; cw[j][3] = a.w; cw[j][4] = b.x; cw[j][5] = b.y; cw[j][6] = b.z; cw[j][7] = b.w; }
        { const f32x4 a = *(const f32x4*)(p.in[17] + c0), b = *(const f32x4*)(p.in[17] + c0 + 4);
            cb[0] = a.x; cb[1] = a.y; cb[2] = a.z; cb[3] = a.w; cb[4] = b.x; cb[5] = b.y; cb[6] = b.z; cb[7] = b.w; }
        const int ch = 128 * n + 16 * wave + lc;
        for (int d = 0; d < 2; ++d) {
            bf16x8 Ba[4], Bi[4];
            { const bf16_t* wa = WG + (size_t)((d * 8 + n) * 2 + 0) * 16384 + (size_t)(16 * wave + lc) * 128 + 8 * g; const bf16_t* wi = wa + 16384;
#pragma unroll
              for (int ks = 0; ks < 4; ++ks) { Ba[ks] = *(const bf16x8*)(wa + 32 * ks); Bi[ks] = *(const bf16x8*)(wi + 32 * ks); } }
            const float ba = p.in[19][d * D + ch], bi = p.in[21][d * D + ch];
            const float lam = p.in[22][d * D + ch];
            const float c8 = -8.0f * log1pf(expf(-lam));
            float carry = 0.f;
            for (int ci = 0; ci < nch; ++ci) {
                const int cc = d ? (nch - 1 - ci) : ci, t0 = cc * 64;
                __syncthreads();
#pragma unroll
                for (int hf = 0; hf < 2; ++hf) {
                    const int tl = tr + 32 * hf, t = t0 + tl;
                    float a[8];
#pragma unroll
                    for (int e = 0; e < 8; ++e) a[e] = cb[e];
#pragma unroll
                    for (int j = 0; j < 4; ++j) { const int tt = t + j - 1;
                        if (tt >= 0 && tt < S) { const u32x4 w = *(const u32x4*)(XL + (size_t)(row0 + tt) * D + c0);
                            a[0] += cw[j][0] * lo_bf(w.x); a[1] += cw[j][1] * hi_bf(w.x); a[2] += cw[j][2] * lo_bf(w.y); a[3] += cw[j][3] * hi_bf(w.y);
                            a[4] += cw[j][4] * lo_bf(w.z); a[5] += cw[j][5] * hi_bf(w.z); a[6] += cw[j][6] * lo_bf(w.w); a[7] += cw[j][7] * hi_bf(w.w); } }
                    u32x4 o; o.x = pk_bf16(a[0], a[1]); o.y = pk_bf16(a[2], a[3]); o.z = pk_bf16(a[4], a[5]); o.w = pk_bf16(a[6], a[7]);
                    *(LAS u32x4*)(lds + tl * XC_PITCH + cgp * 2) = o;
                }
                __syncthreads();
                f32x4 aa[4], ai[4];
#pragma unroll
                for (int mt = 0; mt < 4; ++mt) { aa[mt] = (f32x4){0.f, 0.f, 0.f, 0.f}; ai[mt] = (f32x4){0.f, 0.f, 0.f, 0.f}; }
#pragma unroll
                for (int ks = 0; ks < 4; ++ks)
#pragma unroll
                    for (int mt = 0; mt < 4; ++mt) { const bf16x8 A = *(const LAS bf16x8*)(lds + (16 * mt + lc) * XC_PITCH + (32 * ks + 8 * g) * 2);
                        aa[mt] = __builtin_amdgcn_mfma_f32_16x16x32_bf16(A, Ba[ks], aa[mt], 0, 0, 0);
                        ai[mt] = __builtin_amdgcn_mfma_f32_16x16x32_bf16(A, Bi[ks], ai[mt], 0, 0, 0); }
#pragma unroll
                for (int mt = 0; mt < 4; ++mt)
#pragma unroll
                    for (int j = 0; j < 4; ++j) {
                        const float xcv = bf2f(*(const LAS bf16_t*)(lds + (16 * mt + 4 * g + j) * XC_PITCH + (16 * wave + lc) * 2));
                        const float r = fsigmoid(aa[mt][j] + ba), ig = fsigmoid(ai[mt][j] + bi);
                        const float la = c8 * r;
                        const float av = fexp(la), om = -expm1f(2.0f * la);
                        aa[mt][j] = av; ai[mt][j] = sqrtf(om) * (ig * xcv);
                    }
                if (d == 0) {
#pragma unroll
                    for (int mt = 0; mt < 4; ++mt) {
                        float P = 1.f, Hh = 0.f, pl[4], hl[4];
#pragma unroll
                        for (int j = 0; j < 4; ++j) { Hh = aa[mt][j] * Hh + ai[mt][j]; P *= aa[mt][j]; hl[j] = Hh; pl[j] = P; }
                        float A = P, Hs = Hh;
                        { const float A1 = __shfl_up(A, 16), H1 = __shfl_up(Hs, 16); if (g >= 1) { Hs = A * H1 + Hs; A = A * A1; } }
                        { const float A2 = __shfl_up(A, 32), H2 = __shfl_up(Hs, 32); if (g >= 2) { Hs = A * H2 + Hs; A = A * A2; } }
                        float Aex = __shfl_up(A, 16), Hex = __shfl_up(Hs, 16); if (g == 0) { Aex = 1.f; Hex = 0.f; }
                        const float cin = Aex * carry + Hex;
                        const float At = __shfl(A, 48 + lc), Ht = __shfl(Hs, 48 + lc);
                        carry = At * carry + Ht;
#pragma unroll
                        for (int j = 0; j < 4; ++j) { const float h = hl[j] + pl[j] * cin;
                            HF[(size_t)(row0 + t0 + 16 * mt + 4 * g + j) * D + ch] = (bf16_t)(pk_bf16(h, 0.f) & 0xffffu); }
                    }
                } else {
#pragma unroll
                    for (int mt = 3; mt >= 0; --mt) {
                        float P = 1.f, Hh = 0.f, pl[4], hl[4];
#pragma unroll
                        for (int j = 3; j >= 0; --j) { Hh = aa[mt][j] * Hh + ai[mt][j]; P *= aa[mt][j]; hl[j] = Hh; pl[j] = P; }
                        float A = P, Hs = Hh;
                        { const float A1 = __shfl_down(A, 16), H1 = __shfl_down(Hs, 16); if (g <= 2) { Hs = A * H1 + Hs; A = A * A1; } }
                        { const float A2 = __shfl_down(A, 32), H2 = __shfl_down(Hs, 32); if (g <= 1) { Hs = A * H2 + Hs; A = A * A2; } }
                        float Aex = __shfl_down(A, 16), Hex = __shfl_down(Hs, 16); if (g == 3) { Aex = 1.f; Hex = 0.f; }
                        const float cin = Aex * carry + Hex;
                        const float At = __shfl(A, lc), Ht = __shfl(Hs, lc);
                        carry = At * carry + Ht;
#pragma unroll
                        for (int j = 0; j < 4; ++j) { const float h = hl[j] + pl[j] * cin;
                            const size_t off = (size_t)(row0 + t0 + 16 * mt + 4 * g + j) * D + ch;
                            const float o = (bf2f(HF[off]) + h) * bf2f(GY[off]);
                            GY[off] = (bf16_t)(pk_bf16(o, 0.f) & 0xffffu); }
                    }
                }
            }
        }
        __syncthreads();
    }
}

constexpr int AK_PITCH = 208, AV_PITCH = 160, AK_BYTES = 64 * AK_PITCH, AV_BYTES = 64 * AV_PITCH, ABUF = AK_BYTES + AV_BYTES;
__device__ __forceinline__ void phase_attn(const Params& p, LAS unsigned char* lds) {
    const int tid = threadIdx.x, lane = tid & 63, wave = __builtin_amdgcn_readfirstlane(tid >> 6), g = lane >> 4, lc = lane & 15;
    const bf16_t* Q = (const bf16_t*)(p.ws + WS_F); const bf16_t* KN = (const bf16_t*)(p.ws + WS_XL); const bf16_t* V = KN + (size_t)T * NKV;
    const bf16_t* KR = (const bf16_t*)(p.ws + WS_KR); bf16_t* O = (bf16_t*)(p.ws + WS_ZQ);
    const float csc = 0.10206207261596577f * 1.4426950408889634f;
    const int srow = tid >> 3, sch = tid & 7;
    const int rrow = (tid & 255) >> 2, rch = tid & 3;
    const int vtr = (4 * g + (lc >> 2)) * AV_PITCH + (4 * (lc & 3)) * 2;
    for (int unit = blockIdx.x; unit < 3072; unit += gridDim.x) {
        int gb, h, qt, S, row0;
        if (unit < 2048) { gb = 16 + (unit >> 7); h = (unit & 127) >> 4; qt = unit & 15; S = SS; row0 = TP + (gb - 16) * SS; }
        else { const int u2 = unit - 2048; gb = u2 >> 6; h = (u2 & 63) >> 3; qt = u2 & 7; S = SP; row0 = gb * SP; }
        const int nkt = S >> 6;
        const int qrow = row0 + 256 * qt + 32 * wave;
        bf16x8 qf[2][3];
#pragma unroll
        for (int q2 = 0; q2 < 2; ++q2)
#pragma unroll
            for (int ks = 0; ks < 3; ++ks) qf[q2][ks] = *(const bf16x8*)(Q + (size_t)(qrow + 16 * q2 + lc) * NQ + 96 * h + 32 * ks + 8 * g);
#pragma unroll
        for (int q2 = 0; q2 < 2; ++q2) {
            const int pos = row_pos(qrow + 16 * q2 + lc), i0 = 8 * (g & 1);
            const float* rc = (const float*)(p.ws + WS_ROPE) + pos * 16 + i0; const float* rsn = rc + SS * 16;
            const f32x4 c0 = *(const f32x4*)rc, c1 = *(const f32x4*)(rc + 4), s0 = *(const f32x4*)rsn, s1 = *(const f32x4*)(rsn + 4);
            const float cc[8] = {c0.x, c0.y, c0.z, c0.w, c1.x, c1.y, c1.z, c1.w}, sn[8] = {s0.x, s0.y, s0.z, s0.w, s1.x, s1.y, s1.z, s1.w};
            const u32x4 mine = __builtin_bit_cast(u32x4, qf[q2][2]);
            u32x4 oth; oth.x = __shfl_xor(mine.x, 32); oth.y = __shfl_xor(mine.y, 32); oth.z = __shfl_xor(mine.z, 32); oth.w = __shfl_xor(mine.w, 32);
            const float xm[8] = {lo_bf(mine.x), hi_bf(mine.x), lo_bf(mine.y), hi_bf(mine.y), lo_bf(mine.z), hi_bf(mine.z), lo_bf(mine.w), hi_bf(mine.w)};
            const float xo[8] = {lo_bf(oth.x), hi_bf(oth.x), lo_bf(oth.y), hi_bf(oth.y), lo_bf(oth.z), hi_bf(oth.z), lo_bf(oth.w), hi_bf(oth.w)};
            float o[8];
#pragma unroll
            for (int e = 0; e < 8; ++e) o[e] = g < 2 ? (xm[e] * cc[e] - xo[e] * sn[e]) : (xm[e] * cc[e] + xo[e] * sn[e]);
            u32x4 w; w.x = pk_bf16(o[0], o[1]); w.y = pk_bf16(o[2], o[3]); w.z = pk_bf16(o[4], o[5]); w.w = pk_bf16(o[6], o[7]);
            qf[q2][2] = __builtin_bit_cast(bf16x8, w);
        }
        f32x4 oacc[4][2];
#pragma unroll
        for (int dt = 0; dt < 4; ++dt) { oacc[dt][0] = (f32x4){0.f, 0.f, 0.f, 0.f}; oacc[dt][1] = (f32x4){0.f, 0.f, 0.f, 0.f}; }
        float mrun[2] = {-1e30f, -1e30f}, lrun[2] = {0.f, 0.f};
        u32x4 gk, gr, gv;
        gk = *(const u32x4*)(KN + (size_t)(row0 + srow) * NKV + 64 * h + 8 * sch);
        gv = *(const u32x4*)(V + (size_t)(row0 + srow) * NKV + 64 * h + 8 * sch);
        gr = *(const u32x4*)(KR + (size_t)(row0 + rrow) * 32 + 8 * rch);
        __syncthreads();
        *(LAS u32x4*)(lds + srow * AK_PITCH + sch * 16) = gk;
        *(LAS u32x4*)(lds + AK_BYTES + srow * AV_PITCH + sch * 16) = gv;
        if (tid < 256) *(LAS u32x4*)(lds + rrow * AK_PITCH + 128 + rch * 16) = gr;
        __syncthreads();
        for (int kt = 0; kt < nkt; ++kt) {
            LAS unsigned char* kb = lds + (kt & 1) * ABUF; LAS unsigned char* vb = kb + AK_BYTES;
            LAS unsigned char* nb = lds + ((kt + 1) & 1) * ABUF;
            const bool more = kt + 1 < nkt;
            if (more) { const int kr0 = row0 + 64 * (kt + 1);
                gk = *(const u32x4*)(KN + (size_t)(kr0 + srow) * NKV + 64 * h + 8 * sch);
                gv = *(const u32x4*)(V + (size_t)(kr0 + srow) * NKV + 64 * h + 8 * sch);
                gr = *(const u32x4*)(KR + (size_t)(kr0 + rrow) * 32 + 8 * rch); }
            f32x4 sacc[4][2];
#pragma unroll
            for (int k4 = 0; k4 < 4; ++k4) { sacc[k4][0] = (f32x4){0.f, 0.f, 0.f, 0.f}; sacc[k4][1] = (f32x4){0.f, 0.f, 0.f, 0.f}; }
#pragma unroll
            for (int ks = 0; ks < 3; ++ks)
#pragma unroll
                for (int k4 = 0; k4 < 4; ++k4) { const bf16x8 kf = *(const LAS bf16x8*)(kb + (16 * k4 + lc) * AK_PITCH + (32 * ks + 8 * g) * 2);
                    sacc[k4][0] = __builtin_amdgcn_mfma_f32_16x16x32_bf16(kf, qf[0][ks], sacc[k4][0], 0, 0, 0);
                    sacc[k4][1] = __builtin_amdgcn_mfma_f32_16x16x32_bf16(kf, qf[1][ks], sacc[k4][1], 0, 0, 0); }
            bf16x8 pf[2][2];
#pragma unroll
            for (int q2 = 0; q2 < 2; ++q2) {
                float mx = sacc[0][q2][0];
#pragma unroll
                for (int k4 = 0; k4 < 4; ++k4)
#pragma unroll
                    for (int j = 0; j < 4; ++j) mx = fmaxf(mx, sacc[k4][q2][j]);
                mx = fmaxf(mx, __shfl_xor(mx, 16)); mx = fmaxf(mx, __shfl_xor(mx, 32));
                const float mnew = fmaxf(mrun[q2], mx * csc);
                const float alpha = __builtin_amdgcn_exp2f(mrun[q2] - mnew);
                mrun[q2] = mnew;
                float ps = 0.f; float pv[4][4];
#pragma unroll
                for (int k4 = 0; k4 < 4; ++k4)
#pragma unroll
                    for (int j = 0; j < 4; ++j) { const float e = __builtin_amdgcn_exp2f(sacc[k4][q2][j] * csc - mnew); pv[k4][j] = e; ps += e; }
                lrun[q2] = lrun[q2] * alpha + ps;
#pragma unroll
                for (int dt = 0; dt < 4; ++dt) oacc[dt][q2] *= alpha;
#pragma unroll
                for (int kk = 0; kk < 2; ++kk) {
                    u32x4 w; w.x = pk_bf16(pv[2 * kk][0], pv[2 * kk][1]); w.y = pk_bf16(pv[2 * kk][2], pv[2 * kk][3]);
                    w.z = pk_bf16(pv[2 * kk + 1][0], pv[2 * kk + 1][1]); w.w = pk_bf16(pv[2 * kk + 1][2], pv[2 * kk + 1][3]);
                    pf[q2][kk] = __builtin_bit_cast(bf16x8, w);
                }
            }
#pragma unroll
            for (int kk = 0; kk < 2; ++kk)
#pragma unroll
                for (int dt = 0; dt < 4; ++dt) {
                    const v4i16_t lo = __builtin_amdgcn_ds_read_tr16_b64_v4i16((LAS v4i16_t*)(vb + vtr + (32 * kk) * AV_PITCH + 32 * dt));
                    const v4i16_t hi = __builtin_amdgcn_ds_read_tr16_b64_v4i16((LAS v4i16_t*)(vb + vtr + (32 * kk + 16) * AV_PITCH + 32 * dt));
                    const bf16x8 vf = {lo[0], lo[1], lo[2], lo[3], hi[0], hi[1], hi[2], hi[3]};
                    oacc[dt][0] = __builtin_amdgcn_mfma_f32_16x16x32_bf16(vf, pf[0][kk], oacc[dt][0], 0, 0, 0);
                    oacc[dt][1] = __builtin_amdgcn_mfma_f32_16x16x32_bf16(vf, pf[1][kk], oacc[dt][1], 0, 0, 0);
                }
            if (more) {
                *(LAS u32x4*)(nb + srow * AK_PITCH + sch * 16) = gk;
                *(LAS u32x4*)(nb + AK_BYTES + srow * AV_PITCH + sch * 16) = gv;
                if (tid < 256) *(LAS u32x4*)(nb + rrow * AK_PITCH + 128 + rch * 16) = gr;
            }
            __syncthreads();
        }
#pragma unroll
        for (int q2 = 0; q2 < 2; ++q2) {
            float l = lrun[q2]; l += __shfl_xor(l, 16); l += __shfl_xor(l, 32);
            const float inv = 1.0f / l;
#pragma unroll
            for (int dt = 0; dt < 4; ++dt) { const f32x4 o = oacc[dt][q2] * inv;
                u32x2 w; w.x = pk_bf16(o[0], o[1]); w.y = pk_bf16(o[2], o[3]);
                *(u32x2*)(O + (size_t)(qrow + 16 * q2 + lc) * 512 + 64 * h + 16 * dt + 4 * g) = w; }
        }
    }
    __syncthreads();
}

constexpr int NPHASES = 16;
__global__ void __launch_bounds__(NTHREADS, 2) mega_fwd(Params p) {
    extern __shared__ __attribute__((aligned(16))) unsigned char lds_raw[];
    LAS unsigned char* lds = (LAS unsigned char*)lds_raw;
    cg::grid_group grid = cg::this_grid();
    unsigned char* ws = p.ws;
    const int G = gridDim.x, bid = blockIdx.x;
    bf16_t* Hb = (bf16_t*)(ws + WS_H); bf16_t* Fb = (bf16_t*)(ws + WS_F); bf16_t* ACT = (bf16_t*)(ws + WS_ACT);
    bf16_t* ZQ = (bf16_t*)(ws + WS_ZQ); bf16_t* XL = (bf16_t*)(ws + WS_XL); bf16_t* GY = (bf16_t*)(ws + WS_GY);
#ifndef TESTPH
#define TESTPH -1
#endif
#define IN(k) ((TESTPH < 0 || (k) == TESTPH) && p.ph_lo <= (k) && (k) < p.ph_hi)
#define SEAM(k) do { if (IN(k) && IN((k) + 1)) { __builtin_amdgcn_fence(__ATOMIC_RELEASE, "agent"); asm volatile("s_waitcnt vmcnt(0) lgkmcnt(0)" ::: "memory"); \
        grid.sync(); __builtin_amdgcn_fence(__ATOMIC_ACQUIRE, "agent"); asm volatile("s_waitcnt vmcnt(0) lgkmcnt(0)" ::: "memory"); } } while (0)
    if (IN(0)) phase_prep(p, lds);
    SEAM(0);
    if (IN(1)) phase_rows<false, true>(p, 0, 0, 0.f, true);
    SEAM(1);
#define FFN_PHASES(ffn, pb) do { \
        if (IN(pb)) { \
            pg8::Gemm g{Hb, (const bf16_t*)(ws + ((ffn) ? WS_WGU2 : WS_WGU1)), D, D}; pg8::StaticOrder S; S.init(T, 2 * DFF, G, bid); \
            pg8::EpiSwiglu E{ACT, DFF}; \
            GEMM_PHASE(pg8::EpiSwiglu, lds, g, S, E); \
        } \
        SEAM(pb); \
        if (IN((pb) + 1)) { \
            pg8::Gemm g{ACT, (const bf16_t*)(ws + ((ffn) ? WS_WDN2 : WS_WDN1)), DFF, DFF}; pg8::StaticOrder S; S.init(T, D, G, bid); \
            pg8::EpiAct<0> E{Fb, D, 0}; \
            GEMM_PHASE(pg8::EpiAct<0>, lds, g, S, E); \
        } \
        SEAM((pb) + 1); } while (0)
    FFN_PHASES(0, 2);
        if (IN(4)) phase_rows<true, true>(p, 0, 1, 0.5f, true);
        SEAM(4);
        if (IN(5)) {
            pg8::Gemm g{Hb, (const bf16_t*)(ws + WS_WINA), D, D}; pg8::StaticOrder S; S.init(T, 2560, G, bid);
            pg8::EpiWinA E{ZQ, XL, GY};
            GEMM_PHASE(pg8::EpiWinA, lds, g, S, E);
        }
        SEAM(5);
        if (IN(6)) { phase_stats(p); phase_lru(p, lds); }
        SEAM(6);
        if (IN(7)) {
            pg8::Gemm g{ZQ, (const bf16_t*)(ws + WS_WQKV), 512, 384}; pg8::StaticOrder S; S.init(T, 1792, G, bid);
            pg8::EpiQKV E{Fb, XL, (const float*)(ws + WS_STATS)};
            GEMM_PHASE(pg8::EpiQKV, lds, g, S, E);
        }
        SEAM(7);
        if (IN(8)) phase_attn(p, lds);
        SEAM(8);
        if (IN(9)) {
            pg8::Gemm g{Hb, (const bf16_t*)(ws + WS_WINB), D, D}; pg8::StaticOrder S; S.init(T, 2048, G, bid);
            pg8::EpiWinB E{Fb, XL};
            GEMM_PHASE(pg8::EpiWinB, lds, g, S, E);
        }
        SEAM(9);
        if (IN(10)) {
            { pg8::Gemm g{ZQ, (const bf16_t*)(ws + WS_WAO), 512, 512}; pg8::StaticOrder S; S.init(T, D, G, bid);
              pg8::EpiGate<false> E{Fb, nullptr, Fb};
              GEMM_PHASE(pg8::EpiGate<false>, lds, g, S, E); }
            { pg8::Gemm g{GY, (const bf16_t*)(ws + WS_WLO), D, D}; pg8::StaticOrder S; S.init(T, D, G, bid);
              pg8::EpiGate<true> E{XL, Fb, XL};
              GEMM_PHASE(pg8::EpiGate<true>, lds, g, S, E); }
        }
        SEAM(10);
        if (IN(11)) {
            pg8::Gemm g{XL, (const bf16_t*)(ws + WS_WOUT), D, D}; pg8::StaticOrder S; S.init(T, D, G, bid);
            pg8::EpiAct<0> E{Fb, D, 0};
            GEMM_PHASE(pg8::EpiAct<0>, lds, g, S, E);
        }
        SEAM(11);
        if (IN(12)) phase_rows<true, true>(p, 1, 2, 1.0f, false);
        SEAM(12);
    FFN_PHASES(1, 13);
    if (IN(15)) phase_rows<true, false>(p, 2, 0, 0.5f, false);
#undef IN
#undef SEAM
}

extern "C" void kernel_launch(void* const* d_in, const int* in_sizes, int n_in, void* d_out, int out_size, void* d_ws, size_t ws_size, hipStream_t stream) {
    static int grid = 0;
    if (grid == 0) {
        if (n_in != 27 || out_size != T * D || ws_size < WS_END) { fprintf(stderr, "kernel_launch: unexpected shapes: n_in %d out %d ws %zu (need >= %zu)\n", n_in, out_size, ws_size, (size_t)WS_END); grid = -1; return; }
        int dev = 0, cus = 0, per_cu = 0;
        (void)hipGetDevice(&dev);
        (void)hipDeviceGetAttribute(&cus, hipDeviceAttributeMultiprocessorCount, dev);
        if (hipFuncSetAttribute((const void*)mega_fwd, hipFuncAttributeMaxDynamicSharedMemorySize, LDS_BYTES) != hipSuccess) { fprintf(stderr, "kernel_launch: hipFuncSetAttribute failed\n"); grid = -1; return; }
        if (hipOccupancyMaxActiveBlocksPerMultiprocessor(&per_cu, (const void*)mega_fwd, NTHREADS, LDS_BYTES) != hipSuccess || per_cu < 1) { fprintf(stderr, "kernel_launch: occupancy query failed (%d)\n", per_cu); per_cu = 1; }
        (void)hipGetLastError();
        grid = cus;
        fprintf(stderr, "kernel_launch: grid %d (per_cu %d)\n", grid, per_cu);
    }
    if (grid < 0) return;
    Params p{};
    for (int i = 0; i < 27; ++i) p.in[i] = (const float*)d_in[i];
    p.out = (float*)d_out; p.ws = (unsigned char*)d_ws;
#if defined(MK_SPLIT)
    for (int ph = 0; ph < NPHASES; ++ph) { p.ph_lo = ph; p.ph_hi = ph + 1;
        hipLaunchKernelGGL(mega_fwd, dim3(grid), dim3(NTHREADS), LDS_BYTES, stream, p); }
#else
    p.ph_lo = 0; p.ph_hi = NPHASES;
    void* args[] = {&p};
    hipError_t e = hipLaunchCooperativeKernel((const void*)mega_fwd, dim3(grid), dim3(NTHREADS), args, LDS_BYTES, stream);
    if (e != hipSuccess) fprintf(stderr, "kernel_launch: cooperative launch failed: %s (grid %d)\n", hipGetErrorString(e), grid);
#endif
}
```

```cpp
#include <hip/hip_runtime.h>
#include <hip/hip_cooperative_groups.h>
#include <cstdio>
#include <cstdint>
namespace cg = cooperative_groups;
#ifndef MK_SP2_ALL
#define MK_SP2_ALL false
#endif

#define LAS __attribute__((address_space(3)))
typedef unsigned short bf16_t;
typedef short bf16x8 __attribute__((ext_vector_type(8)));
typedef short v4i16_t __attribute__((ext_vector_type(4)));
typedef float f32x4 __attribute__((ext_vector_type(4)));
typedef float f32x2 __attribute__((ext_vector_type(2)));
typedef unsigned u32x4 __attribute__((ext_vector_type(4)));
typedef unsigned u32x2 __attribute__((ext_vector_type(2)));

constexpr int D = 1024, DFF = 2816, TP = 32768, TS = 65536, T = TP + TS, SP = 2048, SS = 4096;
constexpr int NQ = 768, NKV = 512;
constexpr float EPS = 1e-6f;
constexpr int NTHREADS = 512, NWAVES = 8;

constexpr size_t KiB = 1024, MiB = 1024 * 1024;
constexpr size_t WS_WGU1 = 0, WS_WDN1 = 11 * MiB, WS_WINA = 16 * MiB + 512 * KiB, WS_WINB = 21 * MiB + 512 * KiB, WS_WQKV = 25 * MiB + 512 * KiB,
                 WS_WAO = 27 * MiB, WS_WLO = 28 * MiB, WS_WOUT = 30 * MiB, WS_WGU2 = 32 * MiB, WS_WDN2 = 43 * MiB, WS_WG = 48 * MiB + 512 * KiB,
                 WS_MOD = 49 * MiB + 512 * KiB, WS_ROPE = 50 * MiB + 768 * KiB, WS_STATS = 51 * MiB + 256 * KiB, WS_KR = 52 * MiB;
constexpr size_t WS_H = 64 * MiB, WS_F = 256 * MiB, WS_BIG = 448 * MiB;
constexpr size_t WS_ZQ = WS_BIG, WS_XL = WS_BIG + 96 * MiB, WS_GY = WS_BIG + 288 * MiB, WS_ACT = WS_BIG, WS_END = 976 * MiB;
constexpr int LDS_BYTES = 139264;

struct Params { const float* in[27]; float* out; unsigned char* ws; int ph_lo, ph_hi; };

typedef __bf16 bf16x2_t __attribute__((ext_vector_type(2)));
__device__ __forceinline__ unsigned pk_bf16(float lo, float hi) { const f32x2 v = {lo, hi}; const bf16x2_t b = __builtin_convertvector(v, bf16x2_t); return __builtin_bit_cast(unsigned, b); }
__device__ __forceinline__ float lo_bf(unsigned w) { return __uint_as_float(w << 16); }
__device__ __forceinline__ float hi_bf(unsigned w) { return __uint_as_float(w & 0xffff0000u); }
__device__ __forceinline__ float bf2f(bf16_t h) { return __uint_as_float((unsigned)h << 16); }
__device__ __forceinline__ float fexp(float x) { return __builtin_amdgcn_exp2f(x * 1.4426950408889634f); }
__device__ __forceinline__ float fsigmoid(float x) { return __builtin_amdgcn_rcpf(1.0f + fexp(-x)); }
__device__ __forceinline__ float fsilu(float x) { return x * fsigmoid(x); }
__device__ __forceinline__ float fgelu(float x) { return x * fsigmoid(1.5957691216057308f * (x + 0.044715f * x * x * x)); }
__device__ __forceinline__ float wave_sum(float v) {
#pragma unroll
    for (int o = 1; o < 64; o <<= 1) v += __shfl_xor(v, o);
    return v;
}
__device__ __forceinline__ int row_batch(int row) { return row < TP ? (row >> 11) : 16 + ((row - TP) >> 12); }
__device__ __forceinline__ int row_pos(int row) { return row < TP ? (row & (SP - 1)) : ((row - TP) & (SS - 1)); }

namespace pg8 {
constexpr int BM = 256, BK = 64, HALF = 128, HTB = HALF * BK * 2, STAGE_BYTES = 8 * HTB, NXCD = 8, WGM = 8;
__host__ __device__ __forceinline__ int lds_byte(int r, int c) { const int st = (r >> 4) * 2 + (c >> 5), rr = r & 15, cc = c & 31, ob = rr * 64 + cc * 2; return st * 1024 + (ob ^ (((ob >> 9) & 1) << 5)); }
__host__ __device__ __forceinline__ void stage_rc(int b, int& R, int& C) { const int st = b / 1024, sb = b % 1024, swz = sb ^ (((sb >> 9) & 1) << 5); R = (st >> 1) * 16 + swz / 64; C = (st & 1) * 32 + (swz % 64) / 2; }
__host__ __device__ __forceinline__ int perm32(int rho) { const int n = rho >> 4, i = rho & 15; return 8 * (i >> 2) + 4 * n + (i & 3); }

struct Unit { int pm, pn; };
struct Gemm { const bf16_t* A; const bf16_t* Bt; int lda, K; };

struct StaticOrder {
    int nM, nN, nwg, G, c;
    __device__ void init(int M, int N, int G_, int c_) { nM = M / BM; nN = N / BM; nwg = nM * nN; G = G_; c = c_; }
    __device__ bool next(int i, Unit& u) const {
        const long L = (long)i * G + c; if (L >= nwg) return false;
        int wgid = (int)L; { const int q = nwg / NXCD, r = nwg % NXCD, xcd = wgid % NXCD, off = wgid / NXCD; wgid = (xcd < r ? xcd * (q + 1) : r * (q + 1) + (xcd - r) * q) + off; }
        const int nig = WGM * nN, gid = wgid / nig, fm = gid * WGM, gsz = (nM - fm) < WGM ? (nM - fm) : WGM;
        u.pm = fm + ((wgid % nig) % gsz); u.pn = (wgid % nig) / gsz; return true;
    }
};

template <class Epi, bool SP2 = false>
__device__ __forceinline__ void gemm_phase(LAS unsigned char* lds, const Gemm g, const StaticOrder& S, const Epi& E) {
    const int tid = threadIdx.x, wid = __builtin_amdgcn_readfirstlane(tid >> 6), lane = tid & 63, wr = wid >> 2, wc = wid & 3, fr = lane & 15, fq = lane >> 4;
    const int K = g.K, nt = K / BK, lda = g.lda;
    unsigned voffA[2], voffB[2];
#pragma unroll
    for (int i = 0; i < 2; ++i) { int R, C; stage_rc(tid * 16 + i * 8192, R, C); const int Rb = Epi::PERM ? ((R & ~31) + perm32(R & 31)) : R;
        voffA[i] = (unsigned)(R * lda + C) * 2u; voffB[i] = (unsigned)(Rb * K + C) * 2u; }
    const size_t kstep = (size_t)(BK * 2);
    const size_t hstepA = (size_t)HALF * lda * 2, hstepB = (size_t)HALF * K * 2;
    const size_t tstepA = 2 * hstepA, tstepB = 2 * hstepB;
    const unsigned ldsw = (unsigned)wid * 1024u;
    const int aoff = lds_byte(wr * 64 + fr, fq * 8), boff = lds_byte(wc * 32 + fr, fq * 8);
#define PG8_SA(b, h) (((b) * 2 + (h)) * HTB)
#define PG8_SB(b, h) ((4 + (b) * 2 + (h)) * HTB)
#define PG8_STAGE(bufoff, gbase, voff) do { _Pragma("unroll") for (int _i = 0; _i < 2; ++_i) \
        __builtin_amdgcn_global_load_lds((const unsigned*)((const char*)(gbase) + (voff)[_i]), (LAS unsigned*)(lds + (bufoff) + ldsw + _i * 8192), 16, 0, 0); } while (0)
#define PG8_LDA(dst, b, h) do { _Pragma("unroll") for (int m = 0; m < 4; ++m) _Pragma("unroll") for (int k = 0; k < 2; ++k) dst[m][k] = *(const LAS bf16x8*)(lds + PG8_SA(b, h) + aoff + m * 2048 + k * 1024); } while (0)
#define PG8_LDB(dst, b, h) do { _Pragma("unroll") for (int n = 0; n < 2; ++n) _Pragma("unroll") for (int k = 0; k < 2; ++k) dst[n][k] = *(const LAS bf16x8*)(lds + PG8_SB(b, h) + boff + n * 2048 + k * 1024); } while (0)
#define PG8_MMA(ai, bj, At, Bt) do { __builtin_amdgcn_s_setprio(1); _Pragma("unroll") for (int m = 0; m < 4; ++m) _Pragma("unroll") for (int n = 0; n < 2; ++n) _Pragma("unroll") for (int k = 0; k < 2; ++k) \
        acc[ai][bj][m][n] = __builtin_amdgcn_mfma_f32_16x16x32_bf16(Bt[n][k], At[m][k], acc[ai][bj][m][n], 0, 0, 0); __builtin_amdgcn_s_setprio(0); } while (0)
#define PG8_WAIT_V(n) asm volatile("s_waitcnt vmcnt(" #n ")" ::: "memory")
#define PG8_WAIT_L(n) asm volatile("s_waitcnt lgkmcnt(" #n ")" ::: "memory")
#define PG8_BAR __builtin_amdgcn_s_barrier()
#define PG8_SCHED __builtin_amdgcn_sched_barrier(0)
    Unit cur, nxt; int ui = 0;
    if (!S.next(0, cur)) return;
    f32x4 acc[2][2][4][2];
#pragma unroll
    for (int a = 0; a < 2; ++a)
#pragma unroll
        for (int b = 0; b < 2; ++b)
#pragma unroll
            for (int m = 0; m < 4; ++m)
#pragma unroll
                for (int n = 0; n < 2; ++n) acc[a][b][m][n] = (f32x4){0.f, 0.f, 0.f, 0.f};
    bf16x8 At[4][2], B0[2][2], B1[2][2];
    const char* cA = (const char*)g.A + (size_t)cur.pm * tstepA; const char* cB = (const char*)g.Bt + (size_t)cur.pn * tstepB;
    if constexpr (SP2) {
        PG8_STAGE(PG8_SB(0, 0), cB, voffB); PG8_STAGE(PG8_SB(0, 1), cB + hstepB, voffB); PG8_STAGE(PG8_SA(0, 0), cA, voffA); PG8_STAGE(PG8_SA(0, 1), cA + hstepA, voffA);
        if (wr == 1) PG8_BAR;
        PG8_WAIT_V(2); PG8_BAR;
        PG8_STAGE(PG8_SB(1, 0), cB + kstep, voffB); PG8_STAGE(PG8_SA(1, 0), cA + kstep, voffA); PG8_STAGE(PG8_SB(1, 1), cB + hstepB + kstep, voffB);
        PG8_WAIT_V(6); PG8_BAR;
    } else {
    PG8_STAGE(PG8_SB(0, 0), cB, voffB); PG8_STAGE(PG8_SA(0, 0), cA, voffA); PG8_STAGE(PG8_SB(0, 1), cB + hstepB, voffB); PG8_STAGE(PG8_SA(0, 1), cA + hstepA, voffA);
    if (wr == 1) PG8_BAR;
    PG8_WAIT_V(4); PG8_BAR;
    PG8_STAGE(PG8_SB(1, 0), cB + kstep, voffB); PG8_STAGE(PG8_SA(1, 0), cA + kstep, voffA); PG8_STAGE(PG8_SB(1, 1), cB + hstepB + kstep, voffB);
    PG8_WAIT_V(6); PG8_BAR;
    }
    for (;;) {
        const bool has_next = S.next(ui + 1, nxt);
        const char* nA = has_next ? (const char*)g.A + (size_t)nxt.pm * tstepA : cA; const char* nB = has_next ? (const char*)g.Bt + (size_t)nxt.pn * tstepB : cB;
        for (int t = 0; t < nt; t += 2) {
            const bool last = (t == nt - 2);
            const char* a1 = cA + (size_t)(t + 1) * kstep;
            const char* a2 = last ? nA : cA + (size_t)(t + 2) * kstep; const char* b2 = last ? nB : cB + (size_t)(t + 2) * kstep;
            const char* a3 = a2 + kstep; const char* b3 = b2 + kstep;
            if constexpr (SP2) {
            PG8_LDB(B0, 0, 0); PG8_LDB(B1, 0, 1); PG8_SCHED; PG8_LDA(At, 0, 0); PG8_STAGE(PG8_SA(1, 1), a1 + hstepA, voffA);
            PG8_WAIT_V(8); PG8_WAIT_L(0); PG8_BAR; PG8_MMA(0, 0, At, B0); PG8_MMA(0, 1, At, B1); PG8_BAR; PG8_SCHED;
            PG8_LDA(At, 0, 1); PG8_STAGE(PG8_SB(0, 0), b2, voffB); PG8_STAGE(PG8_SB(0, 1), b2 + hstepB, voffB); PG8_STAGE(PG8_SA(0, 0), a2, voffA);
            PG8_WAIT_V(8); PG8_WAIT_L(0); PG8_BAR; PG8_MMA(1, 0, At, B0); PG8_MMA(1, 1, At, B1); PG8_BAR; PG8_SCHED;
            PG8_LDB(B0, 1, 0); PG8_LDB(B1, 1, 1); PG8_SCHED; PG8_LDA(At, 1, 0); PG8_STAGE(PG8_SA(0, 1), a2 + hstepA, voffA);
            PG8_WAIT_V(8); PG8_WAIT_L(0); PG8_BAR; PG8_MMA(0, 0, At, B0); PG8_MMA(0, 1, At, B1); PG8_BAR; PG8_SCHED;
            PG8_LDA(At, 1, 1); PG8_STAGE(PG8_SB(1, 0), b3, voffB); PG8_STAGE(PG8_SB(1, 1), b3 + hstepB, voffB); PG8_STAGE(PG8_SA(1, 0), a3, voffA);
            PG8_WAIT_V(8); PG8_WAIT_L(0); PG8_BAR; PG8_MMA(1, 0, At, B0); PG8_MMA(1, 1, At, B1); PG8_BAR; PG8_SCHED;
            } else {
            PG8_LDB(B0, 0, 0); PG8_SCHED; PG8_LDA(At, 0, 0); PG8_STAGE(PG8_SA(1, 1), a1 + hstepA, voffA);
            PG8_WAIT_L(8); PG8_BAR; PG8_WAIT_L(0); PG8_MMA(0, 0, At, B0); PG8_BAR; PG8_SCHED;
            PG8_LDB(B1, 0, 1); PG8_STAGE(PG8_SB(0, 0), b2, voffB);
            PG8_BAR; PG8_WAIT_L(0); PG8_MMA(0, 1, At, B1); PG8_BAR;
            PG8_LDA(At, 0, 1); PG8_STAGE(PG8_SA(0, 0), a2, voffA);
            PG8_BAR; PG8_WAIT_L(0); PG8_MMA(1, 0, At, B0); PG8_BAR; PG8_SCHED;
            PG8_STAGE(PG8_SB(0, 1), b2 + hstepB, voffB);
            PG8_WAIT_V(6); PG8_BAR; PG8_MMA(1, 1, At, B1); PG8_BAR;
            PG8_LDB(B0, 1, 0); PG8_SCHED; PG8_LDA(At, 1, 0); PG8_STAGE(PG8_SA(0, 1), a2 + hstepA, voffA);
            PG8_WAIT_L(8); PG8_BAR; PG8_WAIT_L(0); PG8_MMA(0, 0, At, B0); PG8_BAR; PG8_SCHED;
            PG8_LDB(B1, 1, 1); PG8_STAGE(PG8_SB(1, 0), b3, voffB);
            PG8_BAR; PG8_WAIT_L(0); PG8_MMA(0, 1, At, B1); PG8_BAR;
            PG8_LDA(At, 1, 1); PG8_STAGE(PG8_SA(1, 0), a3, voffA);
            PG8_BAR; PG8_WAIT_L(0); PG8_MMA(1, 0, At, B0); PG8_BAR; PG8_SCHED;
            PG8_STAGE(PG8_SB(1, 1), b3 + hstepB, voffB);
            PG8_WAIT_V(6); PG8_BAR; PG8_MMA(1, 1, At, B1); PG8_BAR;
            }
        }
        if constexpr (SP2) { if (wr == 0) PG8_BAR; }
        { int el; asm volatile("v_mbcnt_lo_u32_b32 %0, -1, 0\n\tv_mbcnt_hi_u32_b32 %0, -1, %0" : "=v"(el)); E(acc, cur, wr, wc, el & 15, el >> 4); }
        if (!has_next) break;
#pragma unroll
        for (int a = 0; a < 2; ++a)
#pragma unroll
            for (int b = 0; b < 2; ++b)
#pragma unroll
                for (int m = 0; m < 4; ++m)
#pragma unroll
                    for (int n = 0; n < 2; ++n) acc[a][b][m][n] = (f32x4){0.f, 0.f, 0.f, 0.f};
        cur = nxt; cA = nA; cB = nB; ++ui;
        if constexpr (SP2) { if (wr == 1) PG8_BAR; }
    }
    PG8_WAIT_V(0);
    if constexpr (!SP2) { if (wr == 0) PG8_BAR; }
    PG8_BAR;
#undef PG8_SA
#undef PG8_SB
#undef PG8_STAGE
#undef PG8_LDA
#undef PG8_LDB
#undef PG8_MMA
#undef PG8_WAIT_V
#undef PG8_WAIT_L
#undef PG8_BAR
#undef PG8_SCHED
}

#if defined(MK_SIMPLE_GEMM)
template <class Epi>
__device__ __forceinline__ void gemm_phase_simple(const Gemm g, const StaticOrder& S, const Epi& E) {
    const int tid = threadIdx.x, wid = __builtin_amdgcn_readfirstlane(tid >> 6), lane = tid & 63, wr = wid >> 2, wc = wid & 3, fr = lane & 15, fq = lane >> 4;
    Unit cur;
    for (int ui = 0; S.next(ui, cur); ++ui) {
        f32x4 acc[2][2][4][2];
#pragma unroll
        for (int a = 0; a < 2; ++a)
#pragma unroll
            for (int b = 0; b < 2; ++b)
#pragma unroll
                for (int m = 0; m < 4; ++m)
#pragma unroll
                    for (int n = 0; n < 2; ++n) acc[a][b][m][n] = (f32x4){0.f, 0.f, 0.f, 0.f};
        for (int k0 = 0; k0 < g.K; k0 += 32) {
            bf16x8 bf[2][2];
#pragma unroll
            for (int bj = 0; bj < 2; ++bj)
#pragma unroll
                for (int n = 0; n < 2; ++n) { const int slot = 16 * n + fr; const int wrow = cur.pn * BM + bj * HALF + wc * 32 + (Epi::PERM ? perm32(slot) : slot);
                    bf[bj][n] = *(const bf16x8*)(g.Bt + (size_t)wrow * g.K + k0 + 8 * fq); }
#pragma unroll
            for (int ai = 0; ai < 2; ++ai)
#pragma unroll
                for (int m = 0; m < 4; ++m) { const int arow = cur.pm * BM + ai * HALF + wr * 64 + m * 16 + fr;
                    const bf16x8 af = *(const bf16x8*)(g.A + (size_t)arow * g.lda + k0 + 8 * fq);
#pragma unroll
                    for (int bj = 0; bj < 2; ++bj)
#pragma unroll
                        for (int n = 0; n < 2; ++n) acc[ai][bj][m][n] = __builtin_amdgcn_mfma_f32_16x16x32_bf16(bf[bj][n], af, acc[ai][bj][m][n], 0, 0, 0); }
        }
        E(acc, cur, wr, wc, fr, fq);
    }
}
#define GEMM_PHASE(EPI, lds, g, S, E) pg8::gemm_phase_simple<EPI>(g, S, E)
#define GEMM_PHASE2(EPI, lds, g, S, E) pg8::gemm_phase_simple<EPI>(g, S, E)
#else
#define GEMM_PHASE(EPI, lds, g, S, E) pg8::gemm_phase<EPI, true>(lds, g, S, E)
#define GEMM_PHASE2(EPI, lds, g, S, E) pg8::gemm_phase<EPI, false>(lds, g, S, E)
#endif
struct EpiSwiglu {
    static constexpr bool PERM = true;
    bf16_t* O; int ldc;
    __device__ __forceinline__ void operator()(const f32x4 (&acc)[2][2][4][2], const Unit& u, int wr, int wc, int fr, int fq) const {
        const int row0 = u.pm * BM + wr * 64 + fr, col0 = u.pn * 128 + wc * 32 + 8 * fq;
#pragma unroll
        for (int ai = 0; ai < 2; ++ai)
#pragma unroll
            for (int m = 0; m < 4; ++m) {
                bf16_t* rowp = O + (size_t)(row0 + ai * HALF + m * 16) * ldc + col0;
                const f32x4 g0 = acc[ai][0][m][0], g1 = acc[ai][0][m][1], u0 = acc[ai][1][m][0], u1 = acc[ai][1][m][1];
                float v[8];
#pragma unroll
                for (int j = 0; j < 4; ++j) { v[j] = fsilu(g0[j]) * u0[j]; v[4 + j] = fsilu(g1[j]) * u1[j]; }
                u32x4 w; w.x = pk_bf16(v[0], v[1]); w.y = pk_bf16(v[2], v[3]); w.z = pk_bf16(v[4], v[5]); w.w = pk_bf16(v[6], v[7]);
                *(u32x4*)rowp = w;
                asm volatile("" ::: "memory");
            }
    }
};
__device__ __forceinline__ void store_tile_bf16(const f32x4 (&acc)[2][2][4][2], bf16_t* base, int ld, int row0, int col0, int act) {
#pragma unroll
    for (int ai = 0; ai < 2; ++ai)
#pragma unroll
        for (int m = 0; m < 4; ++m) {
            bf16_t* rowp = base + (size_t)(row0 + ai * HALF + m * 16) * ld + col0;
#pragma unroll
            for (int bj = 0; bj < 2; ++bj) {
                f32x4 v0 = acc[ai][bj][m][0], v1 = acc[ai][bj][m][1];
                if (act == 1) {
#pragma unroll
                    for (int j = 0; j < 4; ++j) { v0[j] = fgelu(v0[j]); v1[j] = fgelu(v1[j]); }
                } else if (act == 2) {
#pragma unroll
                    for (int j = 0; j < 4; ++j) { v0[j] = fsigmoid(v0[j]); v1[j] = fsigmoid(v1[j]); }
                }
                u32x4 w; w.x = pk_bf16(v0[0], v0[1]); w.y = pk_bf16(v0[2], v0[3]); w.z = pk_bf16(v1[0], v1[1]); w.w = pk_bf16(v1[2], v1[3]);
                *(u32x4*)(rowp + bj * HALF) = w;
            }
            asm volatile("" ::: "memory");
        }
}
template <int ACT> struct EpiAct {
    static constexpr bool PERM = true;
    bf16_t* p; int ld, pn0;
    __device__ __forceinline__ void operator()(const f32x4 (&acc)[2][2][4][2], const Unit& u, int wr, int wc, int fr, int fq) const {
        store_tile_bf16(acc, p, ld, u.pm * BM + wr * 64 + fr, (u.pn - pn0) * BM + wc * 32 + 8 * fq, ACT);
    }
};
struct EpiWinA {
    static constexpr bool PERM = true;
    bf16_t* zq; bf16_t* xl; bf16_t* gy;
    __device__ __forceinline__ void operator()(const f32x4 (&acc)[2][2][4][2], const Unit& u, int wr, int wc, int fr, int fq) const {
        size_t boff = 0; if (u.pn >= 2) boff += (size_t)((const char*)xl - (const char*)zq); if (u.pn >= 6) boff += (size_t)((const char*)gy - (const char*)xl);
        bf16_t* base = (bf16_t*)((char*)zq + boff);
        int ld = 512, pn0 = 0; if (u.pn >= 2) { ld = D; pn0 = 2; } if (u.pn >= 6) pn0 = 6;
        store_tile_bf16(acc, base, ld, u.pm * BM + wr * 64 + fr, (u.pn - pn0) * BM + wc * 32 + 8 * fq, u.pn < 6 ? 0 : 1);
    }
};
struct EpiWinB {
    static constexpr bool PERM = true;
    bf16_t* ga; bf16_t* gl;
    __device__ __forceinline__ void operator()(const f32x4 (&acc)[2][2][4][2], const Unit& u, int wr, int wc, int fr, int fq) const {
        store_tile_bf16(acc, u.pn < 4 ? ga : gl, D, u.pm * BM + wr * 64 + fr, (u.pn & 3) * BM + wc * 32 + 8 * fq, 2);
    }
};
template <bool ADD> struct EpiGate {
    static constexpr bool PERM = true;
    const bf16_t* gate; const bf16_t* add; bf16_t* out;
    __device__ __forceinline__ void operator()(const f32x4 (&acc)[2][2][4][2], const Unit& u, int wr, int wc, int fr, int fq) const {
        const int row0 = u.pm * BM + wr * 64 + fr, col0 = u.pn * BM + wc * 32 + 8 * fq;
#pragma unroll
        for (int ai = 0; ai < 2; ++ai)
#pragma unroll
            for (int m = 0; m < 4; ++m) {
                const size_t off = (size_t)(row0 + ai * HALF + m * 16) * D + col0;
#pragma unroll
                for (int bj = 0; bj < 2; ++bj) {
                    const u32x4 gw = *(const u32x4*)(gate + off + bj * HALF);
                    const f32x4 v0 = acc[ai][bj][m][0], v1 = acc[ai][bj][m][1];
                    float r[8];
                    r[0] = lo_bf(gw.x) * v0[0]; r[1] = hi_bf(gw.x) * v0[1]; r[2] = lo_bf(gw.y) * v0[2]; r[3] = hi_bf(gw.y) * v0[3];
                    r[4] = lo_bf(gw.z) * v1[0]; r[5] = hi_bf(gw.z) * v1[1]; r[6] = lo_bf(gw.w) * v1[2]; r[7] = hi_bf(gw.w) * v1[3];
                    if (ADD) {
                        const u32x4 aw = *(const u32x4*)(add + off + bj * HALF);
                        r[0] += lo_bf(aw.x); r[1] += hi_bf(aw.x); r[2] += lo_bf(aw.y); r[3] += hi_bf(aw.y);
                        r[4] += lo_bf(aw.z); r[5] += hi_bf(aw.z); r[6] += lo_bf(aw.w); r[7] += hi_bf(aw.w);
                    }
                    u32x4 w; w.x = pk_bf16(r[0], r[1]); w.y = pk_bf16(r[2], r[3]); w.z = pk_bf16(r[4], r[5]); w.w = pk_bf16(r[6], r[7]);
                    *(u32x4*)(out + off + bj * HALF) = w;
                }
                asm volatile("" ::: "memory");
            }
    }
};
struct EpiQKV {
    static constexpr bool PERM = true;
    bf16_t* Q; bf16_t* Kn; const float* stats;
    __device__ __forceinline__ void operator()(const f32x4 (&acc)[2][2][4][2], const Unit& u, int wr, int wc, int fr, int fq) const {
        const int row0 = u.pm * BM + wr * 64 + fr;
        const int sel = u.pn < 3 ? 0 : 1;
        bf16_t* dst = Q; int ld = NQ, ctile = u.pn * BM;
        if (u.pn >= 3) { dst = Kn; ld = NKV; ctile = ((u.pn - 3) & 1) * BM; if (u.pn >= 5) dst += (size_t)T * NKV; }
        const int col0 = ctile + wc * 32 + 8 * fq;
#pragma unroll
        for (int ai = 0; ai < 2; ++ai)
#pragma unroll
            for (int m = 0; m < 4; ++m) {
                const int row = row0 + ai * HALF + m * 16;
                const float rs = stats[2 * row + sel];
                bf16_t* rowp = dst + (size_t)row * ld + col0;
#pragma unroll
                for (int bj = 0; bj < 2; ++bj) {
                    const f32x4 v0 = acc[ai][bj][m][0] * rs, v1 = acc[ai][bj][m][1] * rs;
                    u32x4 w; w.x = pk_bf16(v0[0], v0[1]); w.y = pk_bf16(v0[2], v0[3]); w.z = pk_bf16(v1[0], v1[1]); w.w = pk_bf16(v1[2], v1[3]);
                    *(u32x4*)(rowp + bj * HALF) = w;
                }
                asm volatile("" ::: "memory");
            }
    }
};
}

struct TJob { const float* src; const float* scale; bf16_t* dst; int ldsrc, K, lddst, dstk0, nrb, map, nbatch, sbs, dbs; };
__device__ __forceinline__ int srccol(int map, int rb) {
    const int r = rb * 32;
    switch (map) {
        case 1: { const int pn = r >> 8, w = r & 255; return w < 128 ? 128 * pn + w : DFF + 128 * pn + (w - 128); }
        case 2: { if (r < 416) return r; if (r < 512) return -1; return r - 96; }
        case 3: return 2464 + r;
        case 4: { const int v = r >= 512 ? 1 : 0; const int rr = r & 511; return (rr >> 6) * 128 + (rr & 63) + 64 * v; }
        default: return r;
    }
}
constexpr int NJOBS = 15;
__device__ __forceinline__ TJob get_job(const Params& p, int j) {
    TJob t; t.scale = nullptr; t.dstk0 = 0; t.map = 0; t.nbatch = 1; t.sbs = 0; t.dbs = 0;
    unsigned char* ws = p.ws;
    switch (j) {
        case 0:  t.src = p.in[8];  t.dst = (bf16_t*)(ws + WS_WGU1); t.ldsrc = 2 * DFF; t.K = D; t.lddst = D; t.nrb = 176; t.map = 1; break;
        case 1:  t.src = p.in[9];  t.dst = (bf16_t*)(ws + WS_WDN1); t.ldsrc = D; t.K = DFF; t.lddst = DFF; t.nrb = 32; break;
        case 2:  t.src = p.in[10]; t.dst = (bf16_t*)(ws + WS_WINA); t.ldsrc = 4512; t.K = D; t.lddst = D; t.nrb = 80; t.map = 2; break;
        case 3:  t.src = p.in[10]; t.dst = (bf16_t*)(ws + WS_WINB); t.ldsrc = 4512; t.K = D; t.lddst = D; t.nrb = 64; t.map = 3; break;
        case 4:  t.src = p.in[13]; t.scale = p.in[11]; t.dst = (bf16_t*)(ws + WS_WQKV); t.ldsrc = 768; t.K = 256; t.lddst = 384; t.nrb = 24; break;
        case 5:  t.src = nullptr;  t.dst = (bf16_t*)(ws + WS_WQKV); t.ldsrc = 0; t.K = 128; t.lddst = 384; t.dstk0 = 256; t.nrb = 24; break;
        case 6:  t.src = p.in[14]; t.scale = p.in[12]; t.dst = (bf16_t*)(ws + WS_WQKV) + 768 * 384; t.ldsrc = 1024; t.K = 128; t.lddst = 384; t.dstk0 = 256; t.nrb = 32; t.map = 4; break;
        case 7:  t.src = nullptr;  t.dst = (bf16_t*)(ws + WS_WQKV) + 768 * 384; t.ldsrc = 0; t.K = 256; t.lddst = 384; t.nrb = 32; break;
        case 8:  t.src = p.in[15]; t.dst = (bf16_t*)(ws + WS_WAO); t.ldsrc = D; t.K = 512; t.lddst = 512; t.nrb = 32; break;
        case 9:  t.src = p.in[23]; t.dst = (bf16_t*)(ws + WS_WLO); t.ldsrc = D; t.K = D; t.lddst = D; t.nrb = 32; break;
        case 10: t.src = p.in[24]; t.dst = (bf16_t*)(ws + WS_WOUT); t.ldsrc = D; t.K = D; t.lddst = D; t.nrb = 32; break;
        case 11: t.src = p.in[25]; t.dst = (bf16_t*)(ws + WS_WGU2); t.ldsrc = 2 * DFF; t.K = D; t.lddst = D; t.nrb = 176; t.map = 1; break;
        case 12: t.src = p.in[26]; t.dst = (bf16_t*)(ws + WS_WDN2); t.ldsrc = D; t.K = DFF; t.lddst = DFF; t.nrb = 32; break;
        case 13: t.src = p.in[18]; t.dst = (bf16_t*)(ws + WS_WG); t.ldsrc = 128; t.K = 128; t.lddst = 128; t.nrb = 4; t.nbatch = 16; t.sbs = 16384; t.dbs = 32768; break;
        default: t.src = p.in[20]; t.dst = (bf16_t*)(ws + WS_WG) + 16384; t.ldsrc = 128; t.K = 128; t.lddst = 128; t.nrb = 4; t.nbatch = 16; t.sbs = 16384; t.dbs = 32768; break;
    }
    return t;
}
__device__ __forceinline__ int job_items(const TJob& t) { return t.nbatch * t.nrb * (t.K >> 6); }

__device__ __forceinline__ void tr_item(const TJob& jb, int item, LAS float* scr, int lane) {
    const int nkb = jb.K >> 6, per_batch = jb.nrb * nkb;
    const int bt = item / per_batch, r = item - bt * per_batch, rb = r / nkb, kb = r - rb * nkb;
    const int sc = srccol(jb.map, rb), k0 = 64 * kb;
    if (jb.src != nullptr && sc >= 0) {
        const float* src = jb.src + (size_t)bt * jb.sbs;
#pragma unroll 8
        for (int i = 0; i < 32; ++i) { const int kk = 2 * i + (lane >> 5);
            float v = src[(size_t)(k0 + kk) * jb.ldsrc + sc + (lane & 31)];
            if (jb.scale) v *= jb.scale[k0 + kk];
            scr[kk * 33 + (lane & 31)] = v; }
    } else {
#pragma unroll 8
        for (int i = 0; i < 32; ++i) { const int kk = 2 * i + (lane >> 5); scr[kk * 33 + (lane & 31)] = 0.f; }
    }
    asm volatile("s_waitcnt lgkmcnt(0)" ::: "memory");
    bf16_t* dst = jb.dst + (size_t)bt * jb.dbs;
    const int c = lane & 7;
#pragma unroll
    for (int j = 0; j < 4; ++j) { const int n = (lane >> 3) + 8 * j; const LAS float* s = scr + (8 * c) * 33 + n;
        u32x4 o; o.x = pk_bf16(s[0 * 33], s[1 * 33]); o.y = pk_bf16(s[2 * 33], s[3 * 33]); o.z = pk_bf16(s[4 * 33], s[5 * 33]); o.w = pk_bf16(s[6 * 33], s[7 * 33]);
        *(u32x4*)(dst + (size_t)(32 * rb + n) * jb.lddst + jb.dstk0 + k0 + 8 * c) = o; }
    asm volatile("s_waitcnt lgkmcnt(0)" ::: "memory");
}

__device__ __forceinline__ void phase_prep(const Params& p, LAS unsigned char* lds) {
    const int tid = threadIdx.x, lane = tid & 63, wave = tid >> 6;
    const int gw = blockIdx.x * NWAVES + wave, NGW = gridDim.x * NWAVES;
    {
        LAS float* scr = (LAS float*)(lds + wave * 8704);
        int base = 0;
        for (int j = 0; j < NJOBS; ++j) {
            const TJob jb = get_job(p, j); const int n = job_items(jb);
            int first = gw - (base % NGW); if (first < 0) first += NGW;
            for (int i = first; i < n; i += NGW) tr_item(jb, i, scr, lane);
            base += n;
        }
    }
    {
        const int gt = blockIdx.x * NTHREADS + tid;
        if (gt < SS * 16) {
            const int pos = gt >> 4, i = gt & 15;
            double inv = 1.0; for (int q = 0; q < i; ++q) inv *= 0.5623413251903491;
            const float ang = (float)pos * (float)inv;
            const double rev = (double)ang * 0.15915494309189535; const float fr = (float)(rev - rint(rev));
            ((float*)(p.ws + WS_ROPE))[gt] = __builtin_amdgcn_cosf(fr);
            ((float*)(p.ws + WS_ROPE))[SS * 16 + gt] = __builtin_amdgcn_sinf(fr);
        }
    }
    __syncthreads();
    for (int item = blockIdx.x; item < 144; item += gridDim.x) {
        LAS float* sc = (LAS float*)(lds) + wave * (128 * 33);
        for (int i = 0; i < 64; ++i) { const int idx = lane + 64 * i, kl = idx & 127, b = idx >> 7;
            const float cv = (b < 16 ? p.in[2] : p.in[3])[(b & 15) * D + 128 * wave + kl];
            sc[kl * 33 + b] = fsilu(cv); }
        asm volatile("s_waitcnt lgkmcnt(0)" ::: "memory");
        float acc[32];
#pragma unroll
        for (int b = 0; b < 32; ++b) acc[b] = 0.f;
        const float* W = p.in[4] + (size_t)(128 * wave) * 9216 + item * 64 + lane;
        for (int k = 0; k < 128; ++k) { const float wv = W[(size_t)k * 9216];
#pragma unroll
            for (int b = 0; b < 32; ++b) acc[b] += sc[k * 33 + b] * wv; }
        __syncthreads();
        LAS float* red = (LAS float*)(lds);
#pragma unroll
        for (int b = 0; b < 32; ++b) red[(wave * 32 + b) * 64 + lane] = acc[b];
        __syncthreads();
        for (int o = tid; o < 2048; o += NTHREADS) { const int b = o >> 6, col = o & 63; float s = 0.f;
#pragma unroll
            for (int w = 0; w < 8; ++w) s += red[(w * 32 + b) * 64 + col];
            const int j = item * 64 + col;
            ((float*)(p.ws + WS_MOD))[b * 9216 + j] = s + p.in[5][j]; }
        __syncthreads();
    }
}

template <bool HAS_F, bool HAS_H>
__device__ __forceinline__ void phase_rows(const Params& p, int sp, int sn, float resw, bool from_input) {
    const int tid = threadIdx.x, lane = tid & 63, wave = tid >> 6;
    const int gw = blockIdx.x * NWAVES + wave, NGW = gridDim.x * NWAVES;
    const float* mod = (const float*)(p.ws + WS_MOD);
    const bf16_t* F = (const bf16_t*)(p.ws + WS_F);
    bf16_t* H = (bf16_t*)(p.ws + WS_H);
    for (int row = gw; row < T; row += NGW) {
        const int b = row_batch(row);
        const float* xin = !from_input ? p.out + (size_t)row * D : (row < TP ? p.in[0] + (size_t)row * D : p.in[1] + (size_t)(row - TP) * D);
        f32x4 v[4];
#pragma unroll
        for (int j = 0; j < 4; ++j) v[j] = *(const f32x4*)(xin + 4 * lane + 256 * j);
        if (HAS_F) {
            f32x4 f[4]; float ss = 0.f;
#pragma unroll
            for (int j = 0; j < 4; ++j) { const u32x2 w = *(const u32x2*)(F + (size_t)row * D + 4 * lane + 256 * j);
                f[j] = (f32x4){lo_bf(w.x), hi_bf(w.x), lo_bf(w.y), hi_bf(w.y)}; ss += (f[j].x * f[j].x + f[j].y * f[j].y) + (f[j].z * f[j].z + f[j].w * f[j].w); }
            const float rs = 1.0f / sqrtf(wave_sum(ss) * (1.0f / D) + EPS) * resw;
            const float* gate = mod + b * 9216 + sp * 3072 + 2048; const float* gp = p.in[7] + sp * D;
#pragma unroll
            for (int j = 0; j < 4; ++j) { const f32x4 g = *(const f32x4*)(gate + 4 * lane + 256 * j), q = *(const f32x4*)(gp + 4 * lane + 256 * j);
                v[j] = v[j] + g * (f[j] * rs * q);
                *(f32x4*)(p.out + (size_t)row * D + 4 * lane + 256 * j) = v[j]; }
        }
        if (HAS_H) {
            float ss = 0.f;
#pragma unroll
            for (int j = 0; j < 4; ++j) ss += (v[j].x * v[j].x + v[j].y * v[j].y) + (v[j].z * v[j].z + v[j].w * v[j].w);
            const float rs = 1.0f / sqrtf(wave_sum(ss) * (1.0f / D) + EPS);
            const float* sh = mod + b * 9216 + sn * 3072; const float* scl = sh + 1024; const float* gq = p.in[6] + sn * D;
#pragma unroll
            for (int j = 0; j < 4; ++j) { const f32x4 a = *(const f32x4*)(sh + 4 * lane + 256 * j), s = *(const f32x4*)(scl + 4 * lane + 256 * j), q = *(const f32x4*)(gq + 4 * lane + 256 * j);
                const f32x4 h = (v[j] * rs * q) * (s + 1.0f) + a;
                u32x2 w; w.x = pk_bf16(h.x, h.y); w.y = pk_bf16(h.z, h.w);
                *(u32x2*)(H + (size_t)row * D + 4 * lane + 256 * j) = w; }
        }
    }
}

__device__ __forceinline__ void phase_stats(const Params& p) {
    const int tid = threadIdx.x, lane = tid & 63, wave = tid >> 6;
    const int gw = blockIdx.x * NWAVES + wave, NGW = gridDim.x * NWAVES;
    const bf16_t* ZQ = (const bf16_t*)(p.ws + WS_ZQ);
    float* stats = (float*)(p.ws + WS_STATS); bf16_t* KR = (bf16_t*)(p.ws + WS_KR);
    const float* rc = (const float*)(p.ws + WS_ROPE); const float* rsn = rc + SS * 16;
    for (int row = gw; row < T; row += NGW) {
        const u32x4 w = *(const u32x4*)(ZQ + (size_t)row * 512 + 8 * lane);
        float x[8] = {lo_bf(w.x), hi_bf(w.x), lo_bf(w.y), hi_bf(w.y), lo_bf(w.z), hi_bf(w.z), lo_bf(w.w), hi_bf(w.w)};
        float ss = 0.f;
#pragma unroll
        for (int e = 0; e < 8; ++e) ss += x[e] * x[e];
        const float sq = wave_sum(lane < 32 ? ss : 0.f), skv = wave_sum((lane >= 32 && lane < 48) ? ss : 0.f);
        if (lane == 0) { f32x2 st; st.x = 1.0f / sqrtf(sq * (1.0f / 256.0f) + EPS); st.y = 1.0f / sqrtf(skv * (1.0f / 128.0f) + EPS); *(f32x2*)(stats + 2 * row) = st; }
        float y[8];
#pragma unroll
        for (int e = 0; e < 8; ++e) y[e] = __shfl_xor(x[e], 2);
        if (lane >= 48 && lane < 52) {
            const int pos = row_pos(row), i0 = 8 * (lane & 1);
            const f32x4 c0 = *(const f32x4*)(rc + pos * 16 + i0), c1 = *(const f32x4*)(rc + pos * 16 + i0 + 4);
            const f32x4 s0 = *(const f32x4*)(rsn + pos * 16 + i0), s1 = *(const f32x4*)(rsn + pos * 16 + i0 + 4);
            const float c[8] = {c0.x, c0.y, c0.z, c0.w, c1.x, c1.y, c1.z, c1.w}, s[8] = {s0.x, s0.y, s0.z, s0.w, s1.x, s1.y, s1.z, s1.w};
            float o[8];
            const bool first = lane < 50;
#pragma unroll
            for (int e = 0; e < 8; ++e) o[e] = first ? (x[e] * c[e] - y[e] * s[e]) : (x[e] * c[e] + y[e] * s[e]);
            u32x4 ow; ow.x = pk_bf16(o[0], o[1]); ow.y = pk_bf16(o[2], o[3]); ow.z = pk_bf16(o[4], o[5]); ow.w = pk_bf16(o[6], o[7]);
            *(u32x4*)(KR + (size_t)row * 32 + 8 * (lane - 48)) = ow;
        }
    }
}

constexpr int XC_PITCH = 272;
__device__ __forceinline__ void phase_lru(const Params& p, LAS unsigned char* lds) {
    const int tid = threadIdx.x, lane = tid & 63, wave = __builtin_amdgcn_readfirstlane(tid >> 6), g = lane >> 4, lc = lane & 15;
    const bf16_t* XL = (const bf16_t*)(p.ws + WS_XL); bf16_t* GY = (bf16_t*)(p.ws + WS_GY); bf16_t* HF = (bf16_t*)(p.ws + WS_F);
    const bf16_t* WG = (const bf16_t*)(p.ws + WS_WG);
    for (int item = blockIdx.x; item < 256; item += gridDim.x) {
        int gb, n;
        if (item < 128) { gb = 16 + (item >> 3); n = item & 7; } else { gb = (item - 128) >> 3; n = item & 7; }
        const int S = gb < 16 ? SP : SS; const int row0 = gb < 16 ? gb * SP : TP + (gb - 16) * SS;
        const int nch = S >> 6;
        const int tr = tid >> 4, cgp = (tid & 15) * 8, c0 = 128 * n + cgp;
        float cw[4][8], cb[8];
#pragma unroll
        for (int j = 0; j < 4; ++j) { const f32x4 a = *(const f32x4*)(p.in[16] + j * D + c0), b = *(const f32x4*)(p.in[16] + j * D + c0 + 4);
            cw[j][0] = a.x; cw[j][1] = a.y; cw[j][2] = a.z; cw[j][3] = a.w; cw[j][4] = b.x; cw[j][5] = b.y; cw[j][6] = b.z; cw[j][7] = b.w; }
        { const f32x4 a = *(const f32x4*)(p.in[17] + c0), b = *(const f32x4*)(p.in[17] + c0 + 4);
            cb[0] = a.x; cb[1] = a.y; cb[2] = a.z; cb[3] = a.w; cb[4] = b.x; cb[5] = b.y; cb[6] = b.z; cb[7] = b.w; }
        const int ch = 128 * n + 16 * wave + lc;
        for (int d = 0; d < 2; ++d) {
            bf16x8 Ba[4], Bi[4];
            { const bf16_t* wa = WG + (size_t)((d * 8 + n) * 2 + 0) * 16384 + (size_t)(16 * wave + lc) * 128 + 8 * g; const bf16_t* wi = wa + 16384;
#pragma unroll
              for (int ks = 0; ks < 4; ++ks) { Ba[ks] = *(const bf16x8*)(wa + 32 * ks); Bi[ks] = *(const bf16x8*)(wi + 32 * ks); } }
            const float ba = p.in[19][d * D + ch], bi = p.in[21][d * D + ch];
            const float lam = p.in[22][d * D + ch];
            const float c8 = -8.0f * log1pf(expf(-lam));
            float carry = 0.f;
            for (int ci = 0; ci < nch; ++ci) {
                const int cc = d ? (nch - 1 - ci) : ci, t0 = cc * 64;
                __syncthreads();
#pragma unroll
                for (int hf = 0; hf < 2; ++hf) {
                    const int tl = tr + 32 * hf, t = t0 + tl;
                    float a[8];
#pragma unroll
                    for (int e = 0; e < 8; ++e) a[e] = cb[e];
#pragma unroll
                    for (int j = 0; j < 4; ++j) { const int tt = t + j - 1;
                        if (tt >= 0 && tt < S) { const u32x4 w = *(const u32x4*)(XL + (size_t)(row0 + tt) * D + c0);
                            a[0] += cw[j][0] * lo_bf(w.x); a[1] += cw[j][1] * hi_bf(w.x); a[2] += cw[j][2] * lo_bf(w.y); a[3] += cw[j][3] * hi_bf(w.y);
                            a[4] += cw[j][4] * lo_bf(w.z); a[5] += cw[j][5] * hi_bf(w.z); a[6] += cw[j][6] * lo_bf(w.w); a[7] += cw[j][7] * hi_bf(w.w); } }
                    u32x4 o; o.x = pk_bf16(a[0], a[1]); o.y = pk_bf16(a[2], a[3]); o.z = pk_bf16(a[4], a[5]); o.w = pk_bf16(a[6], a[7]);
                    *(LAS u32x4*)(lds + tl * XC_PITCH + cgp * 2) = o;
                }
                __syncthreads();
                f32x4 aa[4], ai[4];
#pragma unroll
                for (int mt = 0; mt < 4; ++mt) { aa[mt] = (f32x4){0.f, 0.f, 0.f, 0.f}; ai[mt] = (f32x4){0.f, 0.f, 0.f, 0.f}; }
#pragma unroll
                for (int ks = 0; ks < 4; ++ks)
#pragma unroll
                    for (int mt = 0; mt < 4; ++mt) { const bf16x8 A = *(const LAS bf16x8*)(lds + (16 * mt + lc) * XC_PITCH + (32 * ks + 8 * g) * 2);
                        aa[mt] = __builtin_amdgcn_mfma_f32_16x16x32_bf16(A, Ba[ks], aa[mt], 0, 0, 0);
                        ai[mt] = __builtin_amdgcn_mfma_f32_16x16x32_bf16(A, Bi[ks], ai[mt], 0, 0, 0); }
#pragma unroll
                for (int mt = 0; mt < 4; ++mt)
#pragma unroll
                    for (int j = 0; j < 4; ++j) {
                        const float xcv = bf2f(*(const LAS bf16_t*)(lds + (16 * mt + 4 * g + j) * XC_PITCH + (16 * wave + lc) * 2));
                        const float r = fsigmoid(aa[mt][j] + ba), ig = fsigmoid(ai[mt][j] + bi);
                        const float la = c8 * r;
                        const float av = fexp(la), om = -expm1f(2.0f * la);
                        aa[mt][j] = av; ai[mt][j] = sqrtf(om) * (ig * xcv);
                    }
                if (d == 0) {
#pragma unroll
                    for (int mt = 0; mt < 4; ++mt) {
                        float P = 1.f, Hh = 0.f, pl[4], hl[4];
#pragma unroll
                        for (int j = 0; j < 4; ++j) { Hh = aa[mt][j] * Hh + ai[mt][j]; P *= aa[mt][j]; hl[j] = Hh; pl[j] = P; }
                        float A = P, Hs = Hh;
                        { const float A1 = __shfl_up(A, 16), H1 = __shfl_up(Hs, 16); if (g >= 1) { Hs = A * H1 + Hs; A = A * A1; } }
                        { const float A2 = __shfl_up(A, 32), H2 = __shfl_up(Hs, 32); if (g >= 2) { Hs = A * H2 + Hs; A = A * A2; } }
                        float Aex = __shfl_up(A, 16), Hex = __shfl_up(Hs, 16); if (g == 0) { Aex = 1.f; Hex = 0.f; }
                        const float cin = Aex * carry + Hex;
                        const float At = __shfl(A, 48 + lc), Ht = __shfl(Hs, 48 + lc);
                        carry = At * carry + Ht;
#pragma unroll
                        for (int j = 0; j < 4; ++j) { const float h = hl[j] + pl[j] * cin;
                            HF[(size_t)(row0 + t0 + 16 * mt + 4 * g + j) * D + ch] = (bf16_t)(pk_bf16(h, 0.f) & 0xffffu); }
                    }
                } else {
#pragma unroll
                    for (int mt = 3; mt >= 0; --mt) {
                        float P = 1.f, Hh = 0.f, pl[4], hl[4];
#pragma unroll
                        for (int j = 3; j >= 0; --j) { Hh = aa[mt][j] * Hh + ai[mt][j]; P *= aa[mt][j]; hl[j] = Hh; pl[j] = P; }
                        float A = P, Hs = Hh;
                        { const float A1 = __shfl_down(A, 16), H1 = __shfl_down(Hs, 16); if (g <= 2) { Hs = A * H1 + Hs; A = A * A1; } }
                        { const float A2 = __shfl_down(A, 32), H2 = __shfl_down(Hs, 32); if (g <= 1) { Hs = A * H2 + Hs; A = A * A2; } }
                        float Aex = __shfl_down(A, 16), Hex = __shfl_down(Hs, 16); if (g == 3) { Aex = 1.f; Hex = 0.f; }
                        const float cin = Aex * carry + Hex;
                        const float At = __shfl(A, lc), Ht = __shfl(Hs, lc);
                        carry = At * carry + Ht;
#pragma unroll
                        for (int j = 0; j < 4; ++j) { const float h = hl[j] + pl[j] * cin;
                            const size_t off = (size_t)(row0 + t0 + 16 * mt + 4 * g + j) * D + ch;
                            const float o = (bf2f(HF[off]) + h) * bf2f(GY[off]);
                            GY[off] = (bf16_t)(pk_bf16(o, 0.f) & 0xffffu); }
                    }
                }
            }
        }
        __syncthreads();
    }
}

constexpr int AK_PITCH = 208, AV_PITCH = 160, AK_BYTES = 64 * AK_PITCH, AV_BYTES = 64 * AV_PITCH, ABUF = AK_BYTES + AV_BYTES;
__device__ __forceinline__ void phase_attn(const Params& p, LAS unsigned char* lds) {
    const int tid = threadIdx.x, lane = tid & 63, wave = __builtin_amdgcn_readfirstlane(tid >> 6), g = lane >> 4, lc = lane & 15;
    const bf16_t* Q = (const bf16_t*)(p.ws + WS_F); const bf16_t* KN = (const bf16_t*)(p.ws + WS_XL); const bf16_t* V = KN + (size_t)T * NKV;
    const bf16_t* KR = (const bf16_t*)(p.ws + WS_KR); bf16_t* O = (bf16_t*)(p.ws + WS_ZQ);
    const float csc = 0.10206207261596577f * 1.4426950408889634f;
    const int srow = tid >> 3, sch = tid & 7;
    const int rrow = (tid & 255) >> 2, rch = tid & 3;
    const int vtr = (4 * g + (lc >> 2)) * AV_PITCH + (4 * (lc & 3)) * 2;
    for (int unit = blockIdx.x; unit < 3072; unit += gridDim.x) {
        int gb, h, qt, S, row0;
        if (unit < 2048) { gb = 16 + (unit >> 7); h = (unit & 127) >> 4; qt = unit & 15; S = SS; row0 = TP + (gb - 16) * SS; }
        else { const int u2 = unit - 2048; gb = u2 >> 6; h = (u2 & 63) >> 3; qt = u2 & 7; S = SP; row0 = gb * SP; }
        const int nkt = S >> 6;
        const int qrow = row0 + 256 * qt + 32 * wave;
        bf16x8 qf[2][3];
#pragma unroll
        for (int q2 = 0; q2 < 2; ++q2)
#pragma unroll
            for (int ks = 0; ks < 3; ++ks) qf[q2][ks] = *(const bf16x8*)(Q + (size_t)(qrow + 16 * q2 + lc) * NQ + 96 * h + 32 * ks + 8 * g);
#pragma unroll
        for (int q2 = 0; q2 < 2; ++q2) {
            const int pos = row_pos(qrow + 16 * q2 + lc), i0 = 8 * (g & 1);
            const float* rc = (const float*)(p.ws + WS_ROPE) + pos * 16 + i0; const float* rsn = rc + SS * 16;
            const f32x4 c0 = *(const f32x4*)rc, c1 = *(const f32x4*)(rc + 4), s0 = *(const f32x4*)rsn, s1 = *(const f32x4*)(rsn + 4);
            const float cc[8] = {c0.x, c0.y, c0.z, c0.w, c1.x, c1.y, c1.z, c1.w}, sn[8] = {s0.x, s0.y, s0.z, s0.w, s1.x, s1.y, s1.z, s1.w};
            const u32x4 mine = __builtin_bit_cast(u32x4, qf[q2][2]);
            u32x4 oth; oth.x = __shfl_xor(mine.x, 32); oth.y = __shfl_xor(mine.y, 32); oth.z = __shfl_xor(mine.z, 32); oth.w = __shfl_xor(mine.w, 32);
            const float xm[8] = {lo_bf(mine.x), hi_bf(mine.x), lo_bf(mine.y), hi_bf(mine.y), lo_bf(mine.z), hi_bf(mine.z), lo_bf(mine.w), hi_bf(mine.w)};
            const float xo[8] = {lo_bf(oth.x), hi_bf(oth.x), lo_bf(oth.y), hi_bf(oth.y), lo_bf(oth.z), hi_bf(oth.z), lo_bf(oth.w), hi_bf(oth.w)};
            float o[8];
#pragma unroll
            for (int e = 0; e < 8; ++e) o[e] = g < 2 ? (xm[e] * cc[e] - xo[e] * sn[e]) : (xm[e] * cc[e] + xo[e] * sn[e]);
            u32x4 w; w.x = pk_bf16(o[0], o[1]); w.y = pk_bf16(o[2], o[3]); w.z = pk_bf16(o[4], o[5]); w.w = pk_bf16(o[6], o[7]);
            qf[q2][2] = __builtin_bit_cast(bf16x8, w);
        }
        f32x4 oacc[4][2];
#pragma unroll
        for (int dt = 0; dt < 4; ++dt) { oacc[dt][0] = (f32x4){0.f, 0.f, 0.f, 0.f}; oacc[dt][1] = (f32x4){0.f, 0.f, 0.f, 0.f}; }
        float mrun[2] = {-1e30f, -1e30f}, lrun[2] = {0.f, 0.f};
        u32x4 gk, gr, gv;
        gk = *(const u32x4*)(KN + (size_t)(row0 + srow) * NKV + 64 * h + 8 * sch);
        gv = *(const u32x4*)(V + (size_t)(row0 + srow) * NKV + 64 * h + 8 * sch);
        gr = *(const u32x4*)(KR + (size_t)(row0 + rrow) * 32 + 8 * rch);
        __syncthreads();
        *(LAS u32x4*)(lds + srow * AK_PITCH + sch * 16) = gk;
        *(LAS u32x4*)(lds + AK_BYTES + srow * AV_PITCH + sch * 16) = gv;
        if (tid < 256) *(LAS u32x4*)(lds + rrow * AK_PITCH + 128 + rch * 16) = gr;
        __syncthreads();
        for (int kt = 0; kt < nkt; ++kt) {
            LAS unsigned char* kb = lds + (kt & 1) * ABUF; LAS unsigned char* vb = kb + AK_BYTES;
            LAS unsigned char* nb = lds + ((kt + 1) & 1) * ABUF;
            const bool more = kt + 1 < nkt;
            if (more) { const int kr0 = row0 + 64 * (kt + 1);
                gk = *(const u32x4*)(KN + (size_t)(kr0 + srow) * NKV + 64 * h + 8 * sch);
                gv = *(const u32x4*)(V + (size_t)(kr0 + srow) * NKV + 64 * h + 8 * sch);
                gr = *(const u32x4*)(KR + (size_t)(kr0 + rrow) * 32 + 8 * rch); }
            f32x4 sacc[4][2];
#pragma unroll
            for (int k4 = 0; k4 < 4; ++k4) { sacc[k4][0] = (f32x4){0.f, 0.f, 0.f, 0.f}; sacc[k4][1] = (f32x4){0.f, 0.f, 0.f, 0.f}; }
#pragma unroll
            for (int ks = 0; ks < 3; ++ks)
#pragma unroll
                for (int k4 = 0; k4 < 4; ++k4) { const bf16x8 kf = *(const LAS bf16x8*)(kb + (16 * k4 + lc) * AK_PITCH + (32 * ks + 8 * g) * 2);
                    sacc[k4][0] = __builtin_amdgcn_mfma_f32_16x16x32_bf16(kf, qf[0][ks], sacc[k4][0], 0, 0, 0);
                    sacc[k4][1] = __builtin_amdgcn_mfma_f32_16x16x32_bf16(kf, qf[1][ks], sacc[k4][1], 0, 0, 0); }
            bf16x8 pf[2][2];
#pragma unroll
            for (int q2 = 0; q2 < 2; ++q2) {
                float mx = sacc[0][q2][0];
#pragma unroll
                for (int k4 = 0; k4 < 4; ++k4)
#pragma unroll
                    for (int j = 0; j < 4; ++j) mx = fmaxf(mx, sacc[k4][q2][j]);
                mx = fmaxf(mx, __shfl_xor(mx, 16)); mx = fmaxf(mx, __shfl_xor(mx, 32));
                const float mnew = fmaxf(mrun[q2], mx * csc);
                const float alpha = __builtin_amdgcn_exp2f(mrun[q2] - mnew);
                mrun[q2] = mnew;
                float ps = 0.f; float pv[4][4];
#pragma unroll
                for (int k4 = 0; k4 < 4; ++k4)
#pragma unroll
                    for (int j = 0; j < 4; ++j) { const float e = __builtin_amdgcn_exp2f(sacc[k4][q2][j] * csc - mnew); pv[k4][j] = e; ps += e; }
                lrun[q2] = lrun[q2] * alpha + ps;
#pragma unroll
                for (int dt = 0; dt < 4; ++dt) oacc[dt][q2] *= alpha;
#pragma unroll
                for (int kk = 0; kk < 2; ++kk) {
                    u32x4 w; w.x = pk_bf16(pv[2 * kk][0], pv[2 * kk][1]); w.y = pk_bf16(pv[2 * kk][2], pv[2 * kk][3]);
                    w.z = pk_bf16(pv[2 * kk + 1][0], pv[2 * kk + 1][1]); w.w = pk_bf16(pv[2 * kk + 1][2], pv[2 * kk + 1][3]);
                    pf[q2][kk] = __builtin_bit_cast(bf16x8, w);
                }
            }
#pragma unroll
            for (int kk = 0; kk < 2; ++kk)
#pragma unroll
                for (int dt = 0; dt < 4; ++dt) {
                    const v4i16_t lo = __builtin_amdgcn_ds_read_tr16_b64_v4i16((LAS v4i16_t*)(vb + vtr + (32 * kk) * AV_PITCH + 32 * dt));
                    const v4i16_t hi = __builtin_amdgcn_ds_read_tr16_b64_v4i16((LAS v4i16_t*)(vb + vtr + (32 * kk + 16) * AV_PITCH + 32 * dt));
                    const bf16x8 vf = {lo[0], lo[1], lo[2], lo[3], hi[0], hi[1], hi[2], hi[3]};
                    oacc[dt][0] = __builtin_amdgcn_mfma_f32_16x16x32_bf16(vf, pf[0][kk], oacc[dt][0], 0, 0, 0);
                    oacc[dt][1] = __builtin_amdgcn_mfma_f32_16x16x32_bf16(vf, pf[1][kk], oacc[dt][1], 0, 0, 0);
                }
            if (more) {
                *(LAS u32x4*)(nb + srow * AK_PITCH + sch * 16) = gk;
                *(LAS u32x4*)(nb + AK_BYTES + srow * AV_PITCH + sch * 16) = gv;
                if (tid < 256) *(LAS u32x4*)(nb + rrow * AK_PITCH + 128 + rch * 16) = gr;
            }
            __syncthreads();
        }
#pragma unroll
        for (int q2 = 0; q2 < 2; ++q2) {
            float l = lrun[q2]; l += __shfl_xor(l, 16); l += __shfl_xor(l, 32);
            const float inv = 1.0f / l;
#pragma unroll
            for (int dt = 0; dt < 4; ++dt) { const f32x4 o = oacc[dt][q2] * inv;
                u32x2 w; w.x = pk_bf16(o[0], o[1]); w.y = pk_bf16(o[2], o[3]);
                *(u32x2*)(O + (size_t)(qrow + 16 * q2 + lc) * 512 + 64 * h + 16 * dt + 4 * g) = w; }
        }
    }
    __syncthreads();
}

constexpr int NPHASES = 16;
__global__ void __launch_bounds__(NTHREADS, 2) mega_fwd(Params p) {
    extern __shared__ __attribute__((aligned(16))) unsigned char lds_raw[];
    LAS unsigned char* lds = (LAS unsigned char*)lds_raw;
    cg::grid_group grid = cg::this_grid();
    unsigned char* ws = p.ws;
    const int G = gridDim.x, bid = blockIdx.x;
    bf16_t* Hb = (bf16_t*)(ws + WS_H); bf16_t* Fb = (bf16_t*)(ws + WS_F); bf16_t* ACT = (bf16_t*)(ws + WS_ACT);
    bf16_t* ZQ = (bf16_t*)(ws + WS_ZQ); bf16_t* XL = (bf16_t*)(ws + WS_XL); bf16_t* GY = (bf16_t*)(ws + WS_GY);
#ifndef TESTPH
#define TESTPH -1
#endif
#define IN(k) ((TESTPH < 0 || (k) == TESTPH) && p.ph_lo <= (k) && (k) < p.ph_hi)
#define SEAM(k) do { if (IN(k) && IN((k) + 1)) { __builtin_amdgcn_fence(__ATOMIC_RELEASE, "agent"); asm volatile("s_waitcnt vmcnt(0) lgkmcnt(0)" ::: "memory"); \
        grid.sync(); __builtin_amdgcn_fence(__ATOMIC_ACQUIRE, "agent"); asm volatile("s_waitcnt vmcnt(0) lgkmcnt(0)" ::: "memory"); } } while (0)
    if (IN(0)) phase_prep(p, lds);
    SEAM(0);
    if (IN(1)) phase_rows<false, true>(p, 0, 0, 0.f, true);
    SEAM(1);
#define FFN_PHASES(ffn, pb) do { \
        if (IN(pb)) { \
            pg8::Gemm g{Hb, (const bf16_t*)(ws + ((ffn) ? WS_WGU2 : WS_WGU1)), D, D}; pg8::StaticOrder S; S.init(T, 2 * DFF, G, bid); \
            pg8::EpiSwiglu E{ACT, DFF}; \
            GEMM_PHASE(pg8::EpiSwiglu, lds, g, S, E); \
        } \
        SEAM(pb); \
        if (IN((pb) + 1)) { \
            pg8::Gemm g{ACT, (const bf16_t*)(ws + ((ffn) ? WS_WDN2 : WS_WDN1)), DFF, DFF}; pg8::StaticOrder S; S.init(T, D, G, bid); \
            pg8::EpiAct<0> E{Fb, D, 0}; \
            GEMM_PHASE(pg8::EpiAct<0>, lds, g, S, E); \
        } \
        SEAM((pb) + 1); } while (0)
    FFN_PHASES(0, 2);
        if (IN(4)) phase_rows<true, true>(p, 0, 1, 0.5f, true);
        SEAM(4);
        if (IN(5)) {
            pg8::Gemm g{Hb, (const bf16_t*)(ws + WS_WINA), D, D}; pg8::StaticOrder S; S.init(T, 2560, G, bid);
            pg8::EpiWinA E{ZQ, XL, GY};
            GEMM_PHASE(pg8::EpiWinA, lds, g, S, E);
        }
        SEAM(5);
        if (IN(6)) { phase_stats(p); phase_lru(p, lds); }
        SEAM(6);
        if (IN(7)) {
            pg8::Gemm g{ZQ, (const bf16_t*)(ws + WS_WQKV), 512, 384}; pg8::StaticOrder S; S.init(T, 1792, G, bid);
            pg8::EpiQKV E{Fb, XL, (const float*)(ws + WS_STATS)};
            GEMM_PHASE2(pg8::EpiQKV, lds, g, S, E);
        }
        SEAM(7);
        if (IN(8)) phase_attn(p, lds);
        SEAM(8);
        if (IN(9)) {
            pg8::Gemm g{Hb, (const bf16_t*)(ws + WS_WINB), D, D}; pg8::StaticOrder S; S.init(T, 2048, G, bid);
            pg8::EpiWinB E{Fb, XL};
            GEMM_PHASE(pg8::EpiWinB, lds, g, S, E);
        }
        SEAM(9);
        if (IN(10)) {
            { pg8::Gemm g{ZQ, (const bf16_t*)(ws + WS_WAO), 512, 512}; pg8::StaticOrder S; S.init(T, D, G, bid);
              pg8::EpiGate<false> E{Fb, nullptr, Fb};
              GEMM_PHASE(pg8::EpiGate<false>, lds, g, S, E); }
            { pg8::Gemm g{GY, (const bf16_t*)(ws + WS_WLO), D, D}; pg8::StaticOrder S; S.init(T, D, G, bid);
              pg8::EpiGate<true> E{XL, Fb, XL};
              GEMM_PHASE(pg8::EpiGate<true>, lds, g, S, E); }
        }
        SEAM(10);
        if (IN(11)) {
            pg8::Gemm g{XL, (const bf16_t*)(ws + WS_WOUT), D, D}; pg8::StaticOrder S; S.init(T, D, G, bid);
            pg8::EpiAct<0> E{Fb, D, 0};
            GEMM_PHASE(pg8::EpiAct<0>, lds, g, S, E);
        }
        SEAM(11);
        if (IN(12)) phase_rows<true, true>(p, 1, 2, 1.0f, false);
        SEAM(12);
    FFN_PHASES(1, 13);
    if (IN(15)) phase_rows<true, false>(p, 2, 0, 0.5f, false);
#undef IN
#undef SEAM
}

extern "C" void kernel_launch(void* const* d_in, const int* in_sizes, int n_in, void* d_out, int out_size, void* d_ws, size_t ws_size, hipStream_t stream) {
    static int grid = 0;
    if (grid == 0) {
        if (n_in != 27 || out_size != T * D || ws_size < WS_END) { fprintf(stderr, "kernel_launch: unexpected shapes: n_in %d out %d ws %zu (need >= %zu)\n", n_in, out_size, ws_size, (size_t)WS_END); grid = -1; return; }
        int dev = 0, cus = 0, per_cu = 0;
        (void)hipGetDevice(&dev);
        (void)hipDeviceGetAttribute(&cus, hipDeviceAttributeMultiprocessorCount, dev);
        if (hipFuncSetAttribute((const void*)mega_fwd, hipFuncAttributeMaxDynamicSharedMemorySize, LDS_BYTES) != hipSuccess) { fprintf(stderr, "kernel_launch: hipFuncSetAttribute failed\n"); grid = -1; return; }
        if (hipOccupancyMaxActiveBlocksPerMultiprocessor(&per_cu, (const void*)mega_fwd, NTHREADS, LDS_BYTES) != hipSuccess || per_cu < 1) { fprintf(stderr, "kernel_launch: occupancy query failed (%d)\n", per_cu); per_cu = 1; }
        (void)hipGetLastError();
        grid = cus;
        fprintf(stderr, "kernel_launch: grid %d (per_cu %d)\n", grid, per_cu);
    }
    if (grid < 0) return;
    Params p{};
    for (int i = 0; i < 27; ++i) p.in[i] = (const float*)d_in[i];
    p.out = (float*)d_out; p.ws = (unsigned char*)d_ws;
#if defined(MK_SPLIT)
    for (int ph = 0; ph < NPHASES; ++ph) { p.ph_lo = ph; p.ph_hi = ph + 1;
        hipLaunchKernelGGL(mega_fwd, dim3(grid), dim3(NTHREADS), LDS_BYTES, stream, p); }
#else
    p.ph_lo = 0; p.ph_hi = NPHASES;
    void* args[] = {&p};
    hipError_t e = hipLaunchCooperativeKernel((const void*)mega_fwd, dim3(grid), dim3(NTHREADS), args, LDS_BYTES, stream);
    if (e != hipSuccess) fprintf(stderr, "kernel_launch: cooperative launch failed: %s (grid %d)\n", hipGetErrorString(e), grid);
#endif
}
```

```cpp
#include <hip/hip_runtime.h>
#include <hip/hip_cooperative_groups.h>
#include <cstdio>
#include <cstdint>
namespace cg = cooperative_groups;
#ifndef MK_SP2_ALL
#define MK_SP2_ALL false
#endif

#define LAS __attribute__((address_space(3)))
typedef unsigned short bf16_t;
typedef short bf16x8 __attribute__((ext_vector_type(8)));
typedef short v4i16_t __attribute__((ext_vector_type(4)));
typedef float f32x4 __attribute__((ext_vector_type(4)));
typedef float f32x2 __attribute__((ext_vector_type(2)));
typedef unsigned u32x4 __attribute__((ext_vector_type(4)));
typedef unsigned u32x2 __attribute__((ext_vector_type(2)));

constexpr int D = 1024, DFF = 2816, TP = 32768, TS = 65536, T = TP + TS, SP = 2048, SS = 4096;
constexpr int NQ = 768, NKV = 512;
constexpr float EPS = 1e-6f;
constexpr int NTHREADS = 512, NWAVES = 8;

constexpr size_t KiB = 1024, MiB = 1024 * 1024;
constexpr size_t WS_WGU1 = 0, WS_WDN1 = 11 * MiB, WS_WINA = 16 * MiB + 512 * KiB, WS_WINB = 21 * MiB + 512 * KiB, WS_WQKV = 25 * MiB + 512 * KiB,
                 WS_WAO = 27 * MiB, WS_WLO = 28 * MiB, WS_WOUT = 30 * MiB, WS_WGU2 = 32 * MiB, WS_WDN2 = 43 * MiB, WS_WG = 48 * MiB + 512 * KiB,
                 WS_MOD = 49 * MiB + 512 * KiB, WS_ROPE = 50 * MiB + 768 * KiB, WS_STATS = 51 * MiB + 256 * KiB, WS_KR = 52 * MiB;
constexpr size_t WS_H = 64 * MiB, WS_F = 256 * MiB, WS_BIG = 448 * MiB;
constexpr size_t WS_ZQ = WS_BIG, WS_XL = WS_BIG + 96 * MiB, WS_GY = WS_BIG + 288 * MiB, WS_ACT = WS_BIG, WS_END = 976 * MiB;
constexpr int LDS_BYTES = 139264;

struct Params { const float* in[27]; float* out; unsigned char* ws; int ph_lo, ph_hi; };

typedef __bf16 bf16x2_t __attribute__((ext_vector_type(2)));
__device__ __forceinline__ unsigned pk_bf16(float lo, float hi) { const f32x2 v = {lo, hi}; const bf16x2_t b = __builtin_convertvector(v, bf16x2_t); return __builtin_bit_cast(unsigned, b); }
__device__ __forceinline__ float lo_bf(unsigned w) { return __uint_as_float(w << 16); }
__device__ __forceinline__ float hi_bf(unsigned w) { return __uint_as_float(w & 0xffff0000u); }
__device__ __forceinline__ float bf2f(bf16_t h) { return __uint_as_float((unsigned)h << 16); }
__device__ __forceinline__ float fexp(float x) { return __builtin_amdgcn_exp2f(x * 1.4426950408889634f); }
__device__ __forceinline__ float fsigmoid(float x) { return __builtin_amdgcn_rcpf(1.0f + fexp(-x)); }
__device__ __forceinline__ float fsilu(float x) { return x * fsigmoid(x); }
__device__ __forceinline__ float fgelu(float x) { return x * fsigmoid(1.5957691216057308f * (x + 0.044715f * x * x * x)); }
__device__ __forceinline__ float wave_sum(float v) {
#pragma unroll
    for (int o = 1; o < 64; o <<= 1) v += __shfl_xor(v, o);
    return v;
}
__device__ __forceinline__ int row_batch(int row) { return row < TP ? (row >> 11) : 16 + ((row - TP) >> 12); }
__device__ __forceinline__ int row_pos(int row) { return row < TP ? (row & (SP - 1)) : ((row - TP) & (SS - 1)); }

namespace pg8 {
constexpr int BM = 256, BK = 64, HALF = 128, HTB = HALF * BK * 2, STAGE_BYTES = 8 * HTB, NXCD = 8, WGM = 8;
__host__ __device__ __forceinline__ int lds_byte(int r, int c) { const int st = (r >> 4) * 2 + (c >> 5), rr = r & 15, cc = c & 31, ob = rr * 64 + cc * 2; return st * 1024 + (ob ^ (((ob >> 9) & 1) << 5)); }
__host__ __device__ __forceinline__ void stage_rc(int b, int& R, int& C) { const int st = b / 1024, sb = b % 1024, swz = sb ^ (((sb >> 9) & 1) << 5); R = (st >> 1) * 16 + swz / 64; C = (st & 1) * 32 + (swz % 64) / 2; }
__host__ __device__ __forceinline__ int perm32(int rho) { const int n = rho >> 4, i = rho & 15; return 8 * (i >> 2) + 4 * n + (i & 3); }

struct Unit { int pm, pn; };
struct Gemm { const bf16_t* A; const bf16_t* Bt; int lda, K; };

struct StaticOrder {
    int nM, nN, nwg, G, c;
    __device__ void init(int M, int N, int G_, int c_) { nM = M / BM; nN = N / BM; nwg = nM * nN; G = G_; c = c_; }
    __device__ bool next(int i, Unit& u) const {
        const long L = (long)i * G + c; if (L >= nwg) return false;
        int wgid = (int)L; { const int q = nwg / NXCD, r = nwg % NXCD, xcd = wgid % NXCD, off = wgid / NXCD; wgid = (xcd < r ? xcd * (q + 1) : r * (q + 1) + (xcd - r) * q) + off; }
        const int nig = WGM * nN, gid = wgid / nig, fm = gid * WGM, gsz = (nM - fm) < WGM ? (nM - fm) : WGM;
        u.pm = fm + ((wgid % nig) % gsz); u.pn = (wgid % nig) / gsz; return true;
    }
};

template <class Epi, bool SP2 = false>
__device__ __forceinline__ void gemm_phase(LAS unsigned char* lds, const Gemm g, const StaticOrder& S, const Epi& E) {
    const int tid = threadIdx.x, wid = __builtin_amdgcn_readfirstlane(tid >> 6), lane = tid & 63, wr = wid >> 2, wc = wid & 3, fr = lane & 15, fq = lane >> 4;
    const int K = g.K, nt = K / BK, lda = g.lda;
    unsigned voffA[2], voffB[2];
#pragma unroll
    for (int i = 0; i < 2; ++i) { int R, C; stage_rc(tid * 16 + i * 8192, R, C); const int Rb = Epi::PERM ? ((R & ~31) + perm32(R & 31)) : R;
        voffA[i] = (unsigned)(R * lda + C) * 2u; voffB[i] = (unsigned)(Rb * K + C) * 2u; }
    const size_t kstep = (size_t)(BK * 2);
    const size_t hstepA = (size_t)HALF * lda * 2, hstepB = (size_t)HALF * K * 2;
    const size_t tstepA = 2 * hstepA, tstepB = 2 * hstepB;
    const unsigned ldsw = (unsigned)wid * 1024u;
    const int aoff = lds_byte(wr * 64 + fr, fq * 8), boff = lds_byte(wc * 32 + fr, fq * 8);
#define PG8_SA(b, h) (((b) * 2 + (h)) * HTB)
#define PG8_SB(b, h) ((4 + (b) * 2 + (h)) * HTB)
#define PG8_STAGE(bufoff, gbase, voff) do { _Pragma("unroll") for (int _i = 0; _i < 2; ++_i) \
        __builtin_amdgcn_global_load_lds((const unsigned*)((const char*)(gbase) + (voff)[_i]), (LAS unsigned*)(lds + (bufoff) + ldsw + _i * 8192), 16, 0, 0); } while (0)
#define PG8_LDA(dst, b, h) do { _Pragma("unroll") for (int m = 0; m < 4; ++m) _Pragma("unroll") for (int k = 0; k < 2; ++k) dst[m][k] = *(const LAS bf16x8*)(lds + PG8_SA(b, h) + aoff + m * 2048 + k * 1024); } while (0)
#define PG8_LDB(dst, b, h) do { _Pragma("unroll") for (int n = 0; n < 2; ++n) _Pragma("unroll") for (int k = 0; k < 2; ++k) dst[n][k] = *(const LAS bf16x8*)(lds + PG8_SB(b, h) + boff + n * 2048 + k * 1024); } while (0)
#define PG8_MMA(ai, bj, At, Bt) do { __builtin_amdgcn_s_setprio(1); _Pragma("unroll") for (int m = 0; m < 4; ++m) _Pragma("unroll") for (int n = 0; n < 2; ++n) _Pragma("unroll") for (int k = 0; k < 2; ++k) \
        acc[ai][bj][m][n] = __builtin_amdgcn_mfma_f32_16x16x32_bf16(Bt[n][k], At[m][k], acc[ai][bj][m][n], 0, 0, 0); __builtin_amdgcn_s_setprio(0); } while (0)
#define PG8_WAIT_V(n) asm volatile("s_waitcnt vmcnt(" #n ")" ::: "memory")
#define PG8_WAIT_L(n) asm volatile("s_waitcnt lgkmcnt(" #n ")" ::: "memory")
#define PG8_BAR __builtin_amdgcn_s_barrier()
#define PG8_SCHED __builtin_amdgcn_sched_barrier(0)
    Unit cur, nxt; int ui = 0;
    if (!S.next(0, cur)) return;
    f32x4 acc[2][2][4][2];
#pragma unroll
    for (int a = 0; a < 2; ++a)
#pragma unroll
        for (int b = 0; b < 2; ++b)
#pragma unroll
            for (int m = 0; m < 4; ++m)
#pragma unroll
                for (int n = 0; n < 2; ++n) acc[a][b][m][n] = (f32x4){0.f, 0.f, 0.f, 0.f};
    bf16x8 At[4][2], B0[2][2], B1[2][2];
    const char* cA = (const char*)g.A + (size_t)cur.pm * tstepA; const char* cB = (const char*)g.Bt + (size_t)cur.pn * tstepB;
    if constexpr (SP2) {
        PG8_STAGE(PG8_SB(0, 0), cB, voffB); PG8_STAGE(PG8_SB(0, 1), cB + hstepB, voffB); PG8_STAGE(PG8_SA(0, 0), cA, voffA); PG8_STAGE(PG8_SA(0, 1), cA + hstepA, voffA);
        if (wr == 1) PG8_BAR;
        PG8_WAIT_V(2); PG8_BAR;
        PG8_STAGE(PG8_SB(1, 0), cB + kstep, voffB); PG8_STAGE(PG8_SA(1, 0), cA + kstep, voffA); PG8_STAGE(PG8_SB(1, 1), cB + hstepB + kstep, voffB);
        PG8_WAIT_V(6); PG8_BAR;
    } else {
    PG8_STAGE(PG8_SB(0, 0), cB, voffB); PG8_STAGE(PG8_SA(0, 0), cA, voffA); PG8_STAGE(PG8_SB(0, 1), cB + hstepB, voffB); PG8_STAGE(PG8_SA(0, 1), cA + hstepA, voffA);
    if (wr == 1) PG8_BAR;
    PG8_WAIT_V(4); PG8_BAR;
    PG8_STAGE(PG8_SB(1, 0), cB + kstep, voffB); PG8_STAGE(PG8_SA(1, 0), cA + kstep, voffA); PG8_STAGE(PG8_SB(1, 1), cB + hstepB + kstep, voffB);
    PG8_WAIT_V(6); PG8_BAR;
    }
    for (;;) {
        const bool has_next = S.next(ui + 1, nxt);
        const char* nA = has_next ? (const char*)g.A + (size_t)nxt.pm * tstepA : cA; const char* nB = has_next ? (const char*)g.Bt + (size_t)nxt.pn * tstepB : cB;
        for (int t = 0; t < nt; t += 2) {
            const bool last = (t == nt - 2);
            const char* a1 = cA + (size_t)(t + 1) * kstep;
            const char* a2 = last ? nA : cA + (size_t)(t + 2) * kstep; const char* b2 = last ? nB : cB + (size_t)(t + 2) * kstep;
            const char* a3 = a2 + kstep; const char* b3 = b2 + kstep;
            if constexpr (SP2) {
            PG8_LDB(B0, 0, 0); PG8_LDB(B1, 0, 1); PG8_SCHED; PG8_LDA(At, 0, 0); PG8_STAGE(PG8_SA(1, 1), a1 + hstepA, voffA);
            PG8_WAIT_V(8); PG8_WAIT_L(0); PG8_BAR; PG8_MMA(0, 0, At, B0); PG8_MMA(0, 1, At, B1); PG8_BAR; PG8_SCHED;
            PG8_LDA(At, 0, 1); PG8_STAGE(PG8_SB(0, 0), b2, voffB); PG8_STAGE(PG8_SB(0, 1), b2 + hstepB, voffB); PG8_STAGE(PG8_SA(0, 0), a2, voffA);
            PG8_WAIT_V(8); PG8_WAIT_L(0); PG8_BAR; PG8_MMA(1, 0, At, B0); PG8_MMA(1, 1, At, B1); PG8_BAR; PG8_SCHED;
            PG8_LDB(B0, 1, 0); PG8_LDB(B1, 1, 1); PG8_SCHED; PG8_LDA(At, 1, 0); PG8_STAGE(PG8_SA(0, 1), a2 + hstepA, voffA);
            PG8_WAIT_V(8); PG8_WAIT_L(0); PG8_BAR; PG8_MMA(0, 0, At, B0); PG8_MMA(0, 1, At, B1); PG8_BAR; PG8_SCHED;
            PG8_LDA(At, 1, 1); PG8_STAGE(PG8_SB(1, 0), b3, voffB); PG8_STAGE(PG8_SB(1, 1), b3 + hstepB, voffB); PG8_STAGE(PG8_SA(1, 0), a3, voffA);
            PG8_WAIT_V(8); PG8_WAIT_L(0); PG8_BAR; PG8_MMA(1, 0, At, B0); PG8_MMA(1, 1, At, B1); PG8_BAR; PG8_SCHED;
            } else {
            PG8_LDB(B0, 0, 0); PG8_SCHED; PG8_LDA(At, 0, 0); PG8_STAGE(PG8_SA(1, 1), a1 + hstepA, voffA);
            PG8_WAIT_L(8); PG8_BAR; PG8_WAIT_L(0); PG8_MMA(0, 0, At, B0); PG8_BAR; PG8_SCHED;
            PG8_LDB(B1, 0, 1); PG8_STAGE(PG8_SB(0, 0), b2, voffB);
            PG8_BAR; PG8_WAIT_L(0); PG8_MMA(0, 1, At, B1); PG8_BAR;
            PG8_LDA(At, 0, 1); PG8_STAGE(PG8_SA(0, 0), a2, voffA);
            PG8_BAR; PG8_WAIT_L(0); PG8_MMA(1, 0, At, B0); PG8_BAR; PG8_SCHED;
            PG8_STAGE(PG8_SB(0, 1), b2 + hstepB, voffB);
            PG8_WAIT_V(6); PG8_BAR; PG8_MMA(1, 1, At, B1); PG8_BAR;
            PG8_LDB(B0, 1, 0); PG8_SCHED; PG8_LDA(At, 1, 0); PG8_STAGE(PG8_SA(0, 1), a2 + hstepA, voffA);
            PG8_WAIT_L(8); PG8_BAR; PG8_WAIT_L(0); PG8_MMA(0, 0, At, B0); PG8_BAR; PG8_SCHED;
            PG8_LDB(B1, 1, 1); PG8_STAGE(PG8_SB(1, 0), b3, voffB);
            PG8_BAR; PG8_WAIT_L(0); PG8_MMA(0, 1, At, B1); PG8_BAR;
            PG8_LDA(At, 1, 1); PG8_STAGE(PG8_SA(1, 0), a3, voffA);
            PG8_BAR; PG8_WAIT_L(0); PG8_MMA(1, 0, At, B0); PG8_BAR; PG8_SCHED;
            PG8_STAGE(PG8_SB(1, 1), b3 + hstepB, voffB);
            PG8_WAIT_V(6); PG8_BAR; PG8_MMA(1, 1, At, B1); PG8_BAR;
            }
        }
        if constexpr (SP2) { if (wr == 0) PG8_BAR; }
        { int el; asm volatile("v_mbcnt_lo_u32_b32 %0, -1, 0\n\tv_mbcnt_hi_u32_b32 %0, -1, %0" : "=v"(el)); E(acc, cur, wr, wc, el & 15, el >> 4); }
        if (!has_next) break;
#pragma unroll
        for (int a = 0; a < 2; ++a)
#pragma unroll
            for (int b = 0; b < 2; ++b)
#pragma unroll
                for (int m = 0; m < 4; ++m)
#pragma unroll
                    for (int n = 0; n < 2; ++n) acc[a][b][m][n] = (f32x4){0.f, 0.f, 0.f, 0.f};
        cur = nxt; cA = nA; cB = nB; ++ui;
        if constexpr (SP2) { if (wr == 1) PG8_BAR; }
    }
    PG8_WAIT_V(0);
    if constexpr (!SP2) { if (wr == 0) PG8_BAR; }
    PG8_BAR;
#undef PG8_SA
#undef PG8_SB
#undef PG8_STAGE
#undef PG8_LDA
#undef PG8_LDB
#undef PG8_MMA
#undef PG8_WAIT_V
#undef PG8_WAIT_L
#undef PG8_BAR
#undef PG8_SCHED
}

#if defined(MK_SIMPLE_GEMM)
template <class Epi>
__device__ __forceinline__ void gemm_phase_simple(const Gemm g, const StaticOrder& S, const Epi& E) {
    const int tid = threadIdx.x, wid = __builtin_amdgcn_readfirstlane(tid >> 6), lane = tid & 63, wr = wid >> 2, wc = wid & 3, fr = lane & 15, fq = lane >> 4;
    Unit cur;
    for (int ui = 0; S.next(ui, cur); ++ui) {
        f32x4 acc[2][2][4][2];
#pragma unroll
        for (int a = 0; a < 2; ++a)
#pragma unroll
            for (int b = 0; b < 2; ++b)
#pragma unroll
                for (int m = 0; m < 4; ++m)
#pragma unroll
                    for (int n = 0; n < 2; ++n) acc[a][b][m][n] = (f32x4){0.f, 0.f, 0.f, 0.f};
        for (int k0 = 0; k0 < g.K; k0 += 32) {
            bf16x8 bf[2][2];
#pragma unroll
            for (int bj = 0; bj < 2; ++bj)
#pragma unroll
                for (int n = 0; n < 2; ++n) { const int slot = 16 * n + fr; const int wrow = cur.pn * BM + bj * HALF + wc * 32 + (Epi::PERM ? perm32(slot) : slot);
                    bf[bj][n] = *(const bf16x8*)(g.Bt + (size_t)wrow * g.K + k0 + 8 * fq); }
#pragma unroll
            for (int ai = 0; ai < 2; ++ai)
#pragma unroll
                for (int m = 0; m < 4; ++m) { const int arow = cur.pm * BM + ai * HALF + wr * 64 + m * 16 + fr;
                    const bf16x8 af = *(const bf16x8*)(g.A + (size_t)arow * g.lda + k0 + 8 * fq);
#pragma unroll
                    for (int bj = 0; bj < 2; ++bj)
#pragma unroll
                        for (int n = 0; n < 2; ++n) acc[ai][bj][m][n] = __builtin_amdgcn_mfma_f32_16x16x32_bf16(bf[bj][n], af, acc[ai][bj][m][n], 0, 0, 0); }
        }
        E(acc, cur, wr, wc, fr, fq);
    }
}
#define GEMM_PHASE(EPI, lds, g, S, E) pg8::gemm_phase_simple<EPI>(g, S, E)
#define GEMM_PHASE2(EPI, lds, g, S, E) pg8::gemm_phase_simple<EPI>(g, S, E)
#else
#define GEMM_PHASE(EPI, lds, g, S, E) pg8::gemm_phase<EPI, true>(lds, g, S, E)
#define GEMM_PHASE2(EPI, lds, g, S, E) pg8::gemm_phase<EPI, false>(lds, g, S, E)
#endif
struct EpiSwiglu {
    static constexpr bool PERM = true;
    bf16_t* O; int ldc;
    __device__ __forceinline__ void operator()(const f32x4 (&acc)[2][2][4][2], const Unit& u, int wr, int wc, int fr, int fq) const {
        const int row0 = u.pm * BM + wr * 64 + fr, col0 = u.pn * 128 + wc * 32 + 8 * fq;
#pragma unroll
        for (int ai = 0; ai < 2; ++ai)
#pragma unroll
            for (int m = 0; m < 4; ++m) {
                bf16_t* rowp = O + (size_t)(row0 + ai * HALF + m * 16) * ldc + col0;
                const f32x4 g0 = acc[ai][0][m][0], g1 = acc[ai][0][m][1], u0 = acc[ai][1][m][0], u1 = acc[ai][1][m][1];
                float v[8];
#pragma unroll
                for (int j = 0; j < 4; ++j) { v[j] = fsilu(g0[j]) * u0[j]; v[4 + j] = fsilu(g1[j]) * u1[j]; }
                u32x4 w; w.x = pk_bf16(v[0], v[1]); w.y = pk_bf16(v[2], v[3]); w.z = pk_bf16(v[4], v[5]); w.w = pk_bf16(v[6], v[7]);
                *(u32x4*)rowp = w;
                asm volatile("" ::: "memory");
            }
    }
};
__device__ __forceinline__ void store_tile_bf16(const f32x4 (&acc)[2][2][4][2], bf16_t* base, int ld, int row0, int col0, int act) {
#pragma unroll
    for (int ai = 0; ai < 2; ++ai)
#pragma unroll
        for (int m = 0; m < 4; ++m) {
            bf16_t* rowp = base + (size_t)(row0 + ai * HALF + m * 16) * ld + col0;
#pragma unroll
            for (int bj = 0; bj < 2; ++bj) {
                f32x4 v0 = acc[ai][bj][m][0], v1 = acc[ai][bj][m][1];
                if (act == 1) {
#pragma unroll
                    for (int j = 0; j < 4; ++j) { v0[j] = fgelu(v0[j]); v1[j] = fgelu(v1[j]); }
                } else if (act == 2) {
#pragma unroll
                    for (int j = 0; j < 4; ++j) { v0[j] = fsigmoid(v0[j]); v1[j] = fsigmoid(v1[j]); }
                }
                u32x4 w; w.x = pk_bf16(v0[0], v0[1]); w.y = pk_bf16(v0[2], v0[3]); w.z = pk_bf16(v1[0], v1[1]); w.w = pk_bf16(v1[2], v1[3]);
                *(u32x4*)(rowp + bj * HALF) = w;
            }
            asm volatile("" ::: "memory");
        }
}
template <int ACT> struct EpiAct {
    static constexpr bool PERM = true;
    bf16_t* p; int ld, pn0;
    __device__ __forceinline__ void operator()(const f32x4 (&acc)[2][2][4][2], const Unit& u, int wr, int wc, int fr, int fq) const {
        store_tile_bf16(acc, p, ld, u.pm * BM + wr * 64 + fr, (u.pn - pn0) * BM + wc * 32 + 8 * fq, ACT);
    }
};
struct EpiWinA {
    static constexpr bool PERM = true;
    bf16_t* zq; bf16_t* xl; bf16_t* gy;
    __device__ __forceinline__ void operator()(const f32x4 (&acc)[2][2][4][2], const Unit& u, int wr, int wc, int fr, int fq) const {
        size_t boff = 0; if (u.pn >= 2) boff += (size_t)((const char*)xl - (const char*)zq); if (u.pn >= 6) boff += (size_t)((const char*)gy - (const char*)xl);
        bf16_t* base = (bf16_t*)((char*)zq + boff);
        int ld = 512, pn0 = 0; if (u.pn >= 2) { ld = D; pn0 = 2; } if (u.pn >= 6) pn0 = 6;
        store_tile_bf16(acc, base, ld, u.pm * BM + wr * 64 + fr, (u.pn - pn0) * BM + wc * 32 + 8 * fq, u.pn < 6 ? 0 : 1);
    }
};
struct EpiWinB {
    static constexpr bool PERM = true;
    bf16_t* ga; bf16_t* gl;
    __device__ __forceinline__ void operator()(const f32x4 (&acc)[2][2][4][2], const Unit& u, int wr, int wc, int fr, int fq) const {
        store_tile_bf16(acc, u.pn < 4 ? ga : gl, D, u.pm * BM + wr * 64 + fr, (u.pn & 3) * BM + wc * 32 + 8 * fq, 2);
    }
};
template <bool ADD> struct EpiGate {
    static constexpr bool PERM = true;
    const bf16_t* gate; const bf16_t* add; bf16_t* out;
    __device__ __forceinline__ void operator()(const f32x4 (&acc)[2][2][4][2], const Unit& u, int wr, int wc, int fr, int fq) const {
        const int row0 = u.pm * BM + wr * 64 + fr, col0 = u.pn * BM + wc * 32 + 8 * fq;
#pragma unroll
        for (int ai = 0; ai < 2; ++ai)
#pragma unroll
            for (int m = 0; m < 4; ++m) {
                const size_t off = (size_t)(row0 + ai * HALF + m * 16) * D + col0;
#pragma unroll
                for (int bj = 0; bj < 2; ++bj) {
                    const u32x4 gw = *(const u32x4*)(gate + off + bj * HALF);
                    const f32x4 v0 = acc[ai][bj][m][0], v1 = acc[ai][bj][m][1];
                    float r[8];
                    r[0] = lo_bf(gw.x) * v0[0]; r[1] = hi_bf(gw.x) * v0[1]; r[2] = lo_bf(gw.y) * v0[2]; r[3] = hi_bf(gw.y) * v0[3];
                    r[4] = lo_bf(gw.z) * v1[0]; r[5] = hi_bf(gw.z) * v1[1]; r[6] = lo_bf(gw.w) * v1[2]; r[7] = hi_bf(gw.w) * v1[3];
                    if (ADD) {
                        const u32x4 aw = *(const u32x4*)(add + off + bj * HALF);
                        r[0] += lo_bf(aw.x); r[1] += hi_bf(aw.x); r[2] += lo_bf(aw.y); r[3] += hi_bf(aw.y);
                        r[4] += lo_bf(aw.z); r[5] += hi_bf(aw.z); r[6] += lo_bf(aw.w); r[7] += hi_bf(aw.w);
                    }
                    u32x4 w; w.x = pk_bf16(r[0], r[1]); w.y = pk_bf16(r[2], r[3]); w.z = pk_bf16(r[4], r[5]); w.w = pk_bf16(r[6], r[7]);
                    *(u32x4*)(out + off + bj * HALF) = w;
                }
                asm volatile("" ::: "memory");
            }
    }
};
struct EpiQKV {
    static constexpr bool PERM = true;
    bf16_t* Q; bf16_t* Kn; const float* stats;
    __device__ __forceinline__ void operator()(const f32x4 (&acc)[2][2][4][2], const Unit& u, int wr, int wc, int fr, int fq) const {
        const int row0 = u.pm * BM + wr * 64 + fr;
        const int sel = u.pn < 3 ? 0 : 1;
        bf16_t* dst = Q; int ld = NQ, ctile = u.pn * BM;
        if (u.pn >= 3) { dst = Kn; ld = NKV; ctile = ((u.pn - 3) & 1) * BM; if (u.pn >= 5) dst += (size_t)T * NKV; }
        const int col0 = ctile + wc * 32 + 8 * fq;
#pragma unroll
        for (int ai = 0; ai < 2; ++ai)
#pragma unroll
            for (int m = 0; m < 4; ++m) {
                const int row = row0 + ai * HALF + m * 16;
                const float rs = stats[2 * row + sel];
                bf16_t* rowp = dst + (size_t)row * ld + col0;
#pragma unroll
                for (int bj = 0; bj < 2; ++bj) {
                    const f32x4 v0 = acc[ai][bj][m][0] * rs, v1 = acc[ai][bj][m][1] * rs;
                    u32x4 w; w.x = pk_bf16(v0[0], v0[1]); w.y = pk_bf16(v0[2], v0[3]); w.z = pk_bf16(v1[0], v1[1]); w.w = pk_bf16(v1[2], v1[3]);
                    *(u32x4*)(rowp + bj * HALF) = w;
                }
                asm volatile("" ::: "memory");
            }
    }
};
}

struct TJob { const float* src; const float* scale; bf16_t* dst; int ldsrc, K, lddst, dstk0, nrb, map, nbatch, sbs, dbs; };
__device__ __forceinline__ int srccol(int map, int rb) {
    const int r = rb * 32;
    switch (map) {
        case 1: { const int pn = r >> 8, w = r & 255; return w < 128 ? 128 * pn + w : DFF + 128 * pn + (w - 128); }
        case 2: { if (r < 416) return r; if (r < 512) return -1; return r - 96; }
        case 3: return 2464 + r;
        case 4: { const int v = r >= 512 ? 1 : 0; const int rr = r & 511; return (rr >> 6) * 128 + (rr & 63) + 64 * v; }
        default: return r;
    }
}
constexpr int NJOBS = 15;
__device__ __forceinline__ TJob get_job(const Params& p, int j) {
    TJob t; t.scale = nullptr; t.dstk0 = 0; t.map = 0; t.nbatch = 1; t.sbs = 0; t.dbs = 0;
    unsigned char* ws = p.ws;
    switch (j) {
        case 0:  t.src = p.in[8];  t.dst = (bf16_t*)(ws + WS_WGU1); t.ldsrc = 2 * DFF; t.K = D; t.lddst = D; t.nrb = 176; t.map = 1; break;
        case 1:  t.src = p.in[9];  t.dst = (bf16_t*)(ws + WS_WDN1); t.ldsrc = D; t.K = DFF; t.lddst = DFF; t.nrb = 32; break;
        case 2:  t.src = p.in[10]; t.dst = (bf16_t*)(ws + WS_WINA); t.ldsrc = 4512; t.K = D; t.lddst = D; t.nrb = 80; t.map = 2; break;
        case 3:  t.src = p.in[10]; t.dst = (bf16_t*)(ws + WS_WINB); t.ldsrc = 4512; t.K = D; t.lddst = D; t.nrb = 64; t.map = 3; break;
        case 4:  t.src = p.in[13]; t.scale = p.in[11]; t.dst = (bf16_t*)(ws + WS_WQKV); t.ldsrc = 768; t.K = 256; t.lddst = 384; t.nrb = 24; break;
        case 5:  t.src = nullptr;  t.dst = (bf16_t*)(ws + WS_WQKV); t.ldsrc = 0; t.K = 128; t.lddst = 384; t.dstk0 = 256; t.nrb = 24; break;
        case 6:  t.src = p.in[14]; t.scale = p.in[12]; t.dst = (bf16_t*)(ws + WS_WQKV) + 768 * 384; t.ldsrc = 1024; t.K = 128; t.lddst = 384; t.dstk0 = 256; t.nrb = 32; t.map = 4; break;
        case 7:  t.src = nullptr;  t.dst = (bf16_t*)(ws + WS_WQKV) + 768 * 384; t.ldsrc = 0; t.K = 256; t.lddst = 384; t.nrb = 32; break;
        case 8:  t.src = p.in[15]; t.dst = (bf16_t*)(ws + WS_WAO); t.ldsrc = D; t.K = 512; t.lddst = 512; t.nrb = 32; break;
        case 9:  t.src = p.in[23]; t.dst = (bf16_t*)(ws + WS_WLO); t.ldsrc = D; t.K = D; t.lddst = D; t.nrb = 32; break;
        case 10: t.src = p.in[24]; t.dst = (bf16_t*)(ws + WS_WOUT); t.ldsrc = D; t.K = D; t.lddst = D; t.nrb = 32; break;
        case 11: t.src = p.in[25]; t.dst = (bf16_t*)(ws + WS_WGU2); t.ldsrc = 2 * DFF; t.K = D; t.lddst = D; t.nrb = 176; t.map = 1; break;
        case 12: t.src = p.in[26]; t.dst = (bf16_t*)(ws + WS_WDN2); t.ldsrc = D; t.K = DFF; t.lddst = DFF; t.nrb = 32; break;
        case 13: t.src = p.in[18]; t.dst = (bf16_t*)(ws + WS_WG); t.ldsrc = 128; t.K = 128; t.lddst = 128; t.nrb = 4; t.nbatch = 16; t.sbs = 16384; t.dbs = 32768; break;
        default: t.src = p.in[20]; t.dst = (bf16_t*)(ws + WS_WG) + 16384; t.ldsrc = 128; t.K = 128; t.lddst = 128; t.nrb = 4; t.nbatch = 16; t.sbs = 16384; t.dbs = 32768; break;
    }
    return t;
}
__device__ __forceinline__ int job_items(const TJob& t) { return t.nbatch * t.nrb * (t.K >> 6); }

__device__ __forceinline__ void tr_item(const TJob& jb, int item, LAS float* scr, int lane) {
    const int nkb = jb.K >> 6, per_batch = jb.nrb * nkb;
    const int bt = item / per_batch, r = item - bt * per_batch, rb = r / nkb, kb = r - rb * nkb;
    const int sc = srccol(jb.map, rb), k0 = 64 * kb;
    if (jb.src != nullptr && sc >= 0) {
        const float* src = jb.src + (size_t)bt * jb.sbs;
#pragma unroll 8
        for (int i = 0; i < 32; ++i) { const int kk = 2 * i + (lane >> 5);
            float v = src[(size_t)(k0 + kk) * jb.ldsrc + sc + (lane & 31)];
            if (jb.scale) v *= jb.scale[k0 + kk];
            scr[kk * 33 + (lane & 31)] = v; }
    } else {
#pragma unroll 8
        for (int i = 0; i < 32; ++i) { const int kk = 2 * i + (lane >> 5); scr[kk * 33 + (lane & 31)] = 0.f; }
    }
    asm volatile("s_waitcnt lgkmcnt(0)" ::: "memory");
    bf16_t* dst = jb.dst + (size_t)bt * jb.dbs;
    const int c = lane & 7;
#pragma unroll
    for (int j = 0; j < 4; ++j) { const int n = (lane >> 3) + 8 * j; const LAS float* s = scr + (8 * c) * 33 + n;
        u32x4 o; o.x = pk_bf16(s[0 * 33], s[1 * 33]); o.y = pk_bf16(s[2 * 33], s[3 * 33]); o.z = pk_bf16(s[4 * 33], s[5 * 33]); o.w = pk_bf16(s[6 * 33], s[7 * 33]);
        *(u32x4*)(dst + (size_t)(32 * rb + n) * jb.lddst + jb.dstk0 + k0 + 8 * c) = o; }
    asm volatile("s_waitcnt lgkmcnt(0)" ::: "memory");
}

__device__ __forceinline__ void phase_prep(const Params& p, LAS unsigned char* lds) {
    const int tid = threadIdx.x, lane = tid & 63, wave = tid >> 6;
    const int gw = blockIdx.x * NWAVES + wave, NGW = gridDim.x * NWAVES;
    {
        LAS float* scr = (LAS float*)(lds + wave * 8704);
        int base = 0;
        for (int j = 0; j < NJOBS; ++j) {
            const TJob jb = get_job(p, j); const int n = job_items(jb);
            int first = gw - (base % NGW); if (first < 0) first += NGW;
            for (int i = first; i < n; i += NGW) tr_item(jb, i, scr, lane);
            base += n;
        }
    }
    {
        const int gt = blockIdx.x * NTHREADS + tid;
        if (gt < SS * 16) {
            const int pos = gt >> 4, i = gt & 15;
            double inv = 1.0; for (int q = 0; q < i; ++q) inv *= 0.5623413251903491;
            const float ang = (float)pos * (float)inv;
            const double rev = (double)ang * 0.15915494309189535; const float fr = (float)(rev - rint(rev));
            ((float*)(p.ws + WS_ROPE))[gt] = __builtin_amdgcn_cosf(fr);
            ((float*)(p.ws + WS_ROPE))[SS * 16 + gt] = __builtin_amdgcn_sinf(fr);
        }
    }
    __syncthreads();
    for (int item = blockIdx.x; item < 144; item += gridDim.x) {
        LAS float* sc = (LAS float*)(lds) + wave * (128 * 33);
        for (int i = 0; i < 64; ++i) { const int idx = lane + 64 * i, kl = idx & 127, b = idx >> 7;
            const float cv = (b < 16 ? p.in[2] : p.in[3])[(b & 15) * D + 128 * wave + kl];
            sc[kl * 33 + b] = fsilu(cv); }
        asm volatile("s_waitcnt lgkmcnt(0)" ::: "memory");
        float acc[32];
#pragma unroll
        for (int b = 0; b < 32; ++b) acc[b] = 0.f;
        const float* W = p.in[4] + (size_t)(128 * wave) * 9216 + item * 64 + lane;
        for (int k = 0; k < 128; ++k) { const float wv = W[(size_t)k * 9216];
#pragma unroll
            for (int b = 0; b < 32; ++b) acc[b] += sc[k * 33 + b] * wv; }
        __syncthreads();
        LAS float* red = (LAS float*)(lds);
#pragma unroll
        for (int b = 0; b < 32; ++b) red[(wave * 32 + b) * 64 + lane] = acc[b];
        __syncthreads();
        for (int o = tid; o < 2048; o += NTHREADS) { const int b = o >> 6, col = o & 63; float s = 0.f;
#pragma unroll
            for (int w = 0; w < 8; ++w) s += red[(w * 32 + b) * 64 + col];
            const int j = item * 64 + col;
            ((float*)(p.ws + WS_MOD))[b * 9216 + j] = s + p.in[5][j]; }
        __syncthreads();
    }
}

template <bool HAS_F, bool HAS_H>
__device__ __forceinline__ void phase_rows(const Params& p, int sp, int sn, float resw, bool from_input) {
    const int tid = threadIdx.x, lane = tid & 63, wave = tid >> 6;
    const int gw = blockIdx.x * NWAVES + wave, NGW = gridDim.x * NWAVES;
    const float* mod = (const float*)(p.ws + WS_MOD);
    const bf16_t* F = (const bf16_t*)(p.ws + WS_F);
    bf16_t* H = (bf16_t*)(p.ws + WS_H);
    for (int row = gw; row < T; row += NGW) {
        const int b = row_batch(row);
        const float* xin = !from_input ? p.out + (size_t)row * D : (row < TP ? p.in[0] + (size_t)row * D : p.in[1] + (size_t)(row - TP) * D);
        f32x4 v[4];
#pragma unroll
        for (int j = 0; j < 4; ++j) v[j] = *(const f32x4*)(xin + 4 * lane + 256 * j);
        if (HAS_F) {
            f32x4 f[4]; float ss = 0.f;
#pragma unroll
            for (int j = 0; j < 4; ++j) { const u32x2 w = *(const u32x2*)(F + (size_t)row * D + 4 * lane + 256 * j);
                f[j] = (f32x4){lo_bf(w.x), hi_bf(w.x), lo_bf(w.y), hi_bf(w.y)}; ss += (f[j].x * f[j].x + f[j].y * f[j].y) + (f[j].z * f[j].z + f[j].w * f[j].w); }
            const float rs = 1.0f / sqrtf(wave_sum(ss) * (1.0f / D) + EPS) * resw;
            const float* gate = mod + b * 9216 + sp * 3072 + 2048; const float* gp = p.in[7] + sp * D;
#pragma unroll
            for (int j = 0; j < 4; ++j) { const f32x4 g = *(const f32x4*)(gate + 4 * lane + 256 * j), q = *(const f32x4*)(gp + 4 * lane + 256 * j);
                v[j] = v[j] + g * (f[j] * rs * q);
                *(f32x4*)(p.out + (size_t)row * D + 4 * lane + 256 * j) = v[j]; }
        }
        if (HAS_H) {
            float ss = 0.f;
#pragma unroll
            for (int j = 0; j < 4; ++j) ss += (v[j].x * v[j].x + v[j].y * v[j].y) + (v[j].z * v[j].z + v[j].w * v[j].w);
            const float rs = 1.0f / sqrtf(wave_sum(ss) * (1.0f / D) + EPS);
            const float* sh = mod + b * 9216 + sn * 3072; const float* scl = sh + 1024; const float* gq = p.in[6] + sn * D;
#pragma unroll
            for (int j = 0; j < 4; ++j) { const f32x4 a = *(const f32x4*)(sh + 4 * lane + 256 * j), s = *(const f32x4*)(scl + 4 * lane + 256 * j), q = *(const f32x4*)(gq + 4 * lane + 256 * j);
                const f32x4 h = (v[j] * rs * q) * (s + 1.0f) + a;
                u32x2 w; w.x = pk_bf16(h.x, h.y); w.y = pk_bf16(h.z, h.w);
                *(u32x2*)(H + (size_t)row * D + 4 * lane + 256 * j) = w; }
        }
    }
}

__device__ __forceinline__ void phase_stats(const Params& p) {
    const int tid = threadIdx.x, lane = tid & 63, wave = tid >> 6;
    const int gw = blockIdx.x * NWAVES + wave, NGW = gridDim.x * NWAVES;
    const bf16_t* ZQ = (const bf16_t*)(p.ws + WS_ZQ);
    float* stats = (float*)(p.ws + WS_STATS); bf16_t* KR = (bf16_t*)(p.ws + WS_KR);
    const float* rc = (const float*)(p.ws + WS_ROPE); const float* rsn = rc + SS * 16;
    for (int row = gw; row < T; row += NGW) {
        const u32x4 w = *(const u32x4*)(ZQ + (size_t)row * 512 + 8 * lane);
        float x[8] = {lo_bf(w.x), hi_bf(w.x), lo_bf(w.y), hi_bf(w.y), lo_bf(w.z), hi_bf(w.z), lo_bf(w.w), hi_bf(w.w)};
        float ss = 0.f;
#pragma unroll
        for (int e = 0; e < 8; ++e) ss += x[e] * x[e];
        const float sq = wave_sum(lane < 32 ? ss : 0.f), skv = wave_sum((lane >= 32 && lane < 48) ? ss : 0.f);
        if (lane == 0) { f32x2 st; st.x = 1.0f / sqrtf(sq * (1.0f / 256.0f) + EPS); st.y = 1.0f / sqrtf(skv * (1.0f / 128.0f) + EPS); *(f32x2*)(stats + 2 * row) = st; }
        float y[8];
#pragma unroll
        for (int e = 0; e < 8; ++e) y[e] = __shfl_xor(x[e], 2);
        if (lane >= 48 && lane < 52) {
            const int pos = row_pos(row), i0 = 8 * (lane & 1);
            const f32x4 c0 = *(const f32x4*)(rc + pos * 16 + i0), c1 = *(const f32x4*)(rc + pos * 16 + i0 + 4);
            const f32x4 s0 = *(const f32x4*)(rsn + pos * 16 + i0), s1 = *(const f32x4*)(rsn + pos * 16 + i0 + 4);
            const float c[8] = {c0.x, c0.y, c0.z, c0.w, c1.x, c1.y, c1.z, c1.w}, s[8] = {s0.x, s0.y, s0.z, s0.w, s1.x, s1.y, s1.z, s1.w};
            float o[8];
            const bool first = lane < 50;
#pragma unroll
            for (int e = 0; e < 8; ++e) o[e] = first ? (x[e] * c[e] - y[e] * s[e]) : (x[e] * c[e] + y[e] * s[e]);
            u32x4 ow; ow.x = pk_bf16(o[0], o[1]); ow.y = pk_bf16(o[2], o[3]); ow.z = pk_bf16(o[4], o[5]); ow.w = pk_bf16(o[6], o[7]);
            *(u32x4*)(KR + (size_t)row * 32 + 8 * (lane - 48)) = ow;
        }
    }
}

constexpr int XC_PITCH = 272;
__device__ __forceinline__ void phase_lru(const Params& p, LAS unsigned char* lds) {
    const int tid = threadIdx.x, lane = tid & 63, wave = __builtin_amdgcn_readfirstlane(tid >> 6), g = lane >> 4, lc = lane & 15;
    const bf16_t* XL = (const bf16_t*)(p.ws + WS_XL); bf16_t* GY = (bf16_t*)(p.ws + WS_GY); bf16_t* HF = (bf16_t*)(p.ws + WS_F);
    const bf16_t* WG = (const bf16_t*)(p.ws + WS_WG);
    for (int item = blockIdx.x; item < 256; item += gridDim.x) {
        int gb, n;
        if (item < 128) { gb = 16 + (item >> 3); n = item & 7; } else { gb = (item - 128) >> 3; n = item & 7; }
        const int S = gb < 16 ? SP : SS; const int row0 = gb < 16 ? gb * SP : TP + (gb - 16) * SS;
        const int nch = S >> 6;
        const int tr = tid >> 4, cgp = (tid & 15) * 8, c0 = 128 * n + cgp;
        float cw[4][8], cb[8];
#pragma unroll
        for (int j = 0; j < 4; ++j) { const f32x4 a = *(const f32x4*)(p.in[16] + j * D + c0), b = *(const f32x4*)(p.in[16] + j * D + c0 + 4);
            cw[j][0] = a.x; cw[j][1] = a.y; cw[j][2] = a.z; cw[j][3] = a.w; cw[j][4] = b.x; cw[j][5] = b.y; cw[j][6] = b.z; cw[j][7] = b.w; }
        { const f32x4 a = *(const f32x4*)(p.in[17] + c0), b = *(const f32x4*)(p.in[17] + c0 + 4);
            cb[0] = a.x; cb[1] = a.y; cb[2] = a.z; cb[3] = a.w; cb[4] = b.x; cb[5] = b.y; cb[6] = b.z; cb[7] = b.w; }
        const int ch = 128 * n + 16 * wave + lc;
        for (int d = 0; d < 2; ++d) {
            bf16x8 Ba[4], Bi[4];
            { const bf16_t* wa = WG + (size_t)((d * 8 + n) * 2 + 0) * 16384 + (size_t)(16 * wave + lc) * 128 + 8 * g; const bf16_t* wi = wa + 16384;
#pragma unroll
              for (int ks = 0; ks < 4; ++ks) { Ba[ks] = *(const bf16x8*)(wa + 32 * ks); Bi[ks] = *(const bf16x8*)(wi + 32 * ks); } }
            const float ba = p.in[19][d * D + ch], bi = p.in[21][d * D + ch];
            const float lam = p.in[22][d * D + ch];
            const float c8 = -8.0f * log1pf(expf(-lam));
            float carry = 0.f;
            for (int ci = 0; ci < nch; ++ci) {
                const int cc = d ? (nch - 1 - ci) : ci, t0 = cc * 64;
                __syncthreads();
#pragma unroll
                for (int hf = 0; hf < 2; ++hf) {
                    const int tl = tr + 32 * hf, t = t0 + tl;
                    float a[8];
#pragma unroll
                    for (int e = 0; e < 8; ++e) a[e] = cb[e];
#pragma unroll
                    for (int j = 0; j < 4; ++j) { const int tt = t + j - 1;
                        if (tt >= 0 && tt < S) { const u32x4 w = *(const u32x4*)(XL + (size_t)(row0 + tt) * D + c0);
                            a[0] += cw[j][0] * lo_bf(w.x); a[1] += cw[j][1] * hi_bf(w.x); a[2] += cw[j][2] * lo_bf(w.y); a[3] += cw[j][3] * hi_bf(w.y);
                            a[4] += cw[j][4] * lo_bf(w.z); a[5] += cw[j][5] * hi_bf(w.z); a[6] += cw[j][6] * lo_bf(w.w); a[7] += cw[j][7] * hi_bf(w.w); } }
                    u32x4 o; o.x = pk_bf16(a[0], a[1]); o.y = pk_bf16(a[2], a[3]); o.z = pk_bf16(a[4], a[5]); o.w = pk_bf16(a[6], a[7]);
                    *(LAS u32x4*)(lds + tl * XC_PITCH + cgp * 2) = o;
                }
                __syncthreads();
                float hfv[4][4], gyv[4][4];
                if (d == 1) {
#pragma unroll
                    for (int mt = 0; mt < 4; ++mt)
#pragma unroll
                        for (int j = 0; j < 4; ++j) { const size_t off = (size_t)(row0 + t0 + 16 * mt + 4 * g + j) * D + ch; hfv[mt][j] = bf2f(HF[off]); gyv[mt][j] = bf2f(GY[off]); }
                }
                f32x4 aa[4], ai[4];
#pragma unroll
                for (int mt = 0; mt < 4; ++mt) { aa[mt] = (f32x4){0.f, 0.f, 0.f, 0.f}; ai[mt] = (f32x4){0.f, 0.f, 0.f, 0.f}; }
#pragma unroll
                for (int ks = 0; ks < 4; ++ks)
#pragma unroll
                    for (int mt = 0; mt < 4; ++mt) { const bf16x8 A = *(const LAS bf16x8*)(lds + (16 * mt + lc) * XC_PITCH + (32 * ks + 8 * g) * 2);
                        aa[mt] = __builtin_amdgcn_mfma_f32_16x16x32_bf16(A, Ba[ks], aa[mt], 0, 0, 0);
                        ai[mt] = __builtin_amdgcn_mfma_f32_16x16x32_bf16(A, Bi[ks], ai[mt], 0, 0, 0); }
#pragma unroll
                for (int mt = 0; mt < 4; ++mt)
#pragma unroll
                    for (int j = 0; j < 4; ++j) {
                        const float xcv = bf2f(*(const LAS bf16_t*)(lds + (16 * mt + 4 * g + j) * XC_PITCH + (16 * wave + lc) * 2));
                        const float r = fsigmoid(aa[mt][j] + ba), ig = fsigmoid(ai[mt][j] + bi);
                        const float la = c8 * r;
                        const float av = fexp(la), om = (1.0f - av) * (1.0f + av);
                        aa[mt][j] = av; ai[mt][j] = sqrtf(om) * (ig * xcv);
                    }
                if (d == 0) {
#pragma unroll
                    for (int mt = 0; mt < 4; ++mt) {
                        float P = 1.f, Hh = 0.f, pl[4], hl[4];
#pragma unroll
                        for (int j = 0; j < 4; ++j) { Hh = aa[mt][j] * Hh + ai[mt][j]; P *= aa[mt][j]; hl[j] = Hh; pl[j] = P; }
                        float A = P, Hs = Hh;
                        { const float A1 = __shfl_up(A, 16), H1 = __shfl_up(Hs, 16); if (g >= 1) { Hs = A * H1 + Hs; A = A * A1; } }
                        { const float A2 = __shfl_up(A, 32), H2 = __shfl_up(Hs, 32); if (g >= 2) { Hs = A * H2 + Hs; A = A * A2; } }
                        float Aex = __shfl_up(A, 16), Hex = __shfl_up(Hs, 16); if (g == 0) { Aex = 1.f; Hex = 0.f; }
                        const float cin = Aex * carry + Hex;
                        const float At = __shfl(A, 48 + lc), Ht = __shfl(Hs, 48 + lc);
                        carry = At * carry + Ht;
#pragma unroll
                        for (int j = 0; j < 4; ++j) { const float h = hl[j] + pl[j] * cin;
                            HF[(size_t)(row0 + t0 + 16 * mt + 4 * g + j) * D + ch] = (bf16_t)(pk_bf16(h, 0.f) & 0xffffu); }
                    }
                } else {
#pragma unroll
                    for (int mt = 3; mt >= 0; --mt) {
                        float P = 1.f, Hh = 0.f, pl[4], hl[4];
#pragma unroll
                        for (int j = 3; j >= 0; --j) { Hh = aa[mt][j] * Hh + ai[mt][j]; P *= aa[mt][j]; hl[j] = Hh; pl[j] = P; }
                        float A = P, Hs = Hh;
                        { const float A1 = __shfl_down(A, 16), H1 = __shfl_down(Hs, 16); if (g <= 2) { Hs = A * H1 + Hs; A = A * A1; } }
                        { const float A2 = __shfl_down(A, 32), H2 = __shfl_down(Hs, 32); if (g <= 1) { Hs = A * H2 + Hs; A = A * A2; } }
                        float Aex = __shfl_down(A, 16), Hex = __shfl_down(Hs, 16); if (g == 3) { Aex = 1.f; Hex = 0.f; }
                        const float cin = Aex * carry + Hex;
                        const float At = __shfl(A, lc), Ht = __shfl(Hs, lc);
                        carry = At * carry + Ht;
#pragma unroll
                        for (int j = 0; j < 4; ++j) { const float h = hl[j] + pl[j] * cin;
                            const size_t off = (size_t)(row0 + t0 + 16 * mt + 4 * g + j) * D + ch;
                            const float o = (hfv[mt][j] + h) * gyv[mt][j];
                            GY[off] = (bf16_t)(pk_bf16(o, 0.f) & 0xffffu); }
                    }
                }
            }
        }
        __syncthreads();
    }
}

constexpr int AK_PITCH = 208, AV_PITCH = 160, AK_BYTES = 64 * AK_PITCH, AV_BYTES = 64 * AV_PITCH, ABUF = AK_BYTES + AV_BYTES;
__device__ __forceinline__ void phase_attn(const Params& p, LAS unsigned char* lds) {
    const int tid = threadIdx.x, lane = tid & 63, wave = __builtin_amdgcn_readfirstlane(tid >> 6), g = lane >> 4, lc = lane & 15;
    const bf16_t* Q = (const bf16_t*)(p.ws + WS_F); const bf16_t* KN = (const bf16_t*)(p.ws + WS_XL); const bf16_t* V = KN + (size_t)T * NKV;
    const bf16_t* KR = (const bf16_t*)(p.ws + WS_KR); bf16_t* O = (bf16_t*)(p.ws + WS_ZQ);
    const float csc = 0.10206207261596577f * 1.4426950408889634f;
    const int srow = tid >> 3, sch = tid & 7;
    const int rrow = (tid & 255) >> 2, rch = tid & 3;
    const int vtr = (4 * g + (lc >> 2)) * AV_PITCH + (4 * (lc & 3)) * 2;
    for (int unit = blockIdx.x; unit < 3072; unit += gridDim.x) {
        int gb, h, qt, S, row0;
        if (unit < 2048) { gb = 16 + (unit >> 7); h = (unit & 127) >> 4; qt = unit & 15; S = SS; row0 = TP + (gb - 16) * SS; }
        else { const int u2 = unit - 2048; gb = u2 >> 6; h = (u2 & 63) >> 3; qt = u2 & 7; S = SP; row0 = gb * SP; }
        const int nkt = S >> 6;
        const int qrow = row0 + 256 * qt + 32 * wave;
        bf16x8 qf[2][3];
#pragma unroll
        for (int q2 = 0; q2 < 2; ++q2)
#pragma unroll
            for (int ks = 0; ks < 3; ++ks) qf[q2][ks] = *(const bf16x8*)(Q + (size_t)(qrow + 16 * q2 + lc) * NQ + 96 * h + 32 * ks + 8 * g);
#pragma unroll
        for (int q2 = 0; q2 < 2; ++q2) {
            const int pos = row_pos(qrow + 16 * q2 + lc), i0 = 8 * (g & 1);
            const float* rc = (const float*)(p.ws + WS_ROPE) + pos * 16 + i0; const float* rsn = rc + SS * 16;
            const f32x4 c0 = *(const f32x4*)rc, c1 = *(const f32x4*)(rc + 4), s0 = *(const f32x4*)rsn, s1 = *(const f32x4*)(rsn + 4);
            const float cc[8] = {c0.x, c0.y, c0.z, c0.w, c1.x, c1.y, c1.z, c1.w}, sn[8] = {s0.x, s0.y, s0.z, s0.w, s1.x, s1.y, s1.z, s1.w};
            const u32x4 mine = __builtin_bit_cast(u32x4, qf[q2][2]);
            u32x4 oth; oth.x = __shfl_xor(mine.x, 32); oth.y = __shfl_xor(mine.y, 32); oth.z = __shfl_xor(mine.z, 32); oth.w = __shfl_xor(mine.w, 32);
            const float xm[8] = {lo_bf(mine.x), hi_bf(mine.x), lo_bf(mine.y), hi_bf(mine.y), lo_bf(mine.z), hi_bf(mine.z), lo_bf(mine.w), hi_bf(mine.w)};
            const float xo[8] = {lo_bf(oth.x), hi_bf(oth.x), lo_bf(oth.y), hi_bf(oth.y), lo_bf(oth.z), hi_bf(oth.z), lo_bf(oth.w), hi_bf(oth.w)};
            float o[8];
#pragma unroll
            for (int e = 0; e < 8; ++e) o[e] = g < 2 ? (xm[e] * cc[e] - xo[e] * sn[e]) : (xm[e] * cc[e] + xo[e] * sn[e]);
            u32x4 w; w.x = pk_bf16(o[0], o[1]); w.y = pk_bf16(o[2], o[3]); w.z = pk_bf16(o[4], o[5]); w.w = pk_bf16(o[6], o[7]);
            qf[q2][2] = __builtin_bit_cast(bf16x8, w);
        }
        f32x4 oacc[4][2];
#pragma unroll
        for (int dt = 0; dt < 4; ++dt) { oacc[dt][0] = (f32x4){0.f, 0.f, 0.f, 0.f}; oacc[dt][1] = (f32x4){0.f, 0.f, 0.f, 0.f}; }
        float mrun[2] = {-1e30f, -1e30f}, lrun[2] = {0.f, 0.f};
        u32x4 gk, gr, gv;
        gk = *(const u32x4*)(KN + (size_t)(row0 + srow) * NKV + 64 * h + 8 * sch);
        gv = *(const u32x4*)(V + (size_t)(row0 + srow) * NKV + 64 * h + 8 * sch);
        gr = *(const u32x4*)(KR + (size_t)(row0 + rrow) * 32 + 8 * rch);
        __syncthreads();
        *(LAS u32x4*)(lds + srow * AK_PITCH + sch * 16) = gk;
        *(LAS u32x4*)(lds + AK_BYTES + srow * AV_PITCH + sch * 16) = gv;
        if (tid < 256) *(LAS u32x4*)(lds + rrow * AK_PITCH + 128 + rch * 16) = gr;
        __syncthreads();
        for (int kt = 0; kt < nkt; ++kt) {
            LAS unsigned char* kb = lds + (kt & 1) * ABUF; LAS unsigned char* vb = kb + AK_BYTES;
            LAS unsigned char* nb = lds + ((kt + 1) & 1) * ABUF;
            const bool more = kt + 1 < nkt;
            if (more) { const int kr0 = row0 + 64 * (kt + 1);
                gk = *(const u32x4*)(KN + (size_t)(kr0 + srow) * NKV + 64 * h + 8 * sch);
                gv = *(const u32x4*)(V + (size_t)(kr0 + srow) * NKV + 64 * h + 8 * sch);
                gr = *(const u32x4*)(KR + (size_t)(kr0 + rrow) * 32 + 8 * rch); }
            f32x4 sacc[4][2];
#pragma unroll
            for (int k4 = 0; k4 < 4; ++k4) { sacc[k4][0] = (f32x4){0.f, 0.f, 0.f, 0.f}; sacc[k4][1] = (f32x4){0.f, 0.f, 0.f, 0.f}; }
#pragma unroll
            for (int ks = 0; ks < 3; ++ks)
#pragma unroll
                for (int k4 = 0; k4 < 4; ++k4) { const bf16x8 kf = *(const LAS bf16x8*)(kb + (16 * k4 + lc) * AK_PITCH + (32 * ks + 8 * g) * 2);
                    sacc[k4][0] = __builtin_amdgcn_mfma_f32_16x16x32_bf16(kf, qf[0][ks], sacc[k4][0], 0, 0, 0);
                    sacc[k4][1] = __builtin_amdgcn_mfma_f32_16x16x32_bf16(kf, qf[1][ks], sacc[k4][1], 0, 0, 0); }
            bf16x8 pf[2][2];
#pragma unroll
            for (int q2 = 0; q2 < 2; ++q2) {
                float mx = sacc[0][q2][0];
#pragma unroll
                for (int k4 = 0; k4 < 4; ++k4)
#pragma unroll
                    for (int j = 0; j < 4; ++j) mx = fmaxf(mx, sacc[k4][q2][j]);
                mx = fmaxf(mx, __shfl_xor(mx, 16)); mx = fmaxf(mx, __shfl_xor(mx, 32));
                const float mnew = fmaxf(mrun[q2], mx * csc);
                const float alpha = __builtin_amdgcn_exp2f(mrun[q2] - mnew);
                mrun[q2] = mnew;
                float ps = 0.f; float pv[4][4];
#pragma unroll
                for (int k4 = 0; k4 < 4; ++k4)
#pragma unroll
                    for (int j = 0; j < 4; ++j) { const float e = __builtin_amdgcn_exp2f(sacc[k4][q2][j] * csc - mnew); pv[k4][j] = e; ps += e; }
                lrun[q2] = lrun[q2] * alpha + ps;
#pragma unroll
                for (int dt = 0; dt < 4; ++dt) oacc[dt][q2] *= alpha;
#pragma unroll
                for (int kk = 0; kk < 2; ++kk) {
                    u32x4 w; w.x = pk_bf16(pv[2 * kk][0], pv[2 * kk][1]); w.y = pk_bf16(pv[2 * kk][2], pv[2 * kk][3]);
                    w.z = pk_bf16(pv[2 * kk + 1][0], pv[2 * kk + 1][1]); w.w = pk_bf16(pv[2 * kk + 1][2], pv[2 * kk + 1][3]);
                    pf[q2][kk] = __builtin_bit_cast(bf16x8, w);
                }
            }
#pragma unroll
            for (int kk = 0; kk < 2; ++kk)
#pragma unroll
                for (int dt = 0; dt < 4; ++dt) {
                    const v4i16_t lo = __builtin_amdgcn_ds_read_tr16_b64_v4i16((LAS v4i16_t*)(vb + vtr + (32 * kk) * AV_PITCH + 32 * dt));
                    const v4i16_t hi = __builtin_amdgcn_ds_read_tr16_b64_v4i16((LAS v4i16_t*)(vb + vtr + (32 * kk + 16) * AV_PITCH + 32 * dt));
                    const bf16x8 vf = {lo[0], lo[1], lo[2], lo[3], hi[0], hi[1], hi[2], hi[3]};
                    oacc[dt][0] = __builtin_amdgcn_mfma_f32_16x16x32_bf16(vf, pf[0][kk], oacc[dt][0], 0, 0, 0);
                    oacc[dt][1] = __builtin_amdgcn_mfma_f32_16x16x32_bf16(vf, pf[1][kk], oacc[dt][1], 0, 0, 0);
                }
            if (more) {
                *(LAS u32x4*)(nb + srow * AK_PITCH + sch * 16) = gk;
                *(LAS u32x4*)(nb + AK_BYTES + srow * AV_PITCH + sch * 16) = gv;
                if (tid < 256) *(LAS u32x4*)(nb + rrow * AK_PITCH + 128 + rch * 16) = gr;
            }
            __syncthreads();
        }
#pragma unroll
        for (int q2 = 0; q2 < 2; ++q2) {
            float l = lrun[q2]; l += __shfl_xor(l, 16); l += __shfl_xor(l, 32);
            const float inv = 1.0f / l;
#pragma unroll
            for (int dt = 0; dt < 4; ++dt) { const f32x4 o = oacc[dt][q2] * inv;
                u32x2 w; w.x = pk_bf16(o[0], o[1]); w.y = pk_bf16(o[2], o[3]);
                *(u32x2*)(O + (size_t)(qrow + 16 * q2 + lc) * 512 + 64 * h + 16 * dt + 4 * g) = w; }
        }
    }
    __syncthreads();
}

constexpr int NPHASES = 16;
__global__ void __launch_bounds__(NTHREADS, 2) mega_fwd(Params p) {
    extern __shared__ __attribute__((aligned(16))) unsigned char lds_raw[];
    LAS unsigned char* lds = (LAS unsigned char*)lds_raw;
    cg::grid_group grid = cg::this_grid();
    unsigned char* ws = p.ws;
    const int G = gridDim.x, bid = blockIdx.x;
    bf16_t* Hb = (bf16_t*)(ws + WS_H); bf16_t* Fb = (bf16_t*)(ws + WS_F); bf16_t* ACT = (bf16_t*)(ws + WS_ACT);
    bf16_t* ZQ = (bf16_t*)(ws + WS_ZQ); bf16_t* XL = (bf16_t*)(ws + WS_XL); bf16_t* GY = (bf16_t*)(ws + WS_GY);
#ifndef TESTPH
#define TESTPH -1
#endif
#define IN(k) ((TESTPH < 0 || (k) == TESTPH) && p.ph_lo <= (k) && (k) < p.ph_hi)
#define SEAM(k) do { if (IN(k) && IN((k) + 1)) { __builtin_amdgcn_fence(__ATOMIC_RELEASE, "agent"); asm volatile("s_waitcnt vmcnt(0) lgkmcnt(0)" ::: "memory"); \
        grid.sync(); __builtin_amdgcn_fence(__ATOMIC_ACQUIRE, "agent"); asm volatile("s_waitcnt vmcnt(0) lgkmcnt(0)" ::: "memory"); } } while (0)
    if (IN(0)) phase_prep(p, lds);
    SEAM(0);
    if (IN(1)) phase_rows<false, true>(p, 0, 0, 0.f, true);
    SEAM(1);
#define FFN_PHASES(ffn, pb) do { \
        if (IN(pb)) { \
            pg8::Gemm g{Hb, (const bf16_t*)(ws + ((ffn) ? WS_WGU2 : WS_WGU1)), D, D}; pg8::StaticOrder S; S.init(T, 2 * DFF, G, bid); \
            pg8::EpiSwiglu E{ACT, DFF}; \
            GEMM_PHASE(pg8::EpiSwiglu, lds, g, S, E); \
        } \
        SEAM(pb); \
        if (IN((pb) + 1)) { \
            pg8::Gemm g{ACT, (const bf16_t*)(ws + ((ffn) ? WS_WDN2 : WS_WDN1)), DFF, DFF}; pg8::StaticOrder S; S.init(T, D, G, bid); \
            pg8::EpiAct<0> E{Fb, D, 0}; \
            GEMM_PHASE(pg8::EpiAct<0>, lds, g, S, E); \
        } \
        SEAM((pb) + 1); } while (0)
    FFN_PHASES(0, 2);
        if (IN(4)) phase_rows<true, true>(p, 0, 1, 0.5f, true);
        SEAM(4);
        if (IN(5)) {
            pg8::Gemm g{Hb, (const bf16_t*)(ws + WS_WINA), D, D}; pg8::StaticOrder S; S.init(T, 2560, G, bid);
            pg8::EpiWinA E{ZQ, XL, GY};
            GEMM_PHASE(pg8::EpiWinA, lds, g, S, E);
        }
        SEAM(5);
        if (IN(6)) { phase_stats(p); phase_lru(p, lds); }
        SEAM(6);
        if (IN(7)) {
            pg8::Gemm g{ZQ, (const bf16_t*)(ws + WS_WQKV), 512, 384}; pg8::StaticOrder S; S.init(T, 1792, G, bid);
            pg8::EpiQKV E{Fb, XL, (const float*)(ws + WS_STATS)};
            GEMM_PHASE2(pg8::EpiQKV, lds, g, S, E);
        }
        SEAM(7);
        if (IN(8)) phase_attn(p, lds);
        SEAM(8);
        if (IN(9)) {
            pg8::Gemm g{Hb, (const bf16_t*)(ws + WS_WINB), D, D}; pg8::StaticOrder S; S.init(T, 2048, G, bid);
            pg8::EpiWinB E{Fb, XL};
            GEMM_PHASE(pg8::EpiWinB, lds, g, S, E);
        }
        SEAM(9);
        if (IN(10)) {
            { pg8::Gemm g{ZQ, (const bf16_t*)(ws + WS_WAO), 512, 512}; pg8::StaticOrder S; S.init(T, D, G, bid);
              pg8::EpiGate<false> E{Fb, nullptr, Fb};
              GEMM_PHASE(pg8::EpiGate<false>, lds, g, S, E); }
            { pg8::Gemm g{GY, (const bf16_t*)(ws + WS_WLO), D, D}; pg8::StaticOrder S; S.init(T, D, G, bid);
              pg8::EpiGate<true> E{XL, Fb, XL};
              GEMM_PHASE(pg8::EpiGate<true>, lds, g, S, E); }
        }
        SEAM(10);
        if (IN(11)) {
            pg8::Gemm g{XL, (const bf16_t*)(ws + WS_WOUT), D, D}; pg8::StaticOrder S; S.init(T, D, G, bid);
            pg8::EpiAct<0> E{Fb, D, 0};
            GEMM_PHASE(pg8::EpiAct<0>, lds, g, S, E);
        }
        SEAM(11);
        if (IN(12)) phase_rows<true, true>(p, 1, 2, 1.0f, false);
        SEAM(12);
    FFN_PHASES(1, 13);
    if (IN(15)) phase_rows<true, false>(p, 2, 0, 0.5f, false);
#undef IN
#undef SEAM
}

extern "C" void kernel_launch(void* const* d_in, const int* in_sizes, int n_in, void* d_out, int out_size, void* d_ws, size_t ws_size, hipStream_t stream) {
    static int grid = 0;
    if (grid == 0) {
        if (n_in != 27 || out_size != T * D || ws_size < WS_END) { fprintf(stderr, "kernel_launch: unexpected shapes: n_in %d out %d ws %zu (need >= %zu)\n", n_in, out_size, ws_size, (size_t)WS_END); grid = -1; return; }
        int dev = 0, cus = 0, per_cu = 0;
        (void)hipGetDevice(&dev);
        (void)hipDeviceGetAttribute(&cus, hipDeviceAttributeMultiprocessorCount, dev);
        if (hipFuncSetAttribute((const void*)mega_fwd, hipFuncAttributeMaxDynamicSharedMemorySize, LDS_BYTES) != hipSuccess) { fprintf(stderr, "kernel_launch: hipFuncSetAttribute failed\n"); grid = -1; return; }
        if (hipOccupancyMaxActiveBlocksPerMultiprocessor(&per_cu, (const void*)mega_fwd, NTHREADS, LDS_BYTES) != hipSuccess || per_cu < 1) { fprintf(stderr, "kernel_launch: occupancy query failed (%d)\n", per_cu); per_cu = 1; }
        (void)hipGetLastError();
        grid = cus;
        fprintf(stderr, "kernel_launch: grid %d (per_cu %d)\n", grid, per_cu);
    }
    if (grid < 0) return;
    Params p{};
    for (int i = 0; i < 27; ++i) p.in[i] = (const float*)d_in[i];
    p.out = (float*)d_out; p.ws = (unsigned char*)d_ws;
#if defined(MK_SPLIT)
    for (int ph = 0; ph < NPHASES; ++ph) { p.ph_lo = ph; p.ph_hi = ph + 1;
        hipLaunchKernelGGL(mega_fwd, dim3(grid), dim3(NTHREADS), LDS_BYTES, stream, p); }
#else
    p.ph_lo = 0; p.ph_hi = NPHASES;
    void* args[] = {&p};
    hipError_t e = hipLaunchCooperativeKernel((const void*)mega_fwd, dim3(grid), dim3(NTHREADS), args, LDS_BYTES, stream);
    if (e != hipSuccess) fprintf(stderr, "kernel_launch: cooperative launch failed: %s (grid %d)\n", hipGetErrorString(e), grid);
#endif
}
```

```cpp
#include <hip/hip_runtime.h>
#include <hip/hip_cooperative_groups.h>
#include <cstdio>
#include <cstdint>
namespace cg = cooperative_groups;
#ifndef MK_SP2_ALL
#define MK_SP2_ALL false
#endif

#define LAS __attribute__((address_space(3)))
typedef unsigned short bf16_t;
typedef short bf16x8 __attribute__((ext_vector_type(8)));
typedef short v4i16_t __attribute__((ext_vector_type(4)));
typedef float f32x4 __attribute__((ext_vector_type(4)));
typedef float f32x2 __attribute__((ext_vector_type(2)));
typedef unsigned u32x4 __attribute__((ext_vector_type(4)));
typedef unsigned u32x2 __attribute__((ext_vector_type(2)));

constexpr int D = 1024, DFF = 2816, TP = 32768, TS = 65536, T = TP + TS, SP = 2048, SS = 4096;
constexpr int NQ = 768, NKV = 512;
constexpr float EPS = 1e-6f;
constexpr int NTHREADS = 512, NWAVES = 8;

constexpr size_t KiB = 1024, MiB = 1024 * 1024;
constexpr size_t WS_WGU1 = 0, WS_WDN1 = 11 * MiB, WS_WINA = 16 * MiB + 512 * KiB, WS_WINB = 21 * MiB + 512 * KiB, WS_WQKV = 25 * MiB + 512 * KiB,
                 WS_WAO = 27 * MiB, WS_WLO = 28 * MiB, WS_WOUT = 30 * MiB, WS_WGU2 = 32 * MiB, WS_WDN2 = 43 * MiB, WS_WG = 48 * MiB + 512 * KiB,
                 WS_MOD = 49 * MiB + 512 * KiB, WS_ROPE = 50 * MiB + 768 * KiB, WS_STATS = 51 * MiB + 256 * KiB, WS_KR = 52 * MiB;
constexpr size_t WS_H = 64 * MiB, WS_F = 256 * MiB, WS_BIG = 448 * MiB;
constexpr size_t WS_ZQ = WS_BIG, WS_XL = WS_BIG + 96 * MiB, WS_GY = WS_BIG + 288 * MiB, WS_ACT = WS_BIG, WS_END = 976 * MiB;
constexpr int LDS_BYTES = 139264;

struct Params { const float* in[27]; float* out; unsigned char* ws; int ph_lo, ph_hi; };

typedef __bf16 bf16x2_t __attribute__((ext_vector_type(2)));
__device__ __forceinline__ unsigned pk_bf16(float lo, float hi) { const f32x2 v = {lo, hi}; const bf16x2_t b = __builtin_convertvector(v, bf16x2_t); return __builtin_bit_cast(unsigned, b); }
__device__ __forceinline__ float lo_bf(unsigned w) { return __uint_as_float(w << 16); }
__device__ __forceinline__ float hi_bf(unsigned w) { return __uint_as_float(w & 0xffff0000u); }
__device__ __forceinline__ float bf2f(bf16_t h) { return __uint_as_float((unsigned)h << 16); }
__device__ __forceinline__ float fexp(float x) { return __builtin_amdgcn_exp2f(x * 1.4426950408889634f); }
__device__ __forceinline__ float fsigmoid(float x) { return __builtin_amdgcn_rcpf(1.0f + fexp(-x)); }
__device__ __forceinline__ float fsilu(float x) { return x * fsigmoid(x); }
__device__ __forceinline__ float fgelu(float x) { return x * fsigmoid(1.5957691216057308f * (x + 0.044715f * x * x * x)); }
__device__ __forceinline__ float wave_sum(float v) {
#pragma unroll
    for (int o = 1; o < 64; o <<= 1) v += __shfl_xor(v, o);
    return v;
}
__device__ __forceinline__ int row_batch(int row) { return row < TP ? (row >> 11) : 16 + ((row - TP) >> 12); }
__device__ __forceinline__ int row_pos(int row) { return row < TP ? (row & (SP - 1)) : ((row - TP) & (SS - 1)); }

namespace pg8 {
constexpr int BM = 256, BK = 64, HALF = 128, HTB = HALF * BK * 2, STAGE_BYTES = 8 * HTB, NXCD = 8, WGM = 8;
__host__ __device__ __forceinline__ int lds_byte(int r, int c) { const int st = (r >> 4) * 2 + (c >> 5), rr = r & 15, cc = c & 31, ob = rr * 64 + cc * 2; return st * 1024 + (ob ^ (((ob >> 9) & 1) << 5)); }
__host__ __device__ __forceinline__ void stage_rc(int b, int& R, int& C) { const int st = b / 1024, sb = b % 1024, swz = sb ^ (((sb >> 9) & 1) << 5); R = (st >> 1) * 16 + swz / 64; C = (st & 1) * 32 + (swz % 64) / 2; }
__host__ __device__ __forceinline__ int perm32(int rho) { const int n = rho >> 4, i = rho & 15; return 8 * (i >> 2) + 4 * n + (i & 3); }

struct Unit { int pm, pn; };
struct Gemm { const bf16_t* A; const bf16_t* Bt; int lda, K; };

struct StaticOrder {
    int nM, nN, nwg, G, c;
    __device__ void init(int M, int N, int G_, int c_) { nM = M / BM; nN = N / BM; nwg = nM * nN; G = G_; c = c_; }
    __device__ bool next(int i, Unit& u) const {
        const long L = (long)i * G + c; if (L >= nwg) return false;
        int wgid = (int)L; { const int q = nwg / NXCD, r = nwg % NXCD, xcd = wgid % NXCD, off = wgid / NXCD; wgid = (xcd < r ? xcd * (q + 1) : r * (q + 1) + (xcd - r) * q) + off; }
        const int nig = WGM * nN, gid = wgid / nig, fm = gid * WGM, gsz = (nM - fm) < WGM ? (nM - fm) : WGM;
        u.pm = fm + ((wgid % nig) % gsz); u.pn = (wgid % nig) / gsz; return true;
    }
};

template <class Epi, bool SP2 = false>
__device__ __forceinline__ void gemm_phase(LAS unsigned char* lds, const Gemm g, const StaticOrder& S, const Epi& E) {
    const int tid = threadIdx.x, wid = __builtin_amdgcn_readfirstlane(tid >> 6), lane = tid & 63, wr = wid >> 2, wc = wid & 3, fr = lane & 15, fq = lane >> 4;
    const int K = g.K, nt = K / BK, lda = g.lda;
    unsigned voffA[2], voffB[2];
#pragma unroll
    for (int i = 0; i < 2; ++i) { int R, C; stage_rc(tid * 16 + i * 8192, R, C); const int Rb = Epi::PERM ? ((R & ~31) + perm32(R & 31)) : R;
        voffA[i] = (unsigned)(R * lda + C) * 2u; voffB[i] = (unsigned)(Rb * K + C) * 2u; }
    const size_t kstep = (size_t)(BK * 2);
    const size_t hstepA = (size_t)HALF * lda * 2, hstepB = (size_t)HALF * K * 2;
    const size_t tstepA = 2 * hstepA, tstepB = 2 * hstepB;
    const unsigned ldsw = (unsigned)wid * 1024u;
    const int aoff = lds_byte(wr * 64 + fr, fq * 8), boff = lds_byte(wc * 32 + fr, fq * 8);
#define PG8_SA(b, h) (((b) * 2 + (h)) * HTB)
#define PG8_SB(b, h) ((4 + (b) * 2 + (h)) * HTB)
#define PG8_STAGE(bufoff, gbase, voff) do { _Pragma("unroll") for (int _i = 0; _i < 2; ++_i) \
        __builtin_amdgcn_global_load_lds((const unsigned*)((const char*)(gbase) + (voff)[_i]), (LAS unsigned*)(lds + (bufoff) + ldsw + _i * 8192), 16, 0, 0); } while (0)
#define PG8_LDA(dst, b, h) do { _Pragma("unroll") for (int m = 0; m < 4; ++m) _Pragma("unroll") for (int k = 0; k < 2; ++k) dst[m][k] = *(const LAS bf16x8*)(lds + PG8_SA(b, h) + aoff + m * 2048 + k * 1024); } while (0)
#define PG8_LDB(dst, b, h) do { _Pragma("unroll") for (int n = 0; n < 2; ++n) _Pragma("unroll") for (int k = 0; k < 2; ++k) dst[n][k] = *(const LAS bf16x8*)(lds + PG8_SB(b, h) + boff + n * 2048 + k * 1024); } while (0)
#define PG8_MMA(ai, bj, At, Bt) do { __builtin_amdgcn_s_setprio(1); _Pragma("unroll") for (int m = 0; m < 4; ++m) _Pragma("unroll") for (int n = 0; n < 2; ++n) _Pragma("unroll") for (int k = 0; k < 2; ++k) \
        acc[ai][bj][m][n] = __builtin_amdgcn_mfma_f32_16x16x32_bf16(Bt[n][k], At[m][k], acc[ai][bj][m][n], 0, 0, 0); __builtin_amdgcn_s_setprio(0); } while (0)
#define PG8_WAIT_V(n) asm volatile("s_waitcnt vmcnt(" #n ")" ::: "memory")
#define PG8_WAIT_L(n) asm volatile("s_waitcnt lgkmcnt(" #n ")" ::: "memory")
#define PG8_BAR __builtin_amdgcn_s_barrier()
#define PG8_SCHED __builtin_amdgcn_sched_barrier(0)
    Unit cur, nxt; int ui = 0;
    if (!S.next(0, cur)) return;
    f32x4 acc[2][2][4][2];
#pragma unroll
    for (int a = 0; a < 2; ++a)
#pragma unroll
        for (int b = 0; b < 2; ++b)
#pragma unroll
            for (int m = 0; m < 4; ++m)
#pragma unroll
                for (int n = 0; n < 2; ++n) acc[a][b][m][n] = (f32x4){0.f, 0.f, 0.f, 0.f};
    bf16x8 At[4][2], B0[2][2], B1[2][2];
    const char* cA = (const char*)g.A + (size_t)cur.pm * tstepA; const char* cB = (const char*)g.Bt + (size_t)cur.pn * tstepB;
    if constexpr (SP2) {
        PG8_STAGE(PG8_SB(0, 0), cB, voffB); PG8_STAGE(PG8_SB(0, 1), cB + hstepB, voffB); PG8_STAGE(PG8_SA(0, 0), cA, voffA); PG8_STAGE(PG8_SA(0, 1), cA + hstepA, voffA);
        if (wr == 1) PG8_BAR;
        PG8_WAIT_V(2); PG8_BAR;
        PG8_STAGE(PG8_SB(1, 0), cB + kstep, voffB); PG8_STAGE(PG8_SA(1, 0), cA + kstep, voffA); PG8_STAGE(PG8_SB(1, 1), cB + hstepB + kstep, voffB);
        PG8_WAIT_V(6); PG8_BAR;
    } else {
    PG8_STAGE(PG8_SB(0, 0), cB, voffB); PG8_STAGE(PG8_SA(0, 0), cA, voffA); PG8_STAGE(PG8_SB(0, 1), cB + hstepB, voffB); PG8_STAGE(PG8_SA(0, 1), cA + hstepA, voffA);
    if (wr == 1) PG8_BAR;
    PG8_WAIT_V(4); PG8_BAR;
    PG8_STAGE(PG8_SB(1, 0), cB + kstep, voffB); PG8_STAGE(PG8_SA(1, 0), cA + kstep, voffA); PG8_STAGE(PG8_SB(1, 1), cB + hstepB + kstep, voffB);
    PG8_WAIT_V(6); PG8_BAR;
    }
    for (;;) {
        const bool has_next = S.next(ui + 1, nxt);
        const char* nA = has_next ? (const char*)g.A + (size_t)nxt.pm * tstepA : cA; const char* nB = has_next ? (const char*)g.Bt + (size_t)nxt.pn * tstepB : cB;
        for (int t = 0; t < nt; t += 2) {
            const bool last = (t == nt - 2);
            const char* a1 = cA + (size_t)(t + 1) * kstep;
            const char* a2 = last ? nA : cA + (size_t)(t + 2) * kstep; const char* b2 = last ? nB : cB + (size_t)(t + 2) * kstep;
            const char* a3 = a2 + kstep; const char* b3 = b2 + kstep;
            if constexpr (SP2) {
            PG8_LDB(B0, 0, 0); PG8_LDB(B1, 0, 1); PG8_SCHED; PG8_LDA(At, 0, 0); PG8_STAGE(PG8_SA(1, 1), a1 + hstepA, voffA);
            PG8_WAIT_V(8); PG8_WAIT_L(0); PG8_BAR; PG8_MMA(0, 0, At, B0); PG8_MMA(0, 1, At, B1); PG8_BAR; PG8_SCHED;
            PG8_LDA(At, 0, 1); PG8_STAGE(PG8_SB(0, 0), b2, voffB); PG8_STAGE(PG8_SB(0, 1), b2 + hstepB, voffB); PG8_STAGE(PG8_SA(0, 0), a2, voffA);
            PG8_WAIT_V(8); PG8_WAIT_L(0); PG8_BAR; PG8_MMA(1, 0, At, B0); PG8_MMA(1, 1, At, B1); PG8_BAR; PG8_SCHED;
            PG8_LDB(B0, 1, 0); PG8_LDB(B1, 1, 1); PG8_SCHED; PG8_LDA(At, 1, 0); PG8_STAGE(PG8_SA(0, 1), a2 + hstepA, voffA);
            PG8_WAIT_V(8); PG8_WAIT_L(0); PG8_BAR; PG8_MMA(0, 0, At, B0); PG8_MMA(0, 1, At, B1); PG8_BAR; PG8_SCHED;
            PG8_LDA(At, 1, 1); PG8_STAGE(PG8_SB(1, 0), b3, voffB); PG8_STAGE(PG8_SB(1, 1), b3 + hstepB, voffB); PG8_STAGE(PG8_SA(1, 0), a3, voffA);
            PG8_WAIT_V(8); PG8_WAIT_L(0); PG8_BAR; PG8_MMA(1, 0, At, B0); PG8_MMA(1, 1, At, B1); PG8_BAR; PG8_SCHED;
            } else {
            PG8_LDB(B0, 0, 0); PG8_SCHED; PG8_LDA(At, 0, 0); PG8_STAGE(PG8_SA(1, 1), a1 + hstepA, voffA);
            PG8_WAIT_L(8); PG8_BAR; PG8_WAIT_L(0); PG8_MMA(0, 0, At, B0); PG8_BAR; PG8_SCHED;
            PG8_LDB(B1, 0, 1); PG8_STAGE(PG8_SB(0, 0), b2, voffB);
            PG8_BAR; PG8_WAIT_L(0); PG8_MMA(0, 1, At, B1); PG8_BAR;
            PG8_LDA(At, 0, 1); PG8_STAGE(PG8_SA(0, 0), a2, voffA);
            PG8_BAR; PG8_WAIT_L(0); PG8_MMA(1, 0, At, B0); PG8_BAR; PG8_SCHED;
            PG8_STAGE(PG8_SB(0, 1), b2 + hstepB, voffB);
            PG8_WAIT_V(6); PG8_BAR; PG8_MMA(1, 1, At, B1); PG8_BAR;
            PG8_LDB(B0, 1, 0); PG8_SCHED; PG8_LDA(At, 1, 0); PG8_STAGE(PG8_SA(0, 1), a2 + hstepA, voffA);
            PG8_WAIT_L(8); PG8_BAR; PG8_WAIT_L(0); PG8_MMA(0, 0, At, B0); PG8_BAR; PG8_SCHED;
            PG8_LDB(B1, 1, 1); PG8_STAGE(PG8_SB(1, 0), b3, voffB);
            PG8_BAR; PG8_WAIT_L(0); PG8_MMA(0, 1, At, B1); PG8_BAR;
            PG8_LDA(At, 1, 1); PG8_STAGE(PG8_SA(1, 0), a3, voffA);
            PG8_BAR; PG8_WAIT_L(0); PG8_MMA(1, 0, At, B0); PG8_BAR; PG8_SCHED;
            PG8_STAGE(PG8_SB(1, 1), b3 + hstepB, voffB);
            PG8_WAIT_V(6); PG8_BAR; PG8_MMA(1, 1, At, B1); PG8_BAR;
            }
        }
        if constexpr (SP2) { if (wr == 0) PG8_BAR; }
        { int el; asm volatile("v_mbcnt_lo_u32_b32 %0, -1, 0\n\tv_mbcnt_hi_u32_b32 %0, -1, %0" : "=v"(el)); E(acc, cur, wr, wc, el & 15, el >> 4); }
        if (!has_next) break;
#pragma unroll
        for (int a = 0; a < 2; ++a)
#pragma unroll
            for (int b = 0; b < 2; ++b)
#pragma unroll
                for (int m = 0; m < 4; ++m)
#pragma unroll
                    for (int n = 0; n < 2; ++n) acc[a][b][m][n] = (f32x4){0.f, 0.f, 0.f, 0.f};
        cur = nxt; cA = nA; cB = nB; ++ui;
        if constexpr (SP2) { if (wr == 1) PG8_BAR; }
    }
    PG8_WAIT_V(0);
    if constexpr (!SP2) { if (wr == 0) PG8_BAR; }
    PG8_BAR;
#undef PG8_SA
#undef PG8_SB
#undef PG8_STAGE
#undef PG8_LDA
#undef PG8_LDB
#undef PG8_MMA
#undef PG8_WAIT_V
#undef PG8_WAIT_L
#undef PG8_BAR
#undef PG8_SCHED
}

#if defined(MK_SIMPLE_GEMM)
template <class Epi>
__device__ __forceinline__ void gemm_phase_simple(const Gemm g, const StaticOrder& S, const Epi& E) {
    const int tid = threadIdx.x, wid = __builtin_amdgcn_readfirstlane(tid >> 6), lane = tid & 63, wr = wid >> 2, wc = wid & 3, fr = lane & 15, fq = lane >> 4;
    Unit cur;
    for (int ui = 0; S.next(ui, cur); ++ui) {
        f32x4 acc[2][2][4][2];
#pragma unroll
        for (int a = 0; a < 2; ++a)
#pragma unroll
            for (int b = 0; b < 2; ++b)
#pragma unroll
                for (int m = 0; m < 4; ++m)
#pragma unroll
                    for (int n = 0; n < 2; ++n) acc[a][b][m][n] = (f32x4){0.f, 0.f, 0.f, 0.f};
        for (int k0 = 0; k0 < g.K; k0 += 32) {
            bf16x8 bf[2][2];
#pragma unroll
            for (int bj = 0; bj < 2; ++bj)
#pragma unroll
                for (int n = 0; n < 2; ++n) { const int slot = 16 * n + fr; const int wrow = cur.pn * BM + bj * HALF + wc * 32 + (Epi::PERM ? perm32(slot) : slot);
                    bf[bj][n] = *(const bf16x8*)(g.Bt + (size_t)wrow * g.K + k0 + 8 * fq); }
#pragma unroll
            for (int ai = 0; ai < 2; ++ai)
#pragma unroll
                for (int m = 0; m < 4; ++m) { const int arow = cur.pm * BM + ai * HALF + wr * 64 + m * 16 + fr;
                    const bf16x8 af = *(const bf16x8*)(g.A + (size_t)arow * g.lda + k0 + 8 * fq);
#pragma unroll
                    for (int bj = 0; bj < 2; ++bj)
#pragma unroll
                        for (int n = 0; n < 2; ++n) acc[ai][bj][m][n] = __builtin_amdgcn_mfma_f32_16x16x32_bf16(bf[bj][n], af, acc[ai][bj][m][n], 0, 0, 0); }
        }
        E(acc, cur, wr, wc, fr, fq);
    }
}
#define GEMM_PHASE(EPI, lds, g, S, E) pg8::gemm_phase_simple<EPI>(g, S, E)
#define GEMM_PHASE2(EPI, lds, g, S, E) pg8::gemm_phase_simple<EPI>(g, S, E)
#else
#define GEMM_PHASE(EPI, lds, g, S, E) pg8::gemm_phase<EPI, true>(lds, g, S, E)
#define GEMM_PHASE2(EPI, lds, g, S, E) pg8::gemm_phase<EPI, false>(lds, g, S, E)
#endif
struct EpiSwiglu {
    static constexpr bool PERM = true;
    bf16_t* O; int ldc;
    __device__ __forceinline__ void operator()(const f32x4 (&acc)[2][2][4][2], const Unit& u, int wr, int wc, int fr, int fq) const {
        const int row0 = u.pm * BM + wr * 64 + fr, col0 = u.pn * 128 + wc * 32 + 8 * fq;
#pragma unroll
        for (int ai = 0; ai < 2; ++ai)
#pragma unroll
            for (int m = 0; m < 4; ++m) {
                bf16_t* rowp = O + (size_t)(row0 + ai * HALF + m * 16) * ldc + col0;
                const f32x4 g0 = acc[ai][0][m][0], g1 = acc[ai][0][m][1], u0 = acc[ai][1][m][0], u1 = acc[ai][1][m][1];
                float v[8];
#pragma unroll
                for (int j = 0; j < 4; ++j) { v[j] = fsilu(g0[j]) * u0[j]; v[4 + j] = fsilu(g1[j]) * u1[j]; }
                u32x4 w; w.x = pk_bf16(v[0], v[1]); w.y = pk_bf16(v[2], v[3]); w.z = pk_bf16(v[4], v[5]); w.w = pk_bf16(v[6], v[7]);
                *(u32x4*)rowp = w;
                asm volatile("" ::: "memory");
            }
    }
};
__device__ __forceinline__ void store_tile_bf16(const f32x4 (&acc)[2][2][4][2], bf16_t* base, int ld, int row0, int col0, int act) {
#pragma unroll
    for (int ai = 0; ai < 2; ++ai)
#pragma unroll
        for (int m = 0; m < 4; ++m) {
            bf16_t* rowp = base + (size_t)(row0 + ai * HALF + m * 16) * ld + col0;
#pragma unroll
            for (int bj = 0; bj < 2; ++bj) {
                f32x4 v0 = acc[ai][bj][m][0], v1 = acc[ai][bj][m][1];
                if (act == 1) {
#pragma unroll
                    for (int j = 0; j < 4; ++j) { v0[j] = fgelu(v0[j]); v1[j] = fgelu(v1[j]); }
                } else if (act == 2) {
#pragma unroll
                    for (int j = 0; j < 4; ++j) { v0[j] = fsigmoid(v0[j]); v1[j] = fsigmoid(v1[j]); }
                }
                u32x4 w; w.x = pk_bf16(v0[0], v0[1]); w.y = pk_bf16(v0[2], v0[3]); w.z = pk_bf16(v1[0], v1[1]); w.w = pk_bf16(v1[2], v1[3]);
                *(u32x4*)(rowp + bj * HALF) = w;
            }
            asm volatile("" ::: "memory");
        }
}
template <int ACT> struct EpiAct {
    static constexpr bool PERM = true;
    bf16_t* p; int ld, pn0;
    __device__ __forceinline__ void operator()(const f32x4 (&acc)[2][2][4][2], const Unit& u, int wr, int wc, int fr, int fq) const {
        store_tile_bf16(acc, p, ld, u.pm * BM + wr * 64 + fr, (u.pn - pn0) * BM + wc * 32 + 8 * fq, ACT);
    }
};
struct EpiWinA {
    static constexpr bool PERM = true;
    bf16_t* zq; bf16_t* xl; bf16_t* gy;
    __device__ __forceinline__ void operator()(const f32x4 (&acc)[2][2][4][2], const Unit& u, int wr, int wc, int fr, int fq) const {
        size_t boff = 0; if (u.pn >= 2) boff += (size_t)((const char*)xl - (const char*)zq); if (u.pn >= 6) boff += (size_t)((const char*)gy - (const char*)xl);
        bf16_t* base = (bf16_t*)((char*)zq + boff);
        int ld = 512, pn0 = 0; if (u.pn >= 2) { ld = D; pn0 = 2; } if (u.pn >= 6) pn0 = 6;
        store_tile_bf16(acc, base, ld, u.pm * BM + wr * 64 + fr, (u.pn - pn0) * BM + wc * 32 + 8 * fq, u.pn < 6 ? 0 : 1);
    }
};
struct EpiWinB {
    static constexpr bool PERM = true;
    bf16_t* ga; bf16_t* gl;
    __device__ __forceinline__ void operator()(const f32x4 (&acc)[2][2][4][2], const Unit& u, int wr, int wc, int fr, int fq) const {
        store_tile_bf16(acc, u.pn < 4 ? ga : gl, D, u.pm * BM + wr * 64 + fr, (u.pn & 3) * BM + wc * 32 + 8 * fq, 2);
    }
};
template <bool ADD> struct EpiGate {
    static constexpr bool PERM = true;
    const bf16_t* gate; const bf16_t* add; bf16_t* out;
    __device__ __forceinline__ void operator()(const f32x4 (&acc)[2][2][4][2], const Unit& u, int wr, int wc, int fr, int fq) const {
        const int row0 = u.pm * BM + wr * 64 + fr, col0 = u.pn * BM + wc * 32 + 8 * fq;
#pragma unroll
        for (int ai = 0; ai < 2; ++ai)
#pragma unroll
            for (int m = 0; m < 4; ++m) {
                const size_t off = (size_t)(row0 + ai * HALF + m * 16) * D + col0;
#pragma unroll
                for (int bj = 0; bj < 2; ++bj) {
                    const u32x4 gw = *(const u32x4*)(gate + off + bj * HALF);
                    const f32x4 v0 = acc[ai][bj][m][0], v1 = acc[ai][bj][m][1];
                    float r[8];
                    r[0] = lo_bf(gw.x) * v0[0]; r[1] = hi_bf(gw.x) * v0[1]; r[2] = lo_bf(gw.y) * v0[2]; r[3] = hi_bf(gw.y) * v0[3];
                    r[4] = lo_bf(gw.z) * v1[0]; r[5] = hi_bf(gw.z) * v1[1]; r[6] = lo_bf(gw.w) * v1[2]; r[7] = hi_bf(gw.w) * v1[3];
                    if (ADD) {
                        const u32x4 aw = *(const u32x4*)(add + off + bj * HALF);
                        r[0] += lo_bf(aw.x); r[1] += hi_bf(aw.x); r[2] += lo_bf(aw.y); r[3] += hi_bf(aw.y);
                        r[4] += lo_bf(aw.z); r[5] += hi_bf(aw.z); r[6] += lo_bf(aw.w); r[7] += hi_bf(aw.w);
                    }
                    u32x4 w; w.x = pk_bf16(r[0], r[1]); w.y = pk_bf16(r[2], r[3]); w.z = pk_bf16(r[4], r[5]); w.w = pk_bf16(r[6], r[7]);
                    *(u32x4*)(out + off + bj * HALF) = w;
                }
                asm volatile("" ::: "memory");
            }
    }
};
struct EpiQKV {
    static constexpr bool PERM = true;
    bf16_t* Q; bf16_t* Kn; const float* stats;
    __device__ __forceinline__ void operator()(const f32x4 (&acc)[2][2][4][2], const Unit& u, int wr, int wc, int fr, int fq) const {
        const int row0 = u.pm * BM + wr * 64 + fr;
        const int sel = u.pn < 3 ? 0 : 1;
        bf16_t* dst = Q; int ld = NQ, ctile = u.pn * BM;
        if (u.pn >= 3) { dst = Kn; ld = NKV; ctile = ((u.pn - 3) & 1) * BM; if (u.pn >= 5) dst += (size_t)T * NKV; }
        const int col0 = ctile + wc * 32 + 8 * fq;
#pragma unroll
        for (int ai = 0; ai < 2; ++ai)
#pragma unroll
            for (int m = 0; m < 4; ++m) {
                const int row = row0 + ai * HALF + m * 16;
                const float rs = stats[2 * row + sel];
                bf16_t* rowp = dst + (size_t)row * ld + col0;
#pragma unroll
                for (int bj = 0; bj < 2; ++bj) {
                    const f32x4 v0 = acc[ai][bj][m][0] * rs, v1 = acc[ai][bj][m][1] * rs;
                    u32x4 w; w.x = pk_bf16(v0[0], v0[1]); w.y = pk_bf16(v0[2], v0[3]); w.z = pk_bf16(v1[0], v1[1]); w.w = pk_bf16(v1[2], v1[3]);
                    *(u32x4*)(rowp + bj * HALF) = w;
                }
                asm volatile("" ::: "memory");
            }
    }
};
}

struct TJob { const float* src; const float* scale; bf16_t* dst; int ldsrc, K, lddst, dstk0, nrb, map, nbatch, sbs, dbs; };
__device__ __forceinline__ int srccol(int map, int rb) {
    const int r = rb * 32;
    switch (map) {
        case 1: { const int pn = r >> 8, w = r & 255; return w < 128 ? 128 * pn + w : DFF + 128 * pn + (w - 128); }
        case 2: { if (r < 416) return r; if (r < 512) return -1; return r - 96; }
        case 3: return 2464 + r;
        case 4: { const int v = r >= 512 ? 1 : 0; const int rr = r & 511; return (rr >> 6) * 128 + (rr & 63) + 64 * v; }
        default: return r;
    }
}
constexpr int NJOBS = 15;
__device__ __forceinline__ TJob get_job(const Params& p, int j) {
    TJob t; t.scale = nullptr; t.dstk0 = 0; t.map = 0; t.nbatch = 1; t.sbs = 0; t.dbs = 0;
    unsigned char* ws = p.ws;
    switch (j) {
        case 0:  t.src = p.in[8];  t.dst = (bf16_t*)(ws + WS_WGU1); t.ldsrc = 2 * DFF; t.K = D; t.lddst = D; t.nrb = 176; t.map = 1; break;
        case 1:  t.src = p.in[9];  t.dst = (bf16_t*)(ws + WS_WDN1); t.ldsrc = D; t.K = DFF; t.lddst = DFF; t.nrb = 32; break;
        case 2:  t.src = p.in[10]; t.dst = (bf16_t*)(ws + WS_WINA); t.ldsrc = 4512; t.K = D; t.lddst = D; t.nrb = 80; t.map = 2; break;
        case 3:  t.src = p.in[10]; t.dst = (bf16_t*)(ws + WS_WINB); t.ldsrc = 4512; t.K = D; t.lddst = D; t.nrb = 64; t.map = 3; break;
        case 4:  t.src = p.in[13]; t.scale = p.in[11]; t.dst = (bf16_t*)(ws + WS_WQKV); t.ldsrc = 768; t.K = 256; t.lddst = 384; t.nrb = 24; break;
        case 5:  t.src = nullptr;  t.dst = (bf16_t*)(ws + WS_WQKV); t.ldsrc = 0; t.K = 128; t.lddst = 384; t.dstk0 = 256; t.nrb = 24; break;
        case 6:  t.src = p.in[14]; t.scale = p.in[12]; t.dst = (bf16_t*)(ws + WS_WQKV) + 768 * 384; t.ldsrc = 1024; t.K = 128; t.lddst = 384; t.dstk0 = 256; t.nrb = 32; t.map = 4; break;
        case 7:  t.src = nullptr;  t.dst = (bf16_t*)(ws + WS_WQKV) + 768 * 384; t.ldsrc = 0; t.K = 256; t.lddst = 384; t.nrb = 32; break;
        case 8:  t.src = p.in[15]; t.dst = (bf16_t*)(ws + WS_WAO); t.ldsrc = D; t.K = 512; t.lddst = 512; t.nrb = 32; break;
        case 9:  t.src = p.in[23]; t.dst = (bf16_t*)(ws + WS_WLO); t.ldsrc = D; t.K = D; t.lddst = D; t.nrb = 32; break;
        case 10: t.src = p.in[24]; t.dst = (bf16_t*)(ws + WS_WOUT); t.ldsrc = D; t.K = D; t.lddst = D; t.nrb = 32; break;
        case 11: t.src = p.in[25]; t.dst = (bf16_t*)(ws + WS_WGU2); t.ldsrc = 2 * DFF; t.K = D; t.lddst = D; t.nrb = 176; t.map = 1; break;
        case 12: t.src = p.in[26]; t.dst = (bf16_t*)(ws + WS_WDN2); t.ldsrc = D; t.K = DFF; t.lddst = DFF; t.nrb = 32; break;
        case 13: t.src = p.in[18]; t.dst = (bf16_t*)(ws + WS_WG); t.ldsrc = 128; t.K = 128; t.lddst = 128; t.nrb = 4; t.nbatch = 16; t.sbs = 16384; t.dbs = 32768; break;
        default: t.src = p.in[20]; t.dst = (bf16_t*)(ws + WS_WG) + 16384; t.ldsrc = 128; t.K = 128; t.lddst = 128; t.nrb = 4; t.nbatch = 16; t.sbs = 16384; t.dbs = 32768; break;
    }
    return t;
}
__device__ __forceinline__ int job_items(const TJob& t) { return t.nbatch * t.nrb * (t.K >> 6); }

__device__ __forceinline__ void tr_item(const TJob& jb, int item, LAS float* scr, int lane) {
    const int nkb = jb.K >> 6, per_batch = jb.nrb * nkb;
    const int bt = item / per_batch, r = item - bt * per_batch, rb = r / nkb, kb = r - rb * nkb;
    const int sc = srccol(jb.map, rb), k0 = 64 * kb;
    if (jb.src != nullptr && sc >= 0) {
        const float* src = jb.src + (size_t)bt * jb.sbs;
#pragma unroll 8
        for (int i = 0; i < 32; ++i) { const int kk = 2 * i + (lane >> 5);
            float v = src[(size_t)(k0 + kk) * jb.ldsrc + sc + (lane & 31)];
            if (jb.scale) v *= jb.scale[k0 + kk];
            scr[kk * 33 + (lane & 31)] = v; }
    } else {
#pragma unroll 8
        for (int i = 0; i < 32; ++i) { const int kk = 2 * i + (lane >> 5); scr[kk * 33 + (lane & 31)] = 0.f; }
    }
    asm volatile("s_waitcnt lgkmcnt(0)" ::: "memory");
    bf16_t* dst = jb.dst + (size_t)bt * jb.dbs;
    const int c = lane & 7;
#pragma unroll
    for (int j = 0; j < 4; ++j) { const int n = (lane >> 3) + 8 * j; const LAS float* s = scr + (8 * c) * 33 + n;
        u32x4 o; o.x = pk_bf16(s[0 * 33], s[1 * 33]); o.y = pk_bf16(s[2 * 33], s[3 * 33]); o.z = pk_bf16(s[4 * 33], s[5 * 33]); o.w = pk_bf16(s[6 * 33], s[7 * 33]);
        *(u32x4*)(dst + (size_t)(32 * rb + n) * jb.lddst + jb.dstk0 + k0 + 8 * c) = o; }
    asm volatile("s_waitcnt lgkmcnt(0)" ::: "memory");
}

__device__ __forceinline__ void phase_prep(const Params& p, LAS unsigned char* lds) {
    const int tid = threadIdx.x, lane = tid & 63, wave = tid >> 6;
    const int gw = blockIdx.x * NWAVES + wave, NGW = gridDim.x * NWAVES;
    {
        LAS float* scr = (LAS float*)(lds + wave * 8704);
        int base = 0;
        for (int j = 0; j < NJOBS; ++j) {
            const TJob jb = get_job(p, j); const int n = job_items(jb);
            int first = gw - (base % NGW); if (first < 0) first += NGW;
            for (int i = first; i < n; i += NGW) tr_item(jb, i, scr, lane);
            base += n;
        }
    }
    {
        const int gt = blockIdx.x * NTHREADS + tid;
        if (gt < SS * 16) {
            const int pos = gt >> 4, i = gt & 15;
            double inv = 1.0; for (int q = 0; q < i; ++q) inv *= 0.5623413251903491;
            const float ang = (float)pos * (float)inv;
            const double rev = (double)ang * 0.15915494309189535; const float fr = (float)(rev - rint(rev));
            ((float*)(p.ws + WS_ROPE))[gt] = __builtin_amdgcn_cosf(fr);
            ((float*)(p.ws + WS_ROPE))[SS * 16 + gt] = __builtin_amdgcn_sinf(fr);
        }
    }
    __syncthreads();
    for (int item = blockIdx.x; item < 144; item += gridDim.x) {
        LAS float* sc = (LAS float*)(lds) + wave * (128 * 33);
        for (int i = 0; i < 64; ++i) { const int idx = lane + 64 * i, kl = idx & 127, b = idx >> 7;
            const float cv = (b < 16 ? p.in[2] : p.in[3])[(b & 15) * D + 128 * wave + kl];
            sc[kl * 33 + b] = fsilu(cv); }
        asm volatile("s_waitcnt lgkmcnt(0)" ::: "memory");
        float acc[32];
#pragma unroll
        for (int b = 0; b < 32; ++b) acc[b] = 0.f;
        const float* W = p.in[4] + (size_t)(128 * wave) * 9216 + item * 64 + lane;
        for (int k = 0; k < 128; ++k) { const float wv = W[(size_t)k * 9216];
#pragma unroll
            for (int b = 0; b < 32; ++b) acc[b] += sc[k * 33 + b] * wv; }
        __syncthreads();
        LAS float* red = (LAS float*)(lds);
#pragma unroll
        for (int b = 0; b < 32; ++b) red[(wave * 32 + b) * 64 + lane] = acc[b];
        __syncthreads();
        for (int o = tid; o < 2048; o += NTHREADS) { const int b = o >> 6, col = o & 63; float s = 0.f;
#pragma unroll
            for (int w = 0; w < 8; ++w) s += red[(w * 32 + b) * 64 + col];
            const int j = item * 64 + col;
            ((float*)(p.ws + WS_MOD))[b * 9216 + j] = s + p.in[5][j]; }
        __syncthreads();
    }
}

template <bool HAS_F, bool HAS_H>
__device__ __forceinline__ void phase_rows(const Params& p, int sp, int sn, float resw, bool from_input) {
    const int tid = threadIdx.x, lane = tid & 63, wave = tid >> 6;
    const int gw = blockIdx.x * NWAVES + wave, NGW = gridDim.x * NWAVES;
    const float* mod = (const float*)(p.ws + WS_MOD);
    const bf16_t* F = (const bf16_t*)(p.ws + WS_F);
    bf16_t* H = (bf16_t*)(p.ws + WS_H);
    for (int row = gw; row < T; row += NGW) {
        const int b = row_batch(row);
        const float* xin = !from_input ? p.out + (size_t)row * D : (row < TP ? p.in[0] + (size_t)row * D : p.in[1] + (size_t)(row - TP) * D);
        f32x4 v[4];
#pragma unroll
        for (int j = 0; j < 4; ++j) v[j] = *(const f32x4*)(xin + 4 * lane + 256 * j);
        if (HAS_F) {
            f32x4 f[4]; float ss = 0.f;
#pragma unroll
            for (int j = 0; j < 4; ++j) { const u32x2 w = *(const u32x2*)(F + (size_t)row * D + 4 * lane + 256 * j);
                f[j] = (f32x4){lo_bf(w.x), hi_bf(w.x), lo_bf(w.y), hi_bf(w.y)}; ss += (f[j].x * f[j].x + f[j].y * f[j].y) + (f[j].z * f[j].z + f[j].w * f[j].w); }
            const float rs = 1.0f / sqrtf(wave_sum(ss) * (1.0f / D) + EPS) * resw;
            const float* gate = mod + b * 9216 + sp * 3072 + 2048; const float* gp = p.in[7] + sp * D;
#pragma unroll
            for (int j = 0; j < 4; ++j) { const f32x4 g = *(const f32x4*)(gate + 4 * lane + 256 * j), q = *(const f32x4*)(gp + 4 * lane + 256 * j);
                v[j] = v[j] + g * (f[j] * rs * q);
                *(f32x4*)(p.out + (size_t)row * D + 4 * lane + 256 * j) = v[j]; }
        }
        if (HAS_H) {
            float ss = 0.f;
#pragma unroll
            for (int j = 0; j < 4; ++j) ss += (v[j].x * v[j].x + v[j].y * v[j].y) + (v[j].z * v[j].z + v[j].w * v[j].w);
            const float rs = 1.0f / sqrtf(wave_sum(ss) * (1.0f / D) + EPS);
            const float* sh = mod + b * 9216 + sn * 3072; const float* scl = sh + 1024; const float* gq = p.in[6] + sn * D;
#pragma unroll
            for (int j = 0; j < 4; ++j) { const f32x4 a = *(const f32x4*)(sh + 4 * lane + 256 * j), s = *(const f32x4*)(scl + 4 * lane + 256 * j), q = *(const f32x4*)(gq + 4 * lane + 256 * j);
                const f32x4 h = (v[j] * rs * q) * (s + 1.0f) + a;
                u32x2 w; w.x = pk_bf16(h.x, h.y); w.y = pk_bf16(h.z, h.w);
                *(u32x2*)(H + (size_t)row * D + 4 * lane + 256 * j) = w; }
        }
    }
}

__device__ __forceinline__ void phase_stats(const Params& p) {
    const int tid = threadIdx.x, lane = tid & 63, wave = tid >> 6;
    const int gw = blockIdx.x * NWAVES + wave, NGW = gridDim.x * NWAVES;
    const bf16_t* ZQ = (const bf16_t*)(p.ws + WS_ZQ);
    float* stats = (float*)(p.ws + WS_STATS); bf16_t* KR = (bf16_t*)(p.ws + WS_KR);
    const float* rc = (const float*)(p.ws + WS_ROPE); const float* rsn = rc + SS * 16;
    for (int row = gw; row < T; row += NGW) {
        const u32x4 w = *(const u32x4*)(ZQ + (size_t)row * 512 + 8 * lane);
        float x[8] = {lo_bf(w.x), hi_bf(w.x), lo_bf(w.y), hi_bf(w.y), lo_bf(w.z), hi_bf(w.z), lo_bf(w.w), hi_bf(w.w)};
        float ss = 0.f;
#pragma unroll
        for (int e = 0; e < 8; ++e) ss += x[e] * x[e];
        const float sq = wave_sum(lane < 32 ? ss : 0.f), skv = wave_sum((lane >= 32 && lane < 48) ? ss : 0.f);
        if (lane == 0) { f32x2 st; st.x = 1.0f / sqrtf(sq * (1.0f / 256.0f) + EPS); st.y = 1.0f / sqrtf(skv * (1.0f / 128.0f) + EPS); *(f32x2*)(stats + 2 * row) = st; }
        float y[8];
#pragma unroll
        for (int e = 0; e < 8; ++e) y[e] = __shfl_xor(x[e], 2);
        if (lane >= 48 && lane < 52) {
            const int pos = row_pos(row), i0 = 8 * (lane & 1);
            const f32x4 c0 = *(const f32x4*)(rc + pos * 16 + i0), c1 = *(const f32x4*)(rc + pos * 16 + i0 + 4);
            const f32x4 s0 = *(const f32x4*)(rsn + pos * 16 + i0), s1 = *(const f32x4*)(rsn + pos * 16 + i0 + 4);
            const float c[8] = {c0.x, c0.y, c0.z, c0.w, c1.x, c1.y, c1.z, c1.w}, s[8] = {s0.x, s0.y, s0.z, s0.w, s1.x, s1.y, s1.z, s1.w};
            float o[8];
            const bool first = lane < 50;
#pragma unroll
            for (int e = 0; e < 8; ++e) o[e] = first ? (x[e] * c[e] - y[e] * s[e]) : (x[e] * c[e] + y[e] * s[e]);
            u32x4 ow; ow.x = pk_bf16(o[0], o[1]); ow.y = pk_bf16(o[2], o[3]); ow.z = pk_bf16(o[4], o[5]); ow.w = pk_bf16(o[6], o[7]);
            *(u32x4*)(KR + (size_t)row * 32 + 8 * (lane - 48)) = ow;
        }
    }
}

constexpr int XC_PITCH = 272;
__device__ __forceinline__ void phase_lru(const Params& p, LAS unsigned char* lds) {
    const int tid = threadIdx.x, lane = tid & 63, wave = __builtin_amdgcn_readfirstlane(tid >> 6), g = lane >> 4, lc = lane & 15;
    const bf16_t* XL = (const bf16_t*)(p.ws + WS_XL); bf16_t* GY = (bf16_t*)(p.ws + WS_GY); bf16_t* HF = (bf16_t*)(p.ws + WS_F);
    const bf16_t* WG = (const bf16_t*)(p.ws + WS_WG);
    for (int item = blockIdx.x; item < 256; item += gridDim.x) {
        int gb, n;
        if (item < 128) { gb = 16 + (item >> 3); n = item & 7; } else { gb = (item - 128) >> 3; n = item & 7; }
        const int S = gb < 16 ? SP : SS; const int row0 = gb < 16 ? gb * SP : TP + (gb - 16) * SS;
        const int nch = S >> 6;
        const int tr = tid >> 4, cgp = (tid & 15) * 8, c0 = 128 * n + cgp;
        float cw[4][8], cb[8];
#pragma unroll
        for (int j = 0; j < 4; ++j) { const f32x4 a = *(const f32x4*)(p.in[16] + j * D + c0), b = *(const f32x4*)(p.in[16] + j * D + c0 + 4);
            cw[j][0] = a.x; cw[j][1] = a.y; cw[j][2] = a.z; cw[j][3] = a.w; cw[j][4] = b.x; cw[j][5] = b.y; cw[j][6] = b.z; cw[j][7] = b.w; }
        { const f32x4 a = *(const f32x4*)(p.in[17] + c0), b = *(const f32x4*)(p.in[17] + c0 + 4);
            cb[0] = a.x; cb[1] = a.y; cb[2] = a.z; cb[3] = a.w; cb[4] = b.x; cb[5] = b.y; cb[6] = b.z; cb[7] = b.w; }
        const int ch = 128 * n + 16 * wave + lc;
        for (int d = 0; d < 2; ++d) {
            bf16x8 Ba[4], Bi[4];
            { const bf16_t* wa = WG + (size_t)((d * 8 + n) * 2 + 0) * 16384 + (size_t)(16 * wave + lc) * 128 + 8 * g; const bf16_t* wi = wa + 16384;
#pragma unroll
              for (int ks = 0; ks < 4; ++ks) { Ba[ks] = *(const bf16x8*)(wa + 32 * ks); Bi[ks] = *(const bf16x8*)(wi + 32 * ks); } }
            const float ba = p.in[19][d * D + ch], bi = p.in[21][d * D + ch];
            const float lam = p.in[22][d * D + ch];
            const float c8 = -8.0f * log1pf(expf(-lam));
            float carry = 0.f;
            u32x4 pw[2][4];
#define LRU_PREFETCH(CI) do { const int _cc = d ? (nch - 1 - (CI)) : (CI); _Pragma("unroll") for (int hf = 0; hf < 2; ++hf) _Pragma("unroll") for (int j = 0; j < 4; ++j) { \
                const int tt = _cc * 64 + tr + 32 * hf + j - 1; pw[hf][j] = (tt >= 0 && tt < S) ? *(const u32x4*)(XL + (size_t)(row0 + tt) * D + c0) : (u32x4){0u, 0u, 0u, 0u}; } } while (0)
            LRU_PREFETCH(0);
            for (int ci = 0; ci < nch; ++ci) {
                const int cc = d ? (nch - 1 - ci) : ci, t0 = cc * 64;
                __syncthreads();
#pragma unroll
                for (int hf = 0; hf < 2; ++hf) {
                    const int tl = tr + 32 * hf;
                    float a[8];
#pragma unroll
                    for (int e = 0; e < 8; ++e) a[e] = cb[e];
#pragma unroll
                    for (int j = 0; j < 4; ++j) { const u32x4 w = pw[hf][j];
                        a[0] += cw[j][0] * lo_bf(w.x); a[1] += cw[j][1] * hi_bf(w.x); a[2] += cw[j][2] * lo_bf(w.y); a[3] += cw[j][3] * hi_bf(w.y);
                        a[4] += cw[j][4] * lo_bf(w.z); a[5] += cw[j][5] * hi_bf(w.z); a[6] += cw[j][6] * lo_bf(w.w); a[7] += cw[j][7] * hi_bf(w.w); }
                    u32x4 o; o.x = pk_bf16(a[0], a[1]); o.y = pk_bf16(a[2], a[3]); o.z = pk_bf16(a[4], a[5]); o.w = pk_bf16(a[6], a[7]);
                    *(LAS u32x4*)(lds + tl * XC_PITCH + cgp * 2) = o;
                }
                __syncthreads();
                if (ci + 1 < nch) LRU_PREFETCH(ci + 1);
                float hfv[4][4], gyv[4][4];
                if (d == 1) {
#pragma unroll
                    for (int mt = 0; mt < 4; ++mt)
#pragma unroll
                        for (int j = 0; j < 4; ++j) { const size_t off = (size_t)(row0 + t0 + 16 * mt + 4 * g + j) * D + ch; hfv[mt][j] = bf2f(HF[off]); gyv[mt][j] = bf2f(GY[off]); }
                }
                f32x4 aa[4], ai[4];
#pragma unroll
                for (int mt = 0; mt < 4; ++mt) { aa[mt] = (f32x4){0.f, 0.f, 0.f, 0.f}; ai[mt] = (f32x4){0.f, 0.f, 0.f, 0.f}; }
#pragma unroll
                for (int ks = 0; ks < 4; ++ks)
#pragma unroll
                    for (int mt = 0; mt < 4; ++mt) { const bf16x8 A = *(const LAS bf16x8*)(lds + (16 * mt + lc) * XC_PITCH + (32 * ks + 8 * g) * 2);
                        aa[mt] = __builtin_amdgcn_mfma_f32_16x16x32_bf16(A, Ba[ks], aa[mt], 0, 0, 0);
                        ai[mt] = __builtin_amdgcn_mfma_f32_16x16x32_bf16(A, Bi[ks], ai[mt], 0, 0, 0); }
#pragma unroll
                for (int mt = 0; mt < 4; ++mt)
#pragma unroll
                    for (int j = 0; j < 4; ++j) {
                        const float xcv = bf2f(*(const LAS bf16_t*)(lds + (16 * mt + 4 * g + j) * XC_PITCH + (16 * wave + lc) * 2));
                        const float r = fsigmoid(aa[mt][j] + ba), ig = fsigmoid(ai[mt][j] + bi);
                        const float la = c8 * r;
                        const float av = fexp(la), om = (1.0f - av) * (1.0f + av);
                        aa[mt][j] = av; ai[mt][j] = sqrtf(om) * (ig * xcv);
                    }
                if (d == 0) {
#pragma unroll
                    for (int mt = 0; mt < 4; ++mt) {
                        float P = 1.f, Hh = 0.f, pl[4], hl[4];
#pragma unroll
                        for (int j = 0; j < 4; ++j) { Hh = aa[mt][j] * Hh + ai[mt][j]; P *= aa[mt][j]; hl[j] = Hh; pl[j] = P; }
                        float A = P, Hs = Hh;
                        { const float A1 = __shfl_up(A, 16), H1 = __shfl_up(Hs, 16); if (g >= 1) { Hs = A * H1 + Hs; A = A * A1; } }
                        { const float A2 = __shfl_up(A, 32), H2 = __shfl_up(Hs, 32); if (g >= 2) { Hs = A * H2 + Hs; A = A * A2; } }
                        float Aex = __shfl_up(A, 16), Hex = __shfl_up(Hs, 16); if (g == 0) { Aex = 1.f; Hex = 0.f; }
                        const float cin = Aex * carry + Hex;
                        const float At = __shfl(A, 48 + lc), Ht = __shfl(Hs, 48 + lc);
                        carry = At * carry + Ht;
#pragma unroll
                        for (int j = 0; j < 4; ++j) { const float h = hl[j] + pl[j] * cin;
                            HF[(size_t)(row0 + t0 + 16 * mt + 4 * g + j) * D + ch] = (bf16_t)(pk_bf16(h, 0.f) & 0xffffu); }
                    }
                } else {
#pragma unroll
                    for (int mt = 3; mt >= 0; --mt) {
                        float P = 1.f, Hh = 0.f, pl[4], hl[4];
#pragma unroll
                        for (int j = 3; j >= 0; --j) { Hh = aa[mt][j] * Hh + ai[mt][j]; P *= aa[mt][j]; hl[j] = Hh; pl[j] = P; }
                        float A = P, Hs = Hh;
                        { const float A1 = __shfl_down(A, 16), H1 = __shfl_down(Hs, 16); if (g <= 2) { Hs = A * H1 + Hs; A = A * A1; } }
                        { const float A2 = __shfl_down(A, 32), H2 = __shfl_down(Hs, 32); if (g <= 1) { Hs = A * H2 + Hs; A = A * A2; } }
                        float Aex = __shfl_down(A, 16), Hex = __shfl_down(Hs, 16); if (g == 3) { Aex = 1.f; Hex = 0.f; }
                        const float cin = Aex * carry + Hex;
                        const float At = __shfl(A, lc), Ht = __shfl(Hs, lc);
                        carry = At * carry + Ht;
#pragma unroll
                        for (int j = 0; j < 4; ++j) { const float h = hl[j] + pl[j] * cin;
                            const size_t off = (size_t)(row0 + t0 + 16 * mt + 4 * g + j) * D + ch;
                            const float o = (hfv[mt][j] + h) * gyv[mt][j];
                            GY[off] = (bf16_t)(pk_bf16(o, 0.f) & 0xffffu); }
                    }
                }
            }
        }
        __syncthreads();
    }
}

constexpr int AK_PITCH = 208, AV_PITCH = 160, AK_BYTES = 64 * AK_PITCH, AV_BYTES = 64 * AV_PITCH, ABUF = AK_BYTES + AV_BYTES;
__device__ __forceinline__ void phase_attn(const Params& p, LAS unsigned char* lds) {
    const int tid = threadIdx.x, lane = tid & 63, wave = __builtin_amdgcn_readfirstlane(tid >> 6), g = lane >> 4, lc = lane & 15;
    const bf16_t* Q = (const bf16_t*)(p.ws + WS_F); const bf16_t* KN = (const bf16_t*)(p.ws + WS_XL); const bf16_t* V = KN + (size_t)T * NKV;
    const bf16_t* KR = (const bf16_t*)(p.ws + WS_KR); bf16_t* O = (bf16_t*)(p.ws + WS_ZQ);
    const float csc = 0.10206207261596577f * 1.4426950408889634f;
    const int srow = tid >> 3, sch = tid & 7;
    const int rrow = (tid & 255) >> 2, rch = tid & 3;
    const int vtr = (4 * g + (lc >> 2)) * AV_PITCH + (4 * (lc & 3)) * 2;
    for (int unit = blockIdx.x; unit < 3072; unit += gridDim.x) {
        int gb, h, qt, S, row0;
        if (unit < 2048) { gb = 16 + (unit >> 7); h = (unit & 127) >> 4; qt = unit & 15; S = SS; row0 = TP + (gb - 16) * SS; }
        else { const int u2 = unit - 2048; gb = u2 >> 6; h = (u2 & 63) >> 3; qt = u2 & 7; S = SP; row0 = gb * SP; }
        const int nkt = S >> 6;
        const int qrow = row0 + 256 * qt + 32 * wave;
        bf16x8 qf[2][3];
#pragma unroll
        for (int q2 = 0; q2 < 2; ++q2)
#pragma unroll
            for (int ks = 0; ks < 3; ++ks) qf[q2][ks] = *(const bf16x8*)(Q + (size_t)(qrow + 16 * q2 + lc) * NQ + 96 * h + 32 * ks + 8 * g);
#pragma unroll
        for (int q2 = 0; q2 < 2; ++q2) {
            const int pos = row_pos(qrow + 16 * q2 + lc), i0 = 8 * (g & 1);
            const float* rc = (const float*)(p.ws + WS_ROPE) + pos * 16 + i0; const float* rsn = rc + SS * 16;
            const f32x4 c0 = *(const f32x4*)rc, c1 = *(const f32x4*)(rc + 4), s0 = *(const f32x4*)rsn, s1 = *(const f32x4*)(rsn + 4);
            const float cc[8] = {c0.x, c0.y, c0.z, c0.w, c1.x, c1.y, c1.z, c1.w}, sn[8] = {s0.x, s0.y, s0.z, s0.w, s1.x, s1.y, s1.z, s1.w};
            const u32x4 mine = __builtin_bit_cast(u32x4, qf[q2][2]);
            u32x4 oth; oth.x = __shfl_xor(mine.x, 32); oth.y = __shfl_xor(mine.y, 32); oth.z = __shfl_xor(mine.z, 32); oth.w = __shfl_xor(mine.w, 32);
            const float xm[8] = {lo_bf(mine.x), hi_bf(mine.x), lo_bf(mine.y), hi_bf(mine.y), lo_bf(mine.z), hi_bf(mine.z), lo_bf(mine.w), hi_bf(mine.w)};
            const float xo[8] = {lo_bf(oth.x), hi_bf(oth.x), lo_bf(oth.y), hi_bf(oth.y), lo_bf(oth.z), hi_bf(oth.z), lo_bf(oth.w), hi_bf(oth.w)};
            float o[8];
#pragma unroll
            for (int e = 0; e < 8; ++e) o[e] = g < 2 ? (xm[e] * cc[e] - xo[e] * sn[e]) : (xm[e] * cc[e] + xo[e] * sn[e]);
            u32x4 w; w.x = pk_bf16(o[0], o[1]); w.y = pk_bf16(o[2], o[3]); w.z = pk_bf16(o[4], o[5]); w.w = pk_bf16(o[6], o[7]);
            qf[q2][2] = __builtin_bit_cast(bf16x8, w);
        }
        f32x4 oacc[4][2];
#pragma unroll
        for (int dt = 0; dt < 4; ++dt) { oacc[dt][0] = (f32x4){0.f, 0.f, 0.f, 0.f}; oacc[dt][1] = (f32x4){0.f, 0.f, 0.f, 0.f}; }
        float mrun[2] = {-1e30f, -1e30f}, lrun[2] = {0.f, 0.f};
        u32x4 gk, gr, gv;
        gk = *(const u32x4*)(KN + (size_t)(row0 + srow) * NKV + 64 * h + 8 * sch);
        gv = *(const u32x4*)(V + (size_t)(row0 + srow) * NKV + 64 * h + 8 * sch);
        gr = *(const u32x4*)(KR + (size_t)(row0 + rrow) * 32 + 8 * rch);
        __syncthreads();
        *(LAS u32x4*)(lds + srow * AK_PITCH + sch * 16) = gk;
        *(LAS u32x4*)(lds + AK_BYTES + srow * AV_PITCH + sch * 16) = gv;
        if (tid < 256) *(LAS u32x4*)(lds + rrow * AK_PITCH + 128 + rch * 16) = gr;
        __syncthreads();
        for (int kt = 0; kt < nkt; ++kt) {
            LAS unsigned char* kb = lds + (kt & 1) * ABUF; LAS unsigned char* vb = kb + AK_BYTES;
            LAS unsigned char* nb = lds + ((kt + 1) & 1) * ABUF;
            const bool more = kt + 1 < nkt;
            if (more) { const int kr0 = row0 + 64 * (kt + 1);
                gk = *(const u32x4*)(KN + (size_t)(kr0 + srow) * NKV + 64 * h + 8 * sch);
                gv = *(const u32x4*)(V + (size_t)(kr0 + srow) * NKV + 64 * h + 8 * sch);
                gr = *(const u32x4*)(KR + (size_t)(kr0 + rrow) * 32 + 8 * rch); }
            f32x4 sacc[4][2];
#pragma unroll
            for (int k4 = 0; k4 < 4; ++k4) { sacc[k4][0] = (f32x4){0.f, 0.f, 0.f, 0.f}; sacc[k4][1] = (f32x4){0.f, 0.f, 0.f, 0.f}; }
#pragma unroll
            for (int ks = 0; ks < 3; ++ks)
#pragma unroll
                for (int k4 = 0; k4 < 4; ++k4) { const bf16x8 kf = *(const LAS bf16x8*)(kb + (16 * k4 + lc) * AK_PITCH + (32 * ks + 8 * g) * 2);
                    sacc[k4][0] = __builtin_amdgcn_mfma_f32_16x16x32_bf16(kf, qf[0][ks], sacc[k4][0], 0, 0, 0);
                    sacc[k4][1] = __builtin_amdgcn_mfma_f32_16x16x32_bf16(kf, qf[1][ks], sacc[k4][1], 0, 0, 0); }
            bf16x8 pf[2][2];
#pragma unroll
            for (int q2 = 0; q2 < 2; ++q2) {
                float mx = sacc[0][q2][0];
#pragma unroll
                for (int k4 = 0; k4 < 4; ++k4)
#pragma unroll
                    for (int j = 0; j < 4; ++j) mx = fmaxf(mx, sacc[k4][q2][j]);
                mx = fmaxf(mx, __shfl_xor(mx, 16)); mx = fmaxf(mx, __shfl_xor(mx, 32));
                const float mnew = fmaxf(mrun[q2], mx * csc);
                const float alpha = __builtin_amdgcn_exp2f(mrun[q2] - mnew);
                mrun[q2] = mnew;
                float ps = 0.f; float pv[4][4];
#pragma unroll
                for (int k4 = 0; k4 < 4; ++k4)
#pragma unroll
                    for (int j = 0; j < 4; ++j) { const float e = __builtin_amdgcn_exp2f(sacc[k4][q2][j] * csc - mnew); pv[k4][j] = e; ps += e; }
                lrun[q2] = lrun[q2] * alpha + ps;
#pragma unroll
                for (int dt = 0; dt < 4; ++dt) oacc[dt][q2] *= alpha;
#pragma unroll
                for (int kk = 0; kk < 2; ++kk) {
                    u32x4 w; w.x = pk_bf16(pv[2 * kk][0], pv[2 * kk][1]); w.y = pk_bf16(pv[2 * kk][2], pv[2 * kk][3]);
                    w.z = pk_bf16(pv[2 * kk + 1][0], pv[2 * kk + 1][1]); w.w = pk_bf16(pv[2 * kk + 1][2], pv[2 * kk + 1][3]);
                    pf[q2][kk] = __builtin_bit_cast(bf16x8, w);
                }
            }
#pragma unroll
            for (int kk = 0; kk < 2; ++kk)
#pragma unroll
                for (int dt = 0; dt < 4; ++dt) {
                    const v4i16_t lo = __builtin_amdgcn_ds_read_tr16_b64_v4i16((LAS v4i16_t*)(vb + vtr + (32 * kk) * AV_PITCH + 32 * dt));
                    const v4i16_t hi = __builtin_amdgcn_ds_read_tr16_b64_v4i16((LAS v4i16_t*)(vb + vtr + (32 * kk + 16) * AV_PITCH + 32 * dt));
                    const bf16x8 vf = {lo[0], lo[1], lo[2], lo[3], hi[0], hi[1], hi[2], hi[3]};
                    oacc[dt][0] = __builtin_amdgcn_mfma_f32_16x16x32_bf16(vf, pf[0][kk], oacc[dt][0], 0, 0, 0);
                    oacc[dt][1] = __builtin_amdgcn_mfma_f32_16x16x32_bf16(vf, pf[1][kk], oacc[dt][1], 0, 0, 0);
                }
            if (more) {
                *(LAS u32x4*)(nb + srow * AK_PITCH + sch * 16) = gk;
                *(LAS u32x4*)(nb + AK_BYTES + srow * AV_PITCH + sch * 16) = gv;
                if (tid < 256) *(LAS u32x4*)(nb + rrow * AK_PITCH + 128 + rch * 16) = gr;
            }
            __syncthreads();
        }
#pragma unroll
        for (int q2 = 0; q2 < 2; ++q2) {
            float l = lrun[q2]; l += __shfl_xor(l, 16); l += __shfl_xor(l, 32);
            const float inv = 1.0f / l;
#pragma unroll
            for (int dt = 0; dt < 4; ++dt) { const f32x4 o = oacc[dt][q2] * inv;
                u32x2 w; w.x = pk_bf16(o[0], o[1]); w.y = pk_bf16(o[2], o[3]);
                *(u32x2*)(O + (size_t)(qrow + 16 * q2 + lc) * 512 + 64 * h + 16 * dt + 4 * g) = w; }
        }
    }
    __syncthreads();
}

constexpr int NPHASES = 16;
__global__ void __launch_bounds__(NTHREADS, 2) mega_fwd(Params p) {
    extern __shared__ __attribute__((aligned(16))) unsigned char lds_raw[];
    LAS unsigned char* lds = (LAS unsigned char*)lds_raw;
    cg::grid_group grid = cg::this_grid();
    unsigned char* ws = p.ws;
    const int G = gridDim.x, bid = blockIdx.x;
    bf16_t* Hb = (bf16_t*)(ws + WS_H); bf16_t* Fb = (bf16_t*)(ws + WS_F); bf16_t* ACT = (bf16_t*)(ws + WS_ACT);
    bf16_t* ZQ = (bf16_t*)(ws + WS_ZQ); bf16_t* XL = (bf16_t*)(ws + WS_XL); bf16_t* GY = (bf16_t*)(ws + WS_GY);
#ifndef TESTPH
#define TESTPH -1
#endif
#define IN(k) ((TESTPH < 0 || (k) == TESTPH) && p.ph_lo <= (k) && (k) < p.ph_hi)
#define SEAM(k) do { if (IN(k) && IN((k) + 1)) { __builtin_amdgcn_fence(__ATOMIC_RELEASE, "agent"); asm volatile("s_waitcnt vmcnt(0) lgkmcnt(0)" ::: "memory"); \
        grid.sync(); __builtin_amdgcn_fence(__ATOMIC_ACQUIRE, "agent"); asm volatile("s_waitcnt vmcnt(0) lgkmcnt(0)" ::: "memory"); } } while (0)
    if (IN(0)) phase_prep(p, lds);
    SEAM(0);
    if (IN(1)) phase_rows<false, true>(p, 0, 0, 0.f, true);
    SEAM(1);
#define FFN_PHASES(ffn, pb) do { \
        if (IN(pb)) { \
            pg8::Gemm g{Hb, (const bf16_t*)(ws + ((ffn) ? WS_WGU2 : WS_WGU1)), D, D}; pg8::StaticOrder S; S.init(T, 2 * DFF, G, bid); \
            pg8::EpiSwiglu E{ACT, DFF}; \
            GEMM_PHASE(pg8::EpiSwiglu, lds, g, S, E); \
        } \
        SEAM(pb); \
        if (IN((pb) + 1)) { \
            pg8::Gemm g{ACT, (const bf16_t*)(ws + ((ffn) ? WS_WDN2 : WS_WDN1)), DFF, DFF}; pg8::StaticOrder S; S.init(T, D, G, bid); \
            pg8::EpiAct<0> E{Fb, D, 0}; \
            GEMM_PHASE(pg8::EpiAct<0>, lds, g, S, E); \
        } \
        SEAM((pb) + 1); } while (0)
    FFN_PHASES(0, 2);
        if (IN(4)) phase_rows<true, true>(p, 0, 1, 0.5f, true);
        SEAM(4);
        if (IN(5)) {
            pg8::Gemm g{Hb, (const bf16_t*)(ws + WS_WINA), D, D}; pg8::StaticOrder S; S.init(T, 2560, G, bid);
            pg8::EpiWinA E{ZQ, XL, GY};
            GEMM_PHASE(pg8::EpiWinA, lds, g, S, E);
        }
        SEAM(5);
        if (IN(6)) { phase_stats(p); phase_lru(p, lds); }
        SEAM(6);
        if (IN(7)) {
            pg8::Gemm g{ZQ, (const bf16_t*)(ws + WS_WQKV), 512, 384}; pg8::StaticOrder S; S.init(T, 1792, G, bid);
            pg8::EpiQKV E{Fb, XL, (const float*)(ws + WS_STATS)};
            GEMM_PHASE2(pg8::EpiQKV, lds, g, S, E);
        }
        SEAM(7);
        if (IN(8)) phase_attn(p, lds);
        SEAM(8);
        if (IN(9)) {
            pg8::Gemm g{Hb, (const bf16_t*)(ws + WS_WINB), D, D}; pg8::StaticOrder S; S.init(T, 2048, G, bid);
            pg8::EpiWinB E{Fb, XL};
            GEMM_PHASE(pg8::EpiWinB, lds, g, S, E);
        }
        SEAM(9);
        if (IN(10)) {
            { pg8::Gemm g{ZQ, (const bf16_t*)(ws + WS_WAO), 512, 512}; pg8::StaticOrder S; S.init(T, D, G, bid);
              pg8::EpiGate<false> E{Fb, nullptr, Fb};
              GEMM_PHASE(pg8::EpiGate<false>, lds, g, S, E); }
            { pg8::Gemm g{GY, (const bf16_t*)(ws + WS_WLO), D, D}; pg8::StaticOrder S; S.init(T, D, G, bid);
              pg8::EpiGate<true> E{XL, Fb, XL};
              GEMM_PHASE(pg8::EpiGate<true>, lds, g, S, E); }
        }
        SEAM(10);
        if (IN(11)) {
            pg8::Gemm g{XL, (const bf16_t*)(ws + WS_WOUT), D, D}; pg8::StaticOrder S; S.init(T, D, G, bid);
            pg8::EpiAct<0> E{Fb, D, 0};
            GEMM_PHASE(pg8::EpiAct<0>, lds, g, S, E);
        }
        SEAM(11);
        if (IN(12)) phase_rows<true, true>(p, 1, 2, 1.0f, false);
        SEAM(12);
    FFN_PHASES(1, 13);
    if (IN(15)) phase_rows<true, false>(p, 2, 0, 0.5f, false);
#undef IN
#undef SEAM
}

extern "C" void kernel_launch(void* const* d_in, const int* in_sizes, int n_in, void* d_out, int out_size, void* d_ws, size_t ws_size, hipStream_t stream) {
    static int grid = 0;
    if (grid == 0) {
        if (n_in != 27 || out_size != T * D || ws_size < WS_END) { fprintf(stderr, "kernel_launch: unexpected shapes: n_in %d out %d ws %zu (need >= %zu)\n", n_in, out_size, ws_size, (size_t)WS_END); grid = -1; return; }
        int dev = 0, cus = 0, per_cu = 0;
        (void)hipGetDevice(&dev);
        (void)hipDeviceGetAttribute(&cus, hipDeviceAttributeMultiprocessorCount, dev);
        if (hipFuncSetAttribute((const void*)mega_fwd, hipFuncAttributeMaxDynamicSharedMemorySize, LDS_BYTES) != hipSuccess) { fprintf(stderr, "kernel_launch: hipFuncSetAttribute failed\n"); grid = -1; return; }
        if (hipOccupancyMaxActiveBlocksPerMultiprocessor(&per_cu, (const void*)mega_fwd, NTHREADS, LDS_BYTES) != hipSuccess || per_cu < 1) { fprintf(stderr, "kernel_launch: occupancy query failed (%d)\n", per_cu); per_cu = 1; }
        (void)hipGetLastError();
        grid = cus;
        fprintf(stderr, "kernel_launch: grid %d (per_cu %d)\n", grid, per_cu);
    }
    if (grid < 0) return;
    Params p{};
    for (int i = 0; i < 27; ++i) p.in[i] = (const float*)d_in[i];
    p.out = (float*)d_out; p.ws = (unsigned char*)d_ws;
#if defined(MK_SPLIT)
    for (int ph = 0; ph < NPHASES; ++ph) { p.ph_lo = ph; p.ph_hi = ph + 1;
        hipLaunchKernelGGL(mega_fwd, dim3(grid), dim3(NTHREADS), LDS_BYTES, stream, p); }
#else
    p.ph_lo = 0; p.ph_hi = NPHASES;
    void* args[] = {&p};
    hipError_t e = hipLaunchCooperativeKernel((const void*)mega_fwd, dim3(grid), dim3(NTHREADS), args, LDS_BYTES, stream);
    if (e != hipSuccess) fprintf(stderr, "kernel_launch: cooperative launch failed: %s (grid %d)\n", hipGetErrorString(e), grid);
#endif
}
```

```cpp
#include <hip/hip_runtime.h>
#include <hip/hip_cooperative_groups.h>
#include <cstdio>
#include <cstdint>
namespace cg = cooperative_groups;
#ifndef MK_SP2_ALL
#define MK_SP2_ALL false
#endif

#define LAS __attribute__((address_space(3)))
typedef unsigned short bf16_t;
typedef short bf16x8 __attribute__((ext_vector_type(8)));
typedef short v4i16_t __attribute__((ext_vector_type(4)));
typedef float f32x4 __attribute__((ext_vector_type(4)));
typedef float f32x2 __attribute__((ext_vector_type(2)));
typedef unsigned u32x4 __attribute__((ext_vector_type(4)));
typedef unsigned u32x2 __attribute__((ext_vector_type(2)));

constexpr int D = 1024, DFF = 2816, TP = 32768, TS = 65536, T = TP + TS, SP = 2048, SS = 4096;
constexpr int NQ = 768, NKV = 512;
constexpr float EPS = 1e-6f;
constexpr int NTHREADS = 512, NWAVES = 8;

constexpr size_t KiB = 1024, MiB = 1024 * 1024;
constexpr size_t WS_WGU1 = 0, WS_WDN1 = 11 * MiB, WS_WINA = 16 * MiB + 512 * KiB, WS_WINB = 21 * MiB + 512 * KiB, WS_WQKV = 25 * MiB + 512 * KiB,
                 WS_WAO = 27 * MiB, WS_WLO = 28 * MiB, WS_WOUT = 30 * MiB, WS_WGU2 = 32 * MiB, WS_WDN2 = 43 * MiB, WS_WG = 48 * MiB + 512 * KiB,
                 WS_MOD = 49 * MiB + 512 * KiB, WS_ROPE = 50 * MiB + 768 * KiB, WS_STATS = 51 * MiB + 256 * KiB, WS_KR = 52 * MiB;
constexpr size_t WS_XBAR = 50 * MiB + 640 * KiB;
constexpr size_t WS_H = 64 * MiB, WS_F = 256 * MiB, WS_BIG = 448 * MiB;
constexpr size_t WS_ZQ = WS_BIG, WS_XL = WS_BIG + 96 * MiB, WS_GY = WS_BIG + 288 * MiB, WS_ACT = WS_BIG, WS_END = 976 * MiB;
constexpr int LDS_BYTES = 139264;

struct Params { const float* in[27]; float* out; unsigned char* ws; int ph_lo, ph_hi; };

typedef __bf16 bf16x2_t __attribute__((ext_vector_type(2)));
__device__ __forceinline__ unsigned pk_bf16(float lo, float hi) { const f32x2 v = {lo, hi}; const bf16x2_t b = __builtin_convertvector(v, bf16x2_t); return __builtin_bit_cast(unsigned, b); }
__device__ __forceinline__ float lo_bf(unsigned w) { return __uint_as_float(w << 16); }
__device__ __forceinline__ float hi_bf(unsigned w) { return __uint_as_float(w & 0xffff0000u); }
__device__ __forceinline__ float bf2f(bf16_t h) { return __uint_as_float((unsigned)h << 16); }
__device__ __forceinline__ float fexp(float x) { return __builtin_amdgcn_exp2f(x * 1.4426950408889634f); }
__device__ __forceinline__ float fsigmoid(float x) { return __builtin_amdgcn_rcpf(1.0f + fexp(-x)); }
__device__ __forceinline__ float fsilu(float x) { return x * fsigmoid(x); }
__device__ __forceinline__ float fgelu(float x) { return x * fsigmoid(1.5957691216057308f * (x + 0.044715f * x * x * x)); }
__device__ __forceinline__ float wave_sum(float v) {
#pragma unroll
    for (int o = 1; o < 64; o <<= 1) v += __shfl_xor(v, o);
    return v;
}
__device__ __forceinline__ int row_batch(int row) { return row < TP ? (row >> 11) : 16 + ((row - TP) >> 12); }
__device__ __forceinline__ int row_pos(int row) { return row < TP ? (row & (SP - 1)) : ((row - TP) & (SS - 1)); }

namespace pg8 {
constexpr int BM = 256, BK = 64, HALF = 128, HTB = HALF * BK * 2, STAGE_BYTES = 8 * HTB, NXCD = 8, WGM = 8;
__host__ __device__ __forceinline__ int lds_byte(int r, int c) { const int st = (r >> 4) * 2 + (c >> 5), rr = r & 15, cc = c & 31, ob = rr * 64 + cc * 2; return st * 1024 + (ob ^ (((ob >> 9) & 1) << 5)); }
__host__ __device__ __forceinline__ void stage_rc(int b, int& R, int& C) { const int st = b / 1024, sb = b % 1024, swz = sb ^ (((sb >> 9) & 1) << 5); R = (st >> 1) * 16 + swz / 64; C = (st & 1) * 32 + (swz % 64) / 2; }
__host__ __device__ __forceinline__ int perm32(int rho) { const int n = rho >> 4, i = rho & 15; return 8 * (i >> 2) + 4 * n + (i & 3); }

struct Unit { int pm, pn; };
struct Gemm { const bf16_t* A; const bf16_t* Bt; int lda, K; };

struct StaticOrder {
    int nM, nN, nwg, G, c;
    __device__ void init(int M, int N, int G_, int c_) { nM = M / BM; nN = N / BM; nwg = nM * nN; G = G_; c = c_; }
    __device__ bool next(int i, Unit& u) const {
        const long L = (long)i * G + c; if (L >= nwg) return false;
        int wgid = (int)L; { const int q = nwg / NXCD, r = nwg % NXCD, xcd = wgid % NXCD, off = wgid / NXCD; wgid = (xcd < r ? xcd * (q + 1) : r * (q + 1) + (xcd - r) * q) + off; }
        const int nig = WGM * nN, gid = wgid / nig, fm = gid * WGM, gsz = (nM - fm) < WGM ? (nM - fm) : WGM;
        u.pm = fm + ((wgid % nig) % gsz); u.pn = (wgid % nig) / gsz; return true;
    }
};

template <class Epi, bool SP2 = false>
__device__ __forceinline__ void gemm_phase(LAS unsigned char* lds, const Gemm g, const StaticOrder& S, const Epi& E) {
    const int tid = threadIdx.x, wid = __builtin_amdgcn_readfirstlane(tid >> 6), lane = tid & 63, wr = wid >> 2, wc = wid & 3, fr = lane & 15, fq = lane >> 4;
    const int K = g.K, nt = K / BK, lda = g.lda;
    unsigned voffA[2], voffB[2];
#pragma unroll
    for (int i = 0; i < 2; ++i) { int R, C; stage_rc(tid * 16 + i * 8192, R, C); const int Rb = Epi::PERM ? ((R & ~31) + perm32(R & 31)) : R;
        voffA[i] = (unsigned)(R * lda + C) * 2u; voffB[i] = (unsigned)(Rb * K + C) * 2u; }
    const size_t kstep = (size_t)(BK * 2);
    const size_t hstepA = (size_t)HALF * lda * 2, hstepB = (size_t)HALF * K * 2;
    const size_t tstepA = 2 * hstepA, tstepB = 2 * hstepB;
    const unsigned ldsw = (unsigned)wid * 1024u;
    const int aoff = lds_byte(wr * 64 + fr, fq * 8), boff = lds_byte(wc * 32 + fr, fq * 8);
#define PG8_SA(b, h) (((b) * 2 + (h)) * HTB)
#define PG8_SB(b, h) ((4 + (b) * 2 + (h)) * HTB)
#define PG8_STAGE(bufoff, gbase, voff) do { _Pragma("unroll") for (int _i = 0; _i < 2; ++_i) \
        __builtin_amdgcn_global_load_lds((const unsigned*)((const char*)(gbase) + (voff)[_i]), (LAS unsigned*)(lds + (bufoff) + ldsw + _i * 8192), 16, 0, 0); } while (0)
#define PG8_LDA(dst, b, h) do { _Pragma("unroll") for (int m = 0; m < 4; ++m) _Pragma("unroll") for (int k = 0; k < 2; ++k) dst[m][k] = *(const LAS bf16x8*)(lds + PG8_SA(b, h) + aoff + m * 2048 + k * 1024); } while (0)
#define PG8_LDB(dst, b, h) do { _Pragma("unroll") for (int n = 0; n < 2; ++n) _Pragma("unroll") for (int k = 0; k < 2; ++k) dst[n][k] = *(const LAS bf16x8*)(lds + PG8_SB(b, h) + boff + n * 2048 + k * 1024); } while (0)
#define PG8_MMA(ai, bj, At, Bt) do { __builtin_amdgcn_s_setprio(1); _Pragma("unroll") for (int m = 0; m < 4; ++m) _Pragma("unroll") for (int n = 0; n < 2; ++n) _Pragma("unroll") for (int k = 0; k < 2; ++k) \
        acc[ai][bj][m][n] = __builtin_amdgcn_mfma_f32_16x16x32_bf16(Bt[n][k], At[m][k], acc[ai][bj][m][n], 0, 0, 0); __builtin_amdgcn_s_setprio(0); } while (0)
#define PG8_WAIT_V(n) asm volatile("s_waitcnt vmcnt(" #n ")" ::: "memory")
#define PG8_WAIT_L(n) asm volatile("s_waitcnt lgkmcnt(" #n ")" ::: "memory")
#define PG8_BAR __builtin_amdgcn_s_barrier()
#define PG8_SCHED __builtin_amdgcn_sched_barrier(0)
    Unit cur, nxt; int ui = 0;
    if (!S.next(0, cur)) return;
    f32x4 acc[2][2][4][2];
#pragma unroll
    for (int a = 0; a < 2; ++a)
#pragma unroll
        for (int b = 0; b < 2; ++b)
#pragma unroll
            for (int m = 0; m < 4; ++m)
#pragma unroll
                for (int n = 0; n < 2; ++n) acc[a][b][m][n] = (f32x4){0.f, 0.f, 0.f, 0.f};
    bf16x8 At[4][2], B0[2][2], B1[2][2];
    const char* cA = (const char*)g.A + (size_t)cur.pm * tstepA; const char* cB = (const char*)g.Bt + (size_t)cur.pn * tstepB;
    if constexpr (SP2) {
        PG8_STAGE(PG8_SB(0, 0), cB, voffB); PG8_STAGE(PG8_SB(0, 1), cB + hstepB, voffB); PG8_STAGE(PG8_SA(0, 0), cA, voffA); PG8_STAGE(PG8_SA(0, 1), cA + hstepA, voffA);
        if (wr == 1) PG8_BAR;
        PG8_WAIT_V(2); PG8_BAR;
        PG8_STAGE(PG8_SB(1, 0), cB + kstep, voffB); PG8_STAGE(PG8_SA(1, 0), cA + kstep, voffA); PG8_STAGE(PG8_SB(1, 1), cB + hstepB + kstep, voffB);
        PG8_WAIT_V(6); PG8_BAR;
    } else {
    PG8_STAGE(PG8_SB(0, 0), cB, voffB); PG8_STAGE(PG8_SA(0, 0), cA, voffA); PG8_STAGE(PG8_SB(0, 1), cB + hstepB, voffB); PG8_STAGE(PG8_SA(0, 1), cA + hstepA, voffA);
    if (wr == 1) PG8_BAR;
    PG8_WAIT_V(4); PG8_BAR;
    PG8_STAGE(PG8_SB(1, 0), cB + kstep, voffB); PG8_STAGE(PG8_SA(1, 0), cA + kstep, voffA); PG8_STAGE(PG8_SB(1, 1), cB + hstepB + kstep, voffB);
    PG8_WAIT_V(6); PG8_BAR;
    }
    for (;;) {
        const bool has_next = S.next(ui + 1, nxt);
        const char* nA = has_next ? (const char*)g.A + (size_t)nxt.pm * tstepA : cA; const char* nB = has_next ? (const char*)g.Bt + (size_t)nxt.pn * tstepB : cB;
        for (int t = 0; t < nt; t += 2) {
            const bool last = (t == nt - 2);
            const char* a1 = cA + (size_t)(t + 1) * kstep;
            const char* a2 = last ? nA : cA + (size_t)(t + 2) * kstep; const char* b2 = last ? nB : cB + (size_t)(t + 2) * kstep;
            const char* a3 = a2 + kstep; const char* b3 = b2 + kstep;
            if constexpr (SP2) {
            PG8_LDB(B0, 0, 0); PG8_LDB(B1, 0, 1); PG8_SCHED; PG8_LDA(At, 0, 0); PG8_STAGE(PG8_SA(1, 1), a1 + hstepA, voffA);
            PG8_WAIT_V(8); PG8_WAIT_L(0); PG8_BAR; PG8_MMA(0, 0, At, B0); PG8_MMA(0, 1, At, B1); PG8_BAR; PG8_SCHED;
            PG8_LDA(At, 0, 1); PG8_STAGE(PG8_SB(0, 0), b2, voffB); PG8_STAGE(PG8_SB(0, 1), b2 + hstepB, voffB); PG8_STAGE(PG8_SA(0, 0), a2, voffA);
            PG8_WAIT_V(8); PG8_WAIT_L(0); PG8_BAR; PG8_MMA(1, 0, At, B0); PG8_MMA(1, 1, At, B1); PG8_BAR; PG8_SCHED;
            PG8_LDB(B0, 1, 0); PG8_LDB(B1, 1, 1); PG8_SCHED; PG8_LDA(At, 1, 0); PG8_STAGE(PG8_SA(0, 1), a2 + hstepA, voffA);
            PG8_WAIT_V(8); PG8_WAIT_L(0); PG8_BAR; PG8_MMA(0, 0, At, B0); PG8_MMA(0, 1, At, B1); PG8_BAR; PG8_SCHED;
            PG8_LDA(At, 1, 1); PG8_STAGE(PG8_SB(1, 0), b3, voffB); PG8_STAGE(PG8_SB(1, 1), b3 + hstepB, voffB); PG8_STAGE(PG8_SA(1, 0), a3, voffA);
            PG8_WAIT_V(8); PG8_WAIT_L(0); PG8_BAR; PG8_MMA(1, 0, At, B0); PG8_MMA(1, 1, At, B1); PG8_BAR; PG8_SCHED;
            } else {
            PG8_LDB(B0, 0, 0); PG8_SCHED; PG8_LDA(At, 0, 0); PG8_STAGE(PG8_SA(1, 1), a1 + hstepA, voffA);
            PG8_WAIT_L(8); PG8_BAR; PG8_WAIT_L(0); PG8_MMA(0, 0, At, B0); PG8_BAR; PG8_SCHED;
            PG8_LDB(B1, 0, 1); PG8_STAGE(PG8_SB(0, 0), b2, voffB);
            PG8_BAR; PG8_WAIT_L(0); PG8_MMA(0, 1, At, B1); PG8_BAR;
            PG8_LDA(At, 0, 1); PG8_STAGE(PG8_SA(0, 0), a2, voffA);
            PG8_BAR; PG8_WAIT_L(0); PG8_MMA(1, 0, At, B0); PG8_BAR; PG8_SCHED;
            PG8_STAGE(PG8_SB(0, 1), b2 + hstepB, voffB);
            PG8_WAIT_V(6); PG8_BAR; PG8_MMA(1, 1, At, B1); PG8_BAR;
            PG8_LDB(B0, 1, 0); PG8_SCHED; PG8_LDA(At, 1, 0); PG8_STAGE(PG8_SA(0, 1), a2 + hstepA, voffA);
            PG8_WAIT_L(8); PG8_BAR; PG8_WAIT_L(0); PG8_MMA(0, 0, At, B0); PG8_BAR; PG8_SCHED;
            PG8_LDB(B1, 1, 1); PG8_STAGE(PG8_SB(1, 0), b3, voffB);
            PG8_BAR; PG8_WAIT_L(0); PG8_MMA(0, 1, At, B1); PG8_BAR;
            PG8_LDA(At, 1, 1); PG8_STAGE(PG8_SA(1, 0), a3, voffA);
            PG8_BAR; PG8_WAIT_L(0); PG8_MMA(1, 0, At, B0); PG8_BAR; PG8_SCHED;
            PG8_STAGE(PG8_SB(1, 1), b3 + hstepB, voffB);
            PG8_WAIT_V(6); PG8_BAR; PG8_MMA(1, 1, At, B1); PG8_BAR;
            }
        }
        if constexpr (SP2) { if (wr == 0) PG8_BAR; }
        { int el; asm volatile("v_mbcnt_lo_u32_b32 %0, -1, 0\n\tv_mbcnt_hi_u32_b32 %0, -1, %0" : "=v"(el)); E(acc, cur, wr, wc, el & 15, el >> 4); }
        if (!has_next) break;
#pragma unroll
        for (int a = 0; a < 2; ++a)
#pragma unroll
            for (int b = 0; b < 2; ++b)
#pragma unroll
                for (int m = 0; m < 4; ++m)
#pragma unroll
                    for (int n = 0; n < 2; ++n) acc[a][b][m][n] = (f32x4){0.f, 0.f, 0.f, 0.f};
        cur = nxt; cA = nA; cB = nB; ++ui;
        if constexpr (SP2) { if (wr == 1) PG8_BAR; }
    }
    PG8_WAIT_V(0);
    if constexpr (!SP2) { if (wr == 0) PG8_BAR; }
    PG8_BAR;
#undef PG8_SA
#undef PG8_SB
#undef PG8_STAGE
#undef PG8_LDA
#undef PG8_LDB
#undef PG8_MMA
#undef PG8_WAIT_V
#undef PG8_WAIT_L
#undef PG8_BAR
#undef PG8_SCHED
}

#if defined(MK_SIMPLE_GEMM)
template <class Epi>
__device__ __forceinline__ void gemm_phase_simple(const Gemm g, const StaticOrder& S, const Epi& E) {
    const int tid = threadIdx.x, wid = __builtin_amdgcn_readfirstlane(tid >> 6), lane = tid & 63, wr = wid >> 2, wc = wid & 3, fr = lane & 15, fq = lane >> 4;
    Unit cur;
    for (int ui = 0; S.next(ui, cur); ++ui) {
        f32x4 acc[2][2][4][2];
#pragma unroll
        for (int a = 0; a < 2; ++a)
#pragma unroll
            for (int b = 0; b < 2; ++b)
#pragma unroll
                for (int m = 0; m < 4; ++m)
#pragma unroll
                    for (int n = 0; n < 2; ++n) acc[a][b][m][n] = (f32x4){0.f, 0.f, 0.f, 0.f};
        for (int k0 = 0; k0 < g.K; k0 += 32) {
            bf16x8 bf[2][2];
#pragma unroll
            for (int bj = 0; bj < 2; ++bj)
#pragma unroll
                for (int n = 0; n < 2; ++n) { const int slot = 16 * n + fr; const int wrow = cur.pn * BM + bj * HALF + wc * 32 + (Epi::PERM ? perm32(slot) : slot);
                    bf[bj][n] = *(const bf16x8*)(g.Bt + (size_t)wrow * g.K + k0 + 8 * fq); }
#pragma unroll
            for (int ai = 0; ai < 2; ++ai)
#pragma unroll
                for (int m = 0; m < 4; ++m) { const int arow = cur.pm * BM + ai * HALF + wr * 64 + m * 16 + fr;
                    const bf16x8 af = *(const bf16x8*)(g.A + (size_t)arow * g.lda + k0 + 8 * fq);
#pragma unroll
                    for (int bj = 0; bj < 2; ++bj)
#pragma unroll
                        for (int n = 0; n < 2; ++n) acc[ai][bj][m][n] = __builtin_amdgcn_mfma_f32_16x16x32_bf16(bf[bj][n], af, acc[ai][bj][m][n], 0, 0, 0); }
        }
        E(acc, cur, wr, wc, fr, fq);
    }
}
#define GEMM_PHASE(EPI, lds, g, S, E) pg8::gemm_phase_simple<EPI>(g, S, E)
#define GEMM_PHASE2(EPI, lds, g, S, E) pg8::gemm_phase_simple<EPI>(g, S, E)
#else
#define GEMM_PHASE(EPI, lds, g, S, E) pg8::gemm_phase<EPI, true>(lds, g, S, E)
#define GEMM_PHASE2(EPI, lds, g, S, E) pg8::gemm_phase<EPI, false>(lds, g, S, E)
#endif
struct EpiSwiglu {
    static constexpr bool PERM = true;
    bf16_t* O; int ldc;
    __device__ __forceinline__ void operator()(const f32x4 (&acc)[2][2][4][2], const Unit& u, int wr, int wc, int fr, int fq) const {
        const int row0 = u.pm * BM + wr * 64 + fr, col0 = u.pn * 128 + wc * 32 + 8 * fq;
#pragma unroll
        for (int ai = 0; ai < 2; ++ai)
#pragma unroll
            for (int m = 0; m < 4; ++m) {
                bf16_t* rowp = O + (size_t)(row0 + ai * HALF + m * 16) * ldc + col0;
                const f32x4 g0 = acc[ai][0][m][0], g1 = acc[ai][0][m][1], u0 = acc[ai][1][m][0], u1 = acc[ai][1][m][1];
                float v[8];
#pragma unroll
                for (int j = 0; j < 4; ++j) { v[j] = fsilu(g0[j]) * u0[j]; v[4 + j] = fsilu(g1[j]) * u1[j]; }
                u32x4 w; w.x = pk_bf16(v[0], v[1]); w.y = pk_bf16(v[2], v[3]); w.z = pk_bf16(v[4], v[5]); w.w = pk_bf16(v[6], v[7]);
                *(u32x4*)rowp = w;
                asm volatile("" ::: "memory");
            }
    }
};
__device__ __forceinline__ void store_tile_bf16(const f32x4 (&acc)[2][2][4][2], bf16_t* base, int ld, int row0, int col0, int act) {
#pragma unroll
    for (int ai = 0; ai < 2; ++ai)
#pragma unroll
        for (int m = 0; m < 4; ++m) {
            bf16_t* rowp = base + (size_t)(row0 + ai * HALF + m * 16) * ld + col0;
#pragma unroll
            for (int bj = 0; bj < 2; ++bj) {
                f32x4 v0 = acc[ai][bj][m][0], v1 = acc[ai][bj][m][1];
                if (act == 1) {
#pragma unroll
                    for (int j = 0; j < 4; ++j) { v0[j] = fgelu(v0[j]); v1[j] = fgelu(v1[j]); }
                } else if (act == 2) {
#pragma unroll
                    for (int j = 0; j < 4; ++j) { v0[j] = fsigmoid(v0[j]); v1[j] = fsigmoid(v1[j]); }
                }
                u32x4 w; w.x = pk_bf16(v0[0], v0[1]); w.y = pk_bf16(v0[2], v0[3]); w.z = pk_bf16(v1[0], v1[1]); w.w = pk_bf16(v1[2], v1[3]);
                *(u32x4*)(rowp + bj * HALF) = w;
            }
            asm volatile("" ::: "memory");
        }
}
template <int ACT> struct EpiAct {
    static constexpr bool PERM = true;
    bf16_t* p; int ld, pn0;
    __device__ __forceinline__ void operator()(const f32x4 (&acc)[2][2][4][2], const Unit& u, int wr, int wc, int fr, int fq) const {
        store_tile_bf16(acc, p, ld, u.pm * BM + wr * 64 + fr, (u.pn - pn0) * BM + wc * 32 + 8 * fq, ACT);
    }
};
struct EpiWinA {
    static constexpr bool PERM = true;
    bf16_t* zq; bf16_t* xl; bf16_t* gy;
    __device__ __forceinline__ void operator()(const f32x4 (&acc)[2][2][4][2], const Unit& u, int wr, int wc, int fr, int fq) const {
        size_t boff = 0; if (u.pn >= 2) boff += (size_t)((const char*)xl - (const char*)zq); if (u.pn >= 6) boff += (size_t)((const char*)gy - (const char*)xl);
        bf16_t* base = (bf16_t*)((char*)zq + boff);
        int ld = 512, pn0 = 0; if (u.pn >= 2) { ld = D; pn0 = 2; } if (u.pn >= 6) pn0 = 6;
        store_tile_bf16(acc, base, ld, u.pm * BM + wr * 64 + fr, (u.pn - pn0) * BM + wc * 32 + 8 * fq, u.pn < 6 ? 0 : 1);
    }
};
struct EpiWinB {
    static constexpr bool PERM = true;
    bf16_t* ga; bf16_t* gl;
    __device__ __forceinline__ void operator()(const f32x4 (&acc)[2][2][4][2], const Unit& u, int wr, int wc, int fr, int fq) const {
        store_tile_bf16(acc, u.pn < 4 ? ga : gl, D, u.pm * BM + wr * 64 + fr, (u.pn & 3) * BM + wc * 32 + 8 * fq, 2);
    }
};
template <bool ADD> struct EpiGate {
    static constexpr bool PERM = true;
    const bf16_t* gate; const bf16_t* add; bf16_t* out;
    __device__ __forceinline__ void operator()(const f32x4 (&acc)[2][2][4][2], const Unit& u, int wr, int wc, int fr, int fq) const {
        const int row0 = u.pm * BM + wr * 64 + fr, col0 = u.pn * BM + wc * 32 + 8 * fq;
#pragma unroll
        for (int ai = 0; ai < 2; ++ai)
#pragma unroll
            for (int m = 0; m < 4; ++m) {
                const size_t off = (size_t)(row0 + ai * HALF + m * 16) * D + col0;
#pragma unroll
                for (int bj = 0; bj < 2; ++bj) {
                    const u32x4 gw = *(const u32x4*)(gate + off + bj * HALF);
                    const f32x4 v0 = acc[ai][bj][m][0], v1 = acc[ai][bj][m][1];
                    float r[8];
                    r[0] = lo_bf(gw.x) * v0[0]; r[1] = hi_bf(gw.x) * v0[1]; r[2] = lo_bf(gw.y) * v0[2]; r[3] = hi_bf(gw.y) * v0[3];
                    r[4] = lo_bf(gw.z) * v1[0]; r[5] = hi_bf(gw.z) * v1[1]; r[6] = lo_bf(gw.w) * v1[2]; r[7] = hi_bf(gw.w) * v1[3];
                    if (ADD) {
                        const u32x4 aw = *(const u32x4*)(add + off + bj * HALF);
                        r[0] += lo_bf(aw.x); r[1] += hi_bf(aw.x); r[2] += lo_bf(aw.y); r[3] += hi_bf(aw.y);
                        r[4] += lo_bf(aw.z); r[5] += hi_bf(aw.z); r[6] += lo_bf(aw.w); r[7] += hi_bf(aw.w);
                    }
                    u32x4 w; w.x = pk_bf16(r[0], r[1]); w.y = pk_bf16(r[2], r[3]); w.z = pk_bf16(r[4], r[5]); w.w = pk_bf16(r[6], r[7]);
                    *(u32x4*)(out + off + bj * HALF) = w;
                }
                asm volatile("" ::: "memory");
            }
    }
};
struct EpiQKV {
    static constexpr bool PERM = true;
    bf16_t* Q; bf16_t* Kn; const float* stats;
    __device__ __forceinline__ void operator()(const f32x4 (&acc)[2][2][4][2], const Unit& u, int wr, int wc, int fr, int fq) const {
        const int row0 = u.pm * BM + wr * 64 + fr;
        const int sel = u.pn < 3 ? 0 : 1;
        bf16_t* dst = Q; int ld = NQ, ctile = u.pn * BM;
        if (u.pn >= 3) { dst = Kn; ld = NKV; ctile = ((u.pn - 3) & 1) * BM; if (u.pn >= 5) dst += (size_t)T * NKV; }
        const int col0 = ctile + wc * 32 + 8 * fq;
#pragma unroll
        for (int ai = 0; ai < 2; ++ai)
#pragma unroll
            for (int m = 0; m < 4; ++m) {
                const int row = row0 + ai * HALF + m * 16;
                const float rs = stats[2 * row + sel];
                bf16_t* rowp = dst + (size_t)row * ld + col0;
#pragma unroll
                for (int bj = 0; bj < 2; ++bj) {
                    const f32x4 v0 = acc[ai][bj][m][0] * rs, v1 = acc[ai][bj][m][1] * rs;
                    u32x4 w; w.x = pk_bf16(v0[0], v0[1]); w.y = pk_bf16(v0[2], v0[3]); w.z = pk_bf16(v1[0], v1[1]); w.w = pk_bf16(v1[2], v1[3]);
                    *(u32x4*)(rowp + bj * HALF) = w;
                }
                asm volatile("" ::: "memory");
            }
    }
};
}

struct TJob { const float* src; const float* scale; bf16_t* dst; int ldsrc, K, lddst, dstk0, nrb, map, nbatch, sbs, dbs; };
__device__ __forceinline__ int srccol(int map, int rb) {
    const int r = rb * 32;
    switch (map) {
        case 1: { const int pn = r >> 8, w = r & 255; return w < 128 ? 128 * pn + w : DFF + 128 * pn + (w - 128); }
        case 2: { if (r < 416) return r; if (r < 512) return -1; return r - 96; }
        case 3: return 2464 + r;
        case 4: { const int v = r >= 512 ? 1 : 0; const int rr = r & 511; return (rr >> 6) * 128 + (rr & 63) + 64 * v; }
        default: return r;
    }
}
constexpr int NJOBS = 15;
__device__ __forceinline__ TJob get_job(const Params& p, int j) {
    TJob t; t.scale = nullptr; t.dstk0 = 0; t.map = 0; t.nbatch = 1; t.sbs = 0; t.dbs = 0;
    unsigned char* ws = p.ws;
    switch (j) {
        case 0:  t.src = p.in[8];  t.dst = (bf16_t*)(ws + WS_WGU1); t.ldsrc = 2 * DFF; t.K = D; t.lddst = D; t.nrb = 176; t.map = 1; break;
        case 1:  t.src = p.in[9];  t.dst = (bf16_t*)(ws + WS_WDN1); t.ldsrc = D; t.K = DFF; t.lddst = DFF; t.nrb = 32; break;
        case 2:  t.src = p.in[10]; t.dst = (bf16_t*)(ws + WS_WINA); t.ldsrc = 4512; t.K = D; t.lddst = D; t.nrb = 80; t.map = 2; break;
        case 3:  t.src = p.in[10]; t.dst = (bf16_t*)(ws + WS_WINB); t.ldsrc = 4512; t.K = D; t.lddst = D; t.nrb = 64; t.map = 3; break;
        case 4:  t.src = p.in[13]; t.scale = p.in[11]; t.dst = (bf16_t*)(ws + WS_WQKV); t.ldsrc = 768; t.K = 256; t.lddst = 384; t.nrb = 24; break;
        case 5:  t.src = nullptr;  t.dst = (bf16_t*)(ws + WS_WQKV); t.ldsrc = 0; t.K = 128; t.lddst = 384; t.dstk0 = 256; t.nrb = 24; break;
        case 6:  t.src = p.in[14]; t.scale = p.in[12]; t.dst = (bf16_t*)(ws + WS_WQKV) + 768 * 384; t.ldsrc = 1024; t.K = 128; t.lddst = 384; t.dstk0 = 256; t.nrb = 32; t.map = 4; break;
        case 7:  t.src = nullptr;  t.dst = (bf16_t*)(ws + WS_WQKV) + 768 * 384; t.ldsrc = 0; t.K = 256; t.lddst = 384; t.nrb = 32; break;
        case 8:  t.src = p.in[15]; t.dst = (bf16_t*)(ws + WS_WAO); t.ldsrc = D; t.K = 512; t.lddst = 512; t.nrb = 32; break;
        case 9:  t.src = p.in[23]; t.dst = (bf16_t*)(ws + WS_WLO); t.ldsrc = D; t.K = D; t.lddst = D; t.nrb = 32; break;
        case 10: t.src = p.in[24]; t.dst = (bf16_t*)(ws + WS_WOUT); t.ldsrc = D; t.K = D; t.lddst = D; t.nrb = 32; break;
        case 11: t.src = p.in[25]; t.dst = (bf16_t*)(ws + WS_WGU2); t.ldsrc = 2 * DFF; t.K = D; t.lddst = D; t.nrb = 176; t.map = 1; break;
        case 12: t.src = p.in[26]; t.dst = (bf16_t*)(ws + WS_WDN2); t.ldsrc = D; t.K = DFF; t.lddst = DFF; t.nrb = 32; break;
        case 13: t.src = p.in[18]; t.dst = (bf16_t*)(ws + WS_WG); t.ldsrc = 128; t.K = 128; t.lddst = 128; t.nrb = 4; t.nbatch = 16; t.sbs = 16384; t.dbs = 32768; break;
        default: t.src = p.in[20]; t.dst = (bf16_t*)(ws + WS_WG) + 16384; t.ldsrc = 128; t.K = 128; t.lddst = 128; t.nrb = 4; t.nbatch = 16; t.sbs = 16384; t.dbs = 32768; break;
    }
    return t;
}
__device__ __forceinline__ int job_items(const TJob& t) { return t.nbatch * t.nrb * (t.K >> 6); }

__device__ __forceinline__ void tr_item(const TJob& jb, int item, LAS float* scr, int lane) {
    const int nkb = jb.K >> 6, per_batch = jb.nrb * nkb;
    const int bt = item / per_batch, r = item - bt * per_batch, rb = r / nkb, kb = r - rb * nkb;
    const int sc = srccol(jb.map, rb), k0 = 64 * kb;
    if (jb.src != nullptr && sc >= 0) {
        const float* src = jb.src + (size_t)bt * jb.sbs;
#pragma unroll 8
        for (int i = 0; i < 32; ++i) { const int kk = 2 * i + (lane >> 5);
            float v = src[(size_t)(k0 + kk) * jb.ldsrc + sc + (lane & 31)];
            if (jb.scale) v *= jb.scale[k0 + kk];
            scr[kk * 33 + (lane & 31)] = v; }
    } else {
#pragma unroll 8
        for (int i = 0; i < 32; ++i) { const int kk = 2 * i + (lane >> 5); scr[kk * 33 + (lane & 31)] = 0.f; }
    }
    asm volatile("s_waitcnt lgkmcnt(0)" ::: "memory");
    bf16_t* dst = jb.dst + (size_t)bt * jb.dbs;
    const int c = lane & 7;
#pragma unroll
    for (int j = 0; j < 4; ++j) { const int n = (lane >> 3) + 8 * j; const LAS float* s = scr + (8 * c) * 33 + n;
        u32x4 o; o.x = pk_bf16(s[0 * 33], s[1 * 33]); o.y = pk_bf16(s[2 * 33], s[3 * 33]); o.z = pk_bf16(s[4 * 33], s[5 * 33]); o.w = pk_bf16(s[6 * 33], s[7 * 33]);
        *(u32x4*)(dst + (size_t)(32 * rb + n) * jb.lddst + jb.dstk0 + k0 + 8 * c) = o; }
    asm volatile("s_waitcnt lgkmcnt(0)" ::: "memory");
}

__device__ __forceinline__ void phase_prep(const Params& p, LAS unsigned char* lds) {
    const int tid = threadIdx.x, lane = tid & 63, wave = tid >> 6;
    const int gw = blockIdx.x * NWAVES + wave, NGW = gridDim.x * NWAVES;
    {
        LAS float* scr = (LAS float*)(lds + wave * 8704);
        int base = 0;
        for (int j = 0; j < NJOBS; ++j) {
            const TJob jb = get_job(p, j); const int n = job_items(jb);
            int first = gw - (base % NGW); if (first < 0) first += NGW;
            for (int i = first; i < n; i += NGW) tr_item(jb, i, scr, lane);
            base += n;
        }
    }
    {
        const int gt = blockIdx.x * NTHREADS + tid;
        if (gt < SS * 16) {
            const int pos = gt >> 4, i = gt & 15;
            double inv = 1.0; for (int q = 0; q < i; ++q) inv *= 0.5623413251903491;
            const float ang = (float)pos * (float)inv;
            const double rev = (double)ang * 0.15915494309189535; const float fr = (float)(rev - rint(rev));
            ((float*)(p.ws + WS_ROPE))[gt] = __builtin_amdgcn_cosf(fr);
            ((float*)(p.ws + WS_ROPE))[SS * 16 + gt] = __builtin_amdgcn_sinf(fr);
        }
    }
    __syncthreads();
    for (int item = blockIdx.x; item < 144; item += gridDim.x) {
        LAS float* sc = (LAS float*)(lds) + wave * (128 * 33);
        for (int i = 0; i < 64; ++i) { const int idx = lane + 64 * i, kl = idx & 127, b = idx >> 7;
            const float cv = (b < 16 ? p.in[2] : p.in[3])[(b & 15) * D + 128 * wave + kl];
            sc[kl * 33 + b] = fsilu(cv); }
        asm volatile("s_waitcnt lgkmcnt(0)" ::: "memory");
        float acc[32];
#pragma unroll
        for (int b = 0; b < 32; ++b) acc[b] = 0.f;
        const float* W = p.in[4] + (size_t)(128 * wave) * 9216 + item * 64 + lane;
        for (int k = 0; k < 128; ++k) { const float wv = W[(size_t)k * 9216];
#pragma unroll
            for (int b = 0; b < 32; ++b) acc[b] += sc[k * 33 + b] * wv; }
        __syncthreads();
        LAS float* red = (LAS float*)(lds);
#pragma unroll
        for (int b = 0; b < 32; ++b) red[(wave * 32 + b) * 64 + lane] = acc[b];
        __syncthreads();
        for (int o = tid; o < 2048; o += NTHREADS) { const int b = o >> 6, col = o & 63; float s = 0.f;
#pragma unroll
            for (int w = 0; w < 8; ++w) s += red[(w * 32 + b) * 64 + col];
            const int j = item * 64 + col;
            ((float*)(p.ws + WS_MOD))[b * 9216 + j] = s + p.in[5][j]; }
        __syncthreads();
    }
}

template <bool HAS_F, bool HAS_H>
__device__ __forceinline__ void phase_rows(const Params& p, int sp, int sn, float resw, bool from_input) {
    const int tid = threadIdx.x, lane = tid & 63, wave = tid >> 6;
    const int gw = blockIdx.x * NWAVES + wave, NGW = gridDim.x * NWAVES;
    const float* mod = (const float*)(p.ws + WS_MOD);
    const bf16_t* F = (const bf16_t*)(p.ws + WS_F);
    bf16_t* H = (bf16_t*)(p.ws + WS_H);
    for (int row = gw; row < T; row += NGW) {
        const int b = row_batch(row);
        const float* xin = !from_input ? p.out + (size_t)row * D : (row < TP ? p.in[0] + (size_t)row * D : p.in[1] + (size_t)(row - TP) * D);
        f32x4 v[4];
#pragma unroll
        for (int j = 0; j < 4; ++j) v[j] = *(const f32x4*)(xin + 4 * lane + 256 * j);
        if (HAS_F) {
            f32x4 f[4]; float ss = 0.f;
#pragma unroll
            for (int j = 0; j < 4; ++j) { const u32x2 w = *(const u32x2*)(F + (size_t)row * D + 4 * lane + 256 * j);
                f[j] = (f32x4){lo_bf(w.x), hi_bf(w.x), lo_bf(w.y), hi_bf(w.y)}; ss += (f[j].x * f[j].x + f[j].y * f[j].y) + (f[j].z * f[j].z + f[j].w * f[j].w); }
            const float rs = 1.0f / sqrtf(wave_sum(ss) * (1.0f / D) + EPS) * resw;
            const float* gate = mod + b * 9216 + sp * 3072 + 2048; const float* gp = p.in[7] + sp * D;
#pragma unroll
            for (int j = 0; j < 4; ++j) { const f32x4 g = *(const f32x4*)(gate + 4 * lane + 256 * j), q = *(const f32x4*)(gp + 4 * lane + 256 * j);
                v[j] = v[j] + g * (f[j] * rs * q);
                *(f32x4*)(p.out + (size_t)row * D + 4 * lane + 256 * j) = v[j]; }
        }
        if (HAS_H) {
            float ss = 0.f;
#pragma unroll
            for (int j = 0; j < 4; ++j) ss += (v[j].x * v[j].x + v[j].y * v[j].y) + (v[j].z * v[j].z + v[j].w * v[j].w);
            const float rs = 1.0f / sqrtf(wave_sum(ss) * (1.0f / D) + EPS);
            const float* sh = mod + b * 9216 + sn * 3072; const float* scl = sh + 1024; const float* gq = p.in[6] + sn * D;
#pragma unroll
            for (int j = 0; j < 4; ++j) { const f32x4 a = *(const f32x4*)(sh + 4 * lane + 256 * j), s = *(const f32x4*)(scl + 4 * lane + 256 * j), q = *(const f32x4*)(gq + 4 * lane + 256 * j);
                const f32x4 h = (v[j] * rs * q) * (s + 1.0f) + a;
                u32x2 w; w.x = pk_bf16(h.x, h.y); w.y = pk_bf16(h.z, h.w);
                *(u32x2*)(H + (size_t)row * D + 4 * lane + 256 * j) = w; }
        }
    }
}

__device__ __forceinline__ void phase_stats(const Params& p) {
    const int tid = threadIdx.x, lane = tid & 63, wave = tid >> 6;
    const int gw = blockIdx.x * NWAVES + wave, NGW = gridDim.x * NWAVES;
    const bf16_t* ZQ = (const bf16_t*)(p.ws + WS_ZQ);
    float* stats = (float*)(p.ws + WS_STATS); bf16_t* KR = (bf16_t*)(p.ws + WS_KR);
    const float* rc = (const float*)(p.ws + WS_ROPE); const float* rsn = rc + SS * 16;
    for (int row = gw; row < T; row += NGW) {
        const u32x4 w = *(const u32x4*)(ZQ + (size_t)row * 512 + 8 * lane);
        float x[8] = {lo_bf(w.x), hi_bf(w.x), lo_bf(w.y), hi_bf(w.y), lo_bf(w.z), hi_bf(w.z), lo_bf(w.w), hi_bf(w.w)};
        float ss = 0.f;
#pragma unroll
        for (int e = 0; e < 8; ++e) ss += x[e] * x[e];
        const float sq = wave_sum(lane < 32 ? ss : 0.f), skv = wave_sum((lane >= 32 && lane < 48) ? ss : 0.f);
        if (lane == 0) { f32x2 st; st.x = 1.0f / sqrtf(sq * (1.0f / 256.0f) + EPS); st.y = 1.0f / sqrtf(skv * (1.0f / 128.0f) + EPS); *(f32x2*)(stats + 2 * row) = st; }
        float y[8];
#pragma unroll
        for (int e = 0; e < 8; ++e) y[e] = __shfl_xor(x[e], 2);
        if (lane >= 48 && lane < 52) {
            const int pos = row_pos(row), i0 = 8 * (lane & 1);
            const f32x4 c0 = *(const f32x4*)(rc + pos * 16 + i0), c1 = *(const f32x4*)(rc + pos * 16 + i0 + 4);
            const f32x4 s0 = *(const f32x4*)(rsn + pos * 16 + i0), s1 = *(const f32x4*)(rsn + pos * 16 + i0 + 4);
            const float c[8] = {c0.x, c0.y, c0.z, c0.w, c1.x, c1.y, c1.z, c1.w}, s[8] = {s0.x, s0.y, s0.z, s0.w, s1.x, s1.y, s1.z, s1.w};
            float o[8];
            const bool first = lane < 50;
#pragma unroll
            for (int e = 0; e < 8; ++e) o[e] = first ? (x[e] * c[e] - y[e] * s[e]) : (x[e] * c[e] + y[e] * s[e]);
            u32x4 ow; ow.x = pk_bf16(o[0], o[1]); ow.y = pk_bf16(o[2], o[3]); ow.z = pk_bf16(o[4], o[5]); ow.w = pk_bf16(o[6], o[7]);
            *(u32x4*)(KR + (size_t)row * 32 + 8 * (lane - 48)) = ow;
        }
    }
}

constexpr int XC_PITCH = 272;
__device__ __forceinline__ void phase_lru(const Params& p, LAS unsigned char* lds) {
    const int tid = threadIdx.x, lane = tid & 63, wave = __builtin_amdgcn_readfirstlane(tid >> 6), g = lane >> 4, lc = lane & 15;
    const bf16_t* XL = (const bf16_t*)(p.ws + WS_XL); bf16_t* GY = (bf16_t*)(p.ws + WS_GY); bf16_t* HF = (bf16_t*)(p.ws + WS_F);
    const bf16_t* WG = (const bf16_t*)(p.ws + WS_WG);
    for (int item = blockIdx.x; item < 256; item += gridDim.x) {
        int gb, n;
        if (item < 128) { gb = 16 + (item >> 3); n = item & 7; } else { gb = (item - 128) >> 3; n = item & 7; }
        const int S = gb < 16 ? SP : SS; const int row0 = gb < 16 ? gb * SP : TP + (gb - 16) * SS;
        const int nch = S >> 6;
        const int tr = tid >> 4, cgp = (tid & 15) * 8, c0 = 128 * n + cgp;
        float cw[4][8], cb[8];
#pragma unroll
        for (int j = 0; j < 4; ++j) { const f32x4 a = *(const f32x4*)(p.in[16] + j * D + c0), b = *(const f32x4*)(p.in[16] + j * D + c0 + 4);
            cw[j][0] = a.x; cw[j][1] = a.y; cw[j][2] = a.z; cw[j][3] = a.w; cw[j][4] = b.x; cw[j][5] = b.y; cw[j][6] = b.z; cw[j][7] = b.w; }
        { const f32x4 a = *(const f32x4*)(p.in[17] + c0), b = *(const f32x4*)(p.in[17] + c0 + 4);
            cb[0] = a.x; cb[1] = a.y; cb[2] = a.z; cb[3] = a.w; cb[4] = b.x; cb[5] = b.y; cb[6] = b.z; cb[7] = b.w; }
        const int ch = 128 * n + 16 * wave + lc;
        for (int d = 0; d < 2; ++d) {
            bf16x8 Ba[4], Bi[4];
            { const bf16_t* wa = WG + (size_t)((d * 8 + n) * 2 + 0) * 16384 + (size_t)(16 * wave + lc) * 128 + 8 * g; const bf16_t* wi = wa + 16384;
#pragma unroll
              for (int ks = 0; ks < 4; ++ks) { Ba[ks] = *(const bf16x8*)(wa + 32 * ks); Bi[ks] = *(const bf16x8*)(wi + 32 * ks); } }
            const float ba = p.in[19][d * D + ch], bi = p.in[21][d * D + ch];
            const float lam = p.in[22][d * D + ch];
            const float c8 = -8.0f * log1pf(expf(-lam));
            float carry = 0.f;
            u32x4 pw[2][4];
#define LRU_PREFETCH(CI) do { const int _cc = d ? (nch - 1 - (CI)) : (CI); _Pragma("unroll") for (int hf = 0; hf < 2; ++hf) _Pragma("unroll") for (int j = 0; j < 4; ++j) { \
                const int tt = _cc * 64 + tr + 32 * hf + j - 1; pw[hf][j] = (tt >= 0 && tt < S) ? *(const u32x4*)(XL + (size_t)(row0 + tt) * D + c0) : (u32x4){0u, 0u, 0u, 0u}; } } while (0)
            LRU_PREFETCH(0);
            for (int ci = 0; ci < nch; ++ci) {
                const int cc = d ? (nch - 1 - ci) : ci, t0 = cc * 64;
                __syncthreads();
#pragma unroll
                for (int hf = 0; hf < 2; ++hf) {
                    const int tl = tr + 32 * hf;
                    float a[8];
#pragma unroll
                    for (int e = 0; e < 8; ++e) a[e] = cb[e];
#pragma unroll
                    for (int j = 0; j < 4; ++j) { const u32x4 w = pw[hf][j];
                        a[0] += cw[j][0] * lo_bf(w.x); a[1] += cw[j][1] * hi_bf(w.x); a[2] += cw[j][2] * lo_bf(w.y); a[3] += cw[j][3] * hi_bf(w.y);
                        a[4] += cw[j][4] * lo_bf(w.z); a[5] += cw[j][5] * hi_bf(w.z); a[6] += cw[j][6] * lo_bf(w.w); a[7] += cw[j][7] * hi_bf(w.w); }
                    u32x4 o; o.x = pk_bf16(a[0], a[1]); o.y = pk_bf16(a[2], a[3]); o.z = pk_bf16(a[4], a[5]); o.w = pk_bf16(a[6], a[7]);
                    *(LAS u32x4*)(lds + tl * XC_PITCH + cgp * 2) = o;
                }
                __syncthreads();
                if (ci + 1 < nch) LRU_PREFETCH(ci + 1);
                float hfv[4][4], gyv[4][4];
                if (d == 1) {
#pragma unroll
                    for (int mt = 0; mt < 4; ++mt)
#pragma unroll
                        for (int j = 0; j < 4; ++j) { const size_t off = (size_t)(row0 + t0 + 16 * mt + 4 * g + j) * D + ch; hfv[mt][j] = bf2f(HF[off]); gyv[mt][j] = bf2f(GY[off]); }
                }
                f32x4 aa[4], ai[4];
#pragma unroll
                for (int mt = 0; mt < 4; ++mt) { aa[mt] = (f32x4){0.f, 0.f, 0.f, 0.f}; ai[mt] = (f32x4){0.f, 0.f, 0.f, 0.f}; }
#pragma unroll
                for (int ks = 0; ks < 4; ++ks)
#pragma unroll
                    for (int mt = 0; mt < 4; ++mt) { const bf16x8 A = *(const LAS bf16x8*)(lds + (16 * mt + lc) * XC_PITCH + (32 * ks + 8 * g) * 2);
                        aa[mt] = __builtin_amdgcn_mfma_f32_16x16x32_bf16(A, Ba[ks], aa[mt], 0, 0, 0);
                        ai[mt] = __builtin_amdgcn_mfma_f32_16x16x32_bf16(A, Bi[ks], ai[mt], 0, 0, 0); }
#pragma unroll
                for (int mt = 0; mt < 4; ++mt)
#pragma unroll
                    for (int j = 0; j < 4; ++j) {
                        const float xcv = bf2f(*(const LAS bf16_t*)(lds + (16 * mt + 4 * g + j) * XC_PITCH + (16 * wave + lc) * 2));
                        const float r = fsigmoid(aa[mt][j] + ba), ig = fsigmoid(ai[mt][j] + bi);
                        const float la = c8 * r;
                        const float av = fexp(la), om = (1.0f - av) * (1.0f + av);
                        aa[mt][j] = av; ai[mt][j] = sqrtf(om) * (ig * xcv);
                    }
                if (d == 0) {
#pragma unroll
                    for (int mt = 0; mt < 4; ++mt) {
                        float P = 1.f, Hh = 0.f, pl[4], hl[4];
#pragma unroll
                        for (int j = 0; j < 4; ++j) { Hh = aa[mt][j] * Hh + ai[mt][j]; P *= aa[mt][j]; hl[j] = Hh; pl[j] = P; }
                        float A = P, Hs = Hh;
                        { const float A1 = __shfl_up(A, 16), H1 = __shfl_up(Hs, 16); if (g >= 1) { Hs = A * H1 + Hs; A = A * A1; } }
                        { const float A2 = __shfl_up(A, 32), H2 = __shfl_up(Hs, 32); if (g >= 2) { Hs = A * H2 + Hs; A = A * A2; } }
                        float Aex = __shfl_up(A, 16), Hex = __shfl_up(Hs, 16); if (g == 0) { Aex = 1.f; Hex = 0.f; }
                        const float cin = Aex * carry + Hex;
                        const float At = __shfl(A, 48 + lc), Ht = __shfl(Hs, 48 + lc);
                        carry = At * carry + Ht;
#pragma unroll
                        for (int j = 0; j < 4; ++j) { const float h = hl[j] + pl[j] * cin;
                            HF[(size_t)(row0 + t0 + 16 * mt + 4 * g + j) * D + ch] = (bf16_t)(pk_bf16(h, 0.f) & 0xffffu); }
                    }
                } else {
#pragma unroll
                    for (int mt = 3; mt >= 0; --mt) {
                        float P = 1.f, Hh = 0.f, pl[4], hl[4];
#pragma unroll
                        for (int j = 3; j >= 0; --j) { Hh = aa[mt][j] * Hh + ai[mt][j]; P *= aa[mt][j]; hl[j] = Hh; pl[j] = P; }
                        float A = P, Hs = Hh;
                        { const float A1 = __shfl_down(A, 16), H1 = __shfl_down(Hs, 16); if (g <= 2) { Hs = A * H1 + Hs; A = A * A1; } }
                        { const float A2 = __shfl_down(A, 32), H2 = __shfl_down(Hs, 32); if (g <= 1) { Hs = A * H2 + Hs; A = A * A2; } }
                        float Aex = __shfl_down(A, 16), Hex = __shfl_down(Hs, 16); if (g == 3) { Aex = 1.f; Hex = 0.f; }
                        const float cin = Aex * carry + Hex;
                        const float At = __shfl(A, lc), Ht = __shfl(Hs, lc);
                        carry = At * carry + Ht;
#pragma unroll
                        for (int j = 0; j < 4; ++j) { const float h = hl[j] + pl[j] * cin;
                            const size_t off = (size_t)(row0 + t0 + 16 * mt + 4 * g + j) * D + ch;
                            const float o = (hfv[mt][j] + h) * gyv[mt][j];
                            GY[off] = (bf16_t)(pk_bf16(o, 0.f) & 0xffffu); }
                    }
                }
            }
        }
        __syncthreads();
    }
}

constexpr int AK_PITCH = 208, AV_PITCH = 160, AK_BYTES = 64 * AK_PITCH, AV_BYTES = 64 * AV_PITCH, ABUF = AK_BYTES + AV_BYTES;
__device__ __forceinline__ void phase_attn(const Params& p, LAS unsigned char* lds) {
    const int tid = threadIdx.x, lane = tid & 63, wave = __builtin_amdgcn_readfirstlane(tid >> 6), g = lane >> 4, lc = lane & 15;
    const bf16_t* Q = (const bf16_t*)(p.ws + WS_F); const bf16_t* KN = (const bf16_t*)(p.ws + WS_XL); const bf16_t* V = KN + (size_t)T * NKV;
    const bf16_t* KR = (const bf16_t*)(p.ws + WS_KR); bf16_t* O = (bf16_t*)(p.ws + WS_ZQ);
    const float csc = 0.10206207261596577f * 1.4426950408889634f;
    const int srow = tid >> 3, sch = tid & 7;
    const int rrow = (tid & 255) >> 2, rch = tid & 3;
    const int vtr = (4 * g + (lc >> 2)) * AV_PITCH + (4 * (lc & 3)) * 2;
    for (int unit = blockIdx.x; unit < 3072; unit += gridDim.x) {
        int gb, h, qt, S, row0;
        if (unit < 2048) { gb = 16 + (unit >> 7); h = (unit & 127) >> 4; qt = unit & 15; S = SS; row0 = TP + (gb - 16) * SS; }
        else { const int u2 = unit - 2048; gb = u2 >> 6; h = (u2 & 63) >> 3; qt = u2 & 7; S = SP; row0 = gb * SP; }
        const int nkt = S >> 6;
        const int qrow = row0 + 256 * qt + 32 * wave;
        bf16x8 qf[2][3];
#pragma unroll
        for (int q2 = 0; q2 < 2; ++q2)
#pragma unroll
            for (int ks = 0; ks < 3; ++ks) qf[q2][ks] = *(const bf16x8*)(Q + (size_t)(qrow + 16 * q2 + lc) * NQ + 96 * h + 32 * ks + 8 * g);
#pragma unroll
        for (int q2 = 0; q2 < 2; ++q2) {
            const int pos = row_pos(qrow + 16 * q2 + lc), i0 = 8 * (g & 1);
            const float* rc = (const float*)(p.ws + WS_ROPE) + pos * 16 + i0; const float* rsn = rc + SS * 16;
            const f32x4 c0 = *(const f32x4*)rc, c1 = *(const f32x4*)(rc + 4), s0 = *(const f32x4*)rsn, s1 = *(const f32x4*)(rsn + 4);
            const float cc[8] = {c0.x, c0.y, c0.z, c0.w, c1.x, c1.y, c1.z, c1.w}, sn[8] = {s0.x, s0.y, s0.z, s0.w, s1.x, s1.y, s1.z, s1.w};
            const u32x4 mine = __builtin_bit_cast(u32x4, qf[q2][2]);
            u32x4 oth; oth.x = __shfl_xor(mine.x, 32); oth.y = __shfl_xor(mine.y, 32); oth.z = __shfl_xor(mine.z, 32); oth.w = __shfl_xor(mine.w, 32);
            const float xm[8] = {lo_bf(mine.x), hi_bf(mine.x), lo_bf(mine.y), hi_bf(mine.y), lo_bf(mine.z), hi_bf(mine.z), lo_bf(mine.w), hi_bf(mine.w)};
            const float xo[8] = {lo_bf(oth.x), hi_bf(oth.x), lo_bf(oth.y), hi_bf(oth.y), lo_bf(oth.z), hi_bf(oth.z), lo_bf(oth.w), hi_bf(oth.w)};
            float o[8];
#pragma unroll
            for (int e = 0; e < 8; ++e) o[e] = g < 2 ? (xm[e] * cc[e] - xo[e] * sn[e]) : (xm[e] * cc[e] + xo[e] * sn[e]);
            u32x4 w; w.x = pk_bf16(o[0], o[1]); w.y = pk_bf16(o[2], o[3]); w.z = pk_bf16(o[4], o[5]); w.w = pk_bf16(o[6], o[7]);
            qf[q2][2] = __builtin_bit_cast(bf16x8, w);
        }
        f32x4 oacc[4][2];
#pragma unroll
        for (int dt = 0; dt < 4; ++dt) { oacc[dt][0] = (f32x4){0.f, 0.f, 0.f, 0.f}; oacc[dt][1] = (f32x4){0.f, 0.f, 0.f, 0.f}; }
        float mrun[2] = {-1e30f, -1e30f}, lrun[2] = {0.f, 0.f};
        u32x4 gk, gr, gv;
        gk = *(const u32x4*)(KN + (size_t)(row0 + srow) * NKV + 64 * h + 8 * sch);
        gv = *(const u32x4*)(V + (size_t)(row0 + srow) * NKV + 64 * h + 8 * sch);
        gr = *(const u32x4*)(KR + (size_t)(row0 + rrow) * 32 + 8 * rch);
        __syncthreads();
        *(LAS u32x4*)(lds + srow * AK_PITCH + sch * 16) = gk;
        *(LAS u32x4*)(lds + AK_BYTES + srow * AV_PITCH + sch * 16) = gv;
        if (tid < 256) *(LAS u32x4*)(lds + rrow * AK_PITCH + 128 + rch * 16) = gr;
        __syncthreads();
        for (int kt = 0; kt < nkt; ++kt) {
            LAS unsigned char* kb = lds + (kt & 1) * ABUF; LAS unsigned char* vb = kb + AK_BYTES;
            LAS unsigned char* nb = lds + ((kt + 1) & 1) * ABUF;
            const bool more = kt + 1 < nkt;
            if (more) { const int kr0 = row0 + 64 * (kt + 1);
                gk = *(const u32x4*)(KN + (size_t)(kr0 + srow) * NKV + 64 * h + 8 * sch);
                gv = *(const u32x4*)(V + (size_t)(kr0 + srow) * NKV + 64 * h + 8 * sch);
                gr = *(const u32x4*)(KR + (size_t)(kr0 + rrow) * 32 + 8 * rch); }
            f32x4 sacc[4][2];
#pragma unroll
            for (int k4 = 0; k4 < 4; ++k4) { sacc[k4][0] = (f32x4){0.f, 0.f, 0.f, 0.f}; sacc[k4][1] = (f32x4){0.f, 0.f, 0.f, 0.f}; }
#pragma unroll
            for (int ks = 0; ks < 3; ++ks)
#pragma unroll
                for (int k4 = 0; k4 < 4; ++k4) { const bf16x8 kf = *(const LAS bf16x8*)(kb + (16 * k4 + lc) * AK_PITCH + (32 * ks + 8 * g) * 2);
                    sacc[k4][0] = __builtin_amdgcn_mfma_f32_16x16x32_bf16(kf, qf[0][ks], sacc[k4][0], 0, 0, 0);
                    sacc[k4][1] = __builtin_amdgcn_mfma_f32_16x16x32_bf16(kf, qf[1][ks], sacc[k4][1], 0, 0, 0); }
            bf16x8 pf[2][2];
#pragma unroll
            for (int q2 = 0; q2 < 2; ++q2) {
                float mx = sacc[0][q2][0];
#pragma unroll
                for (int k4 = 0; k4 < 4; ++k4)
#pragma unroll
                    for (int j = 0; j < 4; ++j) mx = fmaxf(mx, sacc[k4][q2][j]);
                mx = fmaxf(mx, __shfl_xor(mx, 16)); mx = fmaxf(mx, __shfl_xor(mx, 32));
                const float mnew = fmaxf(mrun[q2], mx * csc);
                const float alpha = __builtin_amdgcn_exp2f(mrun[q2] - mnew);
                mrun[q2] = mnew;
                float ps = 0.f; float pv[4][4];
#pragma unroll
                for (int k4 = 0; k4 < 4; ++k4)
#pragma unroll
                    for (int j = 0; j < 4; ++j) { const float e = __builtin_amdgcn_exp2f(sacc[k4][q2][j] * csc - mnew); pv[k4][j] = e; ps += e; }
                lrun[q2] = lrun[q2] * alpha + ps;
#pragma unroll
                for (int dt = 0; dt < 4; ++dt) oacc[dt][q2] *= alpha;
#pragma unroll
                for (int kk = 0; kk < 2; ++kk) {
                    u32x4 w; w.x = pk_bf16(pv[2 * kk][0], pv[2 * kk][1]); w.y = pk_bf16(pv[2 * kk][2], pv[2 * kk][3]);
                    w.z = pk_bf16(pv[2 * kk + 1][0], pv[2 * kk + 1][1]); w.w = pk_bf16(pv[2 * kk + 1][2], pv[2 * kk + 1][3]);
                    pf[q2][kk] = __builtin_bit_cast(bf16x8, w);
                }
            }
#pragma unroll
            for (int kk = 0; kk < 2; ++kk)
#pragma unroll
                for (int dt = 0; dt < 4; ++dt) {
                    const v4i16_t lo = __builtin_amdgcn_ds_read_tr16_b64_v4i16((LAS v4i16_t*)(vb + vtr + (32 * kk) * AV_PITCH + 32 * dt));
                    const v4i16_t hi = __builtin_amdgcn_ds_read_tr16_b64_v4i16((LAS v4i16_t*)(vb + vtr + (32 * kk + 16) * AV_PITCH + 32 * dt));
                    const bf16x8 vf = {lo[0], lo[1], lo[2], lo[3], hi[0], hi[1], hi[2], hi[3]};
                    oacc[dt][0] = __builtin_amdgcn_mfma_f32_16x16x32_bf16(vf, pf[0][kk], oacc[dt][0], 0, 0, 0);
                    oacc[dt][1] = __builtin_amdgcn_mfma_f32_16x16x32_bf16(vf, pf[1][kk], oacc[dt][1], 0, 0, 0);
                }
            if (more) {
                *(LAS u32x4*)(nb + srow * AK_PITCH + sch * 16) = gk;
                *(LAS u32x4*)(nb + AK_BYTES + srow * AV_PITCH + sch * 16) = gv;
                if (tid < 256) *(LAS u32x4*)(nb + rrow * AK_PITCH + 128 + rch * 16) = gr;
            }
            __syncthreads();
        }
#pragma unroll
        for (int q2 = 0; q2 < 2; ++q2) {
            float l = lrun[q2]; l += __shfl_xor(l, 16); l += __shfl_xor(l, 32);
            const float inv = 1.0f / l;
#pragma unroll
            for (int dt = 0; dt < 4; ++dt) { const f32x4 o = oacc[dt][q2] * inv;
                u32x2 w; w.x = pk_bf16(o[0], o[1]); w.y = pk_bf16(o[2], o[3]);
                *(u32x2*)(O + (size_t)(qrow + 16 * q2 + lc) * 512 + 64 * h + 16 * dt + 4 * g) = w; }
        }
    }
    __syncthreads();
}

#define XB_TMO      128
#define XB_XCNT(j)  (256  + 64 * (j))
#define XB_XSUB(j)  (1280 + 64 * (j))
#define XB_XGEN(j)  (2304 + 64 * (j))
#define XB_TOP      3328
#define XB_TOPGEN   3392
#define XCD_BAR_WORDS 3456
#define XB_SPIN_CAP (1u << 18)

__device__ __forceinline__ unsigned xb_ld(unsigned* p)              { return __hip_atomic_load(p, __ATOMIC_RELAXED, __HIP_MEMORY_SCOPE_AGENT); }
__device__ __forceinline__ unsigned xb_add(unsigned* p, unsigned v) { return __hip_atomic_fetch_add(p, v, __ATOMIC_RELAXED, __HIP_MEMORY_SCOPE_AGENT); }
__device__ __forceinline__ unsigned xb_xcc_id() { return (unsigned)__builtin_amdgcn_s_getreg((3 << 11) | 20) & 0xFu; }
#define XB_SPIN(cond, bar) do { unsigned _sp = 0; while (cond) { __builtin_amdgcn_s_sleep(1); \
    if ((++_sp & 255u) == 0u) { if (xb_ld(&(bar)[XB_TMO])) break; if (_sp > XB_SPIN_CAP) { atomicAdd(&(bar)[XB_TMO], 1u); break; } } } } while (0)

struct XcdBarrier {
    unsigned* bar; unsigned x;
    volatile LAS unsigned* st;
};

__device__ __forceinline__ XcdBarrier xcd_barrier_post(unsigned* bar, volatile LAS unsigned* st) {
    XcdBarrier b; b.bar = bar; b.x = xb_xcc_id(); b.st = st;
    if (threadIdx.x == 0) (void)xb_add(&bar[XB_XCNT(b.x)], 1u);
    return b;
}
__device__ __forceinline__ void xcd_barrier_complete(unsigned* bar, unsigned x, unsigned& nloc, unsigned& nx) {
    const unsigned G = gridDim.x * gridDim.y * gridDim.z;
    unsigned sum, cnt, mine, sp = 0u;
    for (;;) {
        sum = 0u; cnt = 0u; mine = 0u;
#pragma unroll
        for (unsigned j = 0; j < 16; ++j) { const unsigned c = xb_ld(&bar[XB_XCNT(j)]); sum += c; cnt += (c > 0u) ? 1u : 0u; mine = (j == x) ? c : mine; }
        if (sum == G) break;
        __builtin_amdgcn_s_sleep(1);
        if ((++sp & 255u) == 0u) { if (xb_ld(&bar[XB_TMO])) break; if (sp > XB_SPIN_CAP) { atomicAdd(&bar[XB_TMO], 1u); break; } }
    }
    nloc = mine > 0u ? mine : 1u; nx = cnt > 0u ? cnt : 1u;
}

__device__ __forceinline__ void xcd_barrier(const XcdBarrier& b) {
    asm volatile("s_waitcnt vmcnt(0)" ::: "memory");
    __syncthreads();
    if (threadIdx.x == 0) {
        unsigned* bar = b.bar;
        __builtin_amdgcn_s_waitcnt(0);
        unsigned nloc = b.st[0], nx = b.st[1];
        if (nloc == 0u) { xcd_barrier_complete(bar, b.x, nloc, nx); b.st[0] = nloc; b.st[1] = nx; }
        const unsigned old = xb_add(&bar[XB_XSUB(b.x)], 1u);
        const unsigned gen = old / nloc;
        if (old + 1u == (gen + 1u) * nloc) {
            __builtin_amdgcn_fence(__ATOMIC_RELEASE, "agent");
            asm volatile("s_waitcnt vmcnt(0)" ::: "memory");
            const unsigned og = xb_add(&bar[XB_TOP], 1u);
            const unsigned tg = og / nx;
            if (og + 1u == (tg + 1u) * nx) xb_add(&bar[XB_TOPGEN], 1u);
            else XB_SPIN(xb_ld(&bar[XB_TOPGEN]) == tg, bar);
            __builtin_amdgcn_fence(__ATOMIC_ACQUIRE, "agent");
            xb_add(&bar[XB_XGEN(b.x)], 1u);
            asm volatile("s_waitcnt vmcnt(0)" ::: "memory");
        } else {
            XB_SPIN(xb_ld(&bar[XB_XGEN(b.x)]) == gen, bar);
            __builtin_amdgcn_fence(__ATOMIC_ACQUIRE, "agent");
            asm volatile("s_waitcnt vmcnt(0)" ::: "memory");
        }
    }
    __syncthreads();
}


constexpr int NPHASES = 16;
__global__ void __launch_bounds__(NTHREADS, 2) mega_fwd(Params p) {
    extern __shared__ __attribute__((aligned(16))) unsigned char lds_raw[];
    LAS unsigned char* lds = (LAS unsigned char*)lds_raw;
    cg::grid_group grid = cg::this_grid();
    unsigned char* ws = p.ws;
    const int G = gridDim.x, bid = blockIdx.x;
    bf16_t* Hb = (bf16_t*)(ws + WS_H); bf16_t* Fb = (bf16_t*)(ws + WS_F); bf16_t* ACT = (bf16_t*)(ws + WS_ACT);
    bf16_t* ZQ = (bf16_t*)(ws + WS_ZQ); bf16_t* XL = (bf16_t*)(ws + WS_XL); bf16_t* GY = (bf16_t*)(ws + WS_GY);
#ifndef TESTPH
#define TESTPH -1
#endif
#define IN(k) ((TESTPH < 0 || (k) == TESTPH) && p.ph_lo <= (k) && (k) < p.ph_hi)
#define SEAM0() do { if (IN(0) && IN(1)) { __builtin_amdgcn_fence(__ATOMIC_RELEASE, "agent"); asm volatile("s_waitcnt vmcnt(0) lgkmcnt(0)" ::: "memory"); \
        grid.sync(); __builtin_amdgcn_fence(__ATOMIC_ACQUIRE, "agent"); asm volatile("s_waitcnt vmcnt(0) lgkmcnt(0)" ::: "memory"); \
        xb = xcd_barrier_post((unsigned*)(p.ws + WS_XBAR), xbst); } } while (0)
#define SEAM(k) do { if (IN(k) && IN((k) + 1)) xcd_barrier(xb); } while (0)
    volatile LAS unsigned* xbst = (volatile LAS unsigned*)(lds + LDS_BYTES - 16);
    if (threadIdx.x < 4) xbst[threadIdx.x] = 0u;
    __syncthreads();
    XcdBarrier xb; xb.bar = (unsigned*)(p.ws + WS_XBAR); xb.x = 0; xb.st = xbst;
    if (IN(0)) { if (bid == 0) { unsigned* xw = (unsigned*)(p.ws + WS_XBAR); for (int i = threadIdx.x; i < XCD_BAR_WORDS; i += NTHREADS) xw[i] = 0u; }
        phase_prep(p, lds); }
    SEAM0();
    if (IN(1)) phase_rows<false, true>(p, 0, 0, 0.f, true);
    SEAM(1);
#define FFN_PHASES(ffn, pb) do { \
        if (IN(pb)) { \
            pg8::Gemm g{Hb, (const bf16_t*)(ws + ((ffn) ? WS_WGU2 : WS_WGU1)), D, D}; pg8::StaticOrder S; S.init(T, 2 * DFF, G, bid); \
            pg8::EpiSwiglu E{ACT, DFF}; \
            GEMM_PHASE(pg8::EpiSwiglu, lds, g, S, E); \
        } \
        SEAM(pb); \
        if (IN((pb) + 1)) { \
            pg8::Gemm g{ACT, (const bf16_t*)(ws + ((ffn) ? WS_WDN2 : WS_WDN1)), DFF, DFF}; pg8::StaticOrder S; S.init(T, D, G, bid); \
            pg8::EpiAct<0> E{Fb, D, 0}; \
            GEMM_PHASE(pg8::EpiAct<0>, lds, g, S, E); \
        } \
        SEAM((pb) + 1); } while (0)
    FFN_PHASES(0, 2);
        if (IN(4)) phase_rows<true, true>(p, 0, 1, 0.5f, true);
        SEAM(4);
        if (IN(5)) {
            pg8::Gemm g{Hb, (const bf16_t*)(ws + WS_WINA), D, D}; pg8::StaticOrder S; S.init(T, 2560, G, bid);
            pg8::EpiWinA E{ZQ, XL, GY};
            GEMM_PHASE(pg8::EpiWinA, lds, g, S, E);
        }
        SEAM(5);
        if (IN(6)) { phase_stats(p); phase_lru(p, lds); }
        SEAM(6);
        if (IN(7)) {
            pg8::Gemm g{ZQ, (const bf16_t*)(ws + WS_WQKV), 512, 384}; pg8::StaticOrder S; S.init(T, 1792, G, bid);
            pg8::EpiQKV E{Fb, XL, (const float*)(ws + WS_STATS)};
            GEMM_PHASE2(pg8::EpiQKV, lds, g, S, E);
        }
        SEAM(7);
        if (IN(8)) phase_attn(p, lds);
        SEAM(8);
        if (IN(9)) {
            pg8::Gemm g{Hb, (const bf16_t*)(ws + WS_WINB), D, D}; pg8::StaticOrder S; S.init(T, 2048, G, bid);
            pg8::EpiWinB E{Fb, XL};
            GEMM_PHASE(pg8::EpiWinB, lds, g, S, E);
        }
        SEAM(9);
        if (IN(10)) {
            { pg8::Gemm g{ZQ, (const bf16_t*)(ws + WS_WAO), 512, 512}; pg8::StaticOrder S; S.init(T, D, G, bid);
              pg8::EpiGate<false> E{Fb, nullptr, Fb};
              GEMM_PHASE(pg8::EpiGate<false>, lds, g, S, E); }
            { pg8::Gemm g{GY, (const bf16_t*)(ws + WS_WLO), D, D}; pg8::StaticOrder S; S.init(T, D, G, bid);
              pg8::EpiGate<true> E{XL, Fb, XL};
              GEMM_PHASE(pg8::EpiGate<true>, lds, g, S, E); }
        }
        SEAM(10);
        if (IN(11)) {
            pg8::Gemm g{XL, (const bf16_t*)(ws + WS_WOUT), D, D}; pg8::StaticOrder S; S.init(T, D, G, bid);
            pg8::EpiAct<0> E{Fb, D, 0};
            GEMM_PHASE(pg8::EpiAct<0>, lds, g, S, E);
        }
        SEAM(11);
        if (IN(12)) phase_rows<true, true>(p, 1, 2, 1.0f, false);
        SEAM(12);
    FFN_PHASES(1, 13);
    if (IN(15)) phase_rows<true, false>(p, 2, 0, 0.5f, false);
#undef IN
#undef SEAM
}

extern "C" void kernel_launch(void* const* d_in, const int* in_sizes, int n_in, void* d_out, int out_size, void* d_ws, size_t ws_size, hipStream_t stream) {
    static int grid = 0;
    if (grid == 0) {
        if (n_in != 27 || out_size != T * D || ws_size < WS_END) { fprintf(stderr, "kernel_launch: unexpected shapes: n_in %d out %d ws %zu (need >= %zu)\n", n_in, out_size, ws_size, (size_t)WS_END); grid = -1; return; }
        int dev = 0, cus = 0, per_cu = 0;
        (void)hipGetDevice(&dev);
        (void)hipDeviceGetAttribute(&cus, hipDeviceAttributeMultiprocessorCount, dev);
        if (hipFuncSetAttribute((const void*)mega_fwd, hipFuncAttributeMaxDynamicSharedMemorySize, LDS_BYTES) != hipSuccess) { fprintf(stderr, "kernel_launch: hipFuncSetAttribute failed\n"); grid = -1; return; }
        if (hipOccupancyMaxActiveBlocksPerMultiprocessor(&per_cu, (const void*)mega_fwd, NTHREADS, LDS_BYTES) != hipSuccess || per_cu < 1) { fprintf(stderr, "kernel_launch: occupancy query failed (%d)\n", per_cu); per_cu = 1; }
        (void)hipGetLastError();
        grid = cus;
        fprintf(stderr, "kernel_launch: grid %d (per_cu %d)\n", grid, per_cu);
    }
    if (grid < 0) return;
    Params p{};
    for (int i = 0; i < 27; ++i) p.in[i] = (const float*)d_in[i];
    p.out = (float*)d_out; p.ws = (unsigned char*)d_ws;
#if defined(MK_SPLIT)
    for (int ph = 0; ph < NPHASES; ++ph) { p.ph_lo = ph; p.ph_hi = ph + 1;
        hipLaunchKernelGGL(mega_fwd, dim3(grid), dim3(NTHREADS), LDS_BYTES, stream, p); }
#else
    p.ph_lo = 0; p.ph_hi = NPHASES;
    void* args[] = {&p};
    hipError_t e = hipLaunchCooperativeKernel((const void*)mega_fwd, dim3(grid), dim3(NTHREADS), args, LDS_BYTES, stream);
    if (e != hipSuccess) fprintf(stderr, "kernel_launch: cooperative launch failed: %s (grid %d)\n", hipGetErrorString(e), grid);
#endif
}
```

```cpp
#include <hip/hip_runtime.h>
#include <hip/hip_cooperative_groups.h>
#include <cstdio>
#include <cstdint>
namespace cg = cooperative_groups;
#ifndef MK_SP2_ALL
#define MK_SP2_ALL false
#endif

#define LAS __attribute__((address_space(3)))
typedef unsigned short bf16_t;
typedef short bf16x8 __attribute__((ext_vector_type(8)));
typedef short v4i16_t __attribute__((ext_vector_type(4)));
typedef float f32x4 __attribute__((ext_vector_type(4)));
typedef float f32x2 __attribute__((ext_vector_type(2)));
typedef unsigned u32x4 __attribute__((ext_vector_type(4)));
typedef unsigned u32x2 __attribute__((ext_vector_type(2)));

constexpr int D = 1024, DFF = 2816, TP = 32768, TS = 65536, T = TP + TS, SP = 2048, SS = 4096;
constexpr int NQ = 768, NKV = 512;
constexpr float EPS = 1e-6f;
constexpr int NTHREADS = 512, NWAVES = 8;

constexpr size_t KiB = 1024, MiB = 1024 * 1024;
constexpr size_t WS_WGU1 = 0, WS_WDN1 = 11 * MiB, WS_WINA = 16 * MiB + 512 * KiB, WS_WINB = 21 * MiB + 512 * KiB, WS_WQKV = 25 * MiB + 512 * KiB,
                 WS_WAO = 27 * MiB, WS_WLO = 28 * MiB, WS_WOUT = 30 * MiB, WS_WGU2 = 32 * MiB, WS_WDN2 = 43 * MiB, WS_WG = 48 * MiB + 512 * KiB,
                 WS_MOD = 49 * MiB + 512 * KiB, WS_ROPE = 50 * MiB + 768 * KiB, WS_STATS = 51 * MiB + 256 * KiB, WS_KR = 52 * MiB;
constexpr size_t WS_XBAR = 50 * MiB + 640 * KiB;
constexpr size_t WS_H = 64 * MiB, WS_F = 256 * MiB, WS_BIG = 448 * MiB;
constexpr size_t WS_ZQ = WS_BIG, WS_XL = WS_BIG + 96 * MiB, WS_GY = WS_BIG + 288 * MiB, WS_ACT = WS_BIG, WS_END = 976 * MiB;
constexpr int LDS_BYTES = 139264;

struct Params { const float* in[27]; float* out; unsigned char* ws; int ph_lo, ph_hi; };

typedef __bf16 bf16x2_t __attribute__((ext_vector_type(2)));
__device__ __forceinline__ unsigned pk_bf16(float lo, float hi) { const f32x2 v = {lo, hi}; const bf16x2_t b = __builtin_convertvector(v, bf16x2_t); return __builtin_bit_cast(unsigned, b); }
__device__ __forceinline__ float lo_bf(unsigned w) { return __uint_as_float(w << 16); }
__device__ __forceinline__ float hi_bf(unsigned w) { return __uint_as_float(w & 0xffff0000u); }
__device__ __forceinline__ float bf2f(bf16_t h) { return __uint_as_float((unsigned)h << 16); }
__device__ __forceinline__ float fexp(float x) { return __builtin_amdgcn_exp2f(x * 1.4426950408889634f); }
__device__ __forceinline__ float fsigmoid(float x) { return __builtin_amdgcn_rcpf(1.0f + fexp(-x)); }
__device__ __forceinline__ float fsilu(float x) { return x * fsigmoid(x); }
__device__ __forceinline__ float fgelu(float x) { return x * fsigmoid(1.5957691216057308f * (x + 0.044715f * x * x * x)); }
__device__ __forceinline__ float wave_sum(float v) {
#pragma unroll
    for (int o = 1; o < 64; o <<= 1) v += __shfl_xor(v, o);
    return v;
}
__device__ __forceinline__ int row_batch(int row) { return row < TP ? (row >> 11) : 16 + ((row - TP) >> 12); }
__device__ __forceinline__ int row_pos(int row) { return row < TP ? (row & (SP - 1)) : ((row - TP) & (SS - 1)); }

namespace pg8 {
constexpr int BM = 256, BK = 64, HALF = 128, HTB = HALF * BK * 2, STAGE_BYTES = 8 * HTB, NXCD = 8, WGM = 8;
__host__ __device__ __forceinline__ int lds_byte(int r, int c) { const int st = (r >> 4) * 2 + (c >> 5), rr = r & 15, cc = c & 31, ob = rr * 64 + cc * 2; return st * 1024 + (ob ^ (((ob >> 9) & 1) << 5)); }
__host__ __device__ __forceinline__ void stage_rc(int b, int& R, int& C) { const int st = b / 1024, sb = b % 1024, swz = sb ^ (((sb >> 9) & 1) << 5); R = (st >> 1) * 16 + swz / 64; C = (st & 1) * 32 + (swz % 64) / 2; }
__host__ __device__ __forceinline__ int perm32(int rho) { const int n = rho >> 4, i = rho & 15; return 8 * (i >> 2) + 4 * n + (i & 3); }

struct Unit { int pm, pn; };
struct Gemm { const bf16_t* A; const bf16_t* Bt; int lda, K; };

struct StaticOrder {
    int nM, nN, nwg, G, c;
    __device__ void init(int M, int N, int G_, int c_) { nM = M / BM; nN = N / BM; nwg = nM * nN; G = G_; c = c_; }
    __device__ bool next(int i, Unit& u) const {
        const long L = (long)i * G + c; if (L >= nwg) return false;
        int wgid = (int)L; { const int q = nwg / NXCD, r = nwg % NXCD, xcd = wgid % NXCD, off = wgid / NXCD; wgid = (xcd < r ? xcd * (q + 1) : r * (q + 1) + (xcd - r) * q) + off; }
        const int nig = WGM * nN, gid = wgid / nig, fm = gid * WGM, gsz = (nM - fm) < WGM ? (nM - fm) : WGM;
        u.pm = fm + ((wgid % nig) % gsz); u.pn = (wgid % nig) / gsz; return true;
    }
};

template <class Epi, bool SP2 = false>
__device__ __forceinline__ void gemm_phase(LAS unsigned char* lds, const Gemm g, const StaticOrder& S, const Epi& E) {
    const int tid = threadIdx.x, wid = __builtin_amdgcn_readfirstlane(tid >> 6), lane = tid & 63, wr = wid >> 2, wc = wid & 3, fr = lane & 15, fq = lane >> 4;
    const int K = g.K, nt = K / BK, lda = g.lda;
    unsigned voffA[2], voffB[2];
#pragma unroll
    for (int i = 0; i < 2; ++i) { int R, C; stage_rc(tid * 16 + i * 8192, R, C); const int Rb = Epi::PERM ? ((R & ~31) + perm32(R & 31)) : R;
        voffA[i] = (unsigned)(R * lda + C) * 2u; voffB[i] = (unsigned)(Rb * K + C) * 2u; }
    const size_t kstep = (size_t)(BK * 2);
    const size_t hstepA = (size_t)HALF * lda * 2, hstepB = (size_t)HALF * K * 2;
    const size_t tstepA = 2 * hstepA, tstepB = 2 * hstepB;
    const unsigned ldsw = (unsigned)wid * 1024u;
    const int aoff = lds_byte(wr * 64 + fr, fq * 8), boff = lds_byte(wc * 32 + fr, fq * 8);
#define PG8_SA(b, h) (((b) * 2 + (h)) * HTB)
#define PG8_SB(b, h) ((4 + (b) * 2 + (h)) * HTB)
#define PG8_STAGE(bufoff, gbase, voff) do { _Pragma("unroll") for (int _i = 0; _i < 2; ++_i) \
        __builtin_amdgcn_global_load_lds((const unsigned*)((const char*)(gbase) + (voff)[_i]), (LAS unsigned*)(lds + (bufoff) + ldsw + _i * 8192), 16, 0, 0); } while (0)
#define PG8_LDA(dst, b, h) do { _Pragma("unroll") for (int m = 0; m < 4; ++m) _Pragma("unroll") for (int k = 0; k < 2; ++k) dst[m][k] = *(const LAS bf16x8*)(lds + PG8_SA(b, h) + aoff + m * 2048 + k * 1024); } while (0)
#define PG8_LDB(dst, b, h) do { _Pragma("unroll") for (int n = 0; n < 2; ++n) _Pragma("unroll") for (int k = 0; k < 2; ++k) dst[n][k] = *(const LAS bf16x8*)(lds + PG8_SB(b, h) + boff + n * 2048 + k * 1024); } while (0)
#define PG8_MMA(ai, bj, At, Bt) do { __builtin_amdgcn_s_setprio(1); _Pragma("unroll") for (int m = 0; m < 4; ++m) _Pragma("unroll") for (int n = 0; n < 2; ++n) _Pragma("unroll") for (int k = 0; k < 2; ++k) \
        acc[ai][bj][m][n] = __builtin_amdgcn_mfma_f32_16x16x32_bf16(Bt[n][k], At[m][k], acc[ai][bj][m][n], 0, 0, 0); __builtin_amdgcn_s_setprio(0); } while (0)
#define PG8_WAIT_V(n) asm volatile("s_waitcnt vmcnt(" #n ")" ::: "memory")
#define PG8_WAIT_L(n) asm volatile("s_waitcnt lgkmcnt(" #n ")" ::: "memory")
#define PG8_BAR __builtin_amdgcn_s_barrier()
#define PG8_SCHED __builtin_amdgcn_sched_barrier(0)
    Unit cur, nxt; int ui = 0;
    if (!S.next(0, cur)) return;
    f32x4 acc[2][2][4][2];
#pragma unroll
    for (int a = 0; a < 2; ++a)
#pragma unroll
        for (int b = 0; b < 2; ++b)
#pragma unroll
            for (int m = 0; m < 4; ++m)
#pragma unroll
                for (int n = 0; n < 2; ++n) acc[a][b][m][n] = (f32x4){0.f, 0.f, 0.f, 0.f};
    bf16x8 At[4][2], B0[2][2], B1[2][2];
    const char* cA = (const char*)g.A + (size_t)cur.pm * tstepA; const char* cB = (const char*)g.Bt + (size_t)cur.pn * tstepB;
    if constexpr (SP2) {
        PG8_STAGE(PG8_SB(0, 0), cB, voffB); PG8_STAGE(PG8_SB(0, 1), cB + hstepB, voffB); PG8_STAGE(PG8_SA(0, 0), cA, voffA); PG8_STAGE(PG8_SA(0, 1), cA + hstepA, voffA);
        if (wr == 1) PG8_BAR;
        PG8_WAIT_V(2); PG8_BAR;
        PG8_STAGE(PG8_SB(1, 0), cB + kstep, voffB); PG8_STAGE(PG8_SA(1, 0), cA + kstep, voffA); PG8_STAGE(PG8_SB(1, 1), cB + hstepB + kstep, voffB);
        PG8_WAIT_V(6); PG8_BAR;
    } else {
    PG8_STAGE(PG8_SB(0, 0), cB, voffB); PG8_STAGE(PG8_SA(0, 0), cA, voffA); PG8_STAGE(PG8_SB(0, 1), cB + hstepB, voffB); PG8_STAGE(PG8_SA(0, 1), cA + hstepA, voffA);
    if (wr == 1) PG8_BAR;
    PG8_WAIT_V(4); PG8_BAR;
    PG8_STAGE(PG8_SB(1, 0), cB + kstep, voffB); PG8_STAGE(PG8_SA(1, 0), cA + kstep, voffA); PG8_STAGE(PG8_SB(1, 1), cB + hstepB + kstep, voffB);
    PG8_WAIT_V(6); PG8_BAR;
    }
    for (;;) {
        const bool has_next = S.next(ui + 1, nxt);
        const char* nA = has_next ? (const char*)g.A + (size_t)nxt.pm * tstepA : cA; const char* nB = has_next ? (const char*)g.Bt + (size_t)nxt.pn * tstepB : cB;
        for (int t = 0; t < nt; t += 2) {
            const bool last = (t == nt - 2);
            const char* a1 = cA + (size_t)(t + 1) * kstep;
            const char* a2 = last ? nA : cA + (size_t)(t + 2) * kstep; const char* b2 = last ? nB : cB + (size_t)(t + 2) * kstep;
            const char* a3 = a2 + kstep; const char* b3 = b2 + kstep;
            if constexpr (SP2) {
            PG8_LDB(B0, 0, 0); PG8_LDB(B1, 0, 1); PG8_SCHED; PG8_LDA(At, 0, 0); PG8_STAGE(PG8_SA(1, 1), a1 + hstepA, voffA);
            PG8_WAIT_V(8); PG8_WAIT_L(0); PG8_BAR; PG8_MMA(0, 0, At, B0); PG8_MMA(0, 1, At, B1); PG8_BAR; PG8_SCHED;
            PG8_LDA(At, 0, 1); PG8_STAGE(PG8_SB(0, 0), b2, voffB); PG8_STAGE(PG8_SB(0, 1), b2 + hstepB, voffB); PG8_STAGE(PG8_SA(0, 0), a2, voffA);
            PG8_WAIT_V(8); PG8_WAIT_L(0); PG8_BAR; PG8_MMA(1, 0, At, B0); PG8_MMA(1, 1, At, B1); PG8_BAR; PG8_SCHED;
            PG8_LDB(B0, 1, 0); PG8_LDB(B1, 1, 1); PG8_SCHED; PG8_LDA(At, 1, 0); PG8_STAGE(PG8_SA(0, 1), a2 + hstepA, voffA);
            PG8_WAIT_V(8); PG8_WAIT_L(0); PG8_BAR; PG8_MMA(0, 0, At, B0); PG8_MMA(0, 1, At, B1); PG8_BAR; PG8_SCHED;
            PG8_LDA(At, 1, 1); PG8_STAGE(PG8_SB(1, 0), b3, voffB); PG8_STAGE(PG8_SB(1, 1), b3 + hstepB, voffB); PG8_STAGE(PG8_SA(1, 0), a3, voffA);
            PG8_WAIT_V(8); PG8_WAIT_L(0); PG8_BAR; PG8_MMA(1, 0, At, B0); PG8_MMA(1, 1, At, B1); PG8_BAR; PG8_SCHED;
            } else {
            PG8_LDB(B0, 0, 0); PG8_SCHED; PG8_LDA(At, 0, 0); PG8_STAGE(PG8_SA(1, 1), a1 + hstepA, voffA);
            PG8_WAIT_L(8); PG8_BAR; PG8_WAIT_L(0); PG8_MMA(0, 0, At, B0); PG8_BAR; PG8_SCHED;
            PG8_LDB(B1, 0, 1); PG8_STAGE(PG8_SB(0, 0), b2, voffB);
            PG8_BAR; PG8_WAIT_L(0); PG8_MMA(0, 1, At, B1); PG8_BAR;
            PG8_LDA(At, 0, 1); PG8_STAGE(PG8_SA(0, 0), a2, voffA);
            PG8_BAR; PG8_WAIT_L(0); PG8_MMA(1, 0, At, B0); PG8_BAR; PG8_SCHED;
            PG8_STAGE(PG8_SB(0, 1), b2 + hstepB, voffB);
            PG8_WAIT_V(6); PG8_BAR; PG8_MMA(1, 1, At, B1); PG8_BAR;
            PG8_LDB(B0, 1, 0); PG8_SCHED; PG8_LDA(At, 1, 0); PG8_STAGE(PG8_SA(0, 1), a2 + hstepA, voffA);
            PG8_WAIT_L(8); PG8_BAR; PG8_WAIT_L(0); PG8_MMA(0, 0, At, B0); PG8_BAR; PG8_SCHED;
            PG8_LDB(B1, 1, 1); PG8_STAGE(PG8_SB(1, 0), b3, voffB);
            PG8_BAR; PG8_WAIT_L(0); PG8_MMA(0, 1, At, B1); PG8_BAR;
            PG8_LDA(At, 1, 1); PG8_STAGE(PG8_SA(1, 0), a3, voffA);
            PG8_BAR; PG8_WAIT_L(0); PG8_MMA(1, 0, At, B0); PG8_BAR; PG8_SCHED;
            PG8_STAGE(PG8_SB(1, 1), b3 + hstepB, voffB);
            PG8_WAIT_V(6); PG8_BAR; PG8_MMA(1, 1, At, B1); PG8_BAR;
            }
        }
        if constexpr (SP2) { if (wr == 0) PG8_BAR; }
        { int el; asm volatile("v_mbcnt_lo_u32_b32 %0, -1, 0\n\tv_mbcnt_hi_u32_b32 %0, -1, %0" : "=v"(el)); E(acc, cur, wr, wc, el & 15, el >> 4); }
        if (!has_next) break;
#pragma unroll
        for (int a = 0; a < 2; ++a)
#pragma unroll
            for (int b = 0; b < 2; ++b)
#pragma unroll
                for (int m = 0; m < 4; ++m)
#pragma unroll
                    for (int n = 0; n < 2; ++n) acc[a][b][m][n] = (f32x4){0.f, 0.f, 0.f, 0.f};
        cur = nxt; cA = nA; cB = nB; ++ui;
        if constexpr (SP2) { if (wr == 1) PG8_BAR; }
    }
    PG8_WAIT_V(0);
    if constexpr (!SP2) { if (wr == 0) PG8_BAR; }
    PG8_BAR;
#undef PG8_SA
#undef PG8_SB
#undef PG8_STAGE
#undef PG8_LDA
#undef PG8_LDB
#undef PG8_MMA
#undef PG8_WAIT_V
#undef PG8_WAIT_L
#undef PG8_BAR
#undef PG8_SCHED
}

#if defined(MK_SIMPLE_GEMM)
template <class Epi>
__device__ __forceinline__ void gemm_phase_simple(const Gemm g, const StaticOrder& S, const Epi& E) {
    const int tid = threadIdx.x, wid = __builtin_amdgcn_readfirstlane(tid >> 6), lane = tid & 63, wr = wid >> 2, wc = wid & 3, fr = lane & 15, fq = lane >> 4;
    Unit cur;
    for (int ui = 0; S.next(ui, cur); ++ui) {
        f32x4 acc[2][2][4][2];
#pragma unroll
        for (int a = 0; a < 2; ++a)
#pragma unroll
            for (int b = 0; b < 2; ++b)
#pragma unroll
                for (int m = 0; m < 4; ++m)
#pragma unroll
                    for (int n = 0; n < 2; ++n) acc[a][b][m][n] = (f32x4){0.f, 0.f, 0.f, 0.f};
        for (int k0 = 0; k0 < g.K; k0 += 32) {
            bf16x8 bf[2][2];
#pragma unroll
            for (int bj = 0; bj < 2; ++bj)
#pragma unroll
                for (int n = 0; n < 2; ++n) { const int slot = 16 * n + fr; const int wrow = cur.pn * BM + bj * HALF + wc * 32 + (Epi::PERM ? perm32(slot) : slot);
                    bf[bj][n] = *(const bf16x8*)(g.Bt + (size_t)wrow * g.K + k0 + 8 * fq); }
#pragma unroll
            for (int ai = 0; ai < 2; ++ai)
#pragma unroll
                for (int m = 0; m < 4; ++m) { const int arow = cur.pm * BM + ai * HALF + wr * 64 + m * 16 + fr;
                    const bf16x8 af = *(const bf16x8*)(g.A + (size_t)arow * g.lda + k0 + 8 * fq);
#pragma unroll
                    for (int bj = 0; bj < 2; ++bj)
#pragma unroll
                        for (int n = 0; n < 2; ++n) acc[ai][bj][m][n] = __builtin_amdgcn_mfma_f32_16x16x32_bf16(bf[bj][n], af, acc[ai][bj][m][n], 0, 0, 0); }
        }
        E(acc, cur, wr, wc, fr, fq);
    }
}
#define GEMM_PHASE(EPI, lds, g, S, E) pg8::gemm_phase_simple<EPI>(g, S, E)
#define GEMM_PHASE2(EPI, lds, g, S, E) pg8::gemm_phase_simple<EPI>(g, S, E)
#else
#define GEMM_PHASE(EPI, lds, g, S, E) pg8::gemm_phase<EPI, true>(lds, g, S, E)
#define GEMM_PHASE2(EPI, lds, g, S, E) pg8::gemm_phase<EPI, false>(lds, g, S, E)
#endif
struct EpiSwiglu {
    static constexpr bool PERM = true;
    bf16_t* O; int ldc;
    __device__ __forceinline__ void operator()(const f32x4 (&acc)[2][2][4][2], const Unit& u, int wr, int wc, int fr, int fq) const {
        const int row0 = u.pm * BM + wr * 64 + fr, col0 = u.pn * 128 + wc * 32 + 8 * fq;
#pragma unroll
        for (int ai = 0; ai < 2; ++ai)
#pragma unroll
            for (int m = 0; m < 4; ++m) {
                bf16_t* rowp = O + (size_t)(row0 + ai * HALF + m * 16) * ldc + col0;
                const f32x4 g0 = acc[ai][0][m][0], g1 = acc[ai][0][m][1], u0 = acc[ai][1][m][0], u1 = acc[ai][1][m][1];
                float v[8];
#pragma unroll
                for (int j = 0; j < 4; ++j) { v[j] = fsilu(g0[j]) * u0[j]; v[4 + j] = fsilu(g1[j]) * u1[j]; }
                u32x4 w; w.x = pk_bf16(v[0], v[1]); w.y = pk_bf16(v[2], v[3]); w.z = pk_bf16(v[4], v[5]); w.w = pk_bf16(v[6], v[7]);
                *(u32x4*)rowp = w;
                asm volatile("" ::: "memory");
            }
    }
};
__device__ __forceinline__ void store_tile_bf16(const f32x4 (&acc)[2][2][4][2], bf16_t* base, int ld, int row0, int col0, int act) {
#pragma unroll
    for (int ai = 0; ai < 2; ++ai)
#pragma unroll
        for (int m = 0; m < 4; ++m) {
            bf16_t* rowp = base + (size_t)(row0 + ai * HALF + m * 16) * ld + col0;
#pragma unroll
            for (int bj = 0; bj < 2; ++bj) {
                f32x4 v0 = acc[ai][bj][m][0], v1 = acc[ai][bj][m][1];
                if (act == 1) {
#pragma unroll
                    for (int j = 0; j < 4; ++j) { v0[j] = fgelu(v0[j]); v1[j] = fgelu(v1[j]); }
                } else if (act == 2) {
#pragma unroll
                    for (int j = 0; j < 4; ++j) { v0[j] = fsigmoid(v0[j]); v1[j] = fsigmoid(v1[j]); }
                }
                u32x4 w; w.x = pk_bf16(v0[0], v0[1]); w.y = pk_bf16(v0[2], v0[3]); w.z = pk_bf16(v1[0], v1[1]); w.w = pk_bf16(v1[2], v1[3]);
                *(u32x4*)(rowp + bj * HALF) = w;
            }
            asm volatile("" ::: "memory");
        }
}
template <int ACT> struct EpiAct {
    static constexpr bool PERM = true;
    bf16_t* p; int ld, pn0;
    __device__ __forceinline__ void operator()(const f32x4 (&acc)[2][2][4][2], const Unit& u, int wr, int wc, int fr, int fq) const {
        store_tile_bf16(acc, p, ld, u.pm * BM + wr * 64 + fr, (u.pn - pn0) * BM + wc * 32 + 8 * fq, ACT);
    }
};
struct EpiWinA {
    static constexpr bool PERM = true;
    bf16_t* zq; bf16_t* xl; bf16_t* gy;
    __device__ __forceinline__ void operator()(const f32x4 (&acc)[2][2][4][2], const Unit& u, int wr, int wc, int fr, int fq) const {
        size_t boff = 0; if (u.pn >= 2) boff += (size_t)((const char*)xl - (const char*)zq); if (u.pn >= 6) boff += (size_t)((const char*)gy - (const char*)xl);
        bf16_t* base = (bf16_t*)((char*)zq + boff);
        int ld = 512, pn0 = 0; if (u.pn >= 2) { ld = D; pn0 = 2; } if (u.pn >= 6) pn0 = 6;
        store_tile_bf16(acc, base, ld, u.pm * BM + wr * 64 + fr, (u.pn - pn0) * BM + wc * 32 + 8 * fq, u.pn < 6 ? 0 : 1);
    }
};
struct EpiWinB {
    static constexpr bool PERM = true;
    bf16_t* ga; bf16_t* gl;
    __device__ __forceinline__ void operator()(const f32x4 (&acc)[2][2][4][2], const Unit& u, int wr, int wc, int fr, int fq) const {
        store_tile_bf16(acc, u.pn < 4 ? ga : gl, D, u.pm * BM + wr * 64 + fr, (u.pn & 3) * BM + wc * 32 + 8 * fq, 2);
    }
};
template <bool ADD> struct EpiGate {
    static constexpr bool PERM = true;
    const bf16_t* gate; const bf16_t* add; bf16_t* out;
    __device__ __forceinline__ void operator()(const f32x4 (&acc)[2][2][4][2], const Unit& u, int wr, int wc, int fr, int fq) const {
        const int row0 = u.pm * BM + wr * 64 + fr, col0 = u.pn * BM + wc * 32 + 8 * fq;
#pragma unroll
        for (int ai = 0; ai < 2; ++ai)
#pragma unroll
            for (int m = 0; m < 4; ++m) {
                const size_t off = (size_t)(row0 + ai * HALF + m * 16) * D + col0;
#pragma unroll
                for (int bj = 0; bj < 2; ++bj) {
                    const u32x4 gw = *(const u32x4*)(gate + off + bj * HALF);
                    const f32x4 v0 = acc[ai][bj][m][0], v1 = acc[ai][bj][m][1];
                    float r[8];
                    r[0] = lo_bf(gw.x) * v0[0]; r[1] = hi_bf(gw.x) * v0[1]; r[2] = lo_bf(gw.y) * v0[2]; r[3] = hi_bf(gw.y) * v0[3];
                    r[4] = lo_bf(gw.z) * v1[0]; r[5] = hi_bf(gw.z) * v1[1]; r[6] = lo_bf(gw.w) * v1[2]; r[7] = hi_bf(gw.w) * v1[3];
                    if (ADD) {
                        const u32x4 aw = *(const u32x4*)(add + off + bj * HALF);
                        r[0] += lo_bf(aw.x); r[1] += hi_bf(aw.x); r[2] += lo_bf(aw.y); r[3] += hi_bf(aw.y);
                        r[4] += lo_bf(aw.z); r[5] += hi_bf(aw.z); r[6] += lo_bf(aw.w); r[7] += hi_bf(aw.w);
                    }
                    u32x4 w; w.x = pk_bf16(r[0], r[1]); w.y = pk_bf16(r[2], r[3]); w.z = pk_bf16(r[4], r[5]); w.w = pk_bf16(r[6], r[7]);
                    *(u32x4*)(out + off + bj * HALF) = w;
                }
                asm volatile("" ::: "memory");
            }
    }
};
struct EpiQKV {
    static constexpr bool PERM = true;
    bf16_t* Q; bf16_t* Kn; const float* stats;
    __device__ __forceinline__ void operator()(const f32x4 (&acc)[2][2][4][2], const Unit& u, int wr, int wc, int fr, int fq) const {
        const int row0 = u.pm * BM + wr * 64 + fr;
        const int sel = u.pn < 3 ? 0 : 1;
        bf16_t* dst = Q; int ld = NQ, ctile = u.pn * BM;
        if (u.pn >= 3) { dst = Kn; ld = NKV; ctile = ((u.pn - 3) & 1) * BM; if (u.pn >= 5) dst += (size_t)T * NKV; }
        const int col0 = ctile + wc * 32 + 8 * fq;
#pragma unroll
        for (int ai = 0; ai < 2; ++ai)
#pragma unroll
            for (int m = 0; m < 4; ++m) {
                const int row = row0 + ai * HALF + m * 16;
                const float rs = stats[2 * row + sel];
                bf16_t* rowp = dst + (size_t)row * ld + col0;
#pragma unroll
                for (int bj = 0; bj < 2; ++bj) {
                    const f32x4 v0 = acc[ai][bj][m][0] * rs, v1 = acc[ai][bj][m][1] * rs;
                    u32x4 w; w.x = pk_bf16(v0[0], v0[1]); w.y = pk_bf16(v0[2], v0[3]); w.z = pk_bf16(v1[0], v1[1]); w.w = pk_bf16(v1[2], v1[3]);
                    *(u32x4*)(rowp + bj * HALF) = w;
                }
                asm volatile("" ::: "memory");
            }
    }
};
}

struct TJob { const float* src; const float* scale; bf16_t* dst; int ldsrc, K, lddst, dstk0, nrb, map, nbatch, sbs, dbs; };
__device__ __forceinline__ int srccol(int map, int rb) {
    const int r = rb * 32;
    switch (map) {
        case 1: { const int pn = r >> 8, w = r & 255; return w < 128 ? 128 * pn + w : DFF + 128 * pn + (w - 128); }
        case 2: { if (r < 416) return r; if (r < 512) return -1; return r - 96; }
        case 3: return 2464 + r;
        case 4: { const int v = r >= 512 ? 1 : 0; const int rr = r & 511; return (rr >> 6) * 128 + (rr & 63) + 64 * v; }
        default: return r;
    }
}
constexpr int NJOBS = 15;
__device__ __forceinline__ TJob get_job(const Params& p, int j) {
    TJob t; t.scale = nullptr; t.dstk0 = 0; t.map = 0; t.nbatch = 1; t.sbs = 0; t.dbs = 0;
    unsigned char* ws = p.ws;
    switch (j) {
        case 0:  t.src = p.in[8];  t.dst = (bf16_t*)(ws + WS_WGU1); t.ldsrc = 2 * DFF; t.K = D; t.lddst = D; t.nrb = 176; t.map = 1; break;
        case 1:  t.src = p.in[9];  t.dst = (bf16_t*)(ws + WS_WDN1); t.ldsrc = D; t.K = DFF; t.lddst = DFF; t.nrb = 32; break;
        case 2:  t.src = p.in[10]; t.dst = (bf16_t*)(ws + WS_WINA); t.ldsrc = 4512; t.K = D; t.lddst = D; t.nrb = 80; t.map = 2; break;
        case 3:  t.src = p.in[10]; t.dst = (bf16_t*)(ws + WS_WINB); t.ldsrc = 4512; t.K = D; t.lddst = D; t.nrb = 64; t.map = 3; break;
        case 4:  t.src = p.in[13]; t.scale = p.in[11]; t.dst = (bf16_t*)(ws + WS_WQKV); t.ldsrc = 768; t.K = 256; t.lddst = 384; t.nrb = 24; break;
        case 5:  t.src = nullptr;  t.dst = (bf16_t*)(ws + WS_WQKV); t.ldsrc = 0; t.K = 128; t.lddst = 384; t.dstk0 = 256; t.nrb = 24; break;
        case 6:  t.src = p.in[14]; t.scale = p.in[12]; t.dst = (bf16_t*)(ws + WS_WQKV) + 768 * 384; t.ldsrc = 1024; t.K = 128; t.lddst = 384; t.dstk0 = 256; t.nrb = 32; t.map = 4; break;
        case 7:  t.src = nullptr;  t.dst = (bf16_t*)(ws + WS_WQKV) + 768 * 384; t.ldsrc = 0; t.K = 256; t.lddst = 384; t.nrb = 32; break;
        case 8:  t.src = p.in[15]; t.dst = (bf16_t*)(ws + WS_WAO); t.ldsrc = D; t.K = 512; t.lddst = 512; t.nrb = 32; break;
        case 9:  t.src = p.in[23]; t.dst = (bf16_t*)(ws + WS_WLO); t.ldsrc = D; t.K = D; t.lddst = D; t.nrb = 32; break;
        case 10: t.src = p.in[24]; t.dst = (bf16_t*)(ws + WS_WOUT); t.ldsrc = D; t.K = D; t.lddst = D; t.nrb = 32; break;
        case 11: t.src = p.in[25]; t.dst = (bf16_t*)(ws + WS_WGU2); t.ldsrc = 2 * DFF; t.K = D; t.lddst = D; t.nrb = 176; t.map = 1; break;
        case 12: t.src = p.in[26]; t.dst = (bf16_t*)(ws + WS_WDN2); t.ldsrc = D; t.K = DFF; t.lddst = DFF; t.nrb = 32; break;
        case 13: t.src = p.in[18]; t.dst = (bf16_t*)(ws + WS_WG); t.ldsrc = 128; t.K = 128; t.lddst = 128; t.nrb = 4; t.nbatch = 16; t.sbs = 16384; t.dbs = 32768; break;
        default: t.src = p.in[20]; t.dst = (bf16_t*)(ws + WS_WG) + 16384; t.ldsrc = 128; t.K = 128; t.lddst = 128; t.nrb = 4; t.nbatch = 16; t.sbs = 16384; t.dbs = 32768; break;
    }
    return t;
}
__device__ __forceinline__ int job_items(const TJob& t) { return t.nbatch * t.nrb * (t.K >> 6); }

__device__ __forceinline__ void tr_item(const TJob& jb, int item, LAS float* scr, int lane) {
    const int nkb = jb.K >> 6, per_batch = jb.nrb * nkb;
    const int bt = item / per_batch, r = item - bt * per_batch, rb = r / nkb, kb = r - rb * nkb;
    const int sc = srccol(jb.map, rb), k0 = 64 * kb;
    if (jb.src != nullptr && sc >= 0) {
        const float* src = jb.src + (size_t)bt * jb.sbs;
#pragma unroll 8
        for (int i = 0; i < 32; ++i) { const int kk = 2 * i + (lane >> 5);
            float v = src[(size_t)(k0 + kk) * jb.ldsrc + sc + (lane & 31)];
            if (jb.scale) v *= jb.scale[k0 + kk];
            scr[kk * 33 + (lane & 31)] = v; }
    } else {
#pragma unroll 8
        for (int i = 0; i < 32; ++i) { const int kk = 2 * i + (lane >> 5); scr[kk * 33 + (lane & 31)] = 0.f; }
    }
    asm volatile("s_waitcnt lgkmcnt(0)" ::: "memory");
    bf16_t* dst = jb.dst + (size_t)bt * jb.dbs;
    const int c = lane & 7;
#pragma unroll
    for (int j = 0; j < 4; ++j) { const int n = (lane >> 3) + 8 * j; const LAS float* s = scr + (8 * c) * 33 + n;
        u32x4 o; o.x = pk_bf16(s[0 * 33], s[1 * 33]); o.y = pk_bf16(s[2 * 33], s[3 * 33]); o.z = pk_bf16(s[4 * 33], s[5 * 33]); o.w = pk_bf16(s[6 * 33], s[7 * 33]);
        *(u32x4*)(dst + (size_t)(32 * rb + n) * jb.lddst + jb.dstk0 + k0 + 8 * c) = o; }
    asm volatile("s_waitcnt lgkmcnt(0)" ::: "memory");
}

__device__ __forceinline__ void phase_prep(const Params& p, LAS unsigned char* lds) {
    const int tid = threadIdx.x, lane = tid & 63, wave = tid >> 6;
    const int gw = blockIdx.x * NWAVES + wave, NGW = gridDim.x * NWAVES;
    {
        LAS float* scr = (LAS float*)(lds + wave * 8704);
        int base = 0;
        for (int j = 0; j < NJOBS; ++j) {
            const TJob jb = get_job(p, j); const int n = job_items(jb);
            int first = gw - (base % NGW); if (first < 0) first += NGW;
            for (int i = first; i < n; i += NGW) tr_item(jb, i, scr, lane);
            base += n;
        }
    }
    {
        const int gt = blockIdx.x * NTHREADS + tid;
        if (gt < SS * 16) {
            const int pos = gt >> 4, i = gt & 15;
            double inv = 1.0; for (int q = 0; q < i; ++q) inv *= 0.5623413251903491;
            const float ang = (float)pos * (float)inv;
            const double rev = (double)ang * 0.15915494309189535; const float fr = (float)(rev - rint(rev));
            ((float*)(p.ws + WS_ROPE))[gt] = __builtin_amdgcn_cosf(fr);
            ((float*)(p.ws + WS_ROPE))[SS * 16 + gt] = __builtin_amdgcn_sinf(fr);
        }
    }
    __syncthreads();
    for (int item = blockIdx.x; item < 144; item += gridDim.x) {
        LAS float* sc = (LAS float*)(lds) + wave * (128 * 33);
        for (int i = 0; i < 64; ++i) { const int idx = lane + 64 * i, kl = idx & 127, b = idx >> 7;
            const float cv = (b < 16 ? p.in[2] : p.in[3])[(b & 15) * D + 128 * wave + kl];
            sc[kl * 33 + b] = fsilu(cv); }
        asm volatile("s_waitcnt lgkmcnt(0)" ::: "memory");
        float acc[32];
#pragma unroll
        for (int b = 0; b < 32; ++b) acc[b] = 0.f;
        const float* W = p.in[4] + (size_t)(128 * wave) * 9216 + item * 64 + lane;
        for (int k = 0; k < 128; ++k) { const float wv = W[(size_t)k * 9216];
#pragma unroll
            for (int b = 0; b < 32; ++b) acc[b] += sc[k * 33 + b] * wv; }
        __syncthreads();
        LAS float* red = (LAS float*)(lds);
#pragma unroll
        for (int b = 0; b < 32; ++b) red[(wave * 32 + b) * 64 + lane] = acc[b];
        __syncthreads();
        for (int o = tid; o < 2048; o += NTHREADS) { const int b = o >> 6, col = o & 63; float s = 0.f;
#pragma unroll
            for (int w = 0; w < 8; ++w) s += red[(w * 32 + b) * 64 + col];
            const int j = item * 64 + col;
            ((float*)(p.ws + WS_MOD))[b * 9216 + j] = s + p.in[5][j]; }
        __syncthreads();
    }
}

template <bool HAS_F, bool HAS_H>
__device__ __forceinline__ void phase_rows(const Params& p, int sp, int sn, float resw, bool from_input) {
    const int tid = threadIdx.x, lane = tid & 63, wave = tid >> 6;
    const int gw = blockIdx.x * NWAVES + wave, NGW = gridDim.x * NWAVES;
    const float* mod = (const float*)(p.ws + WS_MOD);
    const bf16_t* F = (const bf16_t*)(p.ws + WS_F);
    bf16_t* H = (bf16_t*)(p.ws + WS_H);
    for (int row = gw; row < T; row += NGW) {
        const int b = row_batch(row);
        const float* xin = !from_input ? p.out + (size_t)row * D : (row < TP ? p.in[0] + (size_t)row * D : p.in[1] + (size_t)(row - TP) * D);
        f32x4 v[4];
#pragma unroll
        for (int j = 0; j < 4; ++j) v[j] = *(const f32x4*)(xin + 4 * lane + 256 * j);
        if (HAS_F) {
            f32x4 f[4]; float ss = 0.f;
#pragma unroll
            for (int j = 0; j < 4; ++j) { const u32x2 w = *(const u32x2*)(F + (size_t)row * D + 4 * lane + 256 * j);
                f[j] = (f32x4){lo_bf(w.x), hi_bf(w.x), lo_bf(w.y), hi_bf(w.y)}; ss += (f[j].x * f[j].x + f[j].y * f[j].y) + (f[j].z * f[j].z + f[j].w * f[j].w); }
            const float rs = 1.0f / sqrtf(wave_sum(ss) * (1.0f / D) + EPS) * resw;
            const float* gate = mod + b * 9216 + sp * 3072 + 2048; const float* gp = p.in[7] + sp * D;
#pragma unroll
            for (int j = 0; j < 4; ++j) { const f32x4 g = *(const f32x4*)(gate + 4 * lane + 256 * j), q = *(const f32x4*)(gp + 4 * lane + 256 * j);
                v[j] = v[j] + g * (f[j] * rs * q);
                *(f32x4*)(p.out + (size_t)row * D + 4 * lane + 256 * j) = v[j]; }
        }
        if (HAS_H) {
            float ss = 0.f;
#pragma unroll
            for (int j = 0; j < 4; ++j) ss += (v[j].x * v[j].x + v[j].y * v[j].y) + (v[j].z * v[j].z + v[j].w * v[j].w);
            const float rs = 1.0f / sqrtf(wave_sum(ss) * (1.0f / D) + EPS);
            const float* sh = mod + b * 9216 + sn * 3072; const float* scl = sh + 1024; const float* gq = p.in[6] + sn * D;
#pragma unroll
            for (int j = 0; j < 4; ++j) { const f32x4 a = *(const f32x4*)(sh + 4 * lane + 256 * j), s = *(const f32x4*)(scl + 4 * lane + 256 * j), q = *(const f32x4*)(gq + 4 * lane + 256 * j);
                const f32x4 h = (v[j] * rs * q) * (s + 1.0f) + a;
                u32x2 w; w.x = pk_bf16(h.x, h.y); w.y = pk_bf16(h.z, h.w);
                *(u32x2*)(H + (size_t)row * D + 4 * lane + 256 * j) = w; }
        }
    }
}

__device__ __forceinline__ void phase_stats(const Params& p) {
    const int tid = threadIdx.x, lane = tid & 63, wave = tid >> 6;
    const int gw = blockIdx.x * NWAVES + wave, NGW = gridDim.x * NWAVES;
    const bf16_t* ZQ = (const bf16_t*)(p.ws + WS_ZQ);
    float* stats = (float*)(p.ws + WS_STATS); bf16_t* KR = (bf16_t*)(p.ws + WS_KR);
    const float* rc = (const float*)(p.ws + WS_ROPE); const float* rsn = rc + SS * 16;
    for (int row = gw; row < T; row += NGW) {
        const u32x4 w = *(const u32x4*)(ZQ + (size_t)row * 512 + 8 * lane);
        float x[8] = {lo_bf(w.x), hi_bf(w.x), lo_bf(w.y), hi_bf(w.y), lo_bf(w.z), hi_bf(w.z), lo_bf(w.w), hi_bf(w.w)};
        float ss = 0.f;
#pragma unroll
        for (int e = 0; e < 8; ++e) ss += x[e] * x[e];
        const float sq = wave_sum(lane < 32 ? ss : 0.f), skv = wave_sum((lane >= 32 && lane < 48) ? ss : 0.f);
        if (lane == 0) { f32x2 st; st.x = 1.0f / sqrtf(sq * (1.0f / 256.0f) + EPS); st.y = 1.0f / sqrtf(skv * (1.0f / 128.0f) + EPS); *(f32x2*)(stats + 2 * row) = st; }
        float y[8];
#pragma unroll
        for (int e = 0; e < 8; ++e) y[e] = __shfl_xor(x[e], 2);
        if (lane >= 48 && lane < 52) {
            const int pos = row_pos(row), i0 = 8 * (lane & 1);
            const f32x4 c0 = *(const f32x4*)(rc + pos * 16 + i0), c1 = *(const f32x4*)(rc + pos * 16 + i0 + 4);
            const f32x4 s0 = *(const f32x4*)(rsn + pos * 16 + i0), s1 = *(const f32x4*)(rsn + pos * 16 + i0 + 4);
            const float c[8] = {c0.x, c0.y, c0.z, c0.w, c1.x, c1.y, c1.z, c1.w}, s[8] = {s0.x, s0.y, s0.z, s0.w, s1.x, s1.y, s1.z, s1.w};
            float o[8];
            const bool first = lane < 50;
#pragma unroll
            for (int e = 0; e < 8; ++e) o[e] = first ? (x[e] * c[e] - y[e] * s[e]) : (x[e] * c[e] + y[e] * s[e]);
            u32x4 ow; ow.x = pk_bf16(o[0], o[1]); ow.y = pk_bf16(o[2], o[3]); ow.z = pk_bf16(o[4], o[5]); ow.w = pk_bf16(o[6], o[7]);
            *(u32x4*)(KR + (size_t)row * 32 + 8 * (lane - 48)) = ow;
        }
    }
}

constexpr int XC_PITCH = 272;
__device__ __forceinline__ void phase_lru(const Params& p, LAS unsigned char* lds) {
    const int tid = threadIdx.x, lane = tid & 63, wave = __builtin_amdgcn_readfirstlane(tid >> 6), g = lane >> 4, lc = lane & 15;
    const bf16_t* XL = (const bf16_t*)(p.ws + WS_XL); bf16_t* GY = (bf16_t*)(p.ws + WS_GY); bf16_t* HF = (bf16_t*)(p.ws + WS_F);
    const bf16_t* WG = (const bf16_t*)(p.ws + WS_WG);
    for (int item = blockIdx.x; item < 256; item += gridDim.x) {
        int gb, n;
        if (item < 128) { gb = 16 + (item >> 3); n = item & 7; } else { gb = (item - 128) >> 3; n = item & 7; }
        const int S = gb < 16 ? SP : SS; const int row0 = gb < 16 ? gb * SP : TP + (gb - 16) * SS;
        const int nch = S >> 6;
        const int tr = tid >> 4, cgp = (tid & 15) * 8, c0 = 128 * n + cgp;
        float cw[4][8], cb[8];
#pragma unroll
        for (int j = 0; j < 4; ++j) { const f32x4 a = *(const f32x4*)(p.in[16] + j * D + c0), b = *(const f32x4*)(p.in[16] + j * D + c0 + 4);
            cw[j][0] = a.x; cw[j][1] = a.y; cw[j][2] = a.z; cw[j][3] = a.w; cw[j][4] = b.x; cw[j][5] = b.y; cw[j][6] = b.z; cw[j][7] = b.w; }
        { const f32x4 a = *(const f32x4*)(p.in[17] + c0), b = *(const f32x4*)(p.in[17] + c0 + 4);
            cb[0] = a.x; cb[1] = a.y; cb[2] = a.z; cb[3] = a.w; cb[4] = b.x; cb[5] = b.y; cb[6] = b.z; cb[7] = b.w; }
        const int ch = 128 * n + 16 * wave + lc;
        for (int d = 0; d < 2; ++d) {
            bf16x8 Ba[4], Bi[4];
            { const bf16_t* wa = WG + (size_t)((d * 8 + n) * 2 + 0) * 16384 + (size_t)(16 * wave + lc) * 128 + 8 * g; const bf16_t* wi = wa + 16384;
#pragma unroll
              for (int ks = 0; ks < 4; ++ks) { Ba[ks] = *(const bf16x8*)(wa + 32 * ks); Bi[ks] = *(const bf16x8*)(wi + 32 * ks); } }
            const float ba = p.in[19][d * D + ch], bi = p.in[21][d * D + ch];
            const float lam = p.in[22][d * D + ch];
            const float c8 = -8.0f * log1pf(expf(-lam));
#define BPERM(addr, v) __builtin_bit_cast(float, __builtin_amdgcn_ds_bpermute((addr), __builtin_bit_cast(int, (v))))
            const int bp16 = ((d ? lane + 16 : lane - 16) & 63) << 2, bp32 = ((d ? lane + 32 : lane - 32) & 63) << 2, bpend = (d ? lc : 48 + lc) << 2;
            float carry = 0.f;
            u32x4 pw[2][4];
#define LRU_PREFETCH(CI) do { const int _cc = d ? (nch - 1 - (CI)) : (CI); _Pragma("unroll") for (int hf = 0; hf < 2; ++hf) _Pragma("unroll") for (int j = 0; j < 4; ++j) { \
                const int tt = _cc * 64 + tr + 32 * hf + j - 1; pw[hf][j] = (tt >= 0 && tt < S) ? *(const u32x4*)(XL + (size_t)(row0 + tt) * D + c0) : (u32x4){0u, 0u, 0u, 0u}; } } while (0)
            LRU_PREFETCH(0);
            for (int ci = 0; ci < nch; ++ci) {
                const int cc = d ? (nch - 1 - ci) : ci, t0 = cc * 64;
                __syncthreads();
#pragma unroll
                for (int hf = 0; hf < 2; ++hf) {
                    const int tl = tr + 32 * hf;
                    float a[8];
#pragma unroll
                    for (int e = 0; e < 8; ++e) a[e] = cb[e];
#pragma unroll
                    for (int j = 0; j < 4; ++j) { const u32x4 w = pw[hf][j];
                        a[0] += cw[j][0] * lo_bf(w.x); a[1] += cw[j][1] * hi_bf(w.x); a[2] += cw[j][2] * lo_bf(w.y); a[3] += cw[j][3] * hi_bf(w.y);
                        a[4] += cw[j][4] * lo_bf(w.z); a[5] += cw[j][5] * hi_bf(w.z); a[6] += cw[j][6] * lo_bf(w.w); a[7] += cw[j][7] * hi_bf(w.w); }
                    u32x4 o; o.x = pk_bf16(a[0], a[1]); o.y = pk_bf16(a[2], a[3]); o.z = pk_bf16(a[4], a[5]); o.w = pk_bf16(a[6], a[7]);
                    *(LAS u32x4*)(lds + tl * XC_PITCH + cgp * 2) = o;
                }
                __syncthreads();
                if (ci + 1 < nch) LRU_PREFETCH(ci + 1);
                float hfv[4][4], gyv[4][4];
                if (d == 1) {
#pragma unroll
                    for (int mt = 0; mt < 4; ++mt)
#pragma unroll
                        for (int j = 0; j < 4; ++j) { const size_t off = (size_t)(row0 + t0 + 16 * mt + 4 * g + j) * D + ch; hfv[mt][j] = bf2f(HF[off]); gyv[mt][j] = bf2f(GY[off]); }
                }
                f32x4 aa[4], ai[4];
#pragma unroll
                for (int mt = 0; mt < 4; ++mt) { aa[mt] = (f32x4){0.f, 0.f, 0.f, 0.f}; ai[mt] = (f32x4){0.f, 0.f, 0.f, 0.f}; }
#pragma unroll
                for (int ks = 0; ks < 4; ++ks)
#pragma unroll
                    for (int mt = 0; mt < 4; ++mt) { const bf16x8 A = *(const LAS bf16x8*)(lds + (16 * mt + lc) * XC_PITCH + (32 * ks + 8 * g) * 2);
                        aa[mt] = __builtin_amdgcn_mfma_f32_16x16x32_bf16(A, Ba[ks], aa[mt], 0, 0, 0);
                        ai[mt] = __builtin_amdgcn_mfma_f32_16x16x32_bf16(A, Bi[ks], ai[mt], 0, 0, 0); }
#pragma unroll
                for (int mt = 0; mt < 4; ++mt)
#pragma unroll
                    for (int j = 0; j < 4; ++j) {
                        const float xcv = bf2f(*(const LAS bf16_t*)(lds + (16 * mt + 4 * g + j) * XC_PITCH + (16 * wave + lc) * 2));
                        const float r = fsigmoid(aa[mt][j] + ba), ig = fsigmoid(ai[mt][j] + bi);
                        const float la = c8 * r;
                        const float av = fexp(la), om = (1.0f - av) * (1.0f + av);
                        aa[mt][j] = av; ai[mt][j] = __builtin_amdgcn_sqrtf(om) * (ig * xcv);
                    }
                if (d == 0) {
#pragma unroll
                    for (int mt = 0; mt < 4; ++mt) {
                        float P = 1.f, Hh = 0.f, pl[4], hl[4];
#pragma unroll
                        for (int j = 0; j < 4; ++j) { Hh = aa[mt][j] * Hh + ai[mt][j]; P *= aa[mt][j]; hl[j] = Hh; pl[j] = P; }
                        float A = P, Hs = Hh;
                        { const float A1 = BPERM(bp16, A), H1 = BPERM(bp16, Hs); if (g >= 1) { Hs = A * H1 + Hs; A = A * A1; } }
                        { const float A2 = BPERM(bp32, A), H2 = BPERM(bp32, Hs); if (g >= 2) { Hs = A * H2 + Hs; A = A * A2; } }
                        float Aex = BPERM(bp16, A), Hex = BPERM(bp16, Hs); if (g == 0) { Aex = 1.f; Hex = 0.f; }
                        const float cin = Aex * carry + Hex;
                        const float At = BPERM(bpend, A), Ht = BPERM(bpend, Hs);
                        carry = At * carry + Ht;
#pragma unroll
                        for (int j = 0; j < 4; ++j) { const float h = hl[j] + pl[j] * cin;
                            HF[(size_t)(row0 + t0 + 16 * mt + 4 * g + j) * D + ch] = (bf16_t)(pk_bf16(h, 0.f) & 0xffffu); }
                    }
                } else {
#pragma unroll
                    for (int mt = 3; mt >= 0; --mt) {
                        float P = 1.f, Hh = 0.f, pl[4], hl[4];
#pragma unroll
                        for (int j = 3; j >= 0; --j) { Hh = aa[mt][j] * Hh + ai[mt][j]; P *= aa[mt][j]; hl[j] = Hh; pl[j] = P; }
                        float A = P, Hs = Hh;
                        { const float A1 = BPERM(bp16, A), H1 = BPERM(bp16, Hs); if (g <= 2) { Hs = A * H1 + Hs; A = A * A1; } }
                        { const float A2 = BPERM(bp32, A), H2 = BPERM(bp32, Hs); if (g <= 1) { Hs = A * H2 + Hs; A = A * A2; } }
                        float Aex = BPERM(bp16, A), Hex = BPERM(bp16, Hs); if (g == 3) { Aex = 1.f; Hex = 0.f; }
                        const float cin = Aex * carry + Hex;
                        const float At = BPERM(bpend, A), Ht = BPERM(bpend, Hs);
                        carry = At * carry + Ht;
#pragma unroll
                        for (int j = 0; j < 4; ++j) { const float h = hl[j] + pl[j] * cin;
                            const size_t off = (size_t)(row0 + t0 + 16 * mt + 4 * g + j) * D + ch;
                            const float o = (hfv[mt][j] + h) * gyv[mt][j];
                            GY[off] = (bf16_t)(pk_bf16(o, 0.f) & 0xffffu); }
                    }
                }
            }
        }
        __syncthreads();
    }
}

constexpr int AK_PITCH = 208, AV_PITCH = 160, AK_BYTES = 64 * AK_PITCH, AV_BYTES = 64 * AV_PITCH, ABUF = AK_BYTES + AV_BYTES;
__device__ __forceinline__ void phase_attn(const Params& p, LAS unsigned char* lds) {
    const int tid = threadIdx.x, lane = tid & 63, wave = __builtin_amdgcn_readfirstlane(tid >> 6), g = lane >> 4, lc = lane & 15;
    const bf16_t* Q = (const bf16_t*)(p.ws + WS_F); const bf16_t* KN = (const bf16_t*)(p.ws + WS_XL); const bf16_t* V = KN + (size_t)T * NKV;
    const bf16_t* KR = (const bf16_t*)(p.ws + WS_KR); bf16_t* O = (bf16_t*)(p.ws + WS_ZQ);
    const float csc = 0.10206207261596577f * 1.4426950408889634f;
    const int srow = tid >> 3, sch = tid & 7;
    const int rrow = (tid & 255) >> 2, rch = tid & 3;
    const int vtr = (4 * g + (lc >> 2)) * AV_PITCH + (4 * (lc & 3)) * 2;
    for (int unit = blockIdx.x; unit < 3072; unit += gridDim.x) {
        int gb, h, qt, S, row0;
        if (unit < 2048) { gb = 16 + (unit >> 7); h = (unit & 127) >> 4; qt = unit & 15; S = SS; row0 = TP + (gb - 16) * SS; }
        else { const int u2 = unit - 2048; gb = u2 >> 6; h = (u2 & 63) >> 3; qt = u2 & 7; S = SP; row0 = gb * SP; }
        const int nkt = S >> 6;
        const int qrow = row0 + 256 * qt + 32 * wave;
        bf16x8 qf[2][3];
#pragma unroll
        for (int q2 = 0; q2 < 2; ++q2)
#pragma unroll
            for (int ks = 0; ks < 3; ++ks) qf[q2][ks] = *(const bf16x8*)(Q + (size_t)(qrow + 16 * q2 + lc) * NQ + 96 * h + 32 * ks + 8 * g);
#pragma unroll
        for (int q2 = 0; q2 < 2; ++q2) {
            const int pos = row_pos(qrow + 16 * q2 + lc), i0 = 8 * (g & 1);
            const float* rc = (const float*)(p.ws + WS_ROPE) + pos * 16 + i0; const float* rsn = rc + SS * 16;
            const f32x4 c0 = *(const f32x4*)rc, c1 = *(const f32x4*)(rc + 4), s0 = *(const f32x4*)rsn, s1 = *(const f32x4*)(rsn + 4);
            const float cc[8] = {c0.x, c0.y, c0.z, c0.w, c1.x, c1.y, c1.z, c1.w}, sn[8] = {s0.x, s0.y, s0.z, s0.w, s1.x, s1.y, s1.z, s1.w};
            const u32x4 mine = __builtin_bit_cast(u32x4, qf[q2][2]);
            u32x4 oth; oth.x = __shfl_xor(mine.x, 32); oth.y = __shfl_xor(mine.y, 32); oth.z = __shfl_xor(mine.z, 32); oth.w = __shfl_xor(mine.w, 32);
            const float xm[8] = {lo_bf(mine.x), hi_bf(mine.x), lo_bf(mine.y), hi_bf(mine.y), lo_bf(mine.z), hi_bf(mine.z), lo_bf(mine.w), hi_bf(mine.w)};
            const float xo[8] = {lo_bf(oth.x), hi_bf(oth.x), lo_bf(oth.y), hi_bf(oth.y), lo_bf(oth.z), hi_bf(oth.z), lo_bf(oth.w), hi_bf(oth.w)};
            float o[8];
#pragma unroll
            for (int e = 0; e < 8; ++e) o[e] = g < 2 ? (xm[e] * cc[e] - xo[e] * sn[e]) : (xm[e] * cc[e] + xo[e] * sn[e]);
            u32x4 w; w.x = pk_bf16(o[0], o[1]); w.y = pk_bf16(o[2], o[3]); w.z = pk_bf16(o[4], o[5]); w.w = pk_bf16(o[6], o[7]);
            qf[q2][2] = __builtin_bit_cast(bf16x8, w);
        }
        f32x4 oacc[4][2];
#pragma unroll
        for (int dt = 0; dt < 4; ++dt) { oacc[dt][0] = (f32x4){0.f, 0.f, 0.f, 0.f}; oacc[dt][1] = (f32x4){0.f, 0.f, 0.f, 0.f}; }
        float mrun[2] = {-1e30f, -1e30f}, lrun[2] = {0.f, 0.f};
        u32x4 gk, gr, gv;
        gk = *(const u32x4*)(KN + (size_t)(row0 + srow) * NKV + 64 * h + 8 * sch);
        gv = *(const u32x4*)(V + (size_t)(row0 + srow) * NKV + 64 * h + 8 * sch);
        gr = *(const u32x4*)(KR + (size_t)(row0 + rrow) * 32 + 8 * rch);
        __syncthreads();
        *(LAS u32x4*)(lds + srow * AK_PITCH + sch * 16) = gk;
        *(LAS u32x4*)(lds + AK_BYTES + srow * AV_PITCH + sch * 16) = gv;
        if (tid < 256) *(LAS u32x4*)(lds + rrow * AK_PITCH + 128 + rch * 16) = gr;
        gk = *(const u32x4*)(KN + (size_t)(row0 + 64 + srow) * NKV + 64 * h + 8 * sch);
        gr = *(const u32x4*)(KR + (size_t)(row0 + 64 + rrow) * 32 + 8 * rch);
        *(LAS u32x4*)(lds + ABUF + srow * AK_PITCH + sch * 16) = gk;
        if (tid < 256) *(LAS u32x4*)(lds + ABUF + rrow * AK_PITCH + 128 + rch * 16) = gr;
        __syncthreads();
        f32x4 sc[4][2];
#pragma unroll
        for (int k4 = 0; k4 < 4; ++k4) { sc[k4][0] = (f32x4){0.f, 0.f, 0.f, 0.f}; sc[k4][1] = (f32x4){0.f, 0.f, 0.f, 0.f}; }
#pragma unroll
        for (int ks = 0; ks < 3; ++ks)
#pragma unroll
            for (int k4 = 0; k4 < 4; ++k4) { const bf16x8 kf = *(const LAS bf16x8*)(lds + (16 * k4 + lc) * AK_PITCH + (32 * ks + 8 * g) * 2);
                sc[k4][0] = __builtin_amdgcn_mfma_f32_16x16x32_bf16(kf, qf[0][ks], sc[k4][0], 0, 0, 0);
                sc[k4][1] = __builtin_amdgcn_mfma_f32_16x16x32_bf16(kf, qf[1][ks], sc[k4][1], 0, 0, 0); }
        for (int kt = 0; kt < nkt; ++kt) {
            LAS unsigned char* kn = lds + ((kt + 1) & 1) * ABUF;
            LAS unsigned char* vb = lds + (kt & 1) * ABUF + AK_BYTES;
            const bool k2 = kt + 2 < nkt, v1 = kt + 1 < nkt;
            if (k2) { const int kr0 = row0 + 64 * (kt + 2);
                gk = *(const u32x4*)(KN + (size_t)(kr0 + srow) * NKV + 64 * h + 8 * sch);
                gr = *(const u32x4*)(KR + (size_t)(kr0 + rrow) * 32 + 8 * rch); }
            if (v1) gv = *(const u32x4*)(V + (size_t)(row0 + 64 * (kt + 1) + srow) * NKV + 64 * h + 8 * sch);
            f32x4 sn[4][2];
#pragma unroll
            for (int k4 = 0; k4 < 4; ++k4) { sn[k4][0] = (f32x4){0.f, 0.f, 0.f, 0.f}; sn[k4][1] = (f32x4){0.f, 0.f, 0.f, 0.f}; }
#pragma unroll
            for (int ks = 0; ks < 3; ++ks)
#pragma unroll
                for (int k4 = 0; k4 < 4; ++k4) { const bf16x8 kf = *(const LAS bf16x8*)(kn + (16 * k4 + lc) * AK_PITCH + (32 * ks + 8 * g) * 2);
                    sn[k4][0] = __builtin_amdgcn_mfma_f32_16x16x32_bf16(kf, qf[0][ks], sn[k4][0], 0, 0, 0);
                    sn[k4][1] = __builtin_amdgcn_mfma_f32_16x16x32_bf16(kf, qf[1][ks], sn[k4][1], 0, 0, 0); }
            bf16x8 pf[2][2];
#pragma unroll
            for (int q2 = 0; q2 < 2; ++q2) {
                float mx = sc[0][q2][0];
#pragma unroll
                for (int k4 = 0; k4 < 4; ++k4)
#pragma unroll
                    for (int j = 0; j < 4; ++j) mx = fmaxf(mx, sc[k4][q2][j]);
                mx = fmaxf(mx, __shfl_xor(mx, 16)); mx = fmaxf(mx, __shfl_xor(mx, 32));
                const float mnew = fmaxf(mrun[q2], mx * csc);
                const float alpha = __builtin_amdgcn_exp2f(mrun[q2] - mnew);
                mrun[q2] = mnew;
                float ps = 0.f; float pv[4][4];
#pragma unroll
                for (int k4 = 0; k4 < 4; ++k4)
#pragma unroll
                    for (int j = 0; j < 4; ++j) { const float e = __builtin_amdgcn_exp2f(sc[k4][q2][j] * csc - mnew); pv[k4][j] = e; ps += e; }
                lrun[q2] = lrun[q2] * alpha + ps;
#pragma unroll
                for (int dt = 0; dt < 4; ++dt) oacc[dt][q2] *= alpha;
#pragma unroll
                for (int kk = 0; kk < 2; ++kk) {
                    u32x4 w; w.x = pk_bf16(pv[2 * kk][0], pv[2 * kk][1]); w.y = pk_bf16(pv[2 * kk][2], pv[2 * kk][3]);
                    w.z = pk_bf16(pv[2 * kk + 1][0], pv[2 * kk + 1][1]); w.w = pk_bf16(pv[2 * kk + 1][2], pv[2 * kk + 1][3]);
                    pf[q2][kk] = __builtin_bit_cast(bf16x8, w);
                }
            }
#pragma unroll
            for (int i = 0; i < 24; ++i) { __builtin_amdgcn_sched_group_barrier(0x008, 1, 0); __builtin_amdgcn_sched_group_barrier(0x002, 10, 0); }
#pragma unroll
            for (int kk = 0; kk < 2; ++kk)
#pragma unroll
                for (int dt = 0; dt < 4; ++dt) {
                    const v4i16_t lo = __builtin_amdgcn_ds_read_tr16_b64_v4i16((LAS v4i16_t*)(vb + vtr + (32 * kk) * AV_PITCH + 32 * dt));
                    const v4i16_t hi = __builtin_amdgcn_ds_read_tr16_b64_v4i16((LAS v4i16_t*)(vb + vtr + (32 * kk + 16) * AV_PITCH + 32 * dt));
                    const bf16x8 vf = {lo[0], lo[1], lo[2], lo[3], hi[0], hi[1], hi[2], hi[3]};
                    oacc[dt][0] = __builtin_amdgcn_mfma_f32_16x16x32_bf16(vf, pf[0][kk], oacc[dt][0], 0, 0, 0);
                    oacc[dt][1] = __builtin_amdgcn_mfma_f32_16x16x32_bf16(vf, pf[1][kk], oacc[dt][1], 0, 0, 0);
                }
            if (k2) { LAS unsigned char* kw = lds + (kt & 1) * ABUF;
                *(LAS u32x4*)(kw + srow * AK_PITCH + sch * 16) = gk;
                if (tid < 256) *(LAS u32x4*)(kw + rrow * AK_PITCH + 128 + rch * 16) = gr; }
            if (v1) *(LAS u32x4*)(lds + ((kt + 1) & 1) * ABUF + AK_BYTES + srow * AV_PITCH + sch * 16) = gv;
            __syncthreads();
#pragma unroll
            for (int k4 = 0; k4 < 4; ++k4) { sc[k4][0] = sn[k4][0]; sc[k4][1] = sn[k4][1]; }
        }
#pragma unroll
        for (int q2 = 0; q2 < 2; ++q2) {
            float l = lrun[q2]; l += __shfl_xor(l, 16); l += __shfl_xor(l, 32);
            const float inv = 1.0f / l;
#pragma unroll
            for (int dt = 0; dt < 4; ++dt) { const f32x4 o = oacc[dt][q2] * inv;
                u32x2 w; w.x = pk_bf16(o[0], o[1]); w.y = pk_bf16(o[2], o[3]);
                *(u32x2*)(O + (size_t)(qrow + 16 * q2 + lc) * 512 + 64 * h + 16 * dt + 4 * g) = w; }
        }
    }
    __syncthreads();
}

#define XB_TMO      128
#define XB_XCNT(j)  (256  + 64 * (j))
#define XB_XSUB(j)  (1280 + 64 * (j))
#define XB_XGEN(j)  (2304 + 64 * (j))
#define XB_TOP      3328
#define XB_TOPGEN   3392
#define XCD_BAR_WORDS 3456
#define XB_SPIN_CAP (1u << 18)

__device__ __forceinline__ unsigned xb_ld(unsigned* p)              { return __hip_atomic_load(p, __ATOMIC_RELAXED, __HIP_MEMORY_SCOPE_AGENT); }
__device__ __forceinline__ unsigned xb_add(unsigned* p, unsigned v) { return __hip_atomic_fetch_add(p, v, __ATOMIC_RELAXED, __HIP_MEMORY_SCOPE_AGENT); }
__device__ __forceinline__ unsigned xb_xcc_id() { return (unsigned)__builtin_amdgcn_s_getreg((3 << 11) | 20) & 0xFu; }
#define XB_SPIN(cond, bar) do { unsigned _sp = 0; while (cond) { __builtin_amdgcn_s_sleep(1); \
    if ((++_sp & 255u) == 0u) { if (xb_ld(&(bar)[XB_TMO])) break; if (_sp > XB_SPIN_CAP) { atomicAdd(&(bar)[XB_TMO], 1u); break; } } } } while (0)

struct XcdBarrier {
    unsigned* bar; unsigned x;
    volatile LAS unsigned* st;
};

__device__ __forceinline__ XcdBarrier xcd_barrier_post(unsigned* bar, volatile LAS unsigned* st) {
    XcdBarrier b; b.bar = bar; b.x = xb_xcc_id(); b.st = st;
    if (threadIdx.x == 0) (void)xb_add(&bar[XB_XCNT(b.x)], 1u);
    return b;
}
__device__ __forceinline__ void xcd_barrier_complete(unsigned* bar, unsigned x, unsigned& nloc, unsigned& nx) {
    const unsigned G = gridDim.x * gridDim.y * gridDim.z;
    unsigned sum, cnt, mine, sp = 0u;
    for (;;) {
        sum = 0u; cnt = 0u; mine = 0u;
#pragma unroll
        for (unsigned j = 0; j < 16; ++j) { const unsigned c = xb_ld(&bar[XB_XCNT(j)]); sum += c; cnt += (c > 0u) ? 1u : 0u; mine = (j == x) ? c : mine; }
        if (sum == G) break;
        __builtin_amdgcn_s_sleep(1);
        if ((++sp & 255u) == 0u) { if (xb_ld(&bar[XB_TMO])) break; if (sp > XB_SPIN_CAP) { atomicAdd(&bar[XB_TMO], 1u); break; } }
    }
    nloc = mine > 0u ? mine : 1u; nx = cnt > 0u ? cnt : 1u;
}

__device__ __forceinline__ void xcd_barrier(const XcdBarrier& b) {
    asm volatile("s_waitcnt vmcnt(0)" ::: "memory");
    __syncthreads();
    if (threadIdx.x == 0) {
        unsigned* bar = b.bar;
        __builtin_amdgcn_s_waitcnt(0);
        unsigned nloc = b.st[0], nx = b.st[1];
        if (nloc == 0u) { xcd_barrier_complete(bar, b.x, nloc, nx); b.st[0] = nloc; b.st[1] = nx; }
        const unsigned old = xb_add(&bar[XB_XSUB(b.x)], 1u);
        const unsigned gen = old / nloc;
        if (old + 1u == (gen + 1u) * nloc) {
            __builtin_amdgcn_fence(__ATOMIC_RELEASE, "agent");
            asm volatile("s_waitcnt vmcnt(0)" ::: "memory");
            const unsigned og = xb_add(&bar[XB_TOP], 1u);
            const unsigned tg = og / nx;
            if (og + 1u == (tg + 1u) * nx) xb_add(&bar[XB_TOPGEN], 1u);
            else XB_SPIN(xb_ld(&bar[XB_TOPGEN]) == tg, bar);
            __builtin_amdgcn_fence(__ATOMIC_ACQUIRE, "agent");
            xb_add(&bar[XB_XGEN(b.x)], 1u);
            asm volatile("s_waitcnt vmcnt(0)" ::: "memory");
        } else {
            XB_SPIN(xb_ld(&bar[XB_XGEN(b.x)]) == gen, bar);
            __builtin_amdgcn_fence(__ATOMIC_ACQUIRE, "agent");
            asm volatile("s_waitcnt vmcnt(0)" ::: "memory");
        }
    }
    __syncthreads();
}


constexpr int NPHASES = 16;
__global__ void __launch_bounds__(NTHREADS, 2) mega_fwd(Params p) {
    extern __shared__ __attribute__((aligned(16))) unsigned char lds_raw[];
    LAS unsigned char* lds = (LAS unsigned char*)lds_raw;
    cg::grid_group grid = cg::this_grid();
    unsigned char* ws = p.ws;
    const int G = gridDim.x, bid = blockIdx.x;
    bf16_t* Hb = (bf16_t*)(ws + WS_H); bf16_t* Fb = (bf16_t*)(ws + WS_F); bf16_t* ACT = (bf16_t*)(ws + WS_ACT);
    bf16_t* ZQ = (bf16_t*)(ws + WS_ZQ); bf16_t* XL = (bf16_t*)(ws + WS_XL); bf16_t* GY = (bf16_t*)(ws + WS_GY);
#ifndef TESTPH
#define TESTPH -1
#endif
#define IN(k) ((TESTPH < 0 || (k) == TESTPH) && p.ph_lo <= (k) && (k) < p.ph_hi)
#define SEAM0() do { if (IN(0) && IN(1)) { __builtin_amdgcn_fence(__ATOMIC_RELEASE, "agent"); asm volatile("s_waitcnt vmcnt(0) lgkmcnt(0)" ::: "memory"); \
        grid.sync(); __builtin_amdgcn_fence(__ATOMIC_ACQUIRE, "agent"); asm volatile("s_waitcnt vmcnt(0) lgkmcnt(0)" ::: "memory"); \
        xb = xcd_barrier_post((unsigned*)(p.ws + WS_XBAR), xbst); } } while (0)
#define SEAM(k) do { if (IN(k) && IN((k) + 1)) xcd_barrier(xb); } while (0)
    volatile LAS unsigned* xbst = (volatile LAS unsigned*)(lds + LDS_BYTES - 16);
    if (threadIdx.x < 4) xbst[threadIdx.x] = 0u;
    __syncthreads();
    XcdBarrier xb; xb.bar = (unsigned*)(p.ws + WS_XBAR); xb.x = 0; xb.st = xbst;
    if (IN(0)) { if (bid == 0) { unsigned* xw = (unsigned*)(p.ws + WS_XBAR); for (int i = threadIdx.x; i < XCD_BAR_WORDS; i += NTHREADS) xw[i] = 0u; }
        phase_prep(p, lds); }
    SEAM0();
    if (IN(1)) phase_rows<false, true>(p, 0, 0, 0.f, true);
    SEAM(1);
#define FFN_PHASES(ffn, pb) do { \
        if (IN(pb)) { \
            pg8::Gemm g{Hb, (const bf16_t*)(ws + ((ffn) ? WS_WGU2 : WS_WGU1)), D, D}; pg8::StaticOrder S; S.init(T, 2 * DFF, G, bid); \
            pg8::EpiSwiglu E{ACT, DFF}; \
            GEMM_PHASE(pg8::EpiSwiglu, lds, g, S, E); \
        } \
        SEAM(pb); \
        if (IN((pb) + 1)) { \
            pg8::Gemm g{ACT, (const bf16_t*)(ws + ((ffn) ? WS_WDN2 : WS_WDN1)), DFF, DFF}; pg8::StaticOrder S; S.init(T, D, G, bid); \
            pg8::EpiAct<0> E{Fb, D, 0}; \
            GEMM_PHASE(pg8::EpiAct<0>, lds, g, S, E); \
        } \
        SEAM((pb) + 1); } while (0)
    FFN_PHASES(0, 2);
        if (IN(4)) phase_rows<true, true>(p, 0, 1, 0.5f, true);
        SEAM(4);
        if (IN(5)) {
            pg8::Gemm g{Hb, (const bf16_t*)(ws + WS_WINA), D, D}; pg8::StaticOrder S; S.init(T, 2560, G, bid);
            pg8::EpiWinA E{ZQ, XL, GY};
            GEMM_PHASE(pg8::EpiWinA, lds, g, S, E);
        }
        SEAM(5);
        if (IN(6)) { phase_stats(p); phase_lru(p, lds); }
        SEAM(6);
        if (IN(7)) {
            pg8::Gemm g{ZQ, (const bf16_t*)(ws + WS_WQKV), 512, 384}; pg8::StaticOrder S; S.init(T, 1792, G, bid);
            pg8::EpiQKV E{Fb, XL, (const float*)(ws + WS_STATS)};
            GEMM_PHASE2(pg8::EpiQKV, lds, g, S, E);
        }
        SEAM(7);
        if (IN(8)) phase_attn(p, lds);
        SEAM(8);
        if (IN(9)) {
            pg8::Gemm g{Hb, (const bf16_t*)(ws + WS_WINB), D, D}; pg8::StaticOrder S; S.init(T, 2048, G, bid);
            pg8::EpiWinB E{Fb, XL};
            GEMM_PHASE(pg8::EpiWinB, lds, g, S, E);
        }
        SEAM(9);
        if (IN(10)) {
            { pg8::Gemm g{ZQ, (const bf16_t*)(ws + WS_WAO), 512, 512}; pg8::StaticOrder S; S.init(T, D, G, bid);
              pg8::EpiGate<false> E{Fb, nullptr, Fb};
              GEMM_PHASE(pg8::EpiGate<false>, lds, g, S, E); }
            { pg8::Gemm g{GY, (const bf16_t*)(ws + WS_WLO), D, D}; pg8::StaticOrder S; S.init(T, D, G, bid);
              pg8::EpiGate<true> E{XL, Fb, XL};
              GEMM_PHASE(pg8::EpiGate<true>, lds, g, S, E); }
        }
        SEAM(10);
        if (IN(11)) {
            pg8::Gemm g{XL, (const bf16_t*)(ws + WS_WOUT), D, D}; pg8::StaticOrder S; S.init(T, D, G, bid);
            pg8::EpiAct<0> E{Fb, D, 0};
            GEMM_PHASE(pg8::EpiAct<0>, lds, g, S, E);
        }
        SEAM(11);
        if (IN(12)) phase_rows<true, true>(p, 1, 2, 1.0f, false);
        SEAM(12);
    FFN_PHASES(1, 13);
    if (IN(15)) phase_rows<true, false>(p, 2, 0, 0.5f, false);
#undef IN
#undef SEAM
}

extern "C" void kernel_launch(void* const* d_in, const int* in_sizes, int n_in, void* d_out, int out_size, void* d_ws, size_t ws_size, hipStream_t stream) {
    static int grid = 0;
    if (grid == 0) {
        if (n_in != 27 || out_size != T * D || ws_size < WS_END) { fprintf(stderr, "kernel_launch: unexpected shapes: n_in %d out %d ws %zu (need >= %zu)\n", n_in, out_size, ws_size, (size_t)WS_END); grid = -1; return; }
        int dev = 0, cus = 0, per_cu = 0;
        (void)hipGetDevice(&dev);
        (void)hipDeviceGetAttribute(&cus, hipDeviceAttributeMultiprocessorCount, dev);
        if (hipFuncSetAttribute((const void*)mega_fwd, hipFuncAttributeMaxDynamicSharedMemorySize, LDS_BYTES) != hipSuccess) { fprintf(stderr, "kernel_launch: hipFuncSetAttribute failed\n"); grid = -1; return; }
        if (hipOccupancyMaxActiveBlocksPerMultiprocessor(&per_cu, (const void*)mega_fwd, NTHREADS, LDS_BYTES) != hipSuccess || per_cu < 1) { fprintf(stderr, "kernel_launch: occupancy query failed (%d)\n", per_cu); per_cu = 1; }
        (void)hipGetLastError();
        grid = cus;
        fprintf(stderr, "kernel_launch: grid %d (per_cu %d)\n", grid, per_cu);
    }
    if (grid < 0) return;
    Params p{};
    for (int i = 0; i < 27; ++i) p.in[i] = (const float*)d_in[i];
    p.out = (float*)d_out; p.ws = (unsigned char*)d_ws;
#if defined(MK_SPLIT)
    for (int ph = 0; ph < NPHASES; ++ph) { p.ph_lo = ph; p.ph_hi = ph + 1;
        hipLaunchKernelGGL(mega_fwd, dim3(grid), dim3(NTHREADS), LDS_BYTES, stream, p); }
#else
    p.ph_lo = 0; p.ph_hi = NPHASES;
    void* args[] = {&p};
    hipError_t e = hipLaunchCooperativeKernel((const void*)mega_fwd, dim3(grid), dim3(NTHREADS), args, LDS_BYTES, stream);
    if (e != hipSuccess) fprintf(stderr, "kernel_launch: cooperative launch failed: %s (grid %d)\n", hipGetErrorString(e), grid);
#endif
}
```

```cpp
#include <hip/hip_runtime.h>
#include <hip/hip_cooperative_groups.h>
#include <cstdio>
#include <cstdint>
namespace cg = cooperative_groups;
#ifndef MK_SP2_ALL
#define MK_SP2_ALL false
#endif

#define LAS __attribute__((address_space(3)))
typedef unsigned short bf16_t;
typedef short bf16x8 __attribute__((ext_vector_type(8)));
typedef short v4i16_t __attribute__((ext_vector_type(4)));
typedef float f32x4 __attribute__((ext_vector_type(4)));
typedef float f32x2 __attribute__((ext_vector_type(2)));
typedef unsigned u32x4 __attribute__((ext_vector_type(4)));
typedef unsigned u32x2 __attribute__((ext_vector_type(2)));

constexpr int D = 1024, DFF = 2816, TP = 32768, TS = 65536, T = TP + TS, SP = 2048, SS = 4096;
constexpr int NQ = 768, NKV = 512;
constexpr float EPS = 1e-6f;
constexpr int NTHREADS = 512, NWAVES = 8;

constexpr size_t KiB = 1024, MiB = 1024 * 1024;
constexpr size_t WS_WGU1 = 0, WS_WDN1 = 11 * MiB, WS_WINA = 16 * MiB + 512 * KiB, WS_WINB = 21 * MiB + 512 * KiB, WS_WQKV = 25 * MiB + 512 * KiB,
                 WS_WAO = 27 * MiB, WS_WLO = 28 * MiB, WS_WOUT = 30 * MiB, WS_WGU2 = 32 * MiB, WS_WDN2 = 43 * MiB, WS_WG = 48 * MiB + 512 * KiB,
                 WS_MOD = 49 * MiB + 512 * KiB, WS_ROPE = 50 * MiB + 768 * KiB, WS_STATS = 51 * MiB + 256 * KiB, WS_KR = 52 * MiB;
constexpr size_t WS_XBAR = 50 * MiB + 640 * KiB;
constexpr size_t WS_H = 64 * MiB, WS_F = 256 * MiB, WS_BIG = 448 * MiB;
constexpr size_t WS_ZQ = WS_BIG, WS_XL = WS_BIG + 96 * MiB, WS_GY = WS_BIG + 288 * MiB, WS_ACT = WS_BIG, WS_END = 976 * MiB;
constexpr int LDS_BYTES = 139264;

struct Params { const float* in[27]; float* out; unsigned char* ws; int ph_lo, ph_hi; };

typedef __bf16 bf16x2_t __attribute__((ext_vector_type(2)));
__device__ __forceinline__ unsigned pk_bf16(float lo, float hi) { const f32x2 v = {lo, hi}; const bf16x2_t b = __builtin_convertvector(v, bf16x2_t); return __builtin_bit_cast(unsigned, b); }
__device__ __forceinline__ float lo_bf(unsigned w) { return __uint_as_float(w << 16); }
__device__ __forceinline__ float hi_bf(unsigned w) { return __uint_as_float(w & 0xffff0000u); }
__device__ __forceinline__ float bf2f(bf16_t h) { return __uint_as_float((unsigned)h << 16); }
__device__ __forceinline__ float fexp(float x) { return __builtin_amdgcn_exp2f(x * 1.4426950408889634f); }
__device__ __forceinline__ float fsigmoid(float x) { return __builtin_amdgcn_rcpf(1.0f + fexp(-x)); }
__device__ __forceinline__ float fsilu(float x) { return x * fsigmoid(x); }
__device__ __forceinline__ float fgelu(float x) { return x * fsigmoid(1.5957691216057308f * (x + 0.044715f * x * x * x)); }
__device__ __forceinline__ float wave_sum(float v) {
#pragma unroll
    for (int o = 1; o < 64; o <<= 1) v += __shfl_xor(v, o);
    return v;
}
__device__ __forceinline__ int row_batch(int row) { return row < TP ? (row >> 11) : 16 + ((row - TP) >> 12); }
__device__ __forceinline__ int row_pos(int row) { return row < TP ? (row & (SP - 1)) : ((row - TP) & (SS - 1)); }

namespace pg8 {
constexpr int BM = 256, BK = 64, HALF = 128, HTB = HALF * BK * 2, STAGE_BYTES = 8 * HTB, NXCD = 8, WGM = 8;
__host__ __device__ __forceinline__ int lds_byte(int r, int c) { const int st = (r >> 4) * 2 + (c >> 5), rr = r & 15, cc = c & 31, ob = rr * 64 + cc * 2; return st * 1024 + (ob ^ (((ob >> 9) & 1) << 5)); }
__host__ __device__ __forceinline__ void stage_rc(int b, int& R, int& C) { const int st = b / 1024, sb = b % 1024, swz = sb ^ (((sb >> 9) & 1) << 5); R = (st >> 1) * 16 + swz / 64; C = (st & 1) * 32 + (swz % 64) / 2; }
__host__ __device__ __forceinline__ int perm32(int rho) { const int n = rho >> 4, i = rho & 15; return 8 * (i >> 2) + 4 * n + (i & 3); }

struct Unit { int pm, pn; };
struct Gemm { const bf16_t* A; const bf16_t* Bt; int lda, K; };

struct StaticOrder {
    int nM, nN, nwg, G, c;
    __device__ void init(int M, int N, int G_, int c_) { nM = M / BM; nN = N / BM; nwg = nM * nN; G = G_; c = c_; }
    __device__ bool next(int i, Unit& u) const {
        const long L = (long)i * G + c; if (L >= nwg) return false;
        int wgid = (int)L; { const int q = nwg / NXCD, r = nwg % NXCD, xcd = wgid % NXCD, off = wgid / NXCD; wgid = (xcd < r ? xcd * (q + 1) : r * (q + 1) + (xcd - r) * q) + off; }
        const int nig = WGM * nN, gid = wgid / nig, fm = gid * WGM, gsz = (nM - fm) < WGM ? (nM - fm) : WGM;
        u.pm = fm + ((wgid % nig) % gsz); u.pn = (wgid % nig) / gsz; return true;
    }
};

template <class Epi, bool SP2 = false>
__device__ __forceinline__ void gemm_phase(LAS unsigned char* lds, const Gemm g, const StaticOrder& S, const Epi& E) {
    const int tid = threadIdx.x, wid = __builtin_amdgcn_readfirstlane(tid >> 6), lane = tid & 63, wr = wid >> 2, wc = wid & 3, fr = lane & 15, fq = lane >> 4;
    const int K = g.K, nt = K / BK, lda = g.lda;
    unsigned voffA[2], voffB[2];
#pragma unroll
    for (int i = 0; i < 2; ++i) { int R, C; stage_rc(tid * 16 + i * 8192, R, C); const int Rb = Epi::PERM ? ((R & ~31) + perm32(R & 31)) : R;
        voffA[i] = (unsigned)(R * lda + C) * 2u; voffB[i] = (unsigned)(Rb * K + C) * 2u; }
    const size_t kstep = (size_t)(BK * 2);
    const size_t hstepA = (size_t)HALF * lda * 2, hstepB = (size_t)HALF * K * 2;
    const size_t tstepA = 2 * hstepA, tstepB = 2 * hstepB;
    const unsigned ldsw = (unsigned)wid * 1024u;
    const int aoff = lds_byte(wr * 64 + fr, fq * 8), boff = lds_byte(wc * 32 + fr, fq * 8);
#define PG8_SA(b, h) (((b) * 2 + (h)) * HTB)
#define PG8_SB(b, h) ((4 + (b) * 2 + (h)) * HTB)
#define PG8_STAGE(bufoff, gbase, voff) do { _Pragma("unroll") for (int _i = 0; _i < 2; ++_i) \
        __builtin_amdgcn_global_load_lds((const unsigned*)((const char*)(gbase) + (voff)[_i]), (LAS unsigned*)(lds + (bufoff) + ldsw + _i * 8192), 16, 0, 0); } while (0)
#define PG8_LDA(dst, b, h) do { _Pragma("unroll") for (int m = 0; m < 4; ++m) _Pragma("unroll") for (int k = 0; k < 2; ++k) dst[m][k] = *(const LAS bf16x8*)(lds + PG8_SA(b, h) + aoff + m * 2048 + k * 1024); } while (0)
#define PG8_LDB(dst, b, h) do { _Pragma("unroll") for (int n = 0; n < 2; ++n) _Pragma("unroll") for (int k = 0; k < 2; ++k) dst[n][k] = *(const LAS bf16x8*)(lds + PG8_SB(b, h) + boff + n * 2048 + k * 1024); } while (0)
#define PG8_MMA(ai, bj, At, Bt) do { __builtin_amdgcn_s_setprio(1); _Pragma("unroll") for (int m = 0; m < 4; ++m) _Pragma("unroll") for (int n = 0; n < 2; ++n) _Pragma("unroll") for (int k = 0; k < 2; ++k) \
        acc[ai][bj][m][n] = __builtin_amdgcn_mfma_f32_16x16x32_bf16(Bt[n][k], At[m][k], acc[ai][bj][m][n], 0, 0, 0); __builtin_amdgcn_s_setprio(0); } while (0)
#define PG8_WAIT_V(n) asm volatile("s_waitcnt vmcnt(" #n ")" ::: "memory")
#define PG8_WAIT_L(n) asm volatile("s_waitcnt lgkmcnt(" #n ")" ::: "memory")
#define PG8_BAR __builtin_amdgcn_s_barrier()
#define PG8_SCHED __builtin_amdgcn_sched_barrier(0)
    Unit cur, nxt; int ui = 0;
    if (!S.next(0, cur)) return;
    f32x4 acc[2][2][4][2];
#pragma unroll
    for (int a = 0; a < 2; ++a)
#pragma unroll
        for (int b = 0; b < 2; ++b)
#pragma unroll
            for (int m = 0; m < 4; ++m)
#pragma unroll
                for (int n = 0; n < 2; ++n) acc[a][b][m][n] = (f32x4){0.f, 0.f, 0.f, 0.f};
    bf16x8 At[4][2], B0[2][2], B1[2][2];
    const char* cA = (const char*)g.A + (size_t)cur.pm * tstepA; const char* cB = (const char*)g.Bt + (size_t)cur.pn * tstepB;
    if constexpr (SP2) {
        PG8_STAGE(PG8_SB(0, 0), cB, voffB); PG8_STAGE(PG8_SB(0, 1), cB + hstepB, voffB); PG8_STAGE(PG8_SA(0, 0), cA, voffA); PG8_STAGE(PG8_SA(0, 1), cA + hstepA, voffA);
        if (wr == 1) PG8_BAR;
        PG8_WAIT_V(2); PG8_BAR;
        PG8_STAGE(PG8_SB(1, 0), cB + kstep, voffB); PG8_STAGE(PG8_SA(1, 0), cA + kstep, voffA); PG8_STAGE(PG8_SB(1, 1), cB + hstepB + kstep, voffB);
        PG8_WAIT_V(6); PG8_BAR;
    } else {
    PG8_STAGE(PG8_SB(0, 0), cB, voffB); PG8_STAGE(PG8_SA(0, 0), cA, voffA); PG8_STAGE(PG8_SB(0, 1), cB + hstepB, voffB); PG8_STAGE(PG8_SA(0, 1), cA + hstepA, voffA);
    if (wr == 1) PG8_BAR;
    PG8_WAIT_V(4); PG8_BAR;
    PG8_STAGE(PG8_SB(1, 0), cB + kstep, voffB); PG8_STAGE(PG8_SA(1, 0), cA + kstep, voffA); PG8_STAGE(PG8_SB(1, 1), cB + hstepB + kstep, voffB);
    PG8_WAIT_V(6); PG8_BAR;
    }
    for (;;) {
        const bool has_next = S.next(ui + 1, nxt);
        const char* nA = has_next ? (const char*)g.A + (size_t)nxt.pm * tstepA : cA; const char* nB = has_next ? (const char*)g.Bt + (size_t)nxt.pn * tstepB : cB;
        for (int t = 0; t < nt; t += 2) {
            const bool last = (t == nt - 2);
            const char* a1 = cA + (size_t)(t + 1) * kstep;
            const char* a2 = last ? nA : cA + (size_t)(t + 2) * kstep; const char* b2 = last ? nB : cB + (size_t)(t + 2) * kstep;
            const char* a3 = a2 + kstep; const char* b3 = b2 + kstep;
            if constexpr (SP2) {
            PG8_LDB(B0, 0, 0); PG8_LDB(B1, 0, 1); PG8_SCHED; PG8_LDA(At, 0, 0); PG8_STAGE(PG8_SA(1, 1), a1 + hstepA, voffA);
            PG8_WAIT_V(8); PG8_WAIT_L(0); PG8_BAR; PG8_MMA(0, 0, At, B0); PG8_MMA(0, 1, At, B1); PG8_BAR; PG8_SCHED;
            PG8_LDA(At, 0, 1); PG8_STAGE(PG8_SB(0, 0), b2, voffB); PG8_STAGE(PG8_SB(0, 1), b2 + hstepB, voffB); PG8_STAGE(PG8_SA(0, 0), a2, voffA);
            PG8_WAIT_V(8); PG8_WAIT_L(0); PG8_BAR; PG8_MMA(1, 0, At, B0); PG8_MMA(1, 1, At, B1); PG8_BAR; PG8_SCHED;
            PG8_LDB(B0, 1, 0); PG8_LDB(B1, 1, 1); PG8_SCHED; PG8_LDA(At, 1, 0); PG8_STAGE(PG8_SA(0, 1), a2 + hstepA, voffA);
            PG8_WAIT_V(8); PG8_WAIT_L(0); PG8_BAR; PG8_MMA(0, 0, At, B0); PG8_MMA(0, 1, At, B1); PG8_BAR; PG8_SCHED;
            PG8_LDA(At, 1, 1); PG8_STAGE(PG8_SB(1, 0), b3, voffB); PG8_STAGE(PG8_SB(1, 1), b3 + hstepB, voffB); PG8_STAGE(PG8_SA(1, 0), a3, voffA);
            PG8_WAIT_V(8); PG8_WAIT_L(0); PG8_BAR; PG8_MMA(1, 0, At, B0); PG8_MMA(1, 1, At, B1); PG8_BAR; PG8_SCHED;
            } else {
            PG8_LDB(B0, 0, 0); PG8_SCHED; PG8_LDA(At, 0, 0); PG8_STAGE(PG8_SA(1, 1), a1 + hstepA, voffA);
            PG8_WAIT_L(8); PG8_BAR; PG8_WAIT_L(0); PG8_MMA(0, 0, At, B0); PG8_BAR; PG8_SCHED;
            PG8_LDB(B1, 0, 1); PG8_STAGE(PG8_SB(0, 0), b2, voffB);
            PG8_BAR; PG8_WAIT_L(0); PG8_MMA(0, 1, At, B1); PG8_BAR;
            PG8_LDA(At, 0, 1); PG8_STAGE(PG8_SA(0, 0), a2, voffA);
            PG8_BAR; PG8_WAIT_L(0); PG8_MMA(1, 0, At, B0); PG8_BAR; PG8_SCHED;
            PG8_STAGE(PG8_SB(0, 1), b2 + hstepB, voffB);
            PG8_WAIT_V(6); PG8_BAR; PG8_MMA(1, 1, At, B1); PG8_BAR;
            PG8_LDB(B0, 1, 0); PG8_SCHED; PG8_LDA(At, 1, 0); PG8_STAGE(PG8_SA(0, 1), a2 + hstepA, voffA);
            PG8_WAIT_L(8); PG8_BAR; PG8_WAIT_L(0); PG8_MMA(0, 0, At, B0); PG8_BAR; PG8_SCHED;
            PG8_LDB(B1, 1, 1); PG8_STAGE(PG8_SB(1, 0), b3, voffB);
            PG8_BAR; PG8_WAIT_L(0); PG8_MMA(0, 1, At, B1); PG8_BAR;
            PG8_LDA(At, 1, 1); PG8_STAGE(PG8_SA(1, 0), a3, voffA);
            PG8_BAR; PG8_WAIT_L(0); PG8_MMA(1, 0, At, B0); PG8_BAR; PG8_SCHED;
            PG8_STAGE(PG8_SB(1, 1), b3 + hstepB, voffB);
            PG8_WAIT_V(6); PG8_BAR; PG8_MMA(1, 1, At, B1); PG8_BAR;
            }
        }
        if constexpr (SP2) { if (wr == 0) PG8_BAR; }
        { int el; asm volatile("v_mbcnt_lo_u32_b32 %0, -1, 0\n\tv_mbcnt_hi_u32_b32 %0, -1, %0" : "=v"(el)); E(acc, cur, wr, wc, el & 15, el >> 4); }
        if (!has_next) break;
#pragma unroll
        for (int a = 0; a < 2; ++a)
#pragma unroll
            for (int b = 0; b < 2; ++b)
#pragma unroll
                for (int m = 0; m < 4; ++m)
#pragma unroll
                    for (int n = 0; n < 2; ++n) acc[a][b][m][n] = (f32x4){0.f, 0.f, 0.f, 0.f};
        cur = nxt; cA = nA; cB = nB; ++ui;
        if constexpr (SP2) { if (wr == 1) PG8_BAR; }
    }
    PG8_WAIT_V(0);
    if constexpr (!SP2) { if (wr == 0) PG8_BAR; }
    PG8_BAR;
#undef PG8_SA
#undef PG8_SB
#undef PG8_STAGE
#undef PG8_LDA
#undef PG8_LDB
#undef PG8_MMA
#undef PG8_WAIT_V
#undef PG8_WAIT_L
#undef PG8_BAR
#undef PG8_SCHED
}

#if defined(MK_SIMPLE_GEMM)
template <class Epi>
__device__ __forceinline__ void gemm_phase_simple(const Gemm g, const StaticOrder& S, const Epi& E) {
    const int tid = threadIdx.x, wid = __builtin_amdgcn_readfirstlane(tid >> 6), lane = tid & 63, wr = wid >> 2, wc = wid & 3, fr = lane & 15, fq = lane >> 4;
    Unit cur;
    for (int ui = 0; S.next(ui, cur); ++ui) {
        f32x4 acc[2][2][4][2];
#pragma unroll
        for (int a = 0; a < 2; ++a)
#pragma unroll
            for (int b = 0; b < 2; ++b)
#pragma unroll
                for (int m = 0; m < 4; ++m)
#pragma unroll
                    for (int n = 0; n < 2; ++n) acc[a][b][m][n] = (f32x4){0.f, 0.f, 0.f, 0.f};
        for (int k0 = 0; k0 < g.K; k0 += 32) {
            bf16x8 bf[2][2];
#pragma unroll
            for (int bj = 0; bj < 2; ++bj)
#pragma unroll
                for (int n = 0; n < 2; ++n) { const int slot = 16 * n + fr; const int wrow = cur.pn * BM + bj * HALF + wc * 32 + (Epi::PERM ? perm32(slot) : slot);
                    bf[bj][n] = *(const bf16x8*)(g.Bt + (size_t)wrow * g.K + k0 + 8 * fq); }
#pragma unroll
            for (int ai = 0; ai < 2; ++ai)
#pragma unroll
                for (int m = 0; m < 4; ++m) { const int arow = cur.pm * BM + ai * HALF + wr * 64 + m * 16 + fr;
                    const bf16x8 af = *(const bf16x8*)(g.A + (size_t)arow * g.lda + k0 + 8 * fq);
#pragma unroll
                    for (int bj = 0; bj < 2; ++bj)
#pragma unroll
                        for (int n = 0; n < 2; ++n) acc[ai][bj][m][n] = __builtin_amdgcn_mfma_f32_16x16x32_bf16(bf[bj][n], af, acc[ai][bj][m][n], 0, 0, 0); }
        }
        E(acc, cur, wr, wc, fr, fq);
    }
}
#define GEMM_PHASE(EPI, lds, g, S, E) pg8::gemm_phase_simple<EPI>(g, S, E)
#define GEMM_PHASE2(EPI, lds, g, S, E) pg8::gemm_phase_simple<EPI>(g, S, E)
#else
#define GEMM_PHASE(EPI, lds, g, S, E) pg8::gemm_phase<EPI, true>(lds, g, S, E)
#define GEMM_PHASE2(EPI, lds, g, S, E) pg8::gemm_phase<EPI, false>(lds, g, S, E)
#endif
struct EpiSwiglu {
    static constexpr bool PERM = true;
    bf16_t* O; int ldc;
    __device__ __forceinline__ void operator()(const f32x4 (&acc)[2][2][4][2], const Unit& u, int wr, int wc, int fr, int fq) const {
        const int row0 = u.pm * BM + wr * 64 + fr, col0 = u.pn * 128 + wc * 32 + 8 * fq;
#pragma unroll
        for (int ai = 0; ai < 2; ++ai)
#pragma unroll
            for (int m = 0; m < 4; ++m) {
                bf16_t* rowp = O + (size_t)(row0 + ai * HALF + m * 16) * ldc + col0;
                const f32x4 g0 = acc[ai][0][m][0], g1 = acc[ai][0][m][1], u0 = acc[ai][1][m][0], u1 = acc[ai][1][m][1];
                float v[8];
#pragma unroll
                for (int j = 0; j < 4; ++j) { v[j] = fsilu(g0[j]) * u0[j]; v[4 + j] = fsilu(g1[j]) * u1[j]; }
                u32x4 w; w.x = pk_bf16(v[0], v[1]); w.y = pk_bf16(v[2], v[3]); w.z = pk_bf16(v[4], v[5]); w.w = pk_bf16(v[6], v[7]);
                *(u32x4*)rowp = w;
                asm volatile("" ::: "memory");
            }
    }
};
__device__ __forceinline__ void store_tile_bf16(const f32x4 (&acc)[2][2][4][2], bf16_t* base, int ld, int row0, int col0, int act) {
#pragma unroll
    for (int ai = 0; ai < 2; ++ai)
#pragma unroll
        for (int m = 0; m < 4; ++m) {
            bf16_t* rowp = base + (size_t)(row0 + ai * HALF + m * 16) * ld + col0;
#pragma unroll
            for (int bj = 0; bj < 2; ++bj) {
                f32x4 v0 = acc[ai][bj][m][0], v1 = acc[ai][bj][m][1];
                if (act == 1) {
#pragma unroll
                    for (int j = 0; j < 4; ++j) { v0[j] = fgelu(v0[j]); v1[j] = fgelu(v1[j]); }
                } else if (act == 2) {
#pragma unroll
                    for (int j = 0; j < 4; ++j) { v0[j] = fsigmoid(v0[j]); v1[j] = fsigmoid(v1[j]); }
                }
                u32x4 w; w.x = pk_bf16(v0[0], v0[1]); w.y = pk_bf16(v0[2], v0[3]); w.z = pk_bf16(v1[0], v1[1]); w.w = pk_bf16(v1[2], v1[3]);
                *(u32x4*)(rowp + bj * HALF) = w;
            }
            asm volatile("" ::: "memory");
        }
}
template <int ACT> struct EpiAct {
    static constexpr bool PERM = true;
    bf16_t* p; int ld, pn0;
    __device__ __forceinline__ void operator()(const f32x4 (&acc)[2][2][4][2], const Unit& u, int wr, int wc, int fr, int fq) const {
        store_tile_bf16(acc, p, ld, u.pm * BM + wr * 64 + fr, (u.pn - pn0) * BM + wc * 32 + 8 * fq, ACT);
    }
};
struct EpiWinA {
    static constexpr bool PERM = true;
    bf16_t* zq; bf16_t* xl; bf16_t* gy;
    __device__ __forceinline__ void operator()(const f32x4 (&acc)[2][2][4][2], const Unit& u, int wr, int wc, int fr, int fq) const {
        size_t boff = 0; if (u.pn >= 2) boff += (size_t)((const char*)xl - (const char*)zq); if (u.pn >= 6) boff += (size_t)((const char*)gy - (const char*)xl);
        bf16_t* base = (bf16_t*)((char*)zq + boff);
        int ld = 512, pn0 = 0; if (u.pn >= 2) { ld = D; pn0 = 2; } if (u.pn >= 6) pn0 = 6;
        store_tile_bf16(acc, base, ld, u.pm * BM + wr * 64 + fr, (u.pn - pn0) * BM + wc * 32 + 8 * fq, u.pn < 6 ? 0 : 1);
    }
};
struct EpiWinB {
    static constexpr bool PERM = true;
    bf16_t* ga; bf16_t* gl;
    __device__ __forceinline__ void operator()(const f32x4 (&acc)[2][2][4][2], const Unit& u, int wr, int wc, int fr, int fq) const {
        store_tile_bf16(acc, u.pn < 4 ? ga : gl, D, u.pm * BM + wr * 64 + fr, (u.pn & 3) * BM + wc * 32 + 8 * fq, 2);
    }
};
template <bool ADD> struct EpiGate {
    static constexpr bool PERM = true;
    const bf16_t* gate; const bf16_t* add; bf16_t* out;
    __device__ __forceinline__ void operator()(const f32x4 (&acc)[2][2][4][2], const Unit& u, int wr, int wc, int fr, int fq) const {
        const int row0 = u.pm * BM + wr * 64 + fr, col0 = u.pn * BM + wc * 32 + 8 * fq;
#pragma unroll
        for (int ai = 0; ai < 2; ++ai)
#pragma unroll
            for (int m = 0; m < 4; ++m) {
                const size_t off = (size_t)(row0 + ai * HALF + m * 16) * D + col0;
#pragma unroll
                for (int bj = 0; bj < 2; ++bj) {
                    const u32x4 gw = *(const u32x4*)(gate + off + bj * HALF);
                    const f32x4 v0 = acc[ai][bj][m][0], v1 = acc[ai][bj][m][1];
                    float r[8];
                    r[0] = lo_bf(gw.x) * v0[0]; r[1] = hi_bf(gw.x) * v0[1]; r[2] = lo_bf(gw.y) * v0[2]; r[3] = hi_bf(gw.y) * v0[3];
                    r[4] = lo_bf(gw.z) * v1[0]; r[5] = hi_bf(gw.z) * v1[1]; r[6] = lo_bf(gw.w) * v1[2]; r[7] = hi_bf(gw.w) * v1[3];
                    if (ADD) {
                        const u32x4 aw = *(const u32x4*)(add + off + bj * HALF);
                        r[0] += lo_bf(aw.x); r[1] += hi_bf(aw.x); r[2] += lo_bf(aw.y); r[3] += hi_bf(aw.y);
                        r[4] += lo_bf(aw.z); r[5] += hi_bf(aw.z); r[6] += lo_bf(aw.w); r[7] += hi_bf(aw.w);
                    }
                    u32x4 w; w.x = pk_bf16(r[0], r[1]); w.y = pk_bf16(r[2], r[3]); w.z = pk_bf16(r[4], r[5]); w.w = pk_bf16(r[6], r[7]);
                    *(u32x4*)(out + off + bj * HALF) = w;
                }
                asm volatile("" ::: "memory");
            }
    }
};
struct EpiQKV {
    static constexpr bool PERM = true;
    bf16_t* Q; bf16_t* Kn;
    __device__ __forceinline__ void operator()(const f32x4 (&acc)[2][2][4][2], const Unit& u, int wr, int wc, int fr, int fq) const {
        size_t boff = 0; if (u.pn >= 3) boff += (size_t)((const char*)Kn - (const char*)Q); if (u.pn >= 5) boff += (size_t)T * NKV * 2;
        bf16_t* dst = (bf16_t*)((char*)Q + boff);
        int ld = NQ, ctile = u.pn * BM; if (u.pn >= 3) { ld = NKV; ctile = ((u.pn - 3) & 1) * BM; }
        store_tile_bf16(acc, dst, ld, u.pm * BM + wr * 64 + fr, ctile + wc * 32 + 8 * fq, 0);
    }
};
}

struct TJob { const float* src; const float* scale; bf16_t* dst; int ldsrc, K, lddst, dstk0, nrb, map, nbatch, sbs, dbs; };
__device__ __forceinline__ int srccol(int map, int rb) {
    const int r = rb * 32;
    switch (map) {
        case 1: { const int pn = r >> 8, w = r & 255; return w < 128 ? 128 * pn + w : DFF + 128 * pn + (w - 128); }
        case 2: { if (r < 416) return r; if (r < 512) return -1; return r - 96; }
        case 3: return 2464 + r;
        case 4: { const int v = r >= 512 ? 1 : 0; const int rr = r & 511; return (rr >> 6) * 128 + (rr & 63) + 64 * v; }
        default: return r;
    }
}
constexpr int NJOBS = 15;
__device__ __forceinline__ TJob get_job(const Params& p, int j) {
    TJob t; t.scale = nullptr; t.dstk0 = 0; t.map = 0; t.nbatch = 1; t.sbs = 0; t.dbs = 0;
    unsigned char* ws = p.ws;
    switch (j) {
        case 0:  t.src = p.in[8];  t.dst = (bf16_t*)(ws + WS_WGU1); t.ldsrc = 2 * DFF; t.K = D; t.lddst = D; t.nrb = 176; t.map = 1; break;
        case 1:  t.src = p.in[9];  t.dst = (bf16_t*)(ws + WS_WDN1); t.ldsrc = D; t.K = DFF; t.lddst = DFF; t.nrb = 32; break;
        case 2:  t.src = p.in[10]; t.dst = (bf16_t*)(ws + WS_WINA); t.ldsrc = 4512; t.K = D; t.lddst = D; t.nrb = 80; t.map = 2; break;
        case 3:  t.src = p.in[10]; t.dst = (bf16_t*)(ws + WS_WINB); t.ldsrc = 4512; t.K = D; t.lddst = D; t.nrb = 64; t.map = 3; break;
        case 4:  t.src = p.in[13]; t.scale = p.in[11]; t.dst = (bf16_t*)(ws + WS_WQKV); t.ldsrc = 768; t.K = 256; t.lddst = 384; t.nrb = 24; break;
        case 5:  t.src = nullptr;  t.dst = (bf16_t*)(ws + WS_WQKV); t.ldsrc = 0; t.K = 128; t.lddst = 384; t.dstk0 = 256; t.nrb = 24; break;
        case 6:  t.src = p.in[14]; t.scale = p.in[12]; t.dst = (bf16_t*)(ws + WS_WQKV) + 768 * 384; t.ldsrc = 1024; t.K = 128; t.lddst = 384; t.dstk0 = 256; t.nrb = 32; t.map = 4; break;
        case 7:  t.src = nullptr;  t.dst = (bf16_t*)(ws + WS_WQKV) + 768 * 384; t.ldsrc = 0; t.K = 256; t.lddst = 384; t.nrb = 32; break;
        case 8:  t.src = p.in[15]; t.dst = (bf16_t*)(ws + WS_WAO); t.ldsrc = D; t.K = 512; t.lddst = 512; t.nrb = 32; break;
        case 9:  t.src = p.in[23]; t.dst = (bf16_t*)(ws + WS_WLO); t.ldsrc = D; t.K = D; t.lddst = D; t.nrb = 32; break;
        case 10: t.src = p.in[24]; t.dst = (bf16_t*)(ws + WS_WOUT); t.ldsrc = D; t.K = D; t.lddst = D; t.nrb = 32; break;
        case 11: t.src = p.in[25]; t.dst = (bf16_t*)(ws + WS_WGU2); t.ldsrc = 2 * DFF; t.K = D; t.lddst = D; t.nrb = 176; t.map = 1; break;
        case 12: t.src = p.in[26]; t.dst = (bf16_t*)(ws + WS_WDN2); t.ldsrc = D; t.K = DFF; t.lddst = DFF; t.nrb = 32; break;
        case 13: t.src = p.in[18]; t.dst = (bf16_t*)(ws + WS_WG); t.ldsrc = 128; t.K = 128; t.lddst = 128; t.nrb = 4; t.nbatch = 16; t.sbs = 16384; t.dbs = 32768; break;
        default: t.src = p.in[20]; t.dst = (bf16_t*)(ws + WS_WG) + 16384; t.ldsrc = 128; t.K = 128; t.lddst = 128; t.nrb = 4; t.nbatch = 16; t.sbs = 16384; t.dbs = 32768; break;
    }
    return t;
}
__device__ __forceinline__ int job_items(const TJob& t) { return t.nbatch * t.nrb * (t.K >> 6); }

__device__ __forceinline__ void tr_item(const TJob& jb, int item, LAS float* scr, int lane) {
    const int nkb = jb.K >> 6, per_batch = jb.nrb * nkb;
    const int bt = item / per_batch, r = item - bt * per_batch, rb = r / nkb, kb = r - rb * nkb;
    const int sc = srccol(jb.map, rb), k0 = 64 * kb;
    if (jb.src != nullptr && sc >= 0) {
        const float* src = jb.src + (size_t)bt * jb.sbs;
#pragma unroll 8
        for (int i = 0; i < 32; ++i) { const int kk = 2 * i + (lane >> 5);
            float v = src[(size_t)(k0 + kk) * jb.ldsrc + sc + (lane & 31)];
            if (jb.scale) v *= jb.scale[k0 + kk];
            scr[kk * 33 + (lane & 31)] = v; }
    } else {
#pragma unroll 8
        for (int i = 0; i < 32; ++i) { const int kk = 2 * i + (lane >> 5); scr[kk * 33 + (lane & 31)] = 0.f; }
    }
    asm volatile("s_waitcnt lgkmcnt(0)" ::: "memory");
    bf16_t* dst = jb.dst + (size_t)bt * jb.dbs;
    const int c = lane & 7;
#pragma unroll
    for (int j = 0; j < 4; ++j) { const int n = (lane >> 3) + 8 * j; const LAS float* s = scr + (8 * c) * 33 + n;
        u32x4 o; o.x = pk_bf16(s[0 * 33], s[1 * 33]); o.y = pk_bf16(s[2 * 33], s[3 * 33]); o.z = pk_bf16(s[4 * 33], s[5 * 33]); o.w = pk_bf16(s[6 * 33], s[7 * 33]);
        *(u32x4*)(dst + (size_t)(32 * rb + n) * jb.lddst + jb.dstk0 + k0 + 8 * c) = o; }
    asm volatile("s_waitcnt lgkmcnt(0)" ::: "memory");
}

__device__ __forceinline__ void phase_prep(const Params& p, LAS unsigned char* lds) {
    const int tid = threadIdx.x, lane = tid & 63, wave = tid >> 6;
    const int gw = blockIdx.x * NWAVES + wave, NGW = gridDim.x * NWAVES;
    {
        LAS float* scr = (LAS float*)(lds + wave * 8704);
        int base = 0;
        for (int j = 0; j < NJOBS; ++j) {
            const TJob jb = get_job(p, j); const int n = job_items(jb);
            int first = gw - (base % NGW); if (first < 0) first += NGW;
            for (int i = first; i < n; i += NGW) tr_item(jb, i, scr, lane);
            base += n;
        }
    }
    {
        const int gt = blockIdx.x * NTHREADS + tid;
        if (gt < SS * 16) {
            const int pos = gt >> 4, i = gt & 15;
            double inv = 1.0; for (int q = 0; q < i; ++q) inv *= 0.5623413251903491;
            const float ang = (float)pos * (float)inv;
            const double rev = (double)ang * 0.15915494309189535; const float fr = (float)(rev - rint(rev));
            ((float*)(p.ws + WS_ROPE))[gt] = __builtin_amdgcn_cosf(fr);
            ((float*)(p.ws + WS_ROPE))[SS * 16 + gt] = __builtin_amdgcn_sinf(fr);
        }
    }
    __syncthreads();
    for (int item = blockIdx.x; item < 144; item += gridDim.x) {
        LAS float* sc = (LAS float*)(lds) + wave * (128 * 33);
        for (int i = 0; i < 64; ++i) { const int idx = lane + 64 * i, kl = idx & 127, b = idx >> 7;
            const float cv = (b < 16 ? p.in[2] : p.in[3])[(b & 15) * D + 128 * wave + kl];
            sc[kl * 33 + b] = fsilu(cv); }
        asm volatile("s_waitcnt lgkmcnt(0)" ::: "memory");
        float acc[32];
#pragma unroll
        for (int b = 0; b < 32; ++b) acc[b] = 0.f;
        const float* W = p.in[4] + (size_t)(128 * wave) * 9216 + item * 64 + lane;
        for (int k = 0; k < 128; ++k) { const float wv = W[(size_t)k * 9216];
#pragma unroll
            for (int b = 0; b < 32; ++b) acc[b] += sc[k * 33 + b] * wv; }
        __syncthreads();
        LAS float* red = (LAS float*)(lds);
#pragma unroll
        for (int b = 0; b < 32; ++b) red[(wave * 32 + b) * 64 + lane] = acc[b];
        __syncthreads();
        for (int o = tid; o < 2048; o += NTHREADS) { const int b = o >> 6, col = o & 63; float s = 0.f;
#pragma unroll
            for (int w = 0; w < 8; ++w) s += red[(w * 32 + b) * 64 + col];
            const int j = item * 64 + col;
            ((float*)(p.ws + WS_MOD))[b * 9216 + j] = s + p.in[5][j]; }
        __syncthreads();
    }
}

template <bool HAS_F, bool HAS_H>
__device__ __forceinline__ void phase_rows(const Params& p, int sp, int sn, float resw, bool from_input) {
    const int tid = threadIdx.x, lane = tid & 63, wave = tid >> 6;
    const int gw = blockIdx.x * NWAVES + wave, NGW = gridDim.x * NWAVES;
    const float* mod = (const float*)(p.ws + WS_MOD);
    const bf16_t* F = (const bf16_t*)(p.ws + WS_F);
    bf16_t* H = (bf16_t*)(p.ws + WS_H);
    for (int row = gw; row < T; row += NGW) {
        const int b = row_batch(row);
        const float* xin = !from_input ? p.out + (size_t)row * D : (row < TP ? p.in[0] + (size_t)row * D : p.in[1] + (size_t)(row - TP) * D);
        f32x4 v[4];
#pragma unroll
        for (int j = 0; j < 4; ++j) v[j] = *(const f32x4*)(xin + 4 * lane + 256 * j);
        if (HAS_F) {
            f32x4 f[4]; float ss = 0.f;
#pragma unroll
            for (int j = 0; j < 4; ++j) { const u32x2 w = *(const u32x2*)(F + (size_t)row * D + 4 * lane + 256 * j);
                f[j] = (f32x4){lo_bf(w.x), hi_bf(w.x), lo_bf(w.y), hi_bf(w.y)}; ss += (f[j].x * f[j].x + f[j].y * f[j].y) + (f[j].z * f[j].z + f[j].w * f[j].w); }
            const float rs = 1.0f / sqrtf(wave_sum(ss) * (1.0f / D) + EPS) * resw;
            const float* gate = mod + b * 9216 + sp * 3072 + 2048; const float* gp = p.in[7] + sp * D;
#pragma unroll
            for (int j = 0; j < 4; ++j) { const f32x4 g = *(const f32x4*)(gate + 4 * lane + 256 * j), q = *(const f32x4*)(gp + 4 * lane + 256 * j);
                v[j] = v[j] + g * (f[j] * rs * q);
                *(f32x4*)(p.out + (size_t)row * D + 4 * lane + 256 * j) = v[j]; }
        }
        if (HAS_H) {
            float ss = 0.f;
#pragma unroll
            for (int j = 0; j < 4; ++j) ss += (v[j].x * v[j].x + v[j].y * v[j].y) + (v[j].z * v[j].z + v[j].w * v[j].w);
            const float rs = 1.0f / sqrtf(wave_sum(ss) * (1.0f / D) + EPS);
            const float* sh = mod + b * 9216 + sn * 3072; const float* scl = sh + 1024; const float* gq = p.in[6] + sn * D;
#pragma unroll
            for (int j = 0; j < 4; ++j) { const f32x4 a = *(const f32x4*)(sh + 4 * lane + 256 * j), s = *(const f32x4*)(scl + 4 * lane + 256 * j), q = *(const f32x4*)(gq + 4 * lane + 256 * j);
                const f32x4 h = (v[j] * rs * q) * (s + 1.0f) + a;
                u32x2 w; w.x = pk_bf16(h.x, h.y); w.y = pk_bf16(h.z, h.w);
                *(u32x2*)(H + (size_t)row * D + 4 * lane + 256 * j) = w; }
        }
    }
}

__device__ __forceinline__ void phase_stats(const Params& p) {
    const int tid = threadIdx.x, lane = tid & 63, wave = tid >> 6;
    const int gw = blockIdx.x * NWAVES + wave, NGW = gridDim.x * NWAVES;
    bf16_t* ZQ = (bf16_t*)(p.ws + WS_ZQ);
    bf16_t* KR = (bf16_t*)(p.ws + WS_KR);
    const float* rc = (const float*)(p.ws + WS_ROPE); const float* rsn = rc + SS * 16;
    for (int row = gw; row < T; row += NGW) {
        const u32x4 w = *(const u32x4*)(ZQ + (size_t)row * 512 + 8 * lane);
        float x[8] = {lo_bf(w.x), hi_bf(w.x), lo_bf(w.y), hi_bf(w.y), lo_bf(w.z), hi_bf(w.z), lo_bf(w.w), hi_bf(w.w)};
        float ss = 0.f;
#pragma unroll
        for (int e = 0; e < 8; ++e) ss += x[e] * x[e];
        const float sq = wave_sum(lane < 32 ? ss : 0.f), skv = wave_sum((lane >= 32 && lane < 48) ? ss : 0.f);
        {
            const float rq = 1.0f / sqrtf(sq * (1.0f / 256.0f) + EPS), rkv = 1.0f / sqrtf(skv * (1.0f / 128.0f) + EPS);
            if (lane < 48) { const float r = lane < 32 ? rq : rkv;
                u32x4 o; o.x = pk_bf16(x[0] * r, x[1] * r); o.y = pk_bf16(x[2] * r, x[3] * r); o.z = pk_bf16(x[4] * r, x[5] * r); o.w = pk_bf16(x[6] * r, x[7] * r);
                *(u32x4*)(ZQ + (size_t)row * 512 + 8 * lane) = o; }
        }
        float y[8];
#pragma unroll
        for (int e = 0; e < 8; ++e) y[e] = __shfl_xor(x[e], 2);
        if (lane >= 48 && lane < 52) {
            const int pos = row_pos(row), i0 = 8 * (lane & 1);
            const f32x4 c0 = *(const f32x4*)(rc + pos * 16 + i0), c1 = *(const f32x4*)(rc + pos * 16 + i0 + 4);
            const f32x4 s0 = *(const f32x4*)(rsn + pos * 16 + i0), s1 = *(const f32x4*)(rsn + pos * 16 + i0 + 4);
            const float c[8] = {c0.x, c0.y, c0.z, c0.w, c1.x, c1.y, c1.z, c1.w}, s[8] = {s0.x, s0.y, s0.z, s0.w, s1.x, s1.y, s1.z, s1.w};
            float o[8];
            const bool first = lane < 50;
#pragma unroll
            for (int e = 0; e < 8; ++e) o[e] = first ? (x[e] * c[e] - y[e] * s[e]) : (x[e] * c[e] + y[e] * s[e]);
            u32x4 ow; ow.x = pk_bf16(o[0], o[1]); ow.y = pk_bf16(o[2], o[3]); ow.z = pk_bf16(o[4], o[5]); ow.w = pk_bf16(o[6], o[7]);
            *(u32x4*)(KR + (size_t)row * 32 + 8 * (lane - 48)) = ow;
        }
    }
}

constexpr int XC_PITCH = 272;
__device__ __forceinline__ void phase_lru(const Params& p, LAS unsigned char* lds) {
    const int tid = threadIdx.x, lane = tid & 63, wave = __builtin_amdgcn_readfirstlane(tid >> 6), g = lane >> 4, lc = lane & 15;
    const bf16_t* XL = (const bf16_t*)(p.ws + WS_XL); bf16_t* GY = (bf16_t*)(p.ws + WS_GY); bf16_t* HF = (bf16_t*)(p.ws + WS_F);
    const bf16_t* WG = (const bf16_t*)(p.ws + WS_WG);
    for (int item = blockIdx.x; item < 256; item += gridDim.x) {
        int gb, n;
        if (item < 128) { gb = 16 + (item >> 3); n = item & 7; } else { gb = (item - 128) >> 3; n = item & 7; }
        const int S = gb < 16 ? SP : SS; const int row0 = gb < 16 ? gb * SP : TP + (gb - 16) * SS;
        const int nch = S >> 6;
        const int tr = tid >> 4, cgp = (tid & 15) * 8, c0 = 128 * n + cgp;
        float cw[4][8], cb[8];
#pragma unroll
        for (int j = 0; j < 4; ++j) { const f32x4 a = *(const f32x4*)(p.in[16] + j * D + c0), b = *(const f32x4*)(p.in[16] + j * D + c0 + 4);
            cw[j][0] = a.x; cw[j][1] = a.y; cw[j][2] = a.z; cw[j][3] = a.w; cw[j][4] = b.x; cw[j][5] = b.y; cw[j][6] = b.z; cw[j][7] = b.w; }
        { const f32x4 a = *(const f32x4*)(p.in[17] + c0), b = *(const f32x4*)(p.in[17] + c0 + 4);
            cb[0] = a.x; cb[1] = a.y; cb[2] = a.z; cb[3] = a.w; cb[4] = b.x; cb[5] = b.y; cb[6] = b.z; cb[7] = b.w; }
        const int ch = 128 * n + 16 * wave + lc;
        for (int d = 0; d < 2; ++d) {
            bf16x8 Ba[4], Bi[4];
            { const bf16_t* wa = WG + (size_t)((d * 8 + n) * 2 + 0) * 16384 + (size_t)(16 * wave + lc) * 128 + 8 * g; const bf16_t* wi = wa + 16384;
#pragma unroll
              for (int ks = 0; ks < 4; ++ks) { Ba[ks] = *(const bf16x8*)(wa + 32 * ks); Bi[ks] = *(const bf16x8*)(wi + 32 * ks); } }
            const float ba = p.in[19][d * D + ch], bi = p.in[21][d * D + ch];
            const float lam = p.in[22][d * D + ch];
            const float c8 = -8.0f * log1pf(expf(-lam));
#define BPERM(addr, v) __builtin_bit_cast(float, __builtin_amdgcn_ds_bpermute((addr), __builtin_bit_cast(int, (v))))
            const int bx16 = (lane ^ 16) << 2, bx32 = (lane ^ 32) << 2;
            const bool s1 = d ? !(g & 1) : (g & 1), s2 = d ? !(g >> 1) : (g >> 1);
            float carry = 0.f;
            u32x4 pw[2][4];
#define LRU_PREFETCH(CI) do { const int _cc = d ? (nch - 1 - (CI)) : (CI); _Pragma("unroll") for (int hf = 0; hf < 2; ++hf) _Pragma("unroll") for (int j = 0; j < 4; ++j) { \
                const int tt = _cc * 64 + tr + 32 * hf + j - 1; pw[hf][j] = (tt >= 0 && tt < S) ? *(const u32x4*)(XL + (size_t)(row0 + tt) * D + c0) : (u32x4){0u, 0u, 0u, 0u}; } } while (0)
            LRU_PREFETCH(0);
            for (int ci = 0; ci < nch; ++ci) {
                const int cc = d ? (nch - 1 - ci) : ci, t0 = cc * 64;
                __syncthreads();
#pragma unroll
                for (int hf = 0; hf < 2; ++hf) {
                    const int tl = tr + 32 * hf;
                    float a[8];
#pragma unroll
                    for (int e = 0; e < 8; ++e) a[e] = cb[e];
#pragma unroll
                    for (int j = 0; j < 4; ++j) { const u32x4 w = pw[hf][j];
                        a[0] += cw[j][0] * lo_bf(w.x); a[1] += cw[j][1] * hi_bf(w.x); a[2] += cw[j][2] * lo_bf(w.y); a[3] += cw[j][3] * hi_bf(w.y);
                        a[4] += cw[j][4] * lo_bf(w.z); a[5] += cw[j][5] * hi_bf(w.z); a[6] += cw[j][6] * lo_bf(w.w); a[7] += cw[j][7] * hi_bf(w.w); }
                    u32x4 o; o.x = pk_bf16(a[0], a[1]); o.y = pk_bf16(a[2], a[3]); o.z = pk_bf16(a[4], a[5]); o.w = pk_bf16(a[6], a[7]);
                    *(LAS u32x4*)(lds + tl * XC_PITCH + cgp * 2) = o;
                }
                __syncthreads();
                if (ci + 1 < nch) LRU_PREFETCH(ci + 1);
                float hfv[4][4], gyv[4][4];
                if (d == 1) {
                    const bf16_t* const hfi = HF + (size_t)(row0 + t0 + 4 * g) * D + ch; const bf16_t* const gyi = GY + (size_t)(row0 + t0 + 4 * g) * D + ch;
#pragma unroll
                    for (int mt = 0; mt < 4; ++mt)
#pragma unroll
                        for (int j = 0; j < 4; ++j) { hfv[mt][j] = bf2f(hfi[(16 * mt + j) * D]); gyv[mt][j] = bf2f(gyi[(16 * mt + j) * D]); }
                }
                f32x4 aa[4], ai[4];
#pragma unroll
                for (int mt = 0; mt < 4; ++mt) { aa[mt] = (f32x4){0.f, 0.f, 0.f, 0.f}; ai[mt] = (f32x4){0.f, 0.f, 0.f, 0.f}; }
#pragma unroll
                for (int ks = 0; ks < 4; ++ks)
#pragma unroll
                    for (int mt = 0; mt < 4; ++mt) { const bf16x8 A = *(const LAS bf16x8*)(lds + (16 * mt + lc) * XC_PITCH + (32 * ks + 8 * g) * 2);
                        aa[mt] = __builtin_amdgcn_mfma_f32_16x16x32_bf16(A, Ba[ks], aa[mt], 0, 0, 0);
                        ai[mt] = __builtin_amdgcn_mfma_f32_16x16x32_bf16(A, Bi[ks], ai[mt], 0, 0, 0); }
#pragma unroll
                for (int mt = 0; mt < 4; ++mt)
#pragma unroll
                    for (int j = 0; j < 4; ++j) {
                        const float xcv = bf2f(*(const LAS bf16_t*)(lds + (16 * mt + 4 * g + j) * XC_PITCH + (16 * wave + lc) * 2));
                        const float r = fsigmoid(aa[mt][j] + ba), ig = fsigmoid(ai[mt][j] + bi);
                        const float la = c8 * r;
                        const float av = fexp(la), om = (1.0f - av) * (1.0f + av);
                        aa[mt][j] = av; ai[mt][j] = __builtin_amdgcn_sqrtf(om) * (ig * xcv);
                    }
#define LRU_COMBINE() \
                        const float A1 = BPERM(bx16, A), H1 = BPERM(bx16, Hs); \
                        const float PA = A * A1, PH = s1 ? (A * H1 + Hs) : (A1 * Hs + H1); \
                        const float exA = s1 ? A1 : 1.f, exH = s1 ? H1 : 0.f; \
                        const float A2 = BPERM(bx32, PA), H2 = BPERM(bx32, PH); \
                        const float TA = PA * A2, TH = s2 ? (PA * H2 + PH) : (A2 * PH + H2); \
                        const float Aex = s2 ? A2 * exA : exA, Hex = s2 ? (exA * H2 + exH) : exH; \
                        const float cin = Aex * carry + Hex; \
                        carry = TA * carry + TH;
                bf16_t* const hfo = HF + (size_t)(row0 + t0 + 4 * g) * D + ch;
                if (d == 0) {
#pragma unroll
                    for (int mt = 0; mt < 4; ++mt) {
                        float P = 1.f, Hh = 0.f, pl[4], hl[4];
#pragma unroll
                        for (int j = 0; j < 4; ++j) { Hh = aa[mt][j] * Hh + ai[mt][j]; P *= aa[mt][j]; hl[j] = Hh; pl[j] = P; }
                        const float A = P, Hs = Hh;
                        LRU_COMBINE()
#pragma unroll
                        for (int j = 0; j < 4; ++j) { const float h = hl[j] + pl[j] * cin;
                            hfo[(16 * mt + j) * D] = (bf16_t)(pk_bf16(h, 0.f) & 0xffffu); }
                    }
                } else {
                    bf16_t* const gyo = GY + (size_t)(row0 + t0 + 4 * g) * D + ch;
#pragma unroll
                    for (int mt = 3; mt >= 0; --mt) {
                        float P = 1.f, Hh = 0.f, pl[4], hl[4];
#pragma unroll
                        for (int j = 3; j >= 0; --j) { Hh = aa[mt][j] * Hh + ai[mt][j]; P *= aa[mt][j]; hl[j] = Hh; pl[j] = P; }
                        const float A = P, Hs = Hh;
                        LRU_COMBINE()
#pragma unroll
                        for (int j = 0; j < 4; ++j) { const float h = hl[j] + pl[j] * cin;
                            const float o = (hfv[mt][j] + h) * gyv[mt][j];
                            gyo[(16 * mt + j) * D] = (bf16_t)(pk_bf16(o, 0.f) & 0xffffu); }
                    }
                }
            }
        }
        __syncthreads();
    }
}

constexpr int AK_PITCH = 208, AV_PITCH = 160, AK_BYTES = 64 * AK_PITCH, AV_BYTES = 64 * AV_PITCH, ABUF = AK_BYTES + AV_BYTES;
__device__ __forceinline__ void phase_attn(const Params& p, LAS unsigned char* lds) {
    const int tid = threadIdx.x, lane = tid & 63, wave = __builtin_amdgcn_readfirstlane(tid >> 6), g = lane >> 4, lc = lane & 15;
    const bf16_t* Q = (const bf16_t*)(p.ws + WS_F); const bf16_t* KN = (const bf16_t*)(p.ws + WS_XL); const bf16_t* V = KN + (size_t)T * NKV;
    const bf16_t* KR = (const bf16_t*)(p.ws + WS_KR); bf16_t* O = (bf16_t*)(p.ws + WS_ZQ);
    const float csc = 0.10206207261596577f * 1.4426950408889634f;
    const int srow = tid >> 3, sch = tid & 7;
    const int rrow = (tid & 255) >> 2, rch = tid & 3;
    const int vtr = (4 * g + (lc >> 2)) * AV_PITCH + (4 * (lc & 3)) * 2;
    for (int unit = blockIdx.x; unit < 3072; unit += gridDim.x) {
        int gb, h, qt, S, row0;
        if (unit < 2048) { gb = 16 + (unit >> 7); h = (unit & 127) >> 4; qt = unit & 15; S = SS; row0 = TP + (gb - 16) * SS; }
        else { const int u2 = unit - 2048; gb = u2 >> 6; h = (u2 & 63) >> 3; qt = u2 & 7; S = SP; row0 = gb * SP; }
        const int nkt = S >> 6;
        const int qrow = row0 + 256 * qt + 32 * wave;
        bf16x8 qf[2][3];
#pragma unroll
        for (int q2 = 0; q2 < 2; ++q2)
#pragma unroll
            for (int ks = 0; ks < 3; ++ks) qf[q2][ks] = *(const bf16x8*)(Q + (size_t)(qrow + 16 * q2 + lc) * NQ + 96 * h + 32 * ks + 8 * g);
#pragma unroll
        for (int q2 = 0; q2 < 2; ++q2) {
            const int pos = row_pos(qrow + 16 * q2 + lc), i0 = 8 * (g & 1);
            const float* rc = (const float*)(p.ws + WS_ROPE) + pos * 16 + i0; const float* rsn = rc + SS * 16;
            const f32x4 c0 = *(const f32x4*)rc, c1 = *(const f32x4*)(rc + 4), s0 = *(const f32x4*)rsn, s1 = *(const f32x4*)(rsn + 4);
            const float cc[8] = {c0.x, c0.y, c0.z, c0.w, c1.x, c1.y, c1.z, c1.w}, sn[8] = {s0.x, s0.y, s0.z, s0.w, s1.x, s1.y, s1.z, s1.w};
            const u32x4 mine = __builtin_bit_cast(u32x4, qf[q2][2]);
            u32x4 oth; oth.x = __shfl_xor(mine.x, 32); oth.y = __shfl_xor(mine.y, 32); oth.z = __shfl_xor(mine.z, 32); oth.w = __shfl_xor(mine.w, 32);
            const float xm[8] = {lo_bf(mine.x), hi_bf(mine.x), lo_bf(mine.y), hi_bf(mine.y), lo_bf(mine.z), hi_bf(mine.z), lo_bf(mine.w), hi_bf(mine.w)};
            const float xo[8] = {lo_bf(oth.x), hi_bf(oth.x), lo_bf(oth.y), hi_bf(oth.y), lo_bf(oth.z), hi_bf(oth.z), lo_bf(oth.w), hi_bf(oth.w)};
            float o[8];
#pragma unroll
            for (int e = 0; e < 8; ++e) o[e] = g < 2 ? (xm[e] * cc[e] - xo[e] * sn[e]) : (xm[e] * cc[e] + xo[e] * sn[e]);
            u32x4 w; w.x = pk_bf16(o[0], o[1]); w.y = pk_bf16(o[2], o[3]); w.z = pk_bf16(o[4], o[5]); w.w = pk_bf16(o[6], o[7]);
            qf[q2][2] = __builtin_bit_cast(bf16x8, w);
        }
        f32x4 oacc[4][2];
#pragma unroll
        for (int dt = 0; dt < 4; ++dt) { oacc[dt][0] = (f32x4){0.f, 0.f, 0.f, 0.f}; oacc[dt][1] = (f32x4){0.f, 0.f, 0.f, 0.f}; }
        float mrun[2] = {-1e30f, -1e30f}, lrun[2] = {0.f, 0.f};
        u32x4 gk, gr, gv;
        gk = *(const u32x4*)(KN + (size_t)(row0 + srow) * NKV + 64 * h + 8 * sch);
        gv = *(const u32x4*)(V + (size_t)(row0 + srow) * NKV + 64 * h + 8 * sch);
        gr = *(const u32x4*)(KR + (size_t)(row0 + rrow) * 32 + 8 * rch);
        __syncthreads();
        *(LAS u32x4*)(lds + srow * AK_PITCH + sch * 16) = gk;
        *(LAS u32x4*)(lds + AK_BYTES + srow * AV_PITCH + sch * 16) = gv;
        if (tid < 256) *(LAS u32x4*)(lds + rrow * AK_PITCH + 128 + rch * 16) = gr;
        u32x4 gk2, gr2, gv2;
        gk = *(const u32x4*)(KN + (size_t)(row0 + 64 + srow) * NKV + 64 * h + 8 * sch);
        gv = *(const u32x4*)(V + (size_t)(row0 + 64 + srow) * NKV + 64 * h + 8 * sch);
        gr = *(const u32x4*)(KR + (size_t)(row0 + 64 + rrow) * 32 + 8 * rch);
        gk2 = *(const u32x4*)(KN + (size_t)(row0 + 128 + srow) * NKV + 64 * h + 8 * sch);
        gv2 = *(const u32x4*)(V + (size_t)(row0 + 128 + srow) * NKV + 64 * h + 8 * sch);
        gr2 = *(const u32x4*)(KR + (size_t)(row0 + 128 + rrow) * 32 + 8 * rch);
        __syncthreads();
#define ATT_BODY(kt, GK, GR, GV) do { \
            LAS unsigned char* kb = lds + ((kt) & 1) * ABUF; LAS unsigned char* vb = kb + AK_BYTES; \
            LAS unsigned char* nb = lds + (((kt) + 1) & 1) * ABUF; \
            const bool more = (kt) + 1 < nkt; \
 \
            f32x4 sacc[4][2]; \
            _Pragma("unroll") \
            for (int k4 = 0; k4 < 4; ++k4) { sacc[k4][0] = (f32x4){0.f, 0.f, 0.f, 0.f}; sacc[k4][1] = (f32x4){0.f, 0.f, 0.f, 0.f}; } \
            _Pragma("unroll") \
            for (int ks = 0; ks < 3; ++ks) \
            _Pragma("unroll") \
                for (int k4 = 0; k4 < 4; ++k4) { const bf16x8 kf = *(const LAS bf16x8*)(kb + (16 * k4 + lc) * AK_PITCH + (32 * ks + 8 * g) * 2); \
                    sacc[k4][0] = __builtin_amdgcn_mfma_f32_16x16x32_bf16(kf, qf[0][ks], sacc[k4][0], 0, 0, 0); \
                    sacc[k4][1] = __builtin_amdgcn_mfma_f32_16x16x32_bf16(kf, qf[1][ks], sacc[k4][1], 0, 0, 0); } \
            bf16x8 pf[2][2]; \
            _Pragma("unroll") \
            for (int q2 = 0; q2 < 2; ++q2) { \
                float mx = sacc[0][q2][0]; \
            _Pragma("unroll") \
                for (int k4 = 0; k4 < 4; ++k4) \
            _Pragma("unroll") \
                    for (int j = 0; j < 4; ++j) mx = fmaxf(mx, sacc[k4][q2][j]); \
                mx = fmaxf(mx, __shfl_xor(mx, 16)); mx = fmaxf(mx, __shfl_xor(mx, 32)); \
                const float mnew = fmaxf(mrun[q2], mx * csc); \
                const float alpha = __builtin_amdgcn_exp2f(mrun[q2] - mnew); \
                mrun[q2] = mnew; \
                float ps = 0.f; float pv[4][4]; \
            _Pragma("unroll") \
                for (int k4 = 0; k4 < 4; ++k4) \
            _Pragma("unroll") \
                    for (int j = 0; j < 4; ++j) { const float e = __builtin_amdgcn_exp2f(sacc[k4][q2][j] * csc - mnew); pv[k4][j] = e; ps += e; } \
                lrun[q2] = lrun[q2] * alpha + ps; \
            _Pragma("unroll") \
                for (int dt = 0; dt < 4; ++dt) oacc[dt][q2] *= alpha; \
            _Pragma("unroll") \
                for (int kk = 0; kk < 2; ++kk) { \
                    u32x4 w; w.x = pk_bf16(pv[2 * kk][0], pv[2 * kk][1]); w.y = pk_bf16(pv[2 * kk][2], pv[2 * kk][3]); \
                    w.z = pk_bf16(pv[2 * kk + 1][0], pv[2 * kk + 1][1]); w.w = pk_bf16(pv[2 * kk + 1][2], pv[2 * kk + 1][3]); \
                    pf[q2][kk] = __builtin_bit_cast(bf16x8, w); \
                } \
            } \
 \
            _Pragma("unroll") \
            for (int kk = 0; kk < 2; ++kk) \
            _Pragma("unroll") \
                for (int dt = 0; dt < 4; ++dt) { \
                    const v4i16_t lo = __builtin_amdgcn_ds_read_tr16_b64_v4i16((LAS v4i16_t*)(vb + vtr + (32 * kk) * AV_PITCH + 32 * dt)); \
                    const v4i16_t hi = __builtin_amdgcn_ds_read_tr16_b64_v4i16((LAS v4i16_t*)(vb + vtr + (32 * kk + 16) * AV_PITCH + 32 * dt)); \
                    const bf16x8 vf = {lo[0], lo[1], lo[2], lo[3], hi[0], hi[1], hi[2], hi[3]}; \
                    oacc[dt][0] = __builtin_amdgcn_mfma_f32_16x16x32_bf16(vf, pf[0][kk], oacc[dt][0], 0, 0, 0); \
                    oacc[dt][1] = __builtin_amdgcn_mfma_f32_16x16x32_bf16(vf, pf[1][kk], oacc[dt][1], 0, 0, 0); \
                } \
            if (more) { \
                *(LAS u32x4*)(nb + srow * AK_PITCH + sch * 16) = GK; \
                *(LAS u32x4*)(nb + AK_BYTES + srow * AV_PITCH + sch * 16) = GV; \
                if (tid < 256) *(LAS u32x4*)(nb + rrow * AK_PITCH + 128 + rch * 16) = GR; \
            } \
            if ((kt) + 3 < nkt) { const int kr0 = row0 + 64 * ((kt) + 3); \
                GK = *(const u32x4*)(KN + (size_t)(kr0 + srow) * NKV + 64 * h + 8 * sch); \
                GV = *(const u32x4*)(V + (size_t)(kr0 + srow) * NKV + 64 * h + 8 * sch); \
                GR = *(const u32x4*)(KR + (size_t)(kr0 + rrow) * 32 + 8 * rch); } \
            __syncthreads(); \
        } while (0)
        for (int kt2 = 0; kt2 < nkt; kt2 += 2) { ATT_BODY(kt2, gk, gr, gv); ATT_BODY(kt2 + 1, gk2, gr2, gv2); }
#undef ATT_BODY
#pragma unroll
        for (int q2 = 0; q2 < 2; ++q2) {
            float l = lrun[q2]; l += __shfl_xor(l, 16); l += __shfl_xor(l, 32);
            const float inv = 1.0f / l;
#pragma unroll
            for (int dt = 0; dt < 4; ++dt) { const f32x4 o = oacc[dt][q2] * inv;
                u32x2 w; w.x = pk_bf16(o[0], o[1]); w.y = pk_bf16(o[2], o[3]);
                *(u32x2*)(O + (size_t)(qrow + 16 * q2 + lc) * 512 + 64 * h + 16 * dt + 4 * g) = w; }
        }
    }
    __syncthreads();
}

#define XB_TMO      128
#define XB_XCNT(j)  (256  + 64 * (j))
#define XB_XSUB(j)  (1280 + 64 * (j))
#define XB_XGEN(j)  (2304 + 64 * (j))
#define XB_TOP      3328
#define XB_TOPGEN   3392
#define XCD_BAR_WORDS 3456
#define XB_SPIN_CAP (1u << 18)

__device__ __forceinline__ unsigned xb_ld(unsigned* p)              { return __hip_atomic_load(p, __ATOMIC_RELAXED, __HIP_MEMORY_SCOPE_AGENT); }
__device__ __forceinline__ unsigned xb_add(unsigned* p, unsigned v) { return __hip_atomic_fetch_add(p, v, __ATOMIC_RELAXED, __HIP_MEMORY_SCOPE_AGENT); }
__device__ __forceinline__ unsigned xb_xcc_id() { return (unsigned)__builtin_amdgcn_s_getreg((3 << 11) | 20) & 0xFu; }
#define XB_SPIN(cond, bar) do { unsigned _sp = 0; while (cond) { __builtin_amdgcn_s_sleep(1); \
    if ((++_sp & 255u) == 0u) { if (xb_ld(&(bar)[XB_TMO])) break; if (_sp > XB_SPIN_CAP) { atomicAdd(&(bar)[XB_TMO], 1u); break; } } } } while (0)

struct XcdBarrier {
    unsigned* bar; unsigned x;
    volatile LAS unsigned* st;
};

__device__ __forceinline__ XcdBarrier xcd_barrier_post(unsigned* bar, volatile LAS unsigned* st) {
    XcdBarrier b; b.bar = bar; b.x = xb_xcc_id(); b.st = st;
    if (threadIdx.x == 0) (void)xb_add(&bar[XB_XCNT(b.x)], 1u);
    return b;
}
__device__ __forceinline__ void xcd_barrier_complete(unsigned* bar, unsigned x, unsigned& nloc, unsigned& nx) {
    const unsigned G = gridDim.x * gridDim.y * gridDim.z;
    unsigned sum, cnt, mine, sp = 0u;
    for (;;) {
        sum = 0u; cnt = 0u; mine = 0u;
#pragma unroll
        for (unsigned j = 0; j < 16; ++j) { const unsigned c = xb_ld(&bar[XB_XCNT(j)]); sum += c; cnt += (c > 0u) ? 1u : 0u; mine = (j == x) ? c : mine; }
        if (sum == G) break;
        __builtin_amdgcn_s_sleep(1);
        if ((++sp & 255u) == 0u) { if (xb_ld(&bar[XB_TMO])) break; if (sp > XB_SPIN_CAP) { atomicAdd(&bar[XB_TMO], 1u); break; } }
    }
    nloc = mine > 0u ? mine : 1u; nx = cnt > 0u ? cnt : 1u;
}

__device__ __forceinline__ void xcd_barrier(const XcdBarrier& b) {
    asm volatile("s_waitcnt vmcnt(0)" ::: "memory");
    __syncthreads();
    if (threadIdx.x == 0) {
        unsigned* bar = b.bar;
        __builtin_amdgcn_s_waitcnt(0);
        unsigned nloc = b.st[0], nx = b.st[1];
        if (nloc == 0u) { xcd_barrier_complete(bar, b.x, nloc, nx); b.st[0] = nloc; b.st[1] = nx; }
        const unsigned old = xb_add(&bar[XB_XSUB(b.x)], 1u);
        const unsigned gen = old / nloc;
        if (old + 1u == (gen + 1u) * nloc) {
            __builtin_amdgcn_fence(__ATOMIC_RELEASE, "agent");
            asm volatile("s_waitcnt vmcnt(0)" ::: "memory");
            const unsigned og = xb_add(&bar[XB_TOP], 1u);
            const unsigned tg = og / nx;
            if (og + 1u == (tg + 1u) * nx) xb_add(&bar[XB_TOPGEN], 1u);
            else XB_SPIN(xb_ld(&bar[XB_TOPGEN]) == tg, bar);
            __builtin_amdgcn_fence(__ATOMIC_ACQUIRE, "agent");
            xb_add(&bar[XB_XGEN(b.x)], 1u);
            asm volatile("s_waitcnt vmcnt(0)" ::: "memory");
        } else {
            XB_SPIN(xb_ld(&bar[XB_XGEN(b.x)]) == gen, bar);
            __builtin_amdgcn_fence(__ATOMIC_ACQUIRE, "agent");
            asm volatile("s_waitcnt vmcnt(0)" ::: "memory");
        }
    }
    __syncthreads();
}


constexpr int NPHASES = 16;
__global__ void __launch_bounds__(NTHREADS, 2) mega_fwd(Params p) {
    extern __shared__ __attribute__((aligned(16))) unsigned char lds_raw[];
    LAS unsigned char* lds = (LAS unsigned char*)lds_raw;
    cg::grid_group grid = cg::this_grid();
    unsigned char* ws = p.ws;
    const int G = gridDim.x, bid = blockIdx.x;
    bf16_t* Hb = (bf16_t*)(ws + WS_H); bf16_t* Fb = (bf16_t*)(ws + WS_F); bf16_t* ACT = (bf16_t*)(ws + WS_ACT);
    bf16_t* ZQ = (bf16_t*)(ws + WS_ZQ); bf16_t* XL = (bf16_t*)(ws + WS_XL); bf16_t* GY = (bf16_t*)(ws + WS_GY);
#ifndef TESTPH
#define TESTPH -1
#endif
#define IN(k) ((TESTPH < 0 || (k) == TESTPH) && p.ph_lo <= (k) && (k) < p.ph_hi)
#define SEAM0() do { if (IN(0) && IN(1)) { __builtin_amdgcn_fence(__ATOMIC_RELEASE, "agent"); asm volatile("s_waitcnt vmcnt(0) lgkmcnt(0)" ::: "memory"); \
        grid.sync(); __builtin_amdgcn_fence(__ATOMIC_ACQUIRE, "agent"); asm volatile("s_waitcnt vmcnt(0) lgkmcnt(0)" ::: "memory"); \
        xb = xcd_barrier_post((unsigned*)(p.ws + WS_XBAR), xbst); } } while (0)
#define SEAM(k) do { if (IN(k) && IN((k) + 1)) xcd_barrier(xb); } while (0)
    volatile LAS unsigned* xbst = (volatile LAS unsigned*)(lds + LDS_BYTES - 16);
    if (threadIdx.x < 4) xbst[threadIdx.x] = 0u;
    __syncthreads();
    XcdBarrier xb; xb.bar = (unsigned*)(p.ws + WS_XBAR); xb.x = 0; xb.st = xbst;
    if (IN(0)) { if (bid == 0) { unsigned* xw = (unsigned*)(p.ws + WS_XBAR); for (int i = threadIdx.x; i < XCD_BAR_WORDS; i += NTHREADS) xw[i] = 0u; }
        phase_prep(p, lds); }
    SEAM0();
    if (IN(1)) phase_rows<false, true>(p, 0, 0, 0.f, true);
    SEAM(1);
#define FFN_PHASES(ffn, pb) do { \
        if (IN(pb)) { \
            pg8::Gemm g{Hb, (const bf16_t*)(ws + ((ffn) ? WS_WGU2 : WS_WGU1)), D, D}; pg8::StaticOrder S; S.init(T, 2 * DFF, G, bid); \
            pg8::EpiSwiglu E{ACT, DFF}; \
            GEMM_PHASE(pg8::EpiSwiglu, lds, g, S, E); \
        } \
        SEAM(pb); \
        if (IN((pb) + 1)) { \
            pg8::Gemm g{ACT, (const bf16_t*)(ws + ((ffn) ? WS_WDN2 : WS_WDN1)), DFF, DFF}; pg8::StaticOrder S; S.init(T, D, G, bid); \
            pg8::EpiAct<0> E{Fb, D, 0}; \
            GEMM_PHASE(pg8::EpiAct<0>, lds, g, S, E); \
        } \
        SEAM((pb) + 1); } while (0)
    FFN_PHASES(0, 2);
        if (IN(4)) phase_rows<true, true>(p, 0, 1, 0.5f, true);
        SEAM(4);
        if (IN(5)) {
            pg8::Gemm g{Hb, (const bf16_t*)(ws + WS_WINA), D, D}; pg8::StaticOrder S; S.init(T, 2560, G, bid);
            pg8::EpiWinA E{ZQ, XL, GY};
            GEMM_PHASE(pg8::EpiWinA, lds, g, S, E);
        }
        SEAM(5);
        if (IN(6)) { phase_stats(p); phase_lru(p, lds); }
        SEAM(6);
        if (IN(7)) {
            pg8::Gemm g{ZQ, (const bf16_t*)(ws + WS_WQKV), 512, 384}; pg8::StaticOrder S; S.init(T, 1792, G, bid);
            pg8::EpiQKV E{Fb, XL};
            GEMM_PHASE2(pg8::EpiQKV, lds, g, S, E);
        }
        SEAM(7);
        if (IN(8)) phase_attn(p, lds);
        SEAM(8);
        if (IN(9)) {
            pg8::Gemm g{Hb, (const bf16_t*)(ws + WS_WINB), D, D}; pg8::StaticOrder S; S.init(T, 2048, G, bid);
            pg8::EpiWinB E{Fb, XL};
            GEMM_PHASE(pg8::EpiWinB, lds, g, S, E);
        }
        SEAM(9);
        if (IN(10)) {
            { pg8::Gemm g{ZQ, (const bf16_t*)(ws + WS_WAO), 512, 512}; pg8::StaticOrder S; S.init(T, D, G, bid);
              pg8::EpiGate<false> E{Fb, nullptr, Fb};
              GEMM_PHASE(pg8::EpiGate<false>, lds, g, S, E); }
            { pg8::Gemm g{GY, (const bf16_t*)(ws + WS_WLO), D, D}; pg8::StaticOrder S; S.init(T, D, G, bid);
              pg8::EpiGate<true> E{XL, Fb, XL};
              GEMM_PHASE(pg8::EpiGate<true>, lds, g, S, E); }
        }
        SEAM(10);
        if (IN(11)) {
            pg8::Gemm g{XL, (const bf16_t*)(ws + WS_WOUT), D, D}; pg8::StaticOrder S; S.init(T, D, G, bid);
            pg8::EpiAct<0> E{Fb, D, 0};
            GEMM_PHASE(pg8::EpiAct<0>, lds, g, S, E);
        }
        SEAM(11);
        if (IN(12)) phase_rows<true, true>(p, 1, 2, 1.0f, false);
        SEAM(12);
    FFN_PHASES(1, 13);
    if (IN(15)) phase_rows<true, false>(p, 2, 0, 0.5f, false);
#undef IN
#undef SEAM
}

extern "C" void kernel_launch(void* const* d_in, const int* in_sizes, int n_in, void* d_out, int out_size, void* d_ws, size_t ws_size, hipStream_t stream) {
    static int grid = 0;
    if (grid == 0) {
        if (n_in != 27 || out_size != T * D || ws_size < WS_END) { fprintf(stderr, "kernel_launch: unexpected shapes: n_in %d out %d ws %zu (need >= %zu)\n", n_in, out_size, ws_size, (size_t)WS_END); grid = -1; return; }
        int dev = 0, cus = 0, per_cu = 0;
        (void)hipGetDevice(&dev);
        (void)hipDeviceGetAttribute(&cus, hipDeviceAttributeMultiprocessorCount, dev);
        if (hipFuncSetAttribute((const void*)mega_fwd, hipFuncAttributeMaxDynamicSharedMemorySize, LDS_BYTES) != hipSuccess) { fprintf(stderr, "kernel_launch: hipFuncSetAttribute failed\n"); grid = -1; return; }
        if (hipOccupancyMaxActiveBlocksPerMultiprocessor(&per_cu, (const void*)mega_fwd, NTHREADS, LDS_BYTES) != hipSuccess || per_cu < 1) { fprintf(stderr, "kernel_launch: occupancy query failed (%d)\n", per_cu); per_cu = 1; }
        (void)hipGetLastError();
        grid = cus;
        fprintf(stderr, "kernel_launch: grid %d (per_cu %d)\n", grid, per_cu);
    }
    if (grid < 0) return;
    Params p{};
    for (int i = 0; i < 27; ++i) p.in[i] = (const float*)d_in[i];
    p.out = (float*)d_out; p.ws = (unsigned char*)d_ws;
#if defined(MK_SPLIT)
    for (int ph = 0; ph < NPHASES; ++ph) { p.ph_lo = ph; p.ph_hi = ph + 1;
        hipLaunchKernelGGL(mega_fwd, dim3(grid), dim3(NTHREADS), LDS_BYTES, stream, p); }
#else
    p.ph_lo = 0; p.ph_hi = NPHASES;
    void* args[] = {&p};
    hipError_t e = hipLaunchCooperativeKernel((const void*)mega_fwd, dim3(grid), dim3(NTHREADS), args, LDS_BYTES, stream);
    if (e != hipSuccess) fprintf(stderr, "kernel_launch: cooperative launch failed: %s (grid %d)\n", hipGetErrorString(e), grid);
#endif
}
```

```cpp
#include <hip/hip_runtime.h>
#include <hip/hip_cooperative_groups.h>
#include <cstdio>
#include <cstdint>
namespace cg = cooperative_groups;
#ifndef MK_SP2_ALL
#define MK_SP2_ALL false
#endif

#define LAS __attribute__((address_space(3)))
typedef unsigned short bf16_t;
typedef short bf16x8 __attribute__((ext_vector_type(8)));
typedef short v4i16_t __attribute__((ext_vector_type(4)));
typedef float f32x4 __attribute__((ext_vector_type(4)));
typedef float f32x2 __attribute__((ext_vector_type(2)));
typedef unsigned u32x4 __attribute__((ext_vector_type(4)));
typedef unsigned u32x2 __attribute__((ext_vector_type(2)));

constexpr int D = 1024, DFF = 2816, TP = 32768, TS = 65536, T = TP + TS, SP = 2048, SS = 4096;
constexpr int NQ = 768, NKV = 512;
constexpr float EPS = 1e-6f;
constexpr int NTHREADS = 512, NWAVES = 8;

constexpr size_t KiB = 1024, MiB = 1024 * 1024;
constexpr size_t WS_WGU1 = 0, WS_WDN1 = 11 * MiB, WS_WINA = 16 * MiB + 512 * KiB, WS_WINB = 21 * MiB + 512 * KiB, WS_WQKV = 25 * MiB + 512 * KiB,
                 WS_WAO = 27 * MiB, WS_WLO = 28 * MiB, WS_WOUT = 30 * MiB, WS_WGU2 = 32 * MiB, WS_WDN2 = 43 * MiB, WS_WG = 48 * MiB + 512 * KiB,
                 WS_MOD = 49 * MiB + 512 * KiB, WS_ROPE = 50 * MiB + 768 * KiB, WS_STATS = 51 * MiB + 256 * KiB, WS_KR = 52 * MiB;
constexpr size_t WS_XBAR = 50 * MiB + 640 * KiB;
constexpr size_t WS_H = 64 * MiB, WS_F = 256 * MiB, WS_BIG = 448 * MiB;
constexpr size_t WS_ZQ = WS_BIG, WS_XL = WS_BIG + 96 * MiB, WS_GY = WS_BIG + 288 * MiB, WS_ACT = WS_BIG, WS_END = 976 * MiB;
constexpr int LDS_BYTES = 139264;

struct Params { const float* in[27]; float* out; unsigned char* ws; int ph_lo, ph_hi; };

typedef __bf16 bf16x2_t __attribute__((ext_vector_type(2)));
__device__ __forceinline__ unsigned pk_bf16(float lo, float hi) { const f32x2 v = {lo, hi}; const bf16x2_t b = __builtin_convertvector(v, bf16x2_t); return __builtin_bit_cast(unsigned, b); }
__device__ __forceinline__ float lo_bf(unsigned w) { return __uint_as_float(w << 16); }
__device__ __forceinline__ float hi_bf(unsigned w) { return __uint_as_float(w & 0xffff0000u); }
__device__ __forceinline__ float bf2f(bf16_t h) { return __uint_as_float((unsigned)h << 16); }
__device__ __forceinline__ float fexp(float x) { return __builtin_amdgcn_exp2f(x * 1.4426950408889634f); }
__device__ __forceinline__ float fsigmoid(float x) { return __builtin_amdgcn_rcpf(1.0f + fexp(-x)); }
__device__ __forceinline__ float fsilu(float x) { return x * fsigmoid(x); }
__device__ __forceinline__ float fgelu(float x) { return x * fsigmoid(1.5957691216057308f * (x + 0.044715f * x * x * x)); }
__device__ __forceinline__ float wave_sum(float v) {
#pragma unroll
    for (int o = 1; o < 64; o <<= 1) v += __shfl_xor(v, o);
    return v;
}
__device__ __forceinline__ int row_batch(int row) { return row < TP ? (row >> 11) : 16 + ((row - TP) >> 12); }
__device__ __forceinline__ int row_pos(int row) { return row < TP ? (row & (SP - 1)) : ((row - TP) & (SS - 1)); }

namespace pg8 {
constexpr int BM = 256, BK = 64, HALF = 128, HTB = HALF * BK * 2, STAGE_BYTES = 8 * HTB, NXCD = 8, WGM = 8;
__host__ __device__ __forceinline__ int lds_byte(int r, int c) { const int st = (r >> 4) * 2 + (c >> 5), rr = r & 15, cc = c & 31, ob = rr * 64 + cc * 2; return st * 1024 + (ob ^ (((ob >> 9) & 1) << 5)); }
__host__ __device__ __forceinline__ void stage_rc(int b, int& R, int& C) { const int st = b / 1024, sb = b % 1024, swz = sb ^ (((sb >> 9) & 1) << 5); R = (st >> 1) * 16 + swz / 64; C = (st & 1) * 32 + (swz % 64) / 2; }
__host__ __device__ __forceinline__ int perm32(int rho) { const int n = rho >> 4, i = rho & 15; return 8 * (i >> 2) + 4 * n + (i & 3); }

struct Unit { int pm, pn; };
struct Gemm { const bf16_t* A; const bf16_t* Bt; int lda, K; };

struct StaticOrder {
    int nM, nN, nwg, G, c;
    __device__ void init(int M, int N, int G_, int c_) { nM = M / BM; nN = N / BM; nwg = nM * nN; G = G_; c = c_; }
    __device__ bool next(int i, Unit& u) const {
        const long L = (long)i * G + c; if (L >= nwg) return false;
        int wgid = (int)L; { const int q = nwg / NXCD, r = nwg % NXCD, xcd = wgid % NXCD, off = wgid / NXCD; wgid = (xcd < r ? xcd * (q + 1) : r * (q + 1) + (xcd - r) * q) + off; }
        const int nig = WGM * nN, gid = wgid / nig, fm = gid * WGM, gsz = (nM - fm) < WGM ? (nM - fm) : WGM;
        u.pm = fm + ((wgid % nig) % gsz); u.pn = (wgid % nig) / gsz; return true;
    }
};

template <class Epi, bool SP2 = false>
__device__ __forceinline__ void gemm_phase(LAS unsigned char* lds, const Gemm g, const StaticOrder& S, const Epi& E) {
    const int tid = threadIdx.x, wid = __builtin_amdgcn_readfirstlane(tid >> 6), lane = tid & 63, wr = wid >> 2, wc = wid & 3, fr = lane & 15, fq = lane >> 4;
    const int K = g.K, nt = K / BK, lda = g.lda;
    unsigned voffA[2], voffB[2];
#pragma unroll
    for (int i = 0; i < 2; ++i) { int R, C; stage_rc(tid * 16 + i * 8192, R, C); const int Rb = Epi::PERM ? ((R & ~31) + perm32(R & 31)) : R;
        voffA[i] = (unsigned)(R * lda + C) * 2u; voffB[i] = (unsigned)(Rb * K + C) * 2u; }
    const size_t kstep = (size_t)(BK * 2);
    const size_t hstepA = (size_t)HALF * lda * 2, hstepB = (size_t)HALF * K * 2;
    const size_t tstepA = 2 * hstepA, tstepB = 2 * hstepB;
    const unsigned ldsw = (unsigned)wid * 1024u;
    const int aoff = lds_byte(wr * 64 + fr, fq * 8), boff = lds_byte(wc * 32 + fr, fq * 8);
#define PG8_SA(b, h) (((b) * 2 + (h)) * HTB)
#define PG8_SB(b, h) ((4 + (b) * 2 + (h)) * HTB)
#define PG8_STAGE(bufoff, gbase, voff) do { _Pragma("unroll") for (int _i = 0; _i < 2; ++_i) \
        __builtin_amdgcn_global_load_lds((const unsigned*)((const char*)(gbase) + (voff)[_i]), (LAS unsigned*)(lds + (bufoff) + ldsw + _i * 8192), 16, 0, 0); } while (0)
#define PG8_LDA(dst, b, h) do { _Pragma("unroll") for (int m = 0; m < 4; ++m) _Pragma("unroll") for (int k = 0; k < 2; ++k) dst[m][k] = *(const LAS bf16x8*)(lds + PG8_SA(b, h) + aoff + m * 2048 + k * 1024); } while (0)
#define PG8_LDB(dst, b, h) do { _Pragma("unroll") for (int n = 0; n < 2; ++n) _Pragma("unroll") for (int k = 0; k < 2; ++k) dst[n][k] = *(const LAS bf16x8*)(lds + PG8_SB(b, h) + boff + n * 2048 + k * 1024); } while (0)
#define PG8_MMA(ai, bj, At, Bt) do { __builtin_amdgcn_s_setprio(1); _Pragma("unroll") for (int m = 0; m < 4; ++m) _Pragma("unroll") for (int n = 0; n < 2; ++n) _Pragma("unroll") for (int k = 0; k < 2; ++k) \
        acc[ai][bj][m][n] = __builtin_amdgcn_mfma_f32_16x16x32_bf16(Bt[n][k], At[m][k], acc[ai][bj][m][n], 0, 0, 0); __builtin_amdgcn_s_setprio(0); } while (0)
#define PG8_WAIT_V(n) asm volatile("s_waitcnt vmcnt(" #n ")" ::: "memory")
#define PG8_WAIT_L(n) asm volatile("s_waitcnt lgkmcnt(" #n ")" ::: "memory")
#define PG8_BAR __builtin_amdgcn_s_barrier()
#define PG8_SCHED __builtin_amdgcn_sched_barrier(0)
    Unit cur, nxt; int ui = 0;
    if (!S.next(0, cur)) return;
    f32x4 acc[2][2][4][2];
#pragma unroll
    for (int a = 0; a < 2; ++a)
#pragma unroll
        for (int b = 0; b < 2; ++b)
#pragma unroll
            for (int m = 0; m < 4; ++m)
#pragma unroll
                for (int n = 0; n < 2; ++n) acc[a][b][m][n] = (f32x4){0.f, 0.f, 0.f, 0.f};
    bf16x8 At[4][2], B0[2][2], B1[2][2];
    const char* cA = (const char*)g.A + (size_t)cur.pm * tstepA; const char* cB = (const char*)g.Bt + (size_t)cur.pn * tstepB;
    if constexpr (SP2) {
        PG8_STAGE(PG8_SB(0, 0), cB, voffB); PG8_STAGE(PG8_SB(0, 1), cB + hstepB, voffB); PG8_STAGE(PG8_SA(0, 0), cA, voffA); PG8_STAGE(PG8_SA(0, 1), cA + hstepA, voffA);
        if (wr == 1) PG8_BAR;
        PG8_WAIT_V(2); PG8_BAR;
        PG8_STAGE(PG8_SB(1, 0), cB + kstep, voffB); PG8_STAGE(PG8_SA(1, 0), cA + kstep, voffA); PG8_STAGE(PG8_SB(1, 1), cB + hstepB + kstep, voffB);
        PG8_WAIT_V(6); PG8_BAR;
    } else {
    PG8_STAGE(PG8_SB(0, 0), cB, voffB); PG8_STAGE(PG8_SA(0, 0), cA, voffA); PG8_STAGE(PG8_SB(0, 1), cB + hstepB, voffB); PG8_STAGE(PG8_SA(0, 1), cA + hstepA, voffA);
    if (wr == 1) PG8_BAR;
    PG8_WAIT_V(4); PG8_BAR;
    PG8_STAGE(PG8_SB(1, 0), cB + kstep, voffB); PG8_STAGE(PG8_SA(1, 0), cA + kstep, voffA); PG8_STAGE(PG8_SB(1, 1), cB + hstepB + kstep, voffB);
    PG8_WAIT_V(6); PG8_BAR;
    }
    for (;;) {
        const bool has_next = S.next(ui + 1, nxt);
        const char* nA = has_next ? (const char*)g.A + (size_t)nxt.pm * tstepA : cA; const char* nB = has_next ? (const char*)g.Bt + (size_t)nxt.pn * tstepB : cB;
        for (int t = 0; t < nt; t += 2) {
            const bool last = (t == nt - 2);
            const char* a1 = cA + (size_t)(t + 1) * kstep;
            const char* a2 = last ? nA : cA + (size_t)(t + 2) * kstep; const char* b2 = last ? nB : cB + (size_t)(t + 2) * kstep;
            const char* a3 = a2 + kstep; const char* b3 = b2 + kstep;
            if constexpr (SP2) {
            PG8_LDB(B0, 0, 0); PG8_LDB(B1, 0, 1); PG8_SCHED; PG8_LDA(At, 0, 0); PG8_STAGE(PG8_SA(1, 1), a1 + hstepA, voffA);
            PG8_WAIT_V(8); PG8_WAIT_L(0); PG8_BAR; PG8_MMA(0, 0, At, B0); PG8_MMA(0, 1, At, B1); PG8_BAR; PG8_SCHED;
            PG8_LDA(At, 0, 1); PG8_STAGE(PG8_SB(0, 0), b2, voffB); PG8_STAGE(PG8_SB(0, 1), b2 + hstepB, voffB); PG8_STAGE(PG8_SA(0, 0), a2, voffA);
            PG8_WAIT_V(8); PG8_WAIT_L(0); PG8_BAR; PG8_MMA(1, 0, At, B0); PG8_MMA(1, 1, At, B1); PG8_BAR; PG8_SCHED;
            PG8_LDB(B0, 1, 0); PG8_LDB(B1, 1, 1); PG8_SCHED; PG8_LDA(At, 1, 0); PG8_STAGE(PG8_SA(0, 1), a2 + hstepA, voffA);
            PG8_WAIT_V(8); PG8_WAIT_L(0); PG8_BAR; PG8_MMA(0, 0, At, B0); PG8_MMA(0, 1, At, B1); PG8_BAR; PG8_SCHED;
            PG8_LDA(At, 1, 1); PG8_STAGE(PG8_SB(1, 0), b3, voffB); PG8_STAGE(PG8_SB(1, 1), b3 + hstepB, voffB); PG8_STAGE(PG8_SA(1, 0), a3, voffA);
            PG8_WAIT_V(8); PG8_WAIT_L(0); PG8_BAR; PG8_MMA(1, 0, At, B0); PG8_MMA(1, 1, At, B1); PG8_BAR; PG8_SCHED;
            } else {
            PG8_LDB(B0, 0, 0); PG8_SCHED; PG8_LDA(At, 0, 0); PG8_STAGE(PG8_SA(1, 1), a1 + hstepA, voffA);
            PG8_WAIT_L(8); PG8_BAR; PG8_WAIT_L(0); PG8_MMA(0, 0, At, B0); PG8_BAR; PG8_SCHED;
            PG8_LDB(B1, 0, 1); PG8_STAGE(PG8_SB(0, 0), b2, voffB);
            PG8_BAR; PG8_WAIT_L(0); PG8_MMA(0, 1, At, B1); PG8_BAR;
            PG8_LDA(At, 0, 1); PG8_STAGE(PG8_SA(0, 0), a2, voffA);
            PG8_BAR; PG8_WAIT_L(0); PG8_MMA(1, 0, At, B0); PG8_BAR; PG8_SCHED;
            PG8_STAGE(PG8_SB(0, 1), b2 + hstepB, voffB);
            PG8_WAIT_V(6); PG8_BAR; PG8_MMA(1, 1, At, B1); PG8_BAR;
            PG8_LDB(B0, 1, 0); PG8_SCHED; PG8_LDA(At, 1, 0); PG8_STAGE(PG8_SA(0, 1), a2 + hstepA, voffA);
            PG8_WAIT_L(8); PG8_BAR; PG8_WAIT_L(0); PG8_MMA(0, 0, At, B0); PG8_BAR; PG8_SCHED;
            PG8_LDB(B1, 1, 1); PG8_STAGE(PG8_SB(1, 0), b3, voffB);
            PG8_BAR; PG8_WAIT_L(0); PG8_MMA(0, 1, At, B1); PG8_BAR;
            PG8_LDA(At, 1, 1); PG8_STAGE(PG8_SA(1, 0), a3, voffA);
            PG8_BAR; PG8_WAIT_L(0); PG8_MMA(1, 0, At, B0); PG8_BAR; PG8_SCHED;
            PG8_STAGE(PG8_SB(1, 1), b3 + hstepB, voffB);
            PG8_WAIT_V(6); PG8_BAR; PG8_MMA(1, 1, At, B1); PG8_BAR;
            }
        }
        if constexpr (SP2) { if (wr == 0) PG8_BAR; }
        { int el; asm volatile("v_mbcnt_lo_u32_b32 %0, -1, 0\n\tv_mbcnt_hi_u32_b32 %0, -1, %0" : "=v"(el)); E(acc, cur, wr, wc, el & 15, el >> 4); }
        if (!has_next) break;
#pragma unroll
        for (int a = 0; a < 2; ++a)
#pragma unroll
            for (int b = 0; b < 2; ++b)
#pragma unroll
                for (int m = 0; m < 4; ++m)
#pragma unroll
                    for (int n = 0; n < 2; ++n) acc[a][b][m][n] = (f32x4){0.f, 0.f, 0.f, 0.f};
        cur = nxt; cA = nA; cB = nB; ++ui;
        if constexpr (SP2) { if (wr == 1) PG8_BAR; }
    }
    PG8_WAIT_V(0);
    if constexpr (!SP2) { if (wr == 0) PG8_BAR; }
    PG8_BAR;
#undef PG8_SA
#undef PG8_SB
#undef PG8_STAGE
#undef PG8_LDA
#undef PG8_LDB
#undef PG8_MMA
#undef PG8_WAIT_V
#undef PG8_WAIT_L
#undef PG8_BAR
#undef PG8_SCHED
}

#if defined(MK_SIMPLE_GEMM)
template <class Epi>
__device__ __forceinline__ void gemm_phase_simple(const Gemm g, const StaticOrder& S, const Epi& E) {
    const int tid = threadIdx.x, wid = __builtin_amdgcn_readfirstlane(tid >> 6), lane = tid & 63, wr = wid >> 2, wc = wid & 3, fr = lane & 15, fq = lane >> 4;
    Unit cur;
    for (int ui = 0; S.next(ui, cur); ++ui) {
        f32x4 acc[2][2][4][2];
#pragma unroll
        for (int a = 0; a < 2; ++a)
#pragma unroll
            for (int b = 0; b < 2; ++b)
#pragma unroll
                for (int m = 0; m < 4; ++m)
#pragma unroll
                    for (int n = 0; n < 2; ++n) acc[a][b][m][n] = (f32x4){0.f, 0.f, 0.f, 0.f};
        for (int k0 = 0; k0 < g.K; k0 += 32) {
            bf16x8 bf[2][2];
#pragma unroll
            for (int bj = 0; bj < 2; ++bj)
#pragma unroll
                for (int n = 0; n < 2; ++n) { const int slot = 16 * n + fr; const int wrow = cur.pn * BM + bj * HALF + wc * 32 + (Epi::PERM ? perm32(slot) : slot);
                    bf[bj][n] = *(const bf16x8*)(g.Bt + (size_t)wrow * g.K + k0 + 8 * fq); }
#pragma unroll
            for (int ai = 0; ai < 2; ++ai)
#pragma unroll
                for (int m = 0; m < 4; ++m) { const int arow = cur.pm * BM + ai * HALF + wr * 64 + m * 16 + fr;
                    const bf16x8 af = *(const bf16x8*)(g.A + (size_t)arow * g.lda + k0 + 8 * fq);
#pragma unroll
                    for (int bj = 0; bj < 2; ++bj)
#pragma unroll
                        for (int n = 0; n < 2; ++n) acc[ai][bj][m][n] = __builtin_amdgcn_mfma_f32_16x16x32_bf16(bf[bj][n], af, acc[ai][bj][m][n], 0, 0, 0); }
        }
        E(acc, cur, wr, wc, fr, fq);
    }
}
#define GEMM_PHASE(EPI, lds, g, S, E) pg8::gemm_phase_simple<EPI>(g, S, E)
#define GEMM_PHASE2(EPI, lds, g, S, E) pg8::gemm_phase_simple<EPI>(g, S, E)
#else
#define GEMM_PHASE(EPI, lds, g, S, E) pg8::gemm_phase<EPI, true>(lds, g, S, E)
#define GEMM_PHASE2(EPI, lds, g, S, E) pg8::gemm_phase<EPI, false>(lds, g, S, E)
#endif
struct EpiSwiglu {
    static constexpr bool PERM = true;
    bf16_t* O; int ldc;
    __device__ __forceinline__ void operator()(const f32x4 (&acc)[2][2][4][2], const Unit& u, int wr, int wc, int fr, int fq) const {
        const int row0 = u.pm * BM + wr * 64 + fr, col0 = u.pn * 128 + wc * 32 + 8 * fq;
#pragma unroll
        for (int ai = 0; ai < 2; ++ai)
#pragma unroll
            for (int m = 0; m < 4; ++m) {
                bf16_t* rowp = O + (size_t)(row0 + ai * HALF + m * 16) * ldc + col0;
                const f32x4 g0 = acc[ai][0][m][0], g1 = acc[ai][0][m][1], u0 = acc[ai][1][m][0], u1 = acc[ai][1][m][1];
                float v[8];
#pragma unroll
                for (int j = 0; j < 4; ++j) { v[j] = fsilu(g0[j]) * u0[j]; v[4 + j] = fsilu(g1[j]) * u1[j]; }
                u32x4 w; w.x = pk_bf16(v[0], v[1]); w.y = pk_bf16(v[2], v[3]); w.z = pk_bf16(v[4], v[5]); w.w = pk_bf16(v[6], v[7]);
                *(u32x4*)rowp = w;
                asm volatile("" ::: "memory");
            }
    }
};
__device__ __forceinline__ void store_tile_bf16(const f32x4 (&acc)[2][2][4][2], bf16_t* base, int ld, int row0, int col0, int act) {
#pragma unroll
    for (int ai = 0; ai < 2; ++ai)
#pragma unroll
        for (int m = 0; m < 4; ++m) {
            bf16_t* rowp = base + (size_t)(row0 + ai * HALF + m * 16) * ld + col0;
#pragma unroll
            for (int bj = 0; bj < 2; ++bj) {
                f32x4 v0 = acc[ai][bj][m][0], v1 = acc[ai][bj][m][1];
                if (act == 1) {
#pragma unroll
                    for (int j = 0; j < 4; ++j) { v0[j] = fgelu(v0[j]); v1[j] = fgelu(v1[j]); }
                } else if (act == 2) {
#pragma unroll
                    for (int j = 0; j < 4; ++j) { v0[j] = fsigmoid(v0[j]); v1[j] = fsigmoid(v1[j]); }
                }
                u32x4 w; w.x = pk_bf16(v0[0], v0[1]); w.y = pk_bf16(v0[2], v0[3]); w.z = pk_bf16(v1[0], v1[1]); w.w = pk_bf16(v1[2], v1[3]);
                *(u32x4*)(rowp + bj * HALF) = w;
            }
            asm volatile("" ::: "memory");
        }
}
template <int ACT> struct EpiAct {
    static constexpr bool PERM = true;
    bf16_t* p; int ld, pn0;
    __device__ __forceinline__ void operator()(const f32x4 (&acc)[2][2][4][2], const Unit& u, int wr, int wc, int fr, int fq) const {
        store_tile_bf16(acc, p, ld, u.pm * BM + wr * 64 + fr, (u.pn - pn0) * BM + wc * 32 + 8 * fq, ACT);
    }
};
struct EpiWinA {
    static constexpr bool PERM = true;
    bf16_t* zq; bf16_t* xl; bf16_t* gy;
    __device__ __forceinline__ void operator()(const f32x4 (&acc)[2][2][4][2], const Unit& u, int wr, int wc, int fr, int fq) const {
        size_t boff = 0; if (u.pn >= 2) boff += (size_t)((const char*)xl - (const char*)zq); if (u.pn >= 6) boff += (size_t)((const char*)gy - (const char*)xl);
        bf16_t* base = (bf16_t*)((char*)zq + boff);
        int ld = 512, pn0 = 0; if (u.pn >= 2) { ld = D; pn0 = 2; } if (u.pn >= 6) pn0 = 6;
        store_tile_bf16(acc, base, ld, u.pm * BM + wr * 64 + fr, (u.pn - pn0) * BM + wc * 32 + 8 * fq, u.pn < 6 ? 0 : 1);
    }
};
struct EpiWinB {
    static constexpr bool PERM = true;
    bf16_t* ga; bf16_t* gl;
    __device__ __forceinline__ void operator()(const f32x4 (&acc)[2][2][4][2], const Unit& u, int wr, int wc, int fr, int fq) const {
        store_tile_bf16(acc, u.pn < 4 ? ga : gl, D, u.pm * BM + wr * 64 + fr, (u.pn & 3) * BM + wc * 32 + 8 * fq, 2);
    }
};
template <bool ADD> struct EpiGate {
    static constexpr bool PERM = true;
    const bf16_t* gate; const bf16_t* add; bf16_t* out;
    __device__ __forceinline__ void operator()(const f32x4 (&acc)[2][2][4][2], const Unit& u, int wr, int wc, int fr, int fq) const {
        const int row0 = u.pm * BM + wr * 64 + fr, col0 = u.pn * BM + wc * 32 + 8 * fq;
#pragma unroll
        for (int ai = 0; ai < 2; ++ai)
#pragma unroll
            for (int m = 0; m < 4; ++m) {
                const size_t off = (size_t)(row0 + ai * HALF + m * 16) * D + col0;
#pragma unroll
                for (int bj = 0; bj < 2; ++bj) {
                    const u32x4 gw = *(const u32x4*)(gate + off + bj * HALF);
                    const f32x4 v0 = acc[ai][bj][m][0], v1 = acc[ai][bj][m][1];
                    float r[8];
                    r[0] = lo_bf(gw.x) * v0[0]; r[1] = hi_bf(gw.x) * v0[1]; r[2] = lo_bf(gw.y) * v0[2]; r[3] = hi_bf(gw.y) * v0[3];
                    r[4] = lo_bf(gw.z) * v1[0]; r[5] = hi_bf(gw.z) * v1[1]; r[6] = lo_bf(gw.w) * v1[2]; r[7] = hi_bf(gw.w) * v1[3];
                    if (ADD) {
                        const u32x4 aw = *(const u32x4*)(add + off + bj * HALF);
                        r[0] += lo_bf(aw.x); r[1] += hi_bf(aw.x); r[2] += lo_bf(aw.y); r[3] += hi_bf(aw.y);
                        r[4] += lo_bf(aw.z); r[5] += hi_bf(aw.z); r[6] += lo_bf(aw.w); r[7] += hi_bf(aw.w);
                    }
                    u32x4 w; w.x = pk_bf16(r[0], r[1]); w.y = pk_bf16(r[2], r[3]); w.z = pk_bf16(r[4], r[5]); w.w = pk_bf16(r[6], r[7]);
                    *(u32x4*)(out + off + bj * HALF) = w;
                }
                asm volatile("" ::: "memory");
            }
    }
};
struct EpiQKV {
    static constexpr bool PERM = true;
    bf16_t* Q; bf16_t* Kn;
    __device__ __forceinline__ void operator()(const f32x4 (&acc)[2][2][4][2], const Unit& u, int wr, int wc, int fr, int fq) const {
        size_t boff = 0; if (u.pn >= 3) boff += (size_t)((const char*)Kn - (const char*)Q); if (u.pn >= 5) boff += (size_t)T * NKV * 2;
        bf16_t* dst = (bf16_t*)((char*)Q + boff);
        int ld = NQ, ctile = u.pn * BM; if (u.pn >= 3) { ld = NKV; ctile = ((u.pn - 3) & 1) * BM; }
        store_tile_bf16(acc, dst, ld, u.pm * BM + wr * 64 + fr, ctile + wc * 32 + 8 * fq, 0);
    }
};
}

struct TJob { const float* src; const float* scale; bf16_t* dst; int ldsrc, K, lddst, dstk0, nrb, map, nbatch, sbs, dbs; };
__device__ __forceinline__ int srccol(int map, int rb) {
    const int r = rb * 32;
    switch (map) {
        case 1: { const int pn = r >> 8, w = r & 255; return w < 128 ? 128 * pn + w : DFF + 128 * pn + (w - 128); }
        case 2: { if (r < 416) return r; if (r < 512) return -1; return r - 96; }
        case 3: return 2464 + r;
        case 4: { const int v = r >= 512 ? 1 : 0; const int rr = r & 511; return (rr >> 6) * 128 + (rr & 63) + 64 * v; }
        default: return r;
    }
}
constexpr int NJOBS = 15;
__device__ __forceinline__ TJob get_job(const Params& p, int j) {
    TJob t; t.scale = nullptr; t.dstk0 = 0; t.map = 0; t.nbatch = 1; t.sbs = 0; t.dbs = 0;
    unsigned char* ws = p.ws;
    switch (j) {
        case 0:  t.src = p.in[8];  t.dst = (bf16_t*)(ws + WS_WGU1); t.ldsrc = 2 * DFF; t.K = D; t.lddst = D; t.nrb = 176; t.map = 1; break;
        case 1:  t.src = p.in[9];  t.dst = (bf16_t*)(ws + WS_WDN1); t.ldsrc = D; t.K = DFF; t.lddst = DFF; t.nrb = 32; break;
        case 2:  t.src = p.in[10]; t.dst = (bf16_t*)(ws + WS_WINA); t.ldsrc = 4512; t.K = D; t.lddst = D; t.nrb = 80; t.map = 2; break;
        case 3:  t.src = p.in[10]; t.dst = (bf16_t*)(ws + WS_WINB); t.ldsrc = 4512; t.K = D; t.lddst = D; t.nrb = 64; t.map = 3; break;
        case 4:  t.src = p.in[13]; t.scale = p.in[11]; t.dst = (bf16_t*)(ws + WS_WQKV); t.ldsrc = 768; t.K = 256; t.lddst = 384; t.nrb = 24; break;
        case 5:  t.src = nullptr;  t.dst = (bf16_t*)(ws + WS_WQKV); t.ldsrc = 0; t.K = 128; t.lddst = 384; t.dstk0 = 256; t.nrb = 24; break;
        case 6:  t.src = p.in[14]; t.scale = p.in[12]; t.dst = (bf16_t*)(ws + WS_WQKV) + 768 * 384; t.ldsrc = 1024; t.K = 128; t.lddst = 384; t.dstk0 = 256; t.nrb = 32; t.map = 4; break;
        case 7:  t.src = nullptr;  t.dst = (bf16_t*)(ws + WS_WQKV) + 768 * 384; t.ldsrc = 0; t.K = 256; t.lddst = 384; t.nrb = 32; break;
        case 8:  t.src = p.in[15]; t.dst = (bf16_t*)(ws + WS_WAO); t.ldsrc = D; t.K = 512; t.lddst = 512; t.nrb = 32; break;
        case 9:  t.src = p.in[23]; t.dst = (bf16_t*)(ws + WS_WLO); t.ldsrc = D; t.K = D; t.lddst = D; t.nrb = 32; break;
        case 10: t.src = p.in[24]; t.dst = (bf16_t*)(ws + WS_WOUT); t.ldsrc = D; t.K = D; t.lddst = D; t.nrb = 32; break;
        case 11: t.src = p.in[25]; t.dst = (bf16_t*)(ws + WS_WGU2); t.ldsrc = 2 * DFF; t.K = D; t.lddst = D; t.nrb = 176; t.map = 1; break;
        case 12: t.src = p.in[26]; t.dst = (bf16_t*)(ws + WS_WDN2); t.ldsrc = D; t.K = DFF; t.lddst = DFF; t.nrb = 32; break;
        case 13: t.src = p.in[18]; t.dst = (bf16_t*)(ws + WS_WG); t.ldsrc = 128; t.K = 128; t.lddst = 128; t.nrb = 4; t.nbatch = 16; t.sbs = 16384; t.dbs = 32768; break;
        default: t.src = p.in[20]; t.dst = (bf16_t*)(ws + WS_WG) + 16384; t.ldsrc = 128; t.K = 128; t.lddst = 128; t.nrb = 4; t.nbatch = 16; t.sbs = 16384; t.dbs = 32768; break;
    }
    return t;
}
__device__ __forceinline__ int job_items(const TJob& t) { return t.nbatch * t.nrb * (t.K >> 6); }

__device__ __forceinline__ void tr_item(const TJob& jb, int item, LAS float* scr, int lane) {
    const int nkb = jb.K >> 6, per_batch = jb.nrb * nkb;
    const int bt = item / per_batch, r = item - bt * per_batch, rb = r / nkb, kb = r - rb * nkb;
    const int sc = srccol(jb.map, rb), k0 = 64 * kb;
    if (jb.src != nullptr && sc >= 0) {
        const float* src = jb.src + (size_t)bt * jb.sbs;
#pragma unroll 8
        for (int i = 0; i < 32; ++i) { const int kk = 2 * i + (lane >> 5);
            float v = src[(size_t)(k0 + kk) * jb.ldsrc + sc + (lane & 31)];
            if (jb.scale) v *= jb.scale[k0 + kk];
            scr[kk * 33 + (lane & 31)] = v; }
    } else {
#pragma unroll 8
        for (int i = 0; i < 32; ++i) { const int kk = 2 * i + (lane >> 5); scr[kk * 33 + (lane & 31)] = 0.f; }
    }
    asm volatile("s_waitcnt lgkmcnt(0)" ::: "memory");
    bf16_t* dst = jb.dst + (size_t)bt * jb.dbs;
    const int c = lane & 7;
#pragma unroll
    for (int j = 0; j < 4; ++j) { const int n = (lane >> 3) + 8 * j; const LAS float* s = scr + (8 * c) * 33 + n;
        u32x4 o; o.x = pk_bf16(s[0 * 33], s[1 * 33]); o.y = pk_bf16(s[2 * 33], s[3 * 33]); o.z = pk_bf16(s[4 * 33], s[5 * 33]); o.w = pk_bf16(s[6 * 33], s[7 * 33]);
        *(u32x4*)(dst + (size_t)(32 * rb + n) * jb.lddst + jb.dstk0 + k0 + 8 * c) = o; }
    asm volatile("s_waitcnt lgkmcnt(0)" ::: "memory");
}

__device__ __forceinline__ void phase_prep(const Params& p, LAS unsigned char* lds) {
    const int tid = threadIdx.x, lane = tid & 63, wave = tid >> 6;
    const int gw = blockIdx.x * NWAVES + wave, NGW = gridDim.x * NWAVES;
    {
        LAS float* scr = (LAS float*)(lds + wave * 8704);
        int base = 0;
        for (int j = 0; j < NJOBS; ++j) {
            const TJob jb = get_job(p, j); const int n = job_items(jb);
            int first = gw - (base % NGW); if (first < 0) first += NGW;
            for (int i = first; i < n; i += NGW) tr_item(jb, i, scr, lane);
            base += n;
        }
    }
    {
        const int gt = blockIdx.x * NTHREADS + tid;
        if (gt < SS * 16) {
            const int pos = gt >> 4, i = gt & 15;
            double inv = 1.0; for (int q = 0; q < i; ++q) inv *= 0.5623413251903491;
            const float ang = (float)pos * (float)inv;
            const double rev = (double)ang * 0.15915494309189535; const float fr = (float)(rev - rint(rev));
            ((float*)(p.ws + WS_ROPE))[gt] = __builtin_amdgcn_cosf(fr);
            ((float*)(p.ws + WS_ROPE))[SS * 16 + gt] = __builtin_amdgcn_sinf(fr);
        }
    }
    __syncthreads();
    for (int item = blockIdx.x; item < 144; item += gridDim.x) {
        LAS float* sc = (LAS float*)(lds) + wave * (128 * 33);
        for (int i = 0; i < 64; ++i) { const int idx = lane + 64 * i, kl = idx & 127, b = idx >> 7;
            const float cv = (b < 16 ? p.in[2] : p.in[3])[(b & 15) * D + 128 * wave + kl];
            sc[kl * 33 + b] = fsilu(cv); }
        asm volatile("s_waitcnt lgkmcnt(0)" ::: "memory");
        float acc[32];
#pragma unroll
        for (int b = 0; b < 32; ++b) acc[b] = 0.f;
        const float* W = p.in[4] + (size_t)(128 * wave) * 9216 + item * 64 + lane;
        for (int k = 0; k < 128; ++k) { const float wv = W[(size_t)k * 9216];
#pragma unroll
            for (int b = 0; b < 32; ++b) acc[b] += sc[k * 33 + b] * wv; }
        __syncthreads();
        LAS float* red = (LAS float*)(lds);
#pragma unroll
        for (int b = 0; b < 32; ++b) red[(wave * 32 + b) * 64 + lane] = acc[b];
        __syncthreads();
        for (int o = tid; o < 2048; o += NTHREADS) { const int b = o >> 6, col = o & 63; float s = 0.f;
#pragma unroll
            for (int w = 0; w < 8; ++w) s += red[(w * 32 + b) * 64 + col];
            const int j = item * 64 + col;
            ((float*)(p.ws + WS_MOD))[b * 9216 + j] = s + p.in[5][j]; }
        __syncthreads();
    }
}

template <bool HAS_F, bool HAS_H>
__device__ __forceinline__ void phase_rows(const Params& p, int sp, int sn, float resw, bool from_input) {
    const int tid = threadIdx.x, lane = tid & 63, wave = tid >> 6;
    const int gw = blockIdx.x * NWAVES + wave, NGW = gridDim.x * NWAVES;
    const float* mod = (const float*)(p.ws + WS_MOD);
    const bf16_t* F = (const bf16_t*)(p.ws + WS_F);
    bf16_t* H = (bf16_t*)(p.ws + WS_H);
    for (int row = gw; row < T; row += NGW) {
        const int b = row_batch(row);
        const float* xin = !from_input ? p.out + (size_t)row * D : (row < TP ? p.in[0] + (size_t)row * D : p.in[1] + (size_t)(row - TP) * D);
        f32x4 v[4];
#pragma unroll
        for (int j = 0; j < 4; ++j) v[j] = *(const f32x4*)(xin + 4 * lane + 256 * j);
        if (HAS_F) {
            f32x4 f[4]; float ss = 0.f;
#pragma unroll
            for (int j = 0; j < 4; ++j) { const u32x2 w = *(const u32x2*)(F + (size_t)row * D + 4 * lane + 256 * j);
                f[j] = (f32x4){lo_bf(w.x), hi_bf(w.x), lo_bf(w.y), hi_bf(w.y)}; ss += (f[j].x * f[j].x + f[j].y * f[j].y) + (f[j].z * f[j].z + f[j].w * f[j].w); }
            const float rs = 1.0f / sqrtf(wave_sum(ss) * (1.0f / D) + EPS) * resw;
            const float* gate = mod + b * 9216 + sp * 3072 + 2048; const float* gp = p.in[7] + sp * D;
#pragma unroll
            for (int j = 0; j < 4; ++j) { const f32x4 g = *(const f32x4*)(gate + 4 * lane + 256 * j), q = *(const f32x4*)(gp + 4 * lane + 256 * j);
                v[j] = v[j] + g * (f[j] * rs * q);
                *(f32x4*)(p.out + (size_t)row * D + 4 * lane + 256 * j) = v[j]; }
        }
        if (HAS_H) {
            float ss = 0.f;
#pragma unroll
            for (int j = 0; j < 4; ++j) ss += (v[j].x * v[j].x + v[j].y * v[j].y) + (v[j].z * v[j].z + v[j].w * v[j].w);
            const float rs = 1.0f / sqrtf(wave_sum(ss) * (1.0f / D) + EPS);
            const float* sh = mod + b * 9216 + sn * 3072; const float* scl = sh + 1024; const float* gq = p.in[6] + sn * D;
#pragma unroll
            for (int j = 0; j < 4; ++j) { const f32x4 a = *(const f32x4*)(sh + 4 * lane + 256 * j), s = *(const f32x4*)(scl + 4 * lane + 256 * j), q = *(const f32x4*)(gq + 4 * lane + 256 * j);
                const f32x4 h = (v[j] * rs * q) * (s + 1.0f) + a;
                u32x2 w; w.x = pk_bf16(h.x, h.y); w.y = pk_bf16(h.z, h.w);
                *(u32x2*)(H + (size_t)row * D + 4 * lane + 256 * j) = w; }
        }
    }
}

__device__ __forceinline__ void phase_stats(const Params& p, const int wg0, const int nwg) {
    const int tid = threadIdx.x, lane = tid & 63, wave = tid >> 6;
    const int gw = ((int)blockIdx.x - wg0) * NWAVES + wave, NGW = nwg * NWAVES;
    bf16_t* ZQ = (bf16_t*)(p.ws + WS_ZQ);
    bf16_t* KR = (bf16_t*)(p.ws + WS_KR);
    const float* rc = (const float*)(p.ws + WS_ROPE); const float* rsn = rc + SS * 16;
    for (int row = gw; row < T; row += NGW) {
        const u32x4 w = *(const u32x4*)(ZQ + (size_t)row * 512 + 8 * lane);
        float x[8] = {lo_bf(w.x), hi_bf(w.x), lo_bf(w.y), hi_bf(w.y), lo_bf(w.z), hi_bf(w.z), lo_bf(w.w), hi_bf(w.w)};
        float ss = 0.f;
#pragma unroll
        for (int e = 0; e < 8; ++e) ss += x[e] * x[e];
        const float sq = wave_sum(lane < 32 ? ss : 0.f), skv = wave_sum((lane >= 32 && lane < 48) ? ss : 0.f);
        {
            const float rq = 1.0f / sqrtf(sq * (1.0f / 256.0f) + EPS), rkv = 1.0f / sqrtf(skv * (1.0f / 128.0f) + EPS);
            if (lane < 48) { const float r = lane < 32 ? rq : rkv;
                u32x4 o; o.x = pk_bf16(x[0] * r, x[1] * r); o.y = pk_bf16(x[2] * r, x[3] * r); o.z = pk_bf16(x[4] * r, x[5] * r); o.w = pk_bf16(x[6] * r, x[7] * r);
                *(u32x4*)(ZQ + (size_t)row * 512 + 8 * lane) = o; }
        }
        float y[8];
#pragma unroll
        for (int e = 0; e < 8; ++e) y[e] = __shfl_xor(x[e], 2);
        if (lane >= 48 && lane < 52) {
            const int pos = row_pos(row), i0 = 8 * (lane & 1);
            const f32x4 c0 = *(const f32x4*)(rc + pos * 16 + i0), c1 = *(const f32x4*)(rc + pos * 16 + i0 + 4);
            const f32x4 s0 = *(const f32x4*)(rsn + pos * 16 + i0), s1 = *(const f32x4*)(rsn + pos * 16 + i0 + 4);
            const float c[8] = {c0.x, c0.y, c0.z, c0.w, c1.x, c1.y, c1.z, c1.w}, s[8] = {s0.x, s0.y, s0.z, s0.w, s1.x, s1.y, s1.z, s1.w};
            float o[8];
            const bool first = lane < 50;
#pragma unroll
            for (int e = 0; e < 8; ++e) o[e] = first ? (x[e] * c[e] - y[e] * s[e]) : (x[e] * c[e] + y[e] * s[e]);
            u32x4 ow; ow.x = pk_bf16(o[0], o[1]); ow.y = pk_bf16(o[2], o[3]); ow.z = pk_bf16(o[4], o[5]); ow.w = pk_bf16(o[6], o[7]);
            *(u32x4*)(KR + (size_t)row * 32 + 8 * (lane - 48)) = ow;
        }
    }
}

constexpr int XC_PITCH = 272;
__device__ __forceinline__ void phase_lru(const Params& p, LAS unsigned char* lds) {
    const int tid = threadIdx.x, lane = tid & 63, wave = __builtin_amdgcn_readfirstlane(tid >> 6), g = lane >> 4, lc = lane & 15;
    const bf16_t* XL = (const bf16_t*)(p.ws + WS_XL); bf16_t* GY = (bf16_t*)(p.ws + WS_GY); bf16_t* HF = (bf16_t*)(p.ws + WS_F);
    const bf16_t* WG = (const bf16_t*)(p.ws + WS_WG);
    for (int item = blockIdx.x; item < 256; item += gridDim.x) {
        int gb, n;
        if (item < 128) { gb = 16 + (item >> 3); n = item & 7; } else { gb = (item - 128) >> 3; n = item & 7; }
        const int S = gb < 16 ? SP : SS; const int row0 = gb < 16 ? gb * SP : TP + (gb - 16) * SS;
        const int nch = S >> 6;
        const int tr = tid >> 4, cgp = (tid & 15) * 8, c0 = 128 * n + cgp;
        float cw[4][8], cb[8];
#pragma unroll
        for (int j = 0; j < 4; ++j) { const f32x4 a = *(const f32x4*)(p.in[16] + j * D + c0), b = *(const f32x4*)(p.in[16] + j * D + c0 + 4);
            cw[j][0] = a.x; cw[j][1] = a.y; cw[j][2] = a.z; cw[j][3] = a.w; cw[j][4] = b.x; cw[j][5] = b.y; cw[j][6] = b.z; cw[j][7] = b.w; }
        { const f32x4 a = *(const f32x4*)(p.in[17] + c0), b = *(const f32x4*)(p.in[17] + c0 + 4);
            cb[0] = a.x; cb[1] = a.y; cb[2] = a.z; cb[3] = a.w; cb[4] = b.x; cb[5] = b.y; cb[6] = b.z; cb[7] = b.w; }
        const int ch = 128 * n + 16 * wave + lc;
        for (int d = 0; d < 2; ++d) {
            bf16x8 Ba[4], Bi[4];
            { const bf16_t* wa = WG + (size_t)((d * 8 + n) * 2 + 0) * 16384 + (size_t)(16 * wave + lc) * 128 + 8 * g; const bf16_t* wi = wa + 16384;
#pragma unroll
              for (int ks = 0; ks < 4; ++ks) { Ba[ks] = *(const bf16x8*)(wa + 32 * ks); Bi[ks] = *(const bf16x8*)(wi + 32 * ks); } }
            const float ba = p.in[19][d * D + ch], bi = p.in[21][d * D + ch];
            const float lam = p.in[22][d * D + ch];
            const float c8 = -8.0f * log1pf(expf(-lam));
            const float nba = -1.4426950408889634f * ba, nbi = -1.4426950408889634f * bi, c8l = 1.4426950408889634f * c8;
#define BPERM(addr, v) __builtin_bit_cast(float, __builtin_amdgcn_ds_bpermute((addr), __builtin_bit_cast(int, (v))))
            const int bx16 = (lane ^ 16) << 2, bx32 = (lane ^ 32) << 2;
            const bool s1 = d ? !(g & 1) : (g & 1), s2 = d ? !(g >> 1) : (g >> 1);
            float carry = 0.f;
            u32x4 pw[2][4];
#define LRU_PREFETCH(CI) do { const int _cc = d ? (nch - 1 - (CI)) : (CI); _Pragma("unroll") for (int hf = 0; hf < 2; ++hf) _Pragma("unroll") for (int j = 0; j < 4; ++j) { \
                const int tt = _cc * 64 + tr + 32 * hf + j - 1; pw[hf][j] = (tt >= 0 && tt < S) ? *(const u32x4*)(XL + (size_t)(row0 + tt) * D + c0) : (u32x4){0u, 0u, 0u, 0u}; } } while (0)
            LRU_PREFETCH(0);
            for (int ci = 0; ci < nch; ++ci) {
                const int cc = d ? (nch - 1 - ci) : ci, t0 = cc * 64;
                __syncthreads();
#pragma unroll
                for (int hf = 0; hf < 2; ++hf) {
                    const int tl = tr + 32 * hf;
                    float a[8];
#pragma unroll
                    for (int e = 0; e < 8; ++e) a[e] = cb[e];
#pragma unroll
                    for (int j = 0; j < 4; ++j) { const u32x4 w = pw[hf][j];
                        a[0] += cw[j][0] * lo_bf(w.x); a[1] += cw[j][1] * hi_bf(w.x); a[2] += cw[j][2] * lo_bf(w.y); a[3] += cw[j][3] * hi_bf(w.y);
                        a[4] += cw[j][4] * lo_bf(w.z); a[5] += cw[j][5] * hi_bf(w.z); a[6] += cw[j][6] * lo_bf(w.w); a[7] += cw[j][7] * hi_bf(w.w); }
                    u32x4 o; o.x = pk_bf16(a[0], a[1]); o.y = pk_bf16(a[2], a[3]); o.z = pk_bf16(a[4], a[5]); o.w = pk_bf16(a[6], a[7]);
                    *(LAS u32x4*)(lds + tl * XC_PITCH + cgp * 2) = o;
                }
                __syncthreads();
                if (ci + 1 < nch) LRU_PREFETCH(ci + 1);
                float hfv[4][4], gyv[4][4];
                if (d == 1) {
                    const bf16_t* const hfi = HF + (size_t)(row0 + t0 + 4 * g) * D + ch; const bf16_t* const gyi = GY + (size_t)(row0 + t0 + 4 * g) * D + ch;
#pragma unroll
                    for (int mt = 0; mt < 4; ++mt)
#pragma unroll
                        for (int j = 0; j < 4; ++j) { hfv[mt][j] = bf2f(hfi[(16 * mt + j) * D]); gyv[mt][j] = bf2f(gyi[(16 * mt + j) * D]); }
                }
                f32x4 aa[4], ai[4];
#pragma unroll
                for (int mt = 0; mt < 4; ++mt) { aa[mt] = (f32x4){0.f, 0.f, 0.f, 0.f}; ai[mt] = (f32x4){0.f, 0.f, 0.f, 0.f}; }
#pragma unroll
                for (int ks = 0; ks < 4; ++ks)
#pragma unroll
                    for (int mt = 0; mt < 4; ++mt) { const bf16x8 A = *(const LAS bf16x8*)(lds + (16 * mt + lc) * XC_PITCH + (32 * ks + 8 * g) * 2);
                        aa[mt] = __builtin_amdgcn_mfma_f32_16x16x32_bf16(A, Ba[ks], aa[mt], 0, 0, 0);
                        ai[mt] = __builtin_amdgcn_mfma_f32_16x16x32_bf16(A, Bi[ks], ai[mt], 0, 0, 0); }
#pragma unroll
                for (int mt = 0; mt < 4; ++mt)
#pragma unroll
                    for (int j = 0; j < 4; ++j) {
                        const float xcv = bf2f(*(const LAS bf16_t*)(lds + (16 * mt + 4 * g + j) * XC_PITCH + (16 * wave + lc) * 2));
                        const float r = __builtin_amdgcn_rcpf(1.0f + __builtin_amdgcn_exp2f(__builtin_fmaf(aa[mt][j], -1.4426950408889634f, nba)));
                        const float ig = __builtin_amdgcn_rcpf(1.0f + __builtin_amdgcn_exp2f(__builtin_fmaf(ai[mt][j], -1.4426950408889634f, nbi)));
                        const float av = __builtin_amdgcn_exp2f(c8l * r), om = __builtin_fmaf(-av, av, 1.0f);
                        aa[mt][j] = av; ai[mt][j] = __builtin_amdgcn_sqrtf(om) * (ig * xcv);
                    }
#define LRU_COMBINE() \
                        const float A1 = BPERM(bx16, A), H1 = BPERM(bx16, Hs); \
                        const float PA = A * A1, PH = s1 ? (A * H1 + Hs) : (A1 * Hs + H1); \
                        const float exA = s1 ? A1 : 1.f, exH = s1 ? H1 : 0.f; \
                        const float A2 = BPERM(bx32, PA), H2 = BPERM(bx32, PH); \
                        const float TA = PA * A2, TH = s2 ? (PA * H2 + PH) : (A2 * PH + H2); \
                        const float Aex = s2 ? A2 * exA : exA, Hex = s2 ? (exA * H2 + exH) : exH; \
                        const float cin = Aex * carry + Hex; \
                        carry = TA * carry + TH;
                bf16_t* const hfo = HF + (size_t)(row0 + t0 + 4 * g) * D + ch;
                if (d == 0) {
#pragma unroll
                    for (int mt = 0; mt < 4; ++mt) {
                        float P = 1.f, Hh = 0.f, pl[4], hl[4];
#pragma unroll
                        for (int j = 0; j < 4; ++j) { Hh = aa[mt][j] * Hh + ai[mt][j]; P *= aa[mt][j]; hl[j] = Hh; pl[j] = P; }
                        const float A = P, Hs = Hh;
                        LRU_COMBINE()
#pragma unroll
                        for (int j = 0; j < 4; ++j) { const float h = hl[j] + pl[j] * cin;
                            hfo[(16 * mt + j) * D] = (bf16_t)(pk_bf16(h, 0.f) & 0xffffu); }
                    }
                } else {
                    bf16_t* const gyo = GY + (size_t)(row0 + t0 + 4 * g) * D + ch;
#pragma unroll
                    for (int mt = 3; mt >= 0; --mt) {
                        float P = 1.f, Hh = 0.f, pl[4], hl[4];
#pragma unroll
                        for (int j = 3; j >= 0; --j) { Hh = aa[mt][j] * Hh + ai[mt][j]; P *= aa[mt][j]; hl[j] = Hh; pl[j] = P; }
                        const float A = P, Hs = Hh;
                        LRU_COMBINE()
#pragma unroll
                        for (int j = 0; j < 4; ++j) { const float h = hl[j] + pl[j] * cin;
                            const float o = (hfv[mt][j] + h) * gyv[mt][j];
                            gyo[(16 * mt + j) * D] = (bf16_t)(pk_bf16(o, 0.f) & 0xffffu); }
                    }
                }
            }
        }
        __syncthreads();
    }
}

constexpr int AK_PITCH = 208, AV_PITCH = 160, AK_BYTES = 64 * AK_PITCH, AV_BYTES = 64 * AV_PITCH, ABUF = AK_BYTES + AV_BYTES;
__device__ __forceinline__ void phase_attn(const Params& p, LAS unsigned char* lds) {
    const int tid = threadIdx.x, lane = tid & 63, wave = __builtin_amdgcn_readfirstlane(tid >> 6), g = lane >> 4, lc = lane & 15;
    const bf16_t* Q = (const bf16_t*)(p.ws + WS_F); const bf16_t* KN = (const bf16_t*)(p.ws + WS_XL); const bf16_t* V = KN + (size_t)T * NKV;
    const bf16_t* KR = (const bf16_t*)(p.ws + WS_KR); bf16_t* O = (bf16_t*)(p.ws + WS_ZQ);
    const float csc = 0.10206207261596577f * 1.4426950408889634f;
    const int srow = tid >> 3, sch = tid & 7;
    const int rrow = (tid & 255) >> 2, rch = tid & 3;
    const int vtr = (4 * g + (lc >> 2)) * AV_PITCH + (4 * (lc & 3)) * 2;
    for (int unit = blockIdx.x; unit < 3072; unit += gridDim.x) {
        int gb, h, qt, S, row0;
        if (unit < 2048) { gb = 16 + (unit >> 7); h = (unit & 127) >> 4; qt = unit & 15; S = SS; row0 = TP + (gb - 16) * SS; }
        else { const int u2 = unit - 2048; gb = u2 >> 6; h = (u2 & 63) >> 3; qt = u2 & 7; S = SP; row0 = gb * SP; }
        const int nkt = S >> 6;
        const int qrow = row0 + 256 * qt + 32 * wave;
        bf16x8 qf[2][3];
#pragma unroll
        for (int q2 = 0; q2 < 2; ++q2)
#pragma unroll
            for (int ks = 0; ks < 3; ++ks) qf[q2][ks] = *(const bf16x8*)(Q + (size_t)(qrow + 16 * q2 + lc) * NQ + 96 * h + 32 * ks + 8 * g);
#pragma unroll
        for (int q2 = 0; q2 < 2; ++q2) {
            const int pos = row_pos(qrow + 16 * q2 + lc), i0 = 8 * (g & 1);
            const float* rc = (const float*)(p.ws + WS_ROPE) + pos * 16 + i0; const float* rsn = rc + SS * 16;
            const f32x4 c0 = *(const f32x4*)rc, c1 = *(const f32x4*)(rc + 4), s0 = *(const f32x4*)rsn, s1 = *(const f32x4*)(rsn + 4);
            const float cc[8] = {c0.x, c0.y, c0.z, c0.w, c1.x, c1.y, c1.z, c1.w}, sn[8] = {s0.x, s0.y, s0.z, s0.w, s1.x, s1.y, s1.z, s1.w};
            const u32x4 mine = __builtin_bit_cast(u32x4, qf[q2][2]);
            u32x4 oth; oth.x = __shfl_xor(mine.x, 32); oth.y = __shfl_xor(mine.y, 32); oth.z = __shfl_xor(mine.z, 32); oth.w = __shfl_xor(mine.w, 32);
            const float xm[8] = {lo_bf(mine.x), hi_bf(mine.x), lo_bf(mine.y), hi_bf(mine.y), lo_bf(mine.z), hi_bf(mine.z), lo_bf(mine.w), hi_bf(mine.w)};
            const float xo[8] = {lo_bf(oth.x), hi_bf(oth.x), lo_bf(oth.y), hi_bf(oth.y), lo_bf(oth.z), hi_bf(oth.z), lo_bf(oth.w), hi_bf(oth.w)};
            float o[8];
#pragma unroll
            for (int e = 0; e < 8; ++e) o[e] = g < 2 ? (xm[e] * cc[e] - xo[e] * sn[e]) : (xm[e] * cc[e] + xo[e] * sn[e]);
            u32x4 w; w.x = pk_bf16(o[0], o[1]); w.y = pk_bf16(o[2], o[3]); w.z = pk_bf16(o[4], o[5]); w.w = pk_bf16(o[6], o[7]);
            qf[q2][2] = __builtin_bit_cast(bf16x8, w);
        }
        f32x4 oacc[4][2];
#pragma unroll
        for (int dt = 0; dt < 4; ++dt) { oacc[dt][0] = (f32x4){0.f, 0.f, 0.f, 0.f}; oacc[dt][1] = (f32x4){0.f, 0.f, 0.f, 0.f}; }
        float mrun[2] = {-1e30f, -1e30f}, lrun[2] = {0.f, 0.f};
        u32x4 gk, gr, gv;
        gk = *(const u32x4*)(KN + (size_t)(row0 + srow) * NKV + 64 * h + 8 * sch);
        gv = *(const u32x4*)(V + (size_t)(row0 + srow) * NKV + 64 * h + 8 * sch);
        gr = *(const u32x4*)(KR + (size_t)(row0 + rrow) * 32 + 8 * rch);
        __syncthreads();
        *(LAS u32x4*)(lds + srow * AK_PITCH + sch * 16) = gk;
        *(LAS u32x4*)(lds + AK_BYTES + srow * AV_PITCH + sch * 16) = gv;
        if (tid < 256) *(LAS u32x4*)(lds + rrow * AK_PITCH + 128 + rch * 16) = gr;
        u32x4 gk2, gr2, gv2;
        gk = *(const u32x4*)(KN + (size_t)(row0 + 64 + srow) * NKV + 64 * h + 8 * sch);
        gv = *(const u32x4*)(V + (size_t)(row0 + 64 + srow) * NKV + 64 * h + 8 * sch);
        gr = *(const u32x4*)(KR + (size_t)(row0 + 64 + rrow) * 32 + 8 * rch);
        gk2 = *(const u32x4*)(KN + (size_t)(row0 + 128 + srow) * NKV + 64 * h + 8 * sch);
        gv2 = *(const u32x4*)(V + (size_t)(row0 + 128 + srow) * NKV + 64 * h + 8 * sch);
        gr2 = *(const u32x4*)(KR + (size_t)(row0 + 128 + rrow) * 32 + 8 * rch);
        __syncthreads();
#define ATT_BODY(kt, GK, GR, GV) do { \
            LAS unsigned char* kb = lds + ((kt) & 1) * ABUF; LAS unsigned char* vb = kb + AK_BYTES; \
            LAS unsigned char* nb = lds + (((kt) + 1) & 1) * ABUF; \
            const bool more = (kt) + 1 < nkt; \
 \
            f32x4 sacc[4][2]; \
            _Pragma("unroll") \
            for (int k4 = 0; k4 < 4; ++k4) { sacc[k4][0] = (f32x4){0.f, 0.f, 0.f, 0.f}; sacc[k4][1] = (f32x4){0.f, 0.f, 0.f, 0.f}; } \
            _Pragma("unroll") \
            for (int ks = 0; ks < 3; ++ks) \
            _Pragma("unroll") \
                for (int k4 = 0; k4 < 4; ++k4) { const bf16x8 kf = *(const LAS bf16x8*)(kb + (16 * k4 + lc) * AK_PITCH + (32 * ks + 8 * g) * 2); \
                    sacc[k4][0] = __builtin_amdgcn_mfma_f32_16x16x32_bf16(kf, qf[0][ks], sacc[k4][0], 0, 0, 0); \
                    sacc[k4][1] = __builtin_amdgcn_mfma_f32_16x16x32_bf16(kf, qf[1][ks], sacc[k4][1], 0, 0, 0); } \
            bf16x8 pf[2][2]; \
            _Pragma("unroll") \
            for (int q2 = 0; q2 < 2; ++q2) { \
                float mx = sacc[0][q2][0]; \
            _Pragma("unroll") \
                for (int k4 = 0; k4 < 4; ++k4) \
            _Pragma("unroll") \
                    for (int j = 0; j < 4; ++j) mx = fmaxf(mx, sacc[k4][q2][j]); \
                mx = fmaxf(mx, __shfl_xor(mx, 16)); mx = fmaxf(mx, __shfl_xor(mx, 32)); \
                const float mnew = fmaxf(mrun[q2], mx * csc); \
                const float alpha = __builtin_amdgcn_exp2f(mrun[q2] - mnew); \
                mrun[q2] = mnew; \
                float ps = 0.f; float pv[4][4]; \
            _Pragma("unroll") \
                for (int k4 = 0; k4 < 4; ++k4) \
            _Pragma("unroll") \
                    for (int j = 0; j < 4; ++j) { const float e = __builtin_amdgcn_exp2f(sacc[k4][q2][j] * csc - mnew); pv[k4][j] = e; ps += e; } \
                lrun[q2] = lrun[q2] * alpha + ps; \
            _Pragma("unroll") \
                for (int dt = 0; dt < 4; ++dt) oacc[dt][q2] *= alpha; \
            _Pragma("unroll") \
                for (int kk = 0; kk < 2; ++kk) { \
                    u32x4 w; w.x = pk_bf16(pv[2 * kk][0], pv[2 * kk][1]); w.y = pk_bf16(pv[2 * kk][2], pv[2 * kk][3]); \
                    w.z = pk_bf16(pv[2 * kk + 1][0], pv[2 * kk + 1][1]); w.w = pk_bf16(pv[2 * kk + 1][2], pv[2 * kk + 1][3]); \
                    pf[q2][kk] = __builtin_bit_cast(bf16x8, w); \
                } \
            } \
 \
            _Pragma("unroll") \
            for (int kk = 0; kk < 2; ++kk) \
            _Pragma("unroll") \
                for (int dt = 0; dt < 4; ++dt) { \
                    const v4i16_t lo = __builtin_amdgcn_ds_read_tr16_b64_v4i16((LAS v4i16_t*)(vb + vtr + (32 * kk) * AV_PITCH + 32 * dt)); \
                    const v4i16_t hi = __builtin_amdgcn_ds_read_tr16_b64_v4i16((LAS v4i16_t*)(vb + vtr + (32 * kk + 16) * AV_PITCH + 32 * dt)); \
                    const bf16x8 vf = {lo[0], lo[1], lo[2], lo[3], hi[0], hi[1], hi[2], hi[3]}; \
                    oacc[dt][0] = __builtin_amdgcn_mfma_f32_16x16x32_bf16(vf, pf[0][kk], oacc[dt][0], 0, 0, 0); \
                    oacc[dt][1] = __builtin_amdgcn_mfma_f32_16x16x32_bf16(vf, pf[1][kk], oacc[dt][1], 0, 0, 0); \
                } \
            if (more) { \
                *(LAS u32x4*)(nb + srow * AK_PITCH + sch * 16) = GK; \
                *(LAS u32x4*)(nb + AK_BYTES + srow * AV_PITCH + sch * 16) = GV; \
                if (tid < 256) *(LAS u32x4*)(nb + rrow * AK_PITCH + 128 + rch * 16) = GR; \
            } \
            if ((kt) + 3 < nkt) { const int kr0 = row0 + 64 * ((kt) + 3); \
                GK = *(const u32x4*)(KN + (size_t)(kr0 + srow) * NKV + 64 * h + 8 * sch); \
                GV = *(const u32x4*)(V + (size_t)(kr0 + srow) * NKV + 64 * h + 8 * sch); \
                GR = *(const u32x4*)(KR + (size_t)(kr0 + rrow) * 32 + 8 * rch); } \
            __syncthreads(); \
        } while (0)
        for (int kt2 = 0; kt2 < nkt; kt2 += 2) { ATT_BODY(kt2, gk, gr, gv); ATT_BODY(kt2 + 1, gk2, gr2, gv2); }
#undef ATT_BODY
#pragma unroll
        for (int q2 = 0; q2 < 2; ++q2) {
            float l = lrun[q2]; l += __shfl_xor(l, 16); l += __shfl_xor(l, 32);
            const float inv = 1.0f / l;
#pragma unroll
            for (int dt = 0; dt < 4; ++dt) { const f32x4 o = oacc[dt][q2] * inv;
                u32x2 w; w.x = pk_bf16(o[0], o[1]); w.y = pk_bf16(o[2], o[3]);
                *(u32x2*)(O + (size_t)(qrow + 16 * q2 + lc) * 512 + 64 * h + 16 * dt + 4 * g) = w; }
        }
    }
    __syncthreads();
}

#define XB_TMO      128
#define XB_XCNT(j)  (256  + 64 * (j))
#define XB_XSUB(j)  (1280 + 64 * (j))
#define XB_XGEN(j)  (2304 + 64 * (j))
#define XB_TOP      3328
#define XB_TOPGEN   3392
#define XCD_BAR_WORDS 3456
#define XB_SPIN_CAP (1u << 18)

__device__ __forceinline__ unsigned xb_ld(unsigned* p)              { return __hip_atomic_load(p, __ATOMIC_RELAXED, __HIP_MEMORY_SCOPE_AGENT); }
__device__ __forceinline__ unsigned xb_add(unsigned* p, unsigned v) { return __hip_atomic_fetch_add(p, v, __ATOMIC_RELAXED, __HIP_MEMORY_SCOPE_AGENT); }
__device__ __forceinline__ unsigned xb_xcc_id() { return (unsigned)__builtin_amdgcn_s_getreg((3 << 11) | 20) & 0xFu; }
#define XB_SPIN(cond, bar) do { unsigned _sp = 0; while (cond) { __builtin_amdgcn_s_sleep(1); \
    if ((++_sp & 255u) == 0u) { if (xb_ld(&(bar)[XB_TMO])) break; if (_sp > XB_SPIN_CAP) { atomicAdd(&(bar)[XB_TMO], 1u); break; } } } } while (0)

struct XcdBarrier {
    unsigned* bar; unsigned x;
    volatile LAS unsigned* st;
};

__device__ __forceinline__ XcdBarrier xcd_barrier_post(unsigned* bar, volatile LAS unsigned* st) {
    XcdBarrier b; b.bar = bar; b.x = xb_xcc_id(); b.st = st;
    if (threadIdx.x == 0) (void)xb_add(&bar[XB_XCNT(b.x)], 1u);
    return b;
}
__device__ __forceinline__ void xcd_barrier_complete(unsigned* bar, unsigned x, unsigned& nloc, unsigned& nx) {
    const unsigned G = gridDim.x * gridDim.y * gridDim.z;
    unsigned sum, cnt, mine, sp = 0u;
    for (;;) {
        sum = 0u; cnt = 0u; mine = 0u;
#pragma unroll
        for (unsigned j = 0; j < 16; ++j) { const unsigned c = xb_ld(&bar[XB_XCNT(j)]); sum += c; cnt += (c > 0u) ? 1u : 0u; mine = (j == x) ? c : mine; }
        if (sum == G) break;
        __builtin_amdgcn_s_sleep(1);
        if ((++sp & 255u) == 0u) { if (xb_ld(&bar[XB_TMO])) break; if (sp > XB_SPIN_CAP) { atomicAdd(&bar[XB_TMO], 1u); break; } }
    }
    nloc = mine > 0u ? mine : 1u; nx = cnt > 0u ? cnt : 1u;
}

__device__ __forceinline__ void xcd_barrier(const XcdBarrier& b) {
    asm volatile("s_waitcnt vmcnt(0)" ::: "memory");
    __syncthreads();
    if (threadIdx.x == 0) {
        unsigned* bar = b.bar;
        __builtin_amdgcn_s_waitcnt(0);
        unsigned nloc = b.st[0], nx = b.st[1];
        if (nloc == 0u) { xcd_barrier_complete(bar, b.x, nloc, nx); b.st[0] = nloc; b.st[1] = nx; }
        const unsigned old = xb_add(&bar[XB_XSUB(b.x)], 1u);
        const unsigned gen = old / nloc;
        if (old + 1u == (gen + 1u) * nloc) {
            __builtin_amdgcn_fence(__ATOMIC_RELEASE, "agent");
            asm volatile("s_waitcnt vmcnt(0)" ::: "memory");
            const unsigned og = xb_add(&bar[XB_TOP], 1u);
            const unsigned tg = og / nx;
            if (og + 1u == (tg + 1u) * nx) xb_add(&bar[XB_TOPGEN], 1u);
            else XB_SPIN(xb_ld(&bar[XB_TOPGEN]) == tg, bar);
            __builtin_amdgcn_fence(__ATOMIC_ACQUIRE, "agent");
            xb_add(&bar[XB_XGEN(b.x)], 1u);
            asm volatile("s_waitcnt vmcnt(0)" ::: "memory");
        } else {
            XB_SPIN(xb_ld(&bar[XB_XGEN(b.x)]) == gen, bar);
            __builtin_amdgcn_fence(__ATOMIC_ACQUIRE, "agent");
            asm volatile("s_waitcnt vmcnt(0)" ::: "memory");
        }
    }
    __syncthreads();
}


constexpr int NPHASES = 16;
__global__ void __launch_bounds__(NTHREADS, 2) mega_fwd(Params p) {
    extern __shared__ __attribute__((aligned(16))) unsigned char lds_raw[];
    LAS unsigned char* lds = (LAS unsigned char*)lds_raw;
    cg::grid_group grid = cg::this_grid();
    unsigned char* ws = p.ws;
    const int G = gridDim.x, bid = blockIdx.x;
    bf16_t* Hb = (bf16_t*)(ws + WS_H); bf16_t* Fb = (bf16_t*)(ws + WS_F); bf16_t* ACT = (bf16_t*)(ws + WS_ACT);
    bf16_t* ZQ = (bf16_t*)(ws + WS_ZQ); bf16_t* XL = (bf16_t*)(ws + WS_XL); bf16_t* GY = (bf16_t*)(ws + WS_GY);
#ifndef TESTPH
#define TESTPH -1
#endif
#define IN(k) ((TESTPH < 0 || (k) == TESTPH) && p.ph_lo <= (k) && (k) < p.ph_hi)
#define SEAM0() do { if (IN(0) && IN(1)) { __builtin_amdgcn_fence(__ATOMIC_RELEASE, "agent"); asm volatile("s_waitcnt vmcnt(0) lgkmcnt(0)" ::: "memory"); \
        grid.sync(); __builtin_amdgcn_fence(__ATOMIC_ACQUIRE, "agent"); asm volatile("s_waitcnt vmcnt(0) lgkmcnt(0)" ::: "memory"); \
        xb = xcd_barrier_post((unsigned*)(p.ws + WS_XBAR), xbst); } } while (0)
#define SEAM(k) do { if (IN(k) && IN((k) + 1)) xcd_barrier(xb); } while (0)
    volatile LAS unsigned* xbst = (volatile LAS unsigned*)(lds + LDS_BYTES - 16);
    if (threadIdx.x < 4) xbst[threadIdx.x] = 0u;
    __syncthreads();
    XcdBarrier xb; xb.bar = (unsigned*)(p.ws + WS_XBAR); xb.x = 0; xb.st = xbst;
    if (IN(0)) { if (bid == 0) { unsigned* xw = (unsigned*)(p.ws + WS_XBAR); for (int i = threadIdx.x; i < XCD_BAR_WORDS; i += NTHREADS) xw[i] = 0u; }
        phase_prep(p, lds); }
    SEAM0();
    if (IN(1)) phase_rows<false, true>(p, 0, 0, 0.f, true);
    SEAM(1);
#define FFN_PHASES(ffn, pb) do { \
        if (IN(pb)) { \
            pg8::Gemm g{Hb, (const bf16_t*)(ws + ((ffn) ? WS_WGU2 : WS_WGU1)), D, D}; pg8::StaticOrder S; S.init(T, 2 * DFF, G, bid); \
            pg8::EpiSwiglu E{ACT, DFF}; \
            GEMM_PHASE(pg8::EpiSwiglu, lds, g, S, E); \
        } \
        SEAM(pb); \
        if (IN((pb) + 1)) { \
            pg8::Gemm g{ACT, (const bf16_t*)(ws + ((ffn) ? WS_WDN2 : WS_WDN1)), DFF, DFF}; pg8::StaticOrder S; S.init(T, D, G, bid); \
            pg8::EpiAct<0> E{Fb, D, 0}; \
            GEMM_PHASE(pg8::EpiAct<0>, lds, g, S, E); \
        } \
        SEAM((pb) + 1); } while (0)
    FFN_PHASES(0, 2);
        if (IN(4)) phase_rows<true, true>(p, 0, 1, 0.5f, true);
        SEAM(4);
        if (IN(5)) {
            pg8::Gemm g{Hb, (const bf16_t*)(ws + WS_WINA), D, D}; pg8::StaticOrder S; S.init(T, 2560, G, bid);
            pg8::EpiWinA E{ZQ, XL, GY};
            GEMM_PHASE(pg8::EpiWinA, lds, g, S, E);
        }
        SEAM(5);
        if (IN(6)) { phase_lru(p, lds); if (bid >= G / 2) phase_stats(p, G / 2, G - G / 2);     }
        SEAM(6);
        if (IN(7)) {
            pg8::Gemm g{ZQ, (const bf16_t*)(ws + WS_WQKV), 512, 384}; pg8::StaticOrder S; S.init(T, 1792, G, bid);
            pg8::EpiQKV E{Fb, XL};
            GEMM_PHASE2(pg8::EpiQKV, lds, g, S, E);
        }
        SEAM(7);
        if (IN(8)) phase_attn(p, lds);
        SEAM(8);
        if (IN(9)) {
            pg8::Gemm g{Hb, (const bf16_t*)(ws + WS_WINB), D, D}; pg8::StaticOrder S; S.init(T, 2048, G, bid);
            pg8::EpiWinB E{Fb, XL};
            GEMM_PHASE(pg8::EpiWinB, lds, g, S, E);
        }
        SEAM(9);
        if (IN(10)) {
            { pg8::Gemm g{ZQ, (const bf16_t*)(ws + WS_WAO), 512, 512}; pg8::StaticOrder S; S.init(T, D, G, bid);
              pg8::EpiGate<false> E{Fb, nullptr, Fb};
              GEMM_PHASE(pg8::EpiGate<false>, lds, g, S, E); }
            { pg8::Gemm g{GY, (const bf16_t*)(ws + WS_WLO), D, D}; pg8::StaticOrder S; S.init(T, D, G, bid);
              pg8::EpiGate<true> E{XL, Fb, XL};
              GEMM_PHASE(pg8::EpiGate<true>, lds, g, S, E); }
        }
        SEAM(10);
        if (IN(11)) {
            pg8::Gemm g{XL, (const bf16_t*)(ws + WS_WOUT), D, D}; pg8::StaticOrder S; S.init(T, D, G, bid);
            pg8::EpiAct<0> E{Fb, D, 0};
            GEMM_PHASE(pg8::EpiAct<0>, lds, g, S, E);
        }
        SEAM(11);
        if (IN(12)) phase_rows<true, true>(p, 1, 2, 1.0f, false);
        SEAM(12);
    FFN_PHASES(1, 13);
    if (IN(15)) phase_rows<true, false>(p, 2, 0, 0.5f, false);
#undef IN
#undef SEAM
}

extern "C" void kernel_launch(void* const* d_in, const int* in_sizes, int n_in, void* d_out, int out_size, void* d_ws, size_t ws_size, hipStream_t stream) {
    static int grid = 0;
    if (grid == 0) {
        if (n_in != 27 || out_size != T * D || ws_size < WS_END) { fprintf(stderr, "kernel_launch: unexpected shapes: n_in %d out %d ws %zu (need >= %zu)\n", n_in, out_size, ws_size, (size_t)WS_END); grid = -1; return; }
        int dev = 0, cus = 0, per_cu = 0;
        (void)hipGetDevice(&dev);
        (void)hipDeviceGetAttribute(&cus, hipDeviceAttributeMultiprocessorCount, dev);
        if (hipFuncSetAttribute((const void*)mega_fwd, hipFuncAttributeMaxDynamicSharedMemorySize, LDS_BYTES) != hipSuccess) { fprintf(stderr, "kernel_launch: hipFuncSetAttribute failed\n"); grid = -1; return; }
        if (hipOccupancyMaxActiveBlocksPerMultiprocessor(&per_cu, (const void*)mega_fwd, NTHREADS, LDS_BYTES) != hipSuccess || per_cu < 1) { fprintf(stderr, "kernel_launch: occupancy query failed (%d)\n", per_cu); per_cu = 1; }
        (void)hipGetLastError();
        grid = cus;
        fprintf(stderr, "kernel_launch: grid %d (per_cu %d)\n", grid, per_cu);
    }
    if (grid < 0) return;
    Params p{};
    for (int i = 0; i < 27; ++i) p.in[i] = (const float*)d_in[i];
    p.out = (float*)d_out; p.ws = (unsigned char*)d_ws;
#if defined(MK_SPLIT)
    for (int ph = 0; ph < NPHASES; ++ph) { p.ph_lo = ph; p.ph_hi = ph + 1;
        hipLaunchKernelGGL(mega_fwd, dim3(grid), dim3(NTHREADS), LDS_BYTES, stream, p); }
#else
    p.ph_lo = 0; p.ph_hi = NPHASES;
    void* args[] = {&p};
    hipError_t e = hipLaunchCooperativeKernel((const void*)mega_fwd, dim3(grid), dim3(NTHREADS), args, LDS_BYTES, stream);
    if (e != hipSuccess) fprintf(stderr, "kernel_launch: cooperative launch failed: %s (grid %d)\n", hipGetErrorString(e), grid);
#endif
}
```

```cpp
#include <hip/hip_runtime.h>
#include <hip/hip_cooperative_groups.h>
#include <cstdio>
#include <cstdint>
namespace cg = cooperative_groups;
#ifndef MK_SP2_ALL
#define MK_SP2_ALL false
#endif

#define LAS __attribute__((address_space(3)))
typedef unsigned short bf16_t;
typedef short bf16x8 __attribute__((ext_vector_type(8)));
typedef short v4i16_t __attribute__((ext_vector_type(4)));
typedef float f32x4 __attribute__((ext_vector_type(4)));
typedef float f32x2 __attribute__((ext_vector_type(2)));
typedef unsigned u32x4 __attribute__((ext_vector_type(4)));
typedef unsigned u32x2 __attribute__((ext_vector_type(2)));

constexpr int D = 1024, DFF = 2816, TP = 32768, TS = 65536, T = TP + TS, SP = 2048, SS = 4096;
constexpr int NQ = 768, NKV = 512;
constexpr float EPS = 1e-6f;
constexpr int NTHREADS = 512, NWAVES = 8;

constexpr size_t KiB = 1024, MiB = 1024 * 1024;
constexpr size_t WS_WGU1 = 0, WS_WDN1 = 11 * MiB, WS_WINA = 16 * MiB + 512 * KiB, WS_WINB = 21 * MiB + 512 * KiB, WS_WQKV = 25 * MiB + 512 * KiB,
                 WS_WAO = 27 * MiB, WS_WLO = 28 * MiB, WS_WOUT = 30 * MiB, WS_WGU2 = 32 * MiB, WS_WDN2 = 43 * MiB, WS_WG = 48 * MiB + 512 * KiB,
                 WS_MOD = 49 * MiB + 512 * KiB, WS_ROPE = 50 * MiB + 768 * KiB, WS_STATS = 51 * MiB + 256 * KiB, WS_KR = 52 * MiB;
constexpr size_t WS_XBAR = 50 * MiB + 640 * KiB;
constexpr size_t WS_H = 64 * MiB, WS_F = 256 * MiB, WS_BIG = 448 * MiB;
constexpr size_t WS_ZQ = WS_BIG, WS_XL = WS_BIG + 96 * MiB, WS_GY = WS_BIG + 288 * MiB, WS_ACT = WS_BIG, WS_END = 976 * MiB;
constexpr int LDS_BYTES = 139264;

struct Params { const float* in[27]; float* out; unsigned char* ws; int ph_lo, ph_hi; };

typedef __bf16 bf16x2_t __attribute__((ext_vector_type(2)));
__device__ __forceinline__ unsigned pk_bf16(float lo, float hi) { const f32x2 v = {lo, hi}; const bf16x2_t b = __builtin_convertvector(v, bf16x2_t); return __builtin_bit_cast(unsigned, b); }
__device__ __forceinline__ float lo_bf(unsigned w) { return __uint_as_float(w << 16); }
__device__ __forceinline__ float hi_bf(unsigned w) { return __uint_as_float(w & 0xffff0000u); }
__device__ __forceinline__ float bf2f(bf16_t h) { return __uint_as_float((unsigned)h << 16); }
__device__ __forceinline__ float fexp(float x) { return __builtin_amdgcn_exp2f(x * 1.4426950408889634f); }
__device__ __forceinline__ float fsigmoid(float x) { return __builtin_amdgcn_rcpf(1.0f + fexp(-x)); }
__device__ __forceinline__ float fsilu(float x) { return x * fsigmoid(x); }
__device__ __forceinline__ float fgelu(float x) { return x * fsigmoid(1.5957691216057308f * (x + 0.044715f * x * x * x)); }
__device__ __forceinline__ float wave_sum(float v) {
#pragma unroll
    for (int o = 1; o < 64; o <<= 1) v += __shfl_xor(v, o);
    return v;
}
__device__ __forceinline__ int row_batch(int row) { return row < TP ? (row >> 11) : 16 + ((row - TP) >> 12); }
__device__ __forceinline__ int row_pos(int row) { return row < TP ? (row & (SP - 1)) : ((row - TP) & (SS - 1)); }

namespace pg8 {
constexpr int BM = 256, BK = 64, HALF = 128, HTB = HALF * BK * 2, STAGE_BYTES = 8 * HTB, NXCD = 8, WGM = 8;
__host__ __device__ __forceinline__ int lds_byte(int r, int c) { const int st = (r >> 4) * 2 + (c >> 5), rr = r & 15, cc = c & 31, ob = rr * 64 + cc * 2; return st * 1024 + (ob ^ (((ob >> 9) & 1) << 5)); }
__host__ __device__ __forceinline__ void stage_rc(int b, int& R, int& C) { const int st = b / 1024, sb = b % 1024, swz = sb ^ (((sb >> 9) & 1) << 5); R = (st >> 1) * 16 + swz / 64; C = (st & 1) * 32 + (swz % 64) / 2; }
__host__ __device__ __forceinline__ int perm32(int rho) { const int n = rho >> 4, i = rho & 15; return 8 * (i >> 2) + 4 * n + (i & 3); }

struct Unit { int pm, pn; };
struct Gemm { const bf16_t* A; const bf16_t* Bt; int lda, K; };

struct StaticOrder {
    int nM, nN, nwg, G, c;
    __device__ void init(int M, int N, int G_, int c_) { nM = M / BM; nN = N / BM; nwg = nM * nN; G = G_; c = c_; }
    __device__ bool next(int i, Unit& u) const {
        const long L = (long)i * G + c; if (L >= nwg) return false;
        int wgid = (int)L; { const int q = nwg / NXCD, r = nwg % NXCD, xcd = wgid % NXCD, off = wgid / NXCD; wgid = (xcd < r ? xcd * (q + 1) : r * (q + 1) + (xcd - r) * q) + off; }
        const int nig = WGM * nN, gid = wgid / nig, fm = gid * WGM, gsz = (nM - fm) < WGM ? (nM - fm) : WGM;
        u.pm = fm + ((wgid % nig) % gsz); u.pn = (wgid % nig) / gsz; return true;
    }
};

template <class Epi, bool SP2 = false>
__device__ __forceinline__ void gemm_phase(LAS unsigned char* lds, const Gemm g, const StaticOrder& S, const Epi& E) {
    const int tid = threadIdx.x, wid = __builtin_amdgcn_readfirstlane(tid >> 6), lane = tid & 63, wr = wid >> 2, wc = wid & 3, fr = lane & 15, fq = lane >> 4;
    const int K = g.K, nt = K / BK, lda = g.lda;
    unsigned voffA[2], voffB[2];
#pragma unroll
    for (int i = 0; i < 2; ++i) { int R, C; stage_rc(tid * 16 + i * 8192, R, C); const int Rb = Epi::PERM ? ((R & ~31) + perm32(R & 31)) : R;
        voffA[i] = (unsigned)(R * lda + C) * 2u; voffB[i] = (unsigned)(Rb * K + C) * 2u; }
    const size_t kstep = (size_t)(BK * 2);
    const size_t hstepA = (size_t)HALF * lda * 2, hstepB = (size_t)HALF * K * 2;
    const size_t tstepA = 2 * hstepA, tstepB = 2 * hstepB;
    const unsigned ldsw = (unsigned)wid * 1024u;
    const int aoff = lds_byte(wr * 64 + fr, fq * 8), boff = lds_byte(wc * 32 + fr, fq * 8);
#define PG8_SA(b, h) (((b) * 2 + (h)) * HTB)
#define PG8_SB(b, h) ((4 + (b) * 2 + (h)) * HTB)
#define PG8_STAGE(bufoff, gbase, voff) do { _Pragma("unroll") for (int _i = 0; _i < 2; ++_i) \
        __builtin_amdgcn_global_load_lds((const unsigned*)((const char*)(gbase) + (voff)[_i]), (LAS unsigned*)(lds + (bufoff) + ldsw + _i * 8192), 16, 0, 0); } while (0)
#define PG8_LDA(dst, b, h) do { _Pragma("unroll") for (int m = 0; m < 4; ++m) _Pragma("unroll") for (int k = 0; k < 2; ++k) dst[m][k] = *(const LAS bf16x8*)(lds + PG8_SA(b, h) + aoff + m * 2048 + k * 1024); } while (0)
#define PG8_LDB(dst, b, h) do { _Pragma("unroll") for (int n = 0; n < 2; ++n) _Pragma("unroll") for (int k = 0; k < 2; ++k) dst[n][k] = *(const LAS bf16x8*)(lds + PG8_SB(b, h) + boff + n * 2048 + k * 1024); } while (0)
#define PG8_MMA(ai, bj, At, Bt) do { __builtin_amdgcn_s_setprio(1); _Pragma("unroll") for (int m = 0; m < 4; ++m) _Pragma("unroll") for (int n = 0; n < 2; ++n) _Pragma("unroll") for (int k = 0; k < 2; ++k) \
        acc[ai][bj][m][n] = __builtin_amdgcn_mfma_f32_16x16x32_bf16(Bt[n][k], At[m][k], acc[ai][bj][m][n], 0, 0, 0); __builtin_amdgcn_s_setprio(0); } while (0)
#define PG8_WAIT_V(n) asm volatile("s_waitcnt vmcnt(" #n ")" ::: "memory")
#define PG8_WAIT_L(n) asm volatile("s_waitcnt lgkmcnt(" #n ")" ::: "memory")
#define PG8_BAR __builtin_amdgcn_s_barrier()
#define PG8_SCHED __builtin_amdgcn_sched_barrier(0)
    Unit cur, nxt; int ui = 0;
    if (!S.next(0, cur)) return;
    f32x4 acc[2][2][4][2];
#pragma unroll
    for (int a = 0; a < 2; ++a)
#pragma unroll
        for (int b = 0; b < 2; ++b)
#pragma unroll
            for (int m = 0; m < 4; ++m)
#pragma unroll
                for (int n = 0; n < 2; ++n) acc[a][b][m][n] = (f32x4){0.f, 0.f, 0.f, 0.f};
    bf16x8 At[4][2], B0[2][2], B1[2][2];
    const char* cA = (const char*)g.A + (size_t)cur.pm * tstepA; const char* cB = (const char*)g.Bt + (size_t)cur.pn * tstepB;
    if constexpr (SP2) {
        PG8_STAGE(PG8_SB(0, 0), cB, voffB); PG8_STAGE(PG8_SB(0, 1), cB + hstepB, voffB); PG8_STAGE(PG8_SA(0, 0), cA, voffA); PG8_STAGE(PG8_SA(0, 1), cA + hstepA, voffA);
        if (wr == 1) PG8_BAR;
        PG8_WAIT_V(2); PG8_BAR;
        PG8_STAGE(PG8_SB(1, 0), cB + kstep, voffB); PG8_STAGE(PG8_SA(1, 0), cA + kstep, voffA); PG8_STAGE(PG8_SB(1, 1), cB + hstepB + kstep, voffB);
        PG8_WAIT_V(6); PG8_BAR;
    } else {
    PG8_STAGE(PG8_SB(0, 0), cB, voffB); PG8_STAGE(PG8_SA(0, 0), cA, voffA); PG8_STAGE(PG8_SB(0, 1), cB + hstepB, voffB); PG8_STAGE(PG8_SA(0, 1), cA + hstepA, voffA);
    if (wr == 1) PG8_BAR;
    PG8_WAIT_V(4); PG8_BAR;
    PG8_STAGE(PG8_SB(1, 0), cB + kstep, voffB); PG8_STAGE(PG8_SA(1, 0), cA + kstep, voffA); PG8_STAGE(PG8_SB(1, 1), cB + hstepB + kstep, voffB);
    PG8_WAIT_V(6); PG8_BAR;
    }
    for (;;) {
        const bool has_next = S.next(ui + 1, nxt);
        const char* nA = has_next ? (const char*)g.A + (size_t)nxt.pm * tstepA : cA; const char* nB = has_next ? (const char*)g.Bt + (size_t)nxt.pn * tstepB : cB;
        for (int t = 0; t < nt; t += 2) {
            const bool last = (t == nt - 2);
            const char* a1 = cA + (size_t)(t + 1) * kstep;
            const char* a2 = last ? nA : cA + (size_t)(t + 2) * kstep; const char* b2 = last ? nB : cB + (size_t)(t + 2) * kstep;
            const char* a3 = a2 + kstep; const char* b3 = b2 + kstep;
            if constexpr (SP2) {
            PG8_LDB(B0, 0, 0); PG8_LDB(B1, 0, 1); PG8_SCHED; PG8_LDA(At, 0, 0); PG8_STAGE(PG8_SA(1, 1), a1 + hstepA, voffA);
            PG8_WAIT_V(8); PG8_WAIT_L(0); PG8_BAR; PG8_MMA(0, 0, At, B0); PG8_MMA(0, 1, At, B1); PG8_BAR; PG8_SCHED;
            PG8_LDA(At, 0, 1); PG8_STAGE(PG8_SB(0, 0), b2, voffB); PG8_STAGE(PG8_SB(0, 1), b2 + hstepB, voffB); PG8_STAGE(PG8_SA(0, 0), a2, voffA);
            PG8_WAIT_V(8); PG8_WAIT_L(0); PG8_BAR; PG8_MMA(1, 0, At, B0); PG8_MMA(1, 1, At, B1); PG8_BAR; PG8_SCHED;
            PG8_LDB(B0, 1, 0); PG8_LDB(B1, 1, 1); PG8_SCHED; PG8_LDA(At, 1, 0); PG8_STAGE(PG8_SA(0, 1), a2 + hstepA, voffA);
            PG8_WAIT_V(8); PG8_WAIT_L(0); PG8_BAR; PG8_MMA(0, 0, At, B0); PG8_MMA(0, 1, At, B1); PG8_BAR; PG8_SCHED;
            PG8_LDA(At, 1, 1); PG8_STAGE(PG8_SB(1, 0), b3, voffB); PG8_STAGE(PG8_SB(1, 1), b3 + hstepB, voffB); PG8_STAGE(PG8_SA(1, 0), a3, voffA);
            PG8_WAIT_V(8); PG8_WAIT_L(0); PG8_BAR; PG8_MMA(1, 0, At, B0); PG8_MMA(1, 1, At, B1); PG8_BAR; PG8_SCHED;
            } else {
            PG8_LDB(B0, 0, 0); PG8_SCHED; PG8_LDA(At, 0, 0); PG8_STAGE(PG8_SA(1, 1), a1 + hstepA, voffA);
            PG8_WAIT_L(8); PG8_BAR; PG8_WAIT_L(0); PG8_MMA(0, 0, At, B0); PG8_BAR; PG8_SCHED;
            PG8_LDB(B1, 0, 1); PG8_STAGE(PG8_SB(0, 0), b2, voffB);
            PG8_BAR; PG8_WAIT_L(0); PG8_MMA(0, 1, At, B1); PG8_BAR;
            PG8_LDA(At, 0, 1); PG8_STAGE(PG8_SA(0, 0), a2, voffA);
            PG8_BAR; PG8_WAIT_L(0); PG8_MMA(1, 0, At, B0); PG8_BAR; PG8_SCHED;
            PG8_STAGE(PG8_SB(0, 1), b2 + hstepB, voffB);
            PG8_WAIT_V(6); PG8_BAR; PG8_MMA(1, 1, At, B1); PG8_BAR;
            PG8_LDB(B0, 1, 0); PG8_SCHED; PG8_LDA(At, 1, 0); PG8_STAGE(PG8_SA(0, 1), a2 + hstepA, voffA);
            PG8_WAIT_L(8); PG8_BAR; PG8_WAIT_L(0); PG8_MMA(0, 0, At, B0); PG8_BAR; PG8_SCHED;
            PG8_LDB(B1, 1, 1); PG8_STAGE(PG8_SB(1, 0), b3, voffB);
            PG8_BAR; PG8_WAIT_L(0); PG8_MMA(0, 1, At, B1); PG8_BAR;
            PG8_LDA(At, 1, 1); PG8_STAGE(PG8_SA(1, 0), a3, voffA);
            PG8_BAR; PG8_WAIT_L(0); PG8_MMA(1, 0, At, B0); PG8_BAR; PG8_SCHED;
            PG8_STAGE(PG8_SB(1, 1), b3 + hstepB, voffB);
            PG8_WAIT_V(6); PG8_BAR; PG8_MMA(1, 1, At, B1); PG8_BAR;
            }
        }
        if constexpr (SP2) { if (wr == 0) PG8_BAR; }
        { int el; asm volatile("v_mbcnt_lo_u32_b32 %0, -1, 0\n\tv_mbcnt_hi_u32_b32 %0, -1, %0" : "=v"(el)); E(acc, cur, wr, wc, el & 15, el >> 4); }
        if (!has_next) break;
#pragma unroll
        for (int a = 0; a < 2; ++a)
#pragma unroll
            for (int b = 0; b < 2; ++b)
#pragma unroll
                for (int m = 0; m < 4; ++m)
#pragma unroll
                    for (int n = 0; n < 2; ++n) acc[a][b][m][n] = (f32x4){0.f, 0.f, 0.f, 0.f};
        cur = nxt; cA = nA; cB = nB; ++ui;
        if constexpr (SP2) { if (wr == 1) PG8_BAR; }
    }
    PG8_WAIT_V(0);
    if constexpr (!SP2) { if (wr == 0) PG8_BAR; }
    PG8_BAR;
#undef PG8_SA
#undef PG8_SB
#undef PG8_STAGE
#undef PG8_LDA
#undef PG8_LDB
#undef PG8_MMA
#undef PG8_WAIT_V
#undef PG8_WAIT_L
#undef PG8_BAR
#undef PG8_SCHED
}

#if defined(MK_SIMPLE_GEMM)
template <class Epi>
__device__ __forceinline__ void gemm_phase_simple(const Gemm g, const StaticOrder& S, const Epi& E) {
    const int tid = threadIdx.x, wid = __builtin_amdgcn_readfirstlane(tid >> 6), lane = tid & 63, wr = wid >> 2, wc = wid & 3, fr = lane & 15, fq = lane >> 4;
    Unit cur;
    for (int ui = 0; S.next(ui, cur); ++ui) {
        f32x4 acc[2][2][4][2];
#pragma unroll
        for (int a = 0; a < 2; ++a)
#pragma unroll
            for (int b = 0; b < 2; ++b)
#pragma unroll
                for (int m = 0; m < 4; ++m)
#pragma unroll
                    for (int n = 0; n < 2; ++n) acc[a][b][m][n] = (f32x4){0.f, 0.f, 0.f, 0.f};
        for (int k0 = 0; k0 < g.K; k0 += 32) {
            bf16x8 bf[2][2];
#pragma unroll
            for (int bj = 0; bj < 2; ++bj)
#pragma unroll
                for (int n = 0; n < 2; ++n) { const int slot = 16 * n + fr; const int wrow = cur.pn * BM + bj * HALF + wc * 32 + (Epi::PERM ? perm32(slot) : slot);
                    bf[bj][n] = *(const bf16x8*)(g.Bt + (size_t)wrow * g.K + k0 + 8 * fq); }
#pragma unroll
            for (int ai = 0; ai < 2; ++ai)
#pragma unroll
                for (int m = 0; m < 4; ++m) { const int arow = cur.pm * BM + ai * HALF + wr * 64 + m * 16 + fr;
                    const bf16x8 af = *(const bf16x8*)(g.A + (size_t)arow * g.lda + k0 + 8 * fq);
#pragma unroll
                    for (int bj = 0; bj < 2; ++bj)
#pragma unroll
                        for (int n = 0; n < 2; ++n) acc[ai][bj][m][n] = __builtin_amdgcn_mfma_f32_16x16x32_bf16(bf[bj][n], af, acc[ai][bj][m][n], 0, 0, 0); }
        }
        E(acc, cur, wr, wc, fr, fq);
    }
}
#define GEMM_PHASE(EPI, lds, g, S, E) pg8::gemm_phase_simple<EPI>(g, S, E)
#define GEMM_PHASE2(EPI, lds, g, S, E) pg8::gemm_phase_simple<EPI>(g, S, E)
#else
#define GEMM_PHASE(EPI, lds, g, S, E) pg8::gemm_phase<EPI, true>(lds, g, S, E)
#define GEMM_PHASE2(EPI, lds, g, S, E) pg8::gemm_phase<EPI, false>(lds, g, S, E)
#endif
struct EpiSwiglu {
    static constexpr bool PERM = true;
    bf16_t* O; int ldc;
    __device__ __forceinline__ void operator()(const f32x4 (&acc)[2][2][4][2], const Unit& u, int wr, int wc, int fr, int fq) const {
        const int row0 = u.pm * BM + wr * 64 + fr, col0 = u.pn * 128 + wc * 32 + 8 * fq;
#pragma unroll
        for (int ai = 0; ai < 2; ++ai)
#pragma unroll
            for (int m = 0; m < 4; ++m) {
                bf16_t* rowp = O + (size_t)(row0 + ai * HALF + m * 16) * ldc + col0;
                const f32x4 g0 = acc[ai][0][m][0], g1 = acc[ai][0][m][1], u0 = acc[ai][1][m][0], u1 = acc[ai][1][m][1];
                float v[8];
#pragma unroll
                for (int j = 0; j < 4; ++j) { v[j] = fsilu(g0[j]) * u0[j]; v[4 + j] = fsilu(g1[j]) * u1[j]; }
                u32x4 w; w.x = pk_bf16(v[0], v[1]); w.y = pk_bf16(v[2], v[3]); w.z = pk_bf16(v[4], v[5]); w.w = pk_bf16(v[6], v[7]);
                *(u32x4*)rowp = w;
                asm volatile("" ::: "memory");
            }
    }
};
__device__ __forceinline__ void store_tile_bf16(const f32x4 (&acc)[2][2][4][2], bf16_t* base, int ld, int row0, int col0, int act) {
#pragma unroll
    for (int ai = 0; ai < 2; ++ai)
#pragma unroll
        for (int m = 0; m < 4; ++m) {
            bf16_t* rowp = base + (size_t)(row0 + ai * HALF + m * 16) * ld + col0;
#pragma unroll
            for (int bj = 0; bj < 2; ++bj) {
                f32x4 v0 = acc[ai][bj][m][0], v1 = acc[ai][bj][m][1];
                if (act == 1) {
#pragma unroll
                    for (int j = 0; j < 4; ++j) { v0[j] = fgelu(v0[j]); v1[j] = fgelu(v1[j]); }
                } else if (act == 2) {
#pragma unroll
                    for (int j = 0; j < 4; ++j) { v0[j] = fsigmoid(v0[j]); v1[j] = fsigmoid(v1[j]); }
                }
                u32x4 w; w.x = pk_bf16(v0[0], v0[1]); w.y = pk_bf16(v0[2], v0[3]); w.z = pk_bf16(v1[0], v1[1]); w.w = pk_bf16(v1[2], v1[3]);
                *(u32x4*)(rowp + bj * HALF) = w;
            }
            asm volatile("" ::: "memory");
        }
}
template <int ACT> struct EpiAct {
    static constexpr bool PERM = true;
    bf16_t* p; int ld, pn0;
    __device__ __forceinline__ void operator()(const f32x4 (&acc)[2][2][4][2], const Unit& u, int wr, int wc, int fr, int fq) const {
        store_tile_bf16(acc, p, ld, u.pm * BM + wr * 64 + fr, (u.pn - pn0) * BM + wc * 32 + 8 * fq, ACT);
    }
};
struct EpiWinA {
    static constexpr bool PERM = true;
    bf16_t* zq; bf16_t* xl; bf16_t* gy;
    __device__ __forceinline__ void operator()(const f32x4 (&acc)[2][2][4][2], const Unit& u, int wr, int wc, int fr, int fq) const {
        size_t boff = 0; if (u.pn >= 2) boff += (size_t)((const char*)xl - (const char*)zq); if (u.pn >= 6) boff += (size_t)((const char*)gy - (const char*)xl);
        bf16_t* base = (bf16_t*)((char*)zq + boff);
        int ld = 512, pn0 = 0; if (u.pn >= 2) { ld = D; pn0 = 2; } if (u.pn >= 6) pn0 = 6;
        store_tile_bf16(acc, base, ld, u.pm * BM + wr * 64 + fr, (u.pn - pn0) * BM + wc * 32 + 8 * fq, u.pn < 6 ? 0 : 1);
    }
};
struct EpiWinB {
    static constexpr bool PERM = true;
    bf16_t* ga; bf16_t* gl;
    __device__ __forceinline__ void operator()(const f32x4 (&acc)[2][2][4][2], const Unit& u, int wr, int wc, int fr, int fq) const {
        store_tile_bf16(acc, u.pn < 4 ? ga : gl, D, u.pm * BM + wr * 64 + fr, (u.pn & 3) * BM + wc * 32 + 8 * fq, 2);
    }
};
template <bool ADD> struct EpiGate {
    static constexpr bool PERM = true;
    const bf16_t* gate; const bf16_t* add; bf16_t* out;
    __device__ __forceinline__ void operator()(const f32x4 (&acc)[2][2][4][2], const Unit& u, int wr, int wc, int fr, int fq) const {
        const int row0 = u.pm * BM + wr * 64 + fr, col0 = u.pn * BM + wc * 32 + 8 * fq;
#pragma unroll
        for (int ai = 0; ai < 2; ++ai)
#pragma unroll
            for (int m = 0; m < 4; ++m) {
                const size_t off = (size_t)(row0 + ai * HALF + m * 16) * D + col0;
#pragma unroll
                for (int bj = 0; bj < 2; ++bj) {
                    const u32x4 gw = *(const u32x4*)(gate + off + bj * HALF);
                    const f32x4 v0 = acc[ai][bj][m][0], v1 = acc[ai][bj][m][1];
                    float r[8];
                    r[0] = lo_bf(gw.x) * v0[0]; r[1] = hi_bf(gw.x) * v0[1]; r[2] = lo_bf(gw.y) * v0[2]; r[3] = hi_bf(gw.y) * v0[3];
                    r[4] = lo_bf(gw.z) * v1[0]; r[5] = hi_bf(gw.z) * v1[1]; r[6] = lo_bf(gw.w) * v1[2]; r[7] = hi_bf(gw.w) * v1[3];
                    if (ADD) {
                        const u32x4 aw = *(const u32x4*)(add + off + bj * HALF);
                        r[0] += lo_bf(aw.x); r[1] += hi_bf(aw.x); r[2] += lo_bf(aw.y); r[3] += hi_bf(aw.y);
                        r[4] += lo_bf(aw.z); r[5] += hi_bf(aw.z); r[6] += lo_bf(aw.w); r[7] += hi_bf(aw.w);
                    }
                    u32x4 w; w.x = pk_bf16(r[0], r[1]); w.y = pk_bf16(r[2], r[3]); w.z = pk_bf16(r[4], r[5]); w.w = pk_bf16(r[6], r[7]);
                    *(u32x4*)(out + off + bj * HALF) = w;
                }
                asm volatile("" ::: "memory");
            }
    }
};
struct EpiQKV {
    static constexpr bool PERM = true;
    bf16_t* Q; bf16_t* Kn;
    __device__ __forceinline__ void operator()(const f32x4 (&acc)[2][2][4][2], const Unit& u, int wr, int wc, int fr, int fq) const {
        size_t boff = 0; if (u.pn >= 3) boff += (size_t)((const char*)Kn - (const char*)Q); if (u.pn >= 5) boff += (size_t)T * NKV * 2;
        bf16_t* dst = (bf16_t*)((char*)Q + boff);
        int ld = NQ, ctile = u.pn * BM; if (u.pn >= 3) { ld = NKV; ctile = ((u.pn - 3) & 1) * BM; }
        store_tile_bf16(acc, dst, ld, u.pm * BM + wr * 64 + fr, ctile + wc * 32 + 8 * fq, 0);
    }
};
}

struct TJob { const float* src; const float* scale; bf16_t* dst; int ldsrc, K, lddst, dstk0, nrb, map, nbatch, sbs, dbs; };
__device__ __forceinline__ int srccol(int map, int rb) {
    const int r = rb * 32;
    switch (map) {
        case 1: { const int pn = r >> 8, w = r & 255; return w < 128 ? 128 * pn + w : DFF + 128 * pn + (w - 128); }
        case 2: { if (r < 416) return r; if (r < 512) return -1; return r - 96; }
        case 3: return 2464 + r;
        case 4: { const int v = r >= 512 ? 1 : 0; const int rr = r & 511; return (rr >> 6) * 128 + (rr & 63) + 64 * v; }
        default: return r;
    }
}
constexpr int NJOBS = 15;
__device__ __forceinline__ TJob get_job(const Params& p, int j) {
    TJob t; t.scale = nullptr; t.dstk0 = 0; t.map = 0; t.nbatch = 1; t.sbs = 0; t.dbs = 0;
    unsigned char* ws = p.ws;
    switch (j) {
        case 0:  t.src = p.in[8];  t.dst = (bf16_t*)(ws + WS_WGU1); t.ldsrc = 2 * DFF; t.K = D; t.lddst = D; t.nrb = 176; t.map = 1; break;
        case 1:  t.src = p.in[9];  t.dst = (bf16_t*)(ws + WS_WDN1); t.ldsrc = D; t.K = DFF; t.lddst = DFF; t.nrb = 32; break;
        case 2:  t.src = p.in[10]; t.dst = (bf16_t*)(ws + WS_WINA); t.ldsrc = 4512; t.K = D; t.lddst = D; t.nrb = 80; t.map = 2; break;
        case 3:  t.src = p.in[10]; t.dst = (bf16_t*)(ws + WS_WINB); t.ldsrc = 4512; t.K = D; t.lddst = D; t.nrb = 64; t.map = 3; break;
        case 4:  t.src = p.in[13]; t.scale = p.in[11]; t.dst = (bf16_t*)(ws + WS_WQKV); t.ldsrc = 768; t.K = 256; t.lddst = 384; t.nrb = 24; break;
        case 5:  t.src = nullptr;  t.dst = (bf16_t*)(ws + WS_WQKV); t.ldsrc = 0; t.K = 128; t.lddst = 384; t.dstk0 = 256; t.nrb = 24; break;
        case 6:  t.src = p.in[14]; t.scale = p.in[12]; t.dst = (bf16_t*)(ws + WS_WQKV) + 768 * 384; t.ldsrc = 1024; t.K = 128; t.lddst = 384; t.dstk0 = 256; t.nrb = 32; t.map = 4; break;
        case 7:  t.src = nullptr;  t.dst = (bf16_t*)(ws + WS_WQKV) + 768 * 384; t.ldsrc = 0; t.K = 256; t.lddst = 384; t.nrb = 32; break;
        case 8:  t.src = p.in[15]; t.dst = (bf16_t*)(ws + WS_WAO); t.ldsrc = D; t.K = 512; t.lddst = 512; t.nrb = 32; break;
        case 9:  t.src = p.in[23]; t.dst = (bf16_t*)(ws + WS_WLO); t.ldsrc = D; t.K = D; t.lddst = D; t.nrb = 32; break;
        case 10: t.src = p.in[24]; t.dst = (bf16_t*)(ws + WS_WOUT); t.ldsrc = D; t.K = D; t.lddst = D; t.nrb = 32; break;
        case 11: t.src = p.in[25]; t.dst = (bf16_t*)(ws + WS_WGU2); t.ldsrc = 2 * DFF; t.K = D; t.lddst = D; t.nrb = 176; t.map = 1; break;
        case 12: t.src = p.in[26]; t.dst = (bf16_t*)(ws + WS_WDN2); t.ldsrc = D; t.K = DFF; t.lddst = DFF; t.nrb = 32; break;
        case 13: t.src = p.in[18]; t.dst = (bf16_t*)(ws + WS_WG); t.ldsrc = 128; t.K = 128; t.lddst = 128; t.nrb = 4; t.nbatch = 16; t.sbs = 16384; t.dbs = 32768; break;
        default: t.src = p.in[20]; t.dst = (bf16_t*)(ws + WS_WG) + 16384; t.ldsrc = 128; t.K = 128; t.lddst = 128; t.nrb = 4; t.nbatch = 16; t.sbs = 16384; t.dbs = 32768; break;
    }
    return t;
}
__device__ __forceinline__ int job_items(const TJob& t) { return t.nbatch * t.nrb * (t.K >> 6); }

__device__ __forceinline__ void tr_item(const TJob& jb, int item, LAS float* scr, int lane) {
    const int nkb = jb.K >> 6, per_batch = jb.nrb * nkb;
    const int bt = item / per_batch, r = item - bt * per_batch, rb = r / nkb, kb = r - rb * nkb;
    const int sc = srccol(jb.map, rb), k0 = 64 * kb;
    if (jb.src != nullptr && sc >= 0) {
        const float* src = jb.src + (size_t)bt * jb.sbs;
#pragma unroll 8
        for (int i = 0; i < 32; ++i) { const int kk = 2 * i + (lane >> 5);
            float v = src[(size_t)(k0 + kk) * jb.ldsrc + sc + (lane & 31)];
            if (jb.scale) v *= jb.scale[k0 + kk];
            scr[kk * 33 + (lane & 31)] = v; }
    } else {
#pragma unroll 8
        for (int i = 0; i < 32; ++i) { const int kk = 2 * i + (lane >> 5); scr[kk * 33 + (lane & 31)] = 0.f; }
    }
    asm volatile("s_waitcnt lgkmcnt(0)" ::: "memory");
    bf16_t* dst = jb.dst + (size_t)bt * jb.dbs;
    const int c = lane & 7;
#pragma unroll
    for (int j = 0; j < 4; ++j) { const int n = (lane >> 3) + 8 * j; const LAS float* s = scr + (8 * c) * 33 + n;
        u32x4 o; o.x = pk_bf16(s[0 * 33], s[1 * 33]); o.y = pk_bf16(s[2 * 33], s[3 * 33]); o.z = pk_bf16(s[4 * 33], s[5 * 33]); o.w = pk_bf16(s[6 * 33], s[7 * 33]);
        *(u32x4*)(dst + (size_t)(32 * rb + n) * jb.lddst + jb.dstk0 + k0 + 8 * c) = o; }
    asm volatile("s_waitcnt lgkmcnt(0)" ::: "memory");
}

__device__ __forceinline__ void phase_prep(const Params& p, LAS unsigned char* lds) {
    const int tid = threadIdx.x, lane = tid & 63, wave = tid >> 6;
    const int gw = blockIdx.x * NWAVES + wave, NGW = gridDim.x * NWAVES;
    {
        LAS float* scr = (LAS float*)(lds + wave * 8704);
        int base = 0;
        for (int j = 0; j < NJOBS; ++j) {
            const TJob jb = get_job(p, j); const int n = job_items(jb);
            int first = gw - (base % NGW); if (first < 0) first += NGW;
            for (int i = first; i < n; i += NGW) tr_item(jb, i, scr, lane);
            base += n;
        }
    }
    {
        const int gt = blockIdx.x * NTHREADS + tid;
        if (gt < SS * 16) {
            const int pos = gt >> 4, i = gt & 15;
            double inv = 1.0; for (int q = 0; q < i; ++q) inv *= 0.5623413251903491;
            const float ang = (float)pos * (float)inv;
            const double rev = (double)ang * 0.15915494309189535; const float fr = (float)(rev - rint(rev));
            ((float*)(p.ws + WS_ROPE))[gt] = __builtin_amdgcn_cosf(fr);
            ((float*)(p.ws + WS_ROPE))[SS * 16 + gt] = __builtin_amdgcn_sinf(fr);
        }
    }
    __syncthreads();
    for (int item = blockIdx.x; item < 144; item += gridDim.x) {
        LAS float* sc = (LAS float*)(lds) + wave * (128 * 33);
        for (int i = 0; i < 64; ++i) { const int idx = lane + 64 * i, kl = idx & 127, b = idx >> 7;
            const float cv = (b < 16 ? p.in[2] : p.in[3])[(b & 15) * D + 128 * wave + kl];
            sc[kl * 33 + b] = fsilu(cv); }
        asm volatile("s_waitcnt lgkmcnt(0)" ::: "memory");
        float acc[32];
#pragma unroll
        for (int b = 0; b < 32; ++b) acc[b] = 0.f;
        const float* W = p.in[4] + (size_t)(128 * wave) * 9216 + item * 64 + lane;
        for (int k = 0; k < 128; ++k) { const float wv = W[(size_t)k * 9216];
#pragma unroll
            for (int b = 0; b < 32; ++b) acc[b] += sc[k * 33 + b] * wv; }
        __syncthreads();
        LAS float* red = (LAS float*)(lds);
#pragma unroll
        for (int b = 0; b < 32; ++b) red[(wave * 32 + b) * 64 + lane] = acc[b];
        __syncthreads();
        for (int o = tid; o < 2048; o += NTHREADS) { const int b = o >> 6, col = o & 63; float s = 0.f;
#pragma unroll
            for (int w = 0; w < 8; ++w) s += red[(w * 32 + b) * 64 + col];
            const int j = item * 64 + col;
            ((float*)(p.ws + WS_MOD))[b * 9216 + j] = s + p.in[5][j]; }
        __syncthreads();
    }
}

template <bool HAS_F, bool HAS_H>
__device__ __forceinline__ void phase_rows(const Params& p, int sp, int sn, float resw, bool from_input) {
    const int tid = threadIdx.x, lane = tid & 63, wave = tid >> 6;
    const int gw = blockIdx.x * NWAVES + wave, NGW = gridDim.x * NWAVES;
    const float* mod = (const float*)(p.ws + WS_MOD);
    const bf16_t* F = (const bf16_t*)(p.ws + WS_F);
    bf16_t* H = (bf16_t*)(p.ws + WS_H);
    for (int row = gw; row < T; row += NGW) {
        const int b = row_batch(row);
        const float* xin = !from_input ? p.out + (size_t)row * D : (row < TP ? p.in[0] + (size_t)row * D : p.in[1] + (size_t)(row - TP) * D);
        f32x4 v[4];
#pragma unroll
        for (int j = 0; j < 4; ++j) v[j] = *(const f32x4*)(xin + 4 * lane + 256 * j);
        if (HAS_F) {
            f32x4 f[4]; float ss = 0.f;
#pragma unroll
            for (int j = 0; j < 4; ++j) { const u32x2 w = *(const u32x2*)(F + (size_t)row * D + 4 * lane + 256 * j);
                f[j] = (f32x4){lo_bf(w.x), hi_bf(w.x), lo_bf(w.y), hi_bf(w.y)}; ss += (f[j].x * f[j].x + f[j].y * f[j].y) + (f[j].z * f[j].z + f[j].w * f[j].w); }
            const float rs = 1.0f / sqrtf(wave_sum(ss) * (1.0f / D) + EPS) * resw;
            const float* gate = mod + b * 9216 + sp * 3072 + 2048; const float* gp = p.in[7] + sp * D;
#pragma unroll
            for (int j = 0; j < 4; ++j) { const f32x4 g = *(const f32x4*)(gate + 4 * lane + 256 * j), q = *(const f32x4*)(gp + 4 * lane + 256 * j);
                v[j] = v[j] + g * (f[j] * rs * q);
                *(f32x4*)(p.out + (size_t)row * D + 4 * lane + 256 * j) = v[j]; }
        }
        if (HAS_H) {
            float ss = 0.f;
#pragma unroll
            for (int j = 0; j < 4; ++j) ss += (v[j].x * v[j].x + v[j].y * v[j].y) + (v[j].z * v[j].z + v[j].w * v[j].w);
            const float rs = 1.0f / sqrtf(wave_sum(ss) * (1.0f / D) + EPS);
            const float* sh = mod + b * 9216 + sn * 3072; const float* scl = sh + 1024; const float* gq = p.in[6] + sn * D;
#pragma unroll
            for (int j = 0; j < 4; ++j) { const f32x4 a = *(const f32x4*)(sh + 4 * lane + 256 * j), s = *(const f32x4*)(scl + 4 * lane + 256 * j), q = *(const f32x4*)(gq + 4 * lane + 256 * j);
                const f32x4 h = (v[j] * rs * q) * (s + 1.0f) + a;
                u32x2 w; w.x = pk_bf16(h.x, h.y); w.y = pk_bf16(h.z, h.w);
                *(u32x2*)(H + (size_t)row * D + 4 * lane + 256 * j) = w; }
        }
    }
}

__device__ __forceinline__ void phase_stats(const Params& p, const int wg0, const int nwg) {
    const int tid = threadIdx.x, lane = tid & 63, wave = tid >> 6;
    const int gw = ((int)blockIdx.x - wg0) * NWAVES + wave, NGW = nwg * NWAVES;
    bf16_t* ZQ = (bf16_t*)(p.ws + WS_ZQ);
    bf16_t* KR = (bf16_t*)(p.ws + WS_KR);
    const float* rc = (const float*)(p.ws + WS_ROPE); const float* rsn = rc + SS * 16;
    for (int row = gw; row < T; row += NGW) {
        const u32x4 w = *(const u32x4*)(ZQ + (size_t)row * 512 + 8 * lane);
        float x[8] = {lo_bf(w.x), hi_bf(w.x), lo_bf(w.y), hi_bf(w.y), lo_bf(w.z), hi_bf(w.z), lo_bf(w.w), hi_bf(w.w)};
        float ss = 0.f;
#pragma unroll
        for (int e = 0; e < 8; ++e) ss += x[e] * x[e];
        const float sq = wave_sum(lane < 32 ? ss : 0.f), skv = wave_sum((lane >= 32 && lane < 48) ? ss : 0.f);
        {
            const float rq = 1.0f / sqrtf(sq * (1.0f / 256.0f) + EPS), rkv = 1.0f / sqrtf(skv * (1.0f / 128.0f) + EPS);
            if (lane < 48) { const float r = lane < 32 ? rq : rkv;
                u32x4 o; o.x = pk_bf16(x[0] * r, x[1] * r); o.y = pk_bf16(x[2] * r, x[3] * r); o.z = pk_bf16(x[4] * r, x[5] * r); o.w = pk_bf16(x[6] * r, x[7] * r);
                *(u32x4*)(ZQ + (size_t)row * 512 + 8 * lane) = o; }
        }
        float y[8];
#pragma unroll
        for (int e = 0; e < 8; ++e) y[e] = __shfl_xor(x[e], 2);
        if (lane >= 48 && lane < 52) {
            const int pos = row_pos(row), i0 = 8 * (lane & 1);
            const f32x4 c0 = *(const f32x4*)(rc + pos * 16 + i0), c1 = *(const f32x4*)(rc + pos * 16 + i0 + 4);
            const f32x4 s0 = *(const f32x4*)(rsn + pos * 16 + i0), s1 = *(const f32x4*)(rsn + pos * 16 + i0 + 4);
            const float c[8] = {c0.x, c0.y, c0.z, c0.w, c1.x, c1.y, c1.z, c1.w}, s[8] = {s0.x, s0.y, s0.z, s0.w, s1.x, s1.y, s1.z, s1.w};
            float o[8];
            const bool first = lane < 50;
#pragma unroll
            for (int e = 0; e < 8; ++e) o[e] = first ? (x[e] * c[e] - y[e] * s[e]) : (x[e] * c[e] + y[e] * s[e]);
            u32x4 ow; ow.x = pk_bf16(o[0], o[1]); ow.y = pk_bf16(o[2], o[3]); ow.z = pk_bf16(o[4], o[5]); ow.w = pk_bf16(o[6], o[7]);
            *(u32x4*)(KR + (size_t)row * 32 + 8 * (lane - 48)) = ow;
        }
    }
}

constexpr int XC_PITCH = 272;
__device__ __forceinline__ void phase_lru(const Params& p, LAS unsigned char* lds) {
    const int tid = threadIdx.x, lane = tid & 63, wave = __builtin_amdgcn_readfirstlane(tid >> 6), g = lane >> 4, lc = lane & 15;
    const bf16_t* XL = (const bf16_t*)(p.ws + WS_XL); bf16_t* GY = (bf16_t*)(p.ws + WS_GY); bf16_t* HF = (bf16_t*)(p.ws + WS_F);
    const bf16_t* WG = (const bf16_t*)(p.ws + WS_WG);
    for (int item = blockIdx.x; item < 256; item += gridDim.x) {
        int gb, n;
        if (item < 128) { gb = 16 + (item >> 3); n = item & 7; } else { gb = (item - 128) >> 3; n = item & 7; }
        const int S = gb < 16 ? SP : SS; const int row0 = gb < 16 ? gb * SP : TP + (gb - 16) * SS;
        const int nch = S >> 6;
        const int tr = tid >> 4, cgp = (tid & 15) * 8, c0 = 128 * n + cgp;
        float cw[4][8], cb[8];
#pragma unroll
        for (int j = 0; j < 4; ++j) { const f32x4 a = *(const f32x4*)(p.in[16] + j * D + c0), b = *(const f32x4*)(p.in[16] + j * D + c0 + 4);
            cw[j][0] = a.x; cw[j][1] = a.y; cw[j][2] = a.z; cw[j][3] = a.w; cw[j][4] = b.x; cw[j][5] = b.y; cw[j][6] = b.z; cw[j][7] = b.w; }
        { const f32x4 a = *(const f32x4*)(p.in[17] + c0), b = *(const f32x4*)(p.in[17] + c0 + 4);
            cb[0] = a.x; cb[1] = a.y; cb[2] = a.z; cb[3] = a.w; cb[4] = b.x; cb[5] = b.y; cb[6] = b.z; cb[7] = b.w; }
        const int ch = 128 * n + 16 * wave + lc;
        for (int d = 0; d < 2; ++d) {
            bf16x8 Ba[4], Bi[4];
            { const bf16_t* wa = WG + (size_t)((d * 8 + n) * 2 + 0) * 16384 + (size_t)(16 * wave + lc) * 128 + 8 * g; const bf16_t* wi = wa + 16384;
#pragma unroll
              for (int ks = 0; ks < 4; ++ks) { Ba[ks] = *(const bf16x8*)(wa + 32 * ks); Bi[ks] = *(const bf16x8*)(wi + 32 * ks); } }
            const float ba = p.in[19][d * D + ch], bi = p.in[21][d * D + ch];
            const float lam = p.in[22][d * D + ch];
            const float c8 = -8.0f * log1pf(expf(-lam));
            const float nba = -1.4426950408889634f * ba, nbi = -1.4426950408889634f * bi, c8l = 1.4426950408889634f * c8;
#define BPERM(addr, v) __builtin_bit_cast(float, __builtin_amdgcn_ds_bpermute((addr), __builtin_bit_cast(int, (v))))
            const int bx16 = (lane ^ 16) << 2, bx32 = (lane ^ 32) << 2;
            const bool s1 = d ? !(g & 1) : (g & 1), s2 = d ? !(g >> 1) : (g >> 1);
            float carry = 0.f;
            u32x4 pw[2][4];
#define LRU_PREFETCH(CI) do { const int _cc = d ? (nch - 1 - (CI)) : (CI); _Pragma("unroll") for (int hf = 0; hf < 2; ++hf) _Pragma("unroll") for (int j = 0; j < 4; ++j) { \
                const int tt = _cc * 64 + tr + 32 * hf + j - 1; pw[hf][j] = (tt >= 0 && tt < S) ? *(const u32x4*)(XL + (size_t)(row0 + tt) * D + c0) : (u32x4){0u, 0u, 0u, 0u}; } } while (0)
            LRU_PREFETCH(0);
            for (int ci = 0; ci < nch; ++ci) {
                const int cc = d ? (nch - 1 - ci) : ci, t0 = cc * 64;
                __syncthreads();
#pragma unroll
                for (int hf = 0; hf < 2; ++hf) {
                    const int tl = tr + 32 * hf;
                    float a[8];
#pragma unroll
                    for (int e = 0; e < 8; ++e) a[e] = cb[e];
#pragma unroll
                    for (int j = 0; j < 4; ++j) { const u32x4 w = pw[hf][j];
                        a[0] += cw[j][0] * lo_bf(w.x); a[1] += cw[j][1] * hi_bf(w.x); a[2] += cw[j][2] * lo_bf(w.y); a[3] += cw[j][3] * hi_bf(w.y);
                        a[4] += cw[j][4] * lo_bf(w.z); a[5] += cw[j][5] * hi_bf(w.z); a[6] += cw[j][6] * lo_bf(w.w); a[7] += cw[j][7] * hi_bf(w.w); }
                    u32x4 o; o.x = pk_bf16(a[0], a[1]); o.y = pk_bf16(a[2], a[3]); o.z = pk_bf16(a[4], a[5]); o.w = pk_bf16(a[6], a[7]);
                    *(LAS u32x4*)(lds + tl * XC_PITCH + cgp * 2) = o;
                }
                __syncthreads();
                if (ci + 1 < nch) LRU_PREFETCH(ci + 1);
                float hfv[4][4], gyv[4][4];
                if (d == 1) {
                    const bf16_t* const hfi = HF + (size_t)(row0 + t0 + 4 * g) * D + ch; const bf16_t* const gyi = GY + (size_t)(row0 + t0 + 4 * g) * D + ch;
#pragma unroll
                    for (int mt = 0; mt < 4; ++mt)
#pragma unroll
                        for (int j = 0; j < 4; ++j) { hfv[mt][j] = bf2f(hfi[(16 * mt + j) * D]); gyv[mt][j] = bf2f(gyi[(16 * mt + j) * D]); }
                }
                f32x4 aa[4], ai[4];
#pragma unroll
                for (int mt = 0; mt < 4; ++mt) { aa[mt] = (f32x4){0.f, 0.f, 0.f, 0.f}; ai[mt] = (f32x4){0.f, 0.f, 0.f, 0.f}; }
#pragma unroll
                for (int ks = 0; ks < 4; ++ks)
#pragma unroll
                    for (int mt = 0; mt < 4; ++mt) { const bf16x8 A = *(const LAS bf16x8*)(lds + (16 * mt + lc) * XC_PITCH + (32 * ks + 8 * g) * 2);
                        aa[mt] = __builtin_amdgcn_mfma_f32_16x16x32_bf16(A, Ba[ks], aa[mt], 0, 0, 0);
                        ai[mt] = __builtin_amdgcn_mfma_f32_16x16x32_bf16(A, Bi[ks], ai[mt], 0, 0, 0); }
#pragma unroll
                for (int mt = 0; mt < 4; ++mt)
#pragma unroll
                    for (int j = 0; j < 4; ++j) {
                        const float xcv = bf2f(*(const LAS bf16_t*)(lds + (16 * mt + 4 * g + j) * XC_PITCH + (16 * wave + lc) * 2));
                        const float r = __builtin_amdgcn_rcpf(1.0f + __builtin_amdgcn_exp2f(__builtin_fmaf(aa[mt][j], -1.4426950408889634f, nba)));
                        const float ig = __builtin_amdgcn_rcpf(1.0f + __builtin_amdgcn_exp2f(__builtin_fmaf(ai[mt][j], -1.4426950408889634f, nbi)));
                        const float av = __builtin_amdgcn_exp2f(c8l * r), om = __builtin_fmaf(-av, av, 1.0f);
                        aa[mt][j] = av; ai[mt][j] = __builtin_amdgcn_sqrtf(om) * (ig * xcv);
                    }
#define LRU_COMBINE() \
                        const float A1 = BPERM(bx16, A), H1 = BPERM(bx16, Hs); \
                        const float PA = A * A1, PH = s1 ? (A * H1 + Hs) : (A1 * Hs + H1); \
                        const float exA = s1 ? A1 : 1.f, exH = s1 ? H1 : 0.f; \
                        const float A2 = BPERM(bx32, PA), H2 = BPERM(bx32, PH); \
                        const float TA = PA * A2, TH = s2 ? (PA * H2 + PH) : (A2 * PH + H2); \
                        const float Aex = s2 ? A2 * exA : exA, Hex = s2 ? (exA * H2 + exH) : exH; \
                        const float cin = Aex * carry + Hex; \
                        carry = TA * carry + TH;
                bf16_t* const hfo = HF + (size_t)(row0 + t0 + 4 * g) * D + ch;
                if (d == 0) {
#pragma unroll
                    for (int mt = 0; mt < 4; ++mt) {
                        float P = 1.f, Hh = 0.f, pl[4], hl[4];
#pragma unroll
                        for (int j = 0; j < 4; ++j) { Hh = aa[mt][j] * Hh + ai[mt][j]; P *= aa[mt][j]; hl[j] = Hh; pl[j] = P; }
                        const float A = P, Hs = Hh;
                        LRU_COMBINE()
#pragma unroll
                        for (int j = 0; j < 4; ++j) { const float h = hl[j] + pl[j] * cin;
                            hfo[(16 * mt + j) * D] = (bf16_t)(pk_bf16(h, 0.f) & 0xffffu); }
                    }
                } else {
                    bf16_t* const gyo = GY + (size_t)(row0 + t0 + 4 * g) * D + ch;
#pragma unroll
                    for (int mt = 3; mt >= 0; --mt) {
                        float P = 1.f, Hh = 0.f, pl[4], hl[4];
#pragma unroll
                        for (int j = 3; j >= 0; --j) { Hh = aa[mt][j] * Hh + ai[mt][j]; P *= aa[mt][j]; hl[j] = Hh; pl[j] = P; }
                        const float A = P, Hs = Hh;
                        LRU_COMBINE()
#pragma unroll
                        for (int j = 0; j < 4; ++j) { const float h = hl[j] + pl[j] * cin;
                            const float o = (hfv[mt][j] + h) * gyv[mt][j];
                            gyo[(16 * mt + j) * D] = (bf16_t)(pk_bf16(o, 0.f) & 0xffffu); }
                    }
                }
            }
        }
        __syncthreads();
    }
}

constexpr int AK_PITCH = 208, AV_PITCH = 160, AK_BYTES = 64 * AK_PITCH, AV_BYTES = 64 * AV_PITCH, ABUF = AK_BYTES + AV_BYTES;
__device__ __forceinline__ void phase_attn(const Params& p, LAS unsigned char* lds) {
    const int tid = threadIdx.x, lane = tid & 63, wave = __builtin_amdgcn_readfirstlane(tid >> 6), g = lane >> 4, lc = lane & 15;
    const bf16_t* Q = (const bf16_t*)(p.ws + WS_F); const bf16_t* KN = (const bf16_t*)(p.ws + WS_XL); const bf16_t* V = KN + (size_t)T * NKV;
    const bf16_t* KR = (const bf16_t*)(p.ws + WS_KR); bf16_t* O = (bf16_t*)(p.ws + WS_ZQ);
    const float csc = 0.10206207261596577f * 1.4426950408889634f;
    const int srow = tid >> 3, sch = tid & 7;
    const int rrow = (tid & 255) >> 2, rch = tid & 3;
    const int vtr = (4 * g + (lc >> 2)) * AV_PITCH + (4 * (lc & 3)) * 2;
    const int vwg = (gridDim.x % 8 == 0) ? (int)(blockIdx.x % 8) * (int)(gridDim.x / 8) + (int)(blockIdx.x / 8) : (int)blockIdx.x;
    for (int unit = vwg; unit < 3072; unit += gridDim.x) {
        int gb, h, qt, S, row0;
        if (unit < 2048) { gb = 16 + (unit >> 7); h = (unit & 127) >> 4; qt = unit & 15; S = SS; row0 = TP + (gb - 16) * SS; }
        else { const int u2 = unit - 2048; gb = u2 >> 6; h = (u2 & 63) >> 3; qt = u2 & 7; S = SP; row0 = gb * SP; }
        const int nkt = S >> 6;
        const int qrow = row0 + 256 * qt + 32 * wave;
        bf16x8 qf[2][3];
#pragma unroll
        for (int q2 = 0; q2 < 2; ++q2)
#pragma unroll
            for (int ks = 0; ks < 3; ++ks) qf[q2][ks] = *(const bf16x8*)(Q + (size_t)(qrow + 16 * q2 + lc) * NQ + 96 * h + 32 * ks + 8 * g);
#pragma unroll
        for (int q2 = 0; q2 < 2; ++q2) {
            const int pos = row_pos(qrow + 16 * q2 + lc), i0 = 8 * (g & 1);
            const float* rc = (const float*)(p.ws + WS_ROPE) + pos * 16 + i0; const float* rsn = rc + SS * 16;
            const f32x4 c0 = *(const f32x4*)rc, c1 = *(const f32x4*)(rc + 4), s0 = *(const f32x4*)rsn, s1 = *(const f32x4*)(rsn + 4);
            const float cc[8] = {c0.x, c0.y, c0.z, c0.w, c1.x, c1.y, c1.z, c1.w}, sn[8] = {s0.x, s0.y, s0.z, s0.w, s1.x, s1.y, s1.z, s1.w};
            const u32x4 mine = __builtin_bit_cast(u32x4, qf[q2][2]);
            u32x4 oth; oth.x = __shfl_xor(mine.x, 32); oth.y = __shfl_xor(mine.y, 32); oth.z = __shfl_xor(mine.z, 32); oth.w = __shfl_xor(mine.w, 32);
            const float xm[8] = {lo_bf(mine.x), hi_bf(mine.x), lo_bf(mine.y), hi_bf(mine.y), lo_bf(mine.z), hi_bf(mine.z), lo_bf(mine.w), hi_bf(mine.w)};
            const float xo[8] = {lo_bf(oth.x), hi_bf(oth.x), lo_bf(oth.y), hi_bf(oth.y), lo_bf(oth.z), hi_bf(oth.z), lo_bf(oth.w), hi_bf(oth.w)};
            float o[8];
#pragma unroll
            for (int e = 0; e < 8; ++e) o[e] = g < 2 ? (xm[e] * cc[e] - xo[e] * sn[e]) : (xm[e] * cc[e] + xo[e] * sn[e]);
            u32x4 w; w.x = pk_bf16(o[0], o[1]); w.y = pk_bf16(o[2], o[3]); w.z = pk_bf16(o[4], o[5]); w.w = pk_bf16(o[6], o[7]);
            qf[q2][2] = __builtin_bit_cast(bf16x8, w);
        }
        f32x4 oacc[4][2];
#pragma unroll
        for (int dt = 0; dt < 4; ++dt) { oacc[dt][0] = (f32x4){0.f, 0.f, 0.f, 0.f}; oacc[dt][1] = (f32x4){0.f, 0.f, 0.f, 0.f}; }
        float mrun[2] = {-1e30f, -1e30f}, lrun[2] = {0.f, 0.f};
        u32x4 gk, gr, gv;
        gk = *(const u32x4*)(KN + (size_t)(row0 + srow) * NKV + 64 * h + 8 * sch);
        gv = *(const u32x4*)(V + (size_t)(row0 + srow) * NKV + 64 * h + 8 * sch);
        gr = *(const u32x4*)(KR + (size_t)(row0 + rrow) * 32 + 8 * rch);
        __syncthreads();
        *(LAS u32x4*)(lds + srow * AK_PITCH + sch * 16) = gk;
        *(LAS u32x4*)(lds + AK_BYTES + srow * AV_PITCH + sch * 16) = gv;
        if (tid < 256) *(LAS u32x4*)(lds + rrow * AK_PITCH + 128 + rch * 16) = gr;
        u32x4 gk2, gr2, gv2;
        gk = *(const u32x4*)(KN + (size_t)(row0 + 64 + srow) * NKV + 64 * h + 8 * sch);
        gv = *(const u32x4*)(V + (size_t)(row0 + 64 + srow) * NKV + 64 * h + 8 * sch);
        gr = *(const u32x4*)(KR + (size_t)(row0 + 64 + rrow) * 32 + 8 * rch);
        gk2 = *(const u32x4*)(KN + (size_t)(row0 + 128 + srow) * NKV + 64 * h + 8 * sch);
        gv2 = *(const u32x4*)(V + (size_t)(row0 + 128 + srow) * NKV + 64 * h + 8 * sch);
        gr2 = *(const u32x4*)(KR + (size_t)(row0 + 128 + rrow) * 32 + 8 * rch);
        __syncthreads();
#define ATT_BODY(kt, GK, GR, GV) do { \
            LAS unsigned char* kb = lds + ((kt) & 1) * ABUF; LAS unsigned char* vb = kb + AK_BYTES; \
            LAS unsigned char* nb = lds + (((kt) + 1) & 1) * ABUF; \
            const bool more = (kt) + 1 < nkt; \
 \
            f32x4 sacc[4][2]; \
            _Pragma("unroll") \
            for (int k4 = 0; k4 < 4; ++k4) { sacc[k4][0] = (f32x4){0.f, 0.f, 0.f, 0.f}; sacc[k4][1] = (f32x4){0.f, 0.f, 0.f, 0.f}; } \
            _Pragma("unroll") \
            for (int ks = 0; ks < 3; ++ks) \
            _Pragma("unroll") \
                for (int k4 = 0; k4 < 4; ++k4) { const bf16x8 kf = *(const LAS bf16x8*)(kb + (16 * k4 + lc) * AK_PITCH + (32 * ks + 8 * g) * 2); \
                    sacc[k4][0] = __builtin_amdgcn_mfma_f32_16x16x32_bf16(kf, qf[0][ks], sacc[k4][0], 0, 0, 0); \
                    sacc[k4][1] = __builtin_amdgcn_mfma_f32_16x16x32_bf16(kf, qf[1][ks], sacc[k4][1], 0, 0, 0); } \
            bf16x8 pf[2][2]; \
            _Pragma("unroll") \
            for (int q2 = 0; q2 < 2; ++q2) { \
                float mx = sacc[0][q2][0]; \
            _Pragma("unroll") \
                for (int k4 = 0; k4 < 4; ++k4) \
            _Pragma("unroll") \
                    for (int j = 0; j < 4; ++j) mx = fmaxf(mx, sacc[k4][q2][j]); \
                mx = fmaxf(mx, __shfl_xor(mx, 16)); mx = fmaxf(mx, __shfl_xor(mx, 32)); \
                const float mnew = fmaxf(mrun[q2], mx * csc); \
                const float alpha = __builtin_amdgcn_exp2f(mrun[q2] - mnew); \
                mrun[q2] = mnew; \
                float ps = 0.f; float pv[4][4]; \
            _Pragma("unroll") \
                for (int k4 = 0; k4 < 4; ++k4) \
            _Pragma("unroll") \
                    for (int j = 0; j < 4; ++j) { const float e = __builtin_amdgcn_exp2f(sacc[k4][q2][j] * csc - mnew); pv[k4][j] = e; ps += e; } \
                lrun[q2] = lrun[q2] * alpha + ps; \
            _Pragma("unroll") \
                for (int dt = 0; dt < 4; ++dt) oacc[dt][q2] *= alpha; \
            _Pragma("unroll") \
                for (int kk = 0; kk < 2; ++kk) { \
                    u32x4 w; w.x = pk_bf16(pv[2 * kk][0], pv[2 * kk][1]); w.y = pk_bf16(pv[2 * kk][2], pv[2 * kk][3]); \
                    w.z = pk_bf16(pv[2 * kk + 1][0], pv[2 * kk + 1][1]); w.w = pk_bf16(pv[2 * kk + 1][2], pv[2 * kk + 1][3]); \
                    pf[q2][kk] = __builtin_bit_cast(bf16x8, w); \
                } \
            } \
 \
            _Pragma("unroll") \
            for (int kk = 0; kk < 2; ++kk) \
            _Pragma("unroll") \
                for (int dt = 0; dt < 4; ++dt) { \
                    const v4i16_t lo = __builtin_amdgcn_ds_read_tr16_b64_v4i16((LAS v4i16_t*)(vb + vtr + (32 * kk) * AV_PITCH + 32 * dt)); \
                    const v4i16_t hi = __builtin_amdgcn_ds_read_tr16_b64_v4i16((LAS v4i16_t*)(vb + vtr + (32 * kk + 16) * AV_PITCH + 32 * dt)); \
                    const bf16x8 vf = {lo[0], lo[1], lo[2], lo[3], hi[0], hi[1], hi[2], hi[3]}; \
                    oacc[dt][0] = __builtin_amdgcn_mfma_f32_16x16x32_bf16(vf, pf[0][kk], oacc[dt][0], 0, 0, 0); \
                    oacc[dt][1] = __builtin_amdgcn_mfma_f32_16x16x32_bf16(vf, pf[1][kk], oacc[dt][1], 0, 0, 0); \
                } \
            if (more) { \
                *(LAS u32x4*)(nb + srow * AK_PITCH + sch * 16) = GK; \
                *(LAS u32x4*)(nb + AK_BYTES + srow * AV_PITCH + sch * 16) = GV; \
                if (tid < 256) *(LAS u32x4*)(nb + rrow * AK_PITCH + 128 + rch * 16) = GR; \
            } \
            if ((kt) + 3 < nkt) { const int kr0 = row0 + 64 * ((kt) + 3); \
                GK = *(const u32x4*)(KN + (size_t)(kr0 + srow) * NKV + 64 * h + 8 * sch); \
                GV = *(const u32x4*)(V + (size_t)(kr0 + srow) * NKV + 64 * h + 8 * sch); \
                GR = *(const u32x4*)(KR + (size_t)(kr0 + rrow) * 32 + 8 * rch); } \
            __syncthreads(); \
        } while (0)
        for (int kt2 = 0; kt2 < nkt; kt2 += 2) { ATT_BODY(kt2, gk, gr, gv); ATT_BODY(kt2 + 1, gk2, gr2, gv2); }
#undef ATT_BODY
#pragma unroll
        for (int q2 = 0; q2 < 2; ++q2) {
            float l = lrun[q2]; l += __shfl_xor(l, 16); l += __shfl_xor(l, 32);
            const float inv = 1.0f / l;
#pragma unroll
            for (int dt = 0; dt < 4; ++dt) { const f32x4 o = oacc[dt][q2] * inv;
                u32x2 w; w.x = pk_bf16(o[0], o[1]); w.y = pk_bf16(o[2], o[3]);
                *(u32x2*)(O + (size_t)(qrow + 16 * q2 + lc) * 512 + 64 * h + 16 * dt + 4 * g) = w; }
        }
    }
    __syncthreads();
}

#define XB_TMO      128
#define XB_XCNT(j)  (256  + 64 * (j))
#define XB_XSUB(j)  (1280 + 64 * (j))
#define XB_XGEN(j)  (2304 + 64 * (j))
#define XB_TOP      3328
#define XB_TOPGEN   3392
#define XCD_BAR_WORDS 3456
#define XB_SPIN_CAP (1u << 18)

__device__ __forceinline__ unsigned xb_ld(unsigned* p)              { return __hip_atomic_load(p, __ATOMIC_RELAXED, __HIP_MEMORY_SCOPE_AGENT); }
__device__ __forceinline__ unsigned xb_add(unsigned* p, unsigned v) { return __hip_atomic_fetch_add(p, v, __ATOMIC_RELAXED, __HIP_MEMORY_SCOPE_AGENT); }
__device__ __forceinline__ unsigned xb_xcc_id() { return (unsigned)__builtin_amdgcn_s_getreg((3 << 11) | 20) & 0xFu; }
#define XB_SPIN(cond, bar) do { unsigned _sp = 0; while (cond) { __builtin_amdgcn_s_sleep(1); \
    if ((++_sp & 255u) == 0u) { if (xb_ld(&(bar)[XB_TMO])) break; if (_sp > XB_SPIN_CAP) { atomicAdd(&(bar)[XB_TMO], 1u); break; } } } } while (0)

struct XcdBarrier {
    unsigned* bar; unsigned x;
    volatile LAS unsigned* st;
};

__device__ __forceinline__ XcdBarrier xcd_barrier_post(unsigned* bar, volatile LAS unsigned* st) {
    XcdBarrier b; b.bar = bar; b.x = xb_xcc_id(); b.st = st;
    if (threadIdx.x == 0) (void)xb_add(&bar[XB_XCNT(b.x)], 1u);
    return b;
}
__device__ __forceinline__ void xcd_barrier_complete(unsigned* bar, unsigned x, unsigned& nloc, unsigned& nx) {
    const unsigned G = gridDim.x * gridDim.y * gridDim.z;
    unsigned sum, cnt, mine, sp = 0u;
    for (;;) {
        sum = 0u; cnt = 0u; mine = 0u;
#pragma unroll
        for (unsigned j = 0; j < 16; ++j) { const unsigned c = xb_ld(&bar[XB_XCNT(j)]); sum += c; cnt += (c > 0u) ? 1u : 0u; mine = (j == x) ? c : mine; }
        if (sum == G) break;
        __builtin_amdgcn_s_sleep(1);
        if ((++sp & 255u) == 0u) { if (xb_ld(&bar[XB_TMO])) break; if (sp > XB_SPIN_CAP) { atomicAdd(&bar[XB_TMO], 1u); break; } }
    }
    nloc = mine > 0u ? mine : 1u; nx = cnt > 0u ? cnt : 1u;
}

__device__ __forceinline__ void xcd_barrier(const XcdBarrier& b) {
    asm volatile("s_waitcnt vmcnt(0)" ::: "memory");
    __syncthreads();
    if (threadIdx.x == 0) {
        unsigned* bar = b.bar;
        __builtin_amdgcn_s_waitcnt(0);
        unsigned nloc = b.st[0], nx = b.st[1];
        if (nloc == 0u) { xcd_barrier_complete(bar, b.x, nloc, nx); b.st[0] = nloc; b.st[1] = nx; }
        const unsigned old = xb_add(&bar[XB_XSUB(b.x)], 1u);
        const unsigned gen = old / nloc;
        if (old + 1u == (gen + 1u) * nloc) {
            __builtin_amdgcn_fence(__ATOMIC_RELEASE, "agent");
            asm volatile("s_waitcnt vmcnt(0)" ::: "memory");
            const unsigned og = xb_add(&bar[XB_TOP], 1u);
            const unsigned tg = og / nx;
            if (og + 1u == (tg + 1u) * nx) xb_add(&bar[XB_TOPGEN], 1u);
            else XB_SPIN(xb_ld(&bar[XB_TOPGEN]) == tg, bar);
            __builtin_amdgcn_fence(__ATOMIC_ACQUIRE, "agent");
            xb_add(&bar[XB_XGEN(b.x)], 1u);
            asm volatile("s_waitcnt vmcnt(0)" ::: "memory");
        } else {
            XB_SPIN(xb_ld(&bar[XB_XGEN(b.x)]) == gen, bar);
            __builtin_amdgcn_fence(__ATOMIC_ACQUIRE, "agent");
            asm volatile("s_waitcnt vmcnt(0)" ::: "memory");
        }
    }
    __syncthreads();
}


constexpr int NPHASES = 16;
__global__ void __launch_bounds__(NTHREADS, 2) mega_fwd(Params p) {
    extern __shared__ __attribute__((aligned(16))) unsigned char lds_raw[];
    LAS unsigned char* lds = (LAS unsigned char*)lds_raw;
    cg::grid_group grid = cg::this_grid();
    unsigned char* ws = p.ws;
    const int G = gridDim.x, bid = blockIdx.x;
    bf16_t* Hb = (bf16_t*)(ws + WS_H); bf16_t* Fb = (bf16_t*)(ws + WS_F); bf16_t* ACT = (bf16_t*)(ws + WS_ACT);
    bf16_t* ZQ = (bf16_t*)(ws + WS_ZQ); bf16_t* XL = (bf16_t*)(ws + WS_XL); bf16_t* GY = (bf16_t*)(ws + WS_GY);
#ifndef TESTPH
#define TESTPH -1
#endif
#define IN(k) ((TESTPH < 0 || (k) == TESTPH) && p.ph_lo <= (k) && (k) < p.ph_hi)
#define SEAM0() do { if (IN(0) && IN(1)) { __builtin_amdgcn_fence(__ATOMIC_RELEASE, "agent"); asm volatile("s_waitcnt vmcnt(0) lgkmcnt(0)" ::: "memory"); \
        grid.sync(); __builtin_amdgcn_fence(__ATOMIC_ACQUIRE, "agent"); asm volatile("s_waitcnt vmcnt(0) lgkmcnt(0)" ::: "memory"); \
        xb = xcd_barrier_post((unsigned*)(p.ws + WS_XBAR), xbst); } } while (0)
#define SEAM(k) do { if (IN(k) && IN((k) + 1)) xcd_barrier(xb); } while (0)
    volatile LAS unsigned* xbst = (volatile LAS unsigned*)(lds + LDS_BYTES - 16);
    if (threadIdx.x < 4) xbst[threadIdx.x] = 0u;
    __syncthreads();
    XcdBarrier xb; xb.bar = (unsigned*)(p.ws + WS_XBAR); xb.x = 0; xb.st = xbst;
    if (IN(0)) { if (bid == 0) { unsigned* xw = (unsigned*)(p.ws + WS_XBAR); for (int i = threadIdx.x; i < XCD_BAR_WORDS; i += NTHREADS) xw[i] = 0u; }
        phase_prep(p, lds); }
    SEAM0();
    if (IN(1)) phase_rows<false, true>(p, 0, 0, 0.f, true);
    SEAM(1);
#define FFN_PHASES(ffn, pb) do { \
        if (IN(pb)) { \
            pg8::Gemm g{Hb, (const bf16_t*)(ws + ((ffn) ? WS_WGU2 : WS_WGU1)), D, D}; pg8::StaticOrder S; S.init(T, 2 * DFF, G, bid); \
            pg8::EpiSwiglu E{ACT, DFF}; \
            GEMM_PHASE(pg8::EpiSwiglu, lds, g, S, E); \
        } \
        SEAM(pb); \
        if (IN((pb) + 1)) { \
            pg8::Gemm g{ACT, (const bf16_t*)(ws + ((ffn) ? WS_WDN2 : WS_WDN1)), DFF, DFF}; pg8::StaticOrder S; S.init(T, D, G, bid); \
            pg8::EpiAct<0> E{Fb, D, 0}; \
            GEMM_PHASE(pg8::EpiAct<0>, lds, g, S, E); \
        } \
        SEAM((pb) + 1); } while (0)
    FFN_PHASES(0, 2);
        if (IN(4)) phase_rows<true, true>(p, 0, 1, 0.5f, true);
        SEAM(4);
        if (IN(5)) {
            pg8::Gemm g{Hb, (const bf16_t*)(ws + WS_WINA), D, D}; pg8::StaticOrder S; S.init(T, 2560, G, bid);
            pg8::EpiWinA E{ZQ, XL, GY};
            GEMM_PHASE(pg8::EpiWinA, lds, g, S, E);
        }
        SEAM(5);
        if (IN(6)) { phase_lru(p, lds); if (bid >= G / 2) phase_stats(p, G / 2, G - G / 2);     }
        SEAM(6);
        if (IN(7)) {
            pg8::Gemm g{ZQ, (const bf16_t*)(ws + WS_WQKV), 512, 384}; pg8::StaticOrder S; S.init(T, 1792, G, bid);
            pg8::EpiQKV E{Fb, XL};
            GEMM_PHASE2(pg8::EpiQKV, lds, g, S, E);
        }
        SEAM(7);
        if (IN(8)) phase_attn(p, lds);
        SEAM(8);
        if (IN(9)) {
            pg8::Gemm g{Hb, (const bf16_t*)(ws + WS_WINB), D, D}; pg8::StaticOrder S; S.init(T, 2048, G, bid);
            pg8::EpiWinB E{Fb, XL};
            GEMM_PHASE(pg8::EpiWinB, lds, g, S, E);
        }
        SEAM(9);
        if (IN(10)) {
            { pg8::Gemm g{ZQ, (const bf16_t*)(ws + WS_WAO), 512, 512}; pg8::StaticOrder S; S.init(T, D, G, bid);
              pg8::EpiGate<false> E{Fb, nullptr, Fb};
              GEMM_PHASE(pg8::EpiGate<false>, lds, g, S, E); }
            { pg8::Gemm g{GY, (const bf16_t*)(ws + WS_WLO), D, D}; pg8::StaticOrder S; S.init(T, D, G, bid);
              pg8::EpiGate<true> E{XL, Fb, XL};
              GEMM_PHASE(pg8::EpiGate<true>, lds, g, S, E); }
        }
        SEAM(10);
        if (IN(11)) {
            pg8::Gemm g{XL, (const bf16_t*)(ws + WS_WOUT), D, D}; pg8::StaticOrder S; S.init(T, D, G, bid);
            pg8::EpiAct<0> E{Fb, D, 0};
            GEMM_PHASE(pg8::EpiAct<0>, lds, g, S, E);
        }
        SEAM(11);
        if (IN(12)) phase_rows<true, true>(p, 1, 2, 1.0f, false);
        SEAM(12);
    FFN_PHASES(1, 13);
    if (IN(15)) phase_rows<true, false>(p, 2, 0, 0.5f, false);
#undef IN
#undef SEAM
}

extern "C" void kernel_launch(void* const* d_in, const int* in_sizes, int n_in, void* d_out, int out_size, void* d_ws, size_t ws_size, hipStream_t stream) {
    static int grid = 0;
    if (grid == 0) {
        if (n_in != 27 || out_size != T * D || ws_size < WS_END) { fprintf(stderr, "kernel_launch: unexpected shapes: n_in %d out %d ws %zu (need >= %zu)\n", n_in, out_size, ws_size, (size_t)WS_END); grid = -1; return; }
        int dev = 0, cus = 0, per_cu = 0;
        (void)hipGetDevice(&dev);
        (void)hipDeviceGetAttribute(&cus, hipDeviceAttributeMultiprocessorCount, dev);
        if (hipFuncSetAttribute((const void*)mega_fwd, hipFuncAttributeMaxDynamicSharedMemorySize, LDS_BYTES) != hipSuccess) { fprintf(stderr, "kernel_launch: hipFuncSetAttribute failed\n"); grid = -1; return; }
        if (hipOccupancyMaxActiveBlocksPerMultiprocessor(&per_cu, (const void*)mega_fwd, NTHREADS, LDS_BYTES) != hipSuccess || per_cu < 1) { fprintf(stderr, "kernel_launch: occupancy query failed (%d)\n", per_cu); per_cu = 1; }
        (void)hipGetLastError();
        grid = cus;
        fprintf(stderr, "kernel_launch: grid %d (per_cu %d)\n", grid, per_cu);
    }
    if (grid < 0) return;
    Params p{};
    for (int i = 0; i < 27; ++i) p.in[i] = (const float*)d_in[i];
    p.out = (float*)d_out; p.ws = (unsigned char*)d_ws;
#if defined(MK_SPLIT)
    for (int ph = 0; ph < NPHASES; ++ph) { p.ph_lo = ph; p.ph_hi = ph + 1;
        hipLaunchKernelGGL(mega_fwd, dim3(grid), dim3(NTHREADS), LDS_BYTES, stream, p); }
#else
    p.ph_lo = 0; p.ph_hi = NPHASES;
    void* args[] = {&p};
    hipError_t e = hipLaunchCooperativeKernel((const void*)mega_fwd, dim3(grid), dim3(NTHREADS), args, LDS_BYTES, stream);
    if (e != hipSuccess) fprintf(stderr, "kernel_launch: cooperative launch failed: %s (grid %d)\n", hipGetErrorString(e), grid);
#endif
}
```

```cpp
#include <hip/hip_runtime.h>
#include <hip/hip_cooperative_groups.h>
#include <cstdio>
#include <cstdint>
namespace cg = cooperative_groups;
#ifndef MK_SP2_ALL
#define MK_SP2_ALL false
#endif

#define LAS __attribute__((address_space(3)))
typedef unsigned short bf16_t;
typedef short bf16x8 __attribute__((ext_vector_type(8)));
typedef short v4i16_t __attribute__((ext_vector_type(4)));
typedef float f32x4 __attribute__((ext_vector_type(4)));
typedef float f32x2 __attribute__((ext_vector_type(2)));
typedef unsigned u32x4 __attribute__((ext_vector_type(4)));
typedef unsigned u32x2 __attribute__((ext_vector_type(2)));

constexpr int D = 1024, DFF = 2816, TP = 32768, TS = 65536, T = TP + TS, SP = 2048, SS = 4096;
constexpr int NQ = 768, NKV = 512;
constexpr float EPS = 1e-6f;
constexpr int NTHREADS = 512, NWAVES = 8;

constexpr size_t KiB = 1024, MiB = 1024 * 1024;
constexpr size_t WS_WGU1 = 0, WS_WDN1 = 11 * MiB, WS_WINA = 16 * MiB + 512 * KiB, WS_WINB = 21 * MiB + 512 * KiB, WS_WQKV = 25 * MiB + 512 * KiB,
                 WS_WAO = 27 * MiB, WS_WLO = 28 * MiB, WS_WOUT = 30 * MiB, WS_WGU2 = 32 * MiB, WS_WDN2 = 43 * MiB, WS_WG = 48 * MiB + 512 * KiB,
                 WS_MOD = 49 * MiB + 512 * KiB, WS_ROPE = 50 * MiB + 768 * KiB, WS_STATS = 51 * MiB + 256 * KiB, WS_KR = 52 * MiB;
constexpr size_t WS_XBAR = 50 * MiB + 640 * KiB;
constexpr size_t WS_H = 64 * MiB, WS_F = 256 * MiB, WS_BIG = 448 * MiB;
constexpr size_t WS_ZQ = WS_BIG, WS_XL = WS_BIG + 96 * MiB, WS_GY = WS_BIG + 288 * MiB, WS_ACT = WS_BIG, WS_END = 976 * MiB;
constexpr int LDS_BYTES = 139264;

struct Params { const float* in[27]; float* out; unsigned char* ws; int ph_lo, ph_hi; };

typedef __bf16 bf16x2_t __attribute__((ext_vector_type(2)));
__device__ __forceinline__ unsigned pk_bf16(float lo, float hi) { const f32x2 v = {lo, hi}; const bf16x2_t b = __builtin_convertvector(v, bf16x2_t); return __builtin_bit_cast(unsigned, b); }
__device__ __forceinline__ float lo_bf(unsigned w) { return __uint_as_float(w << 16); }
__device__ __forceinline__ float hi_bf(unsigned w) { return __uint_as_float(w & 0xffff0000u); }
__device__ __forceinline__ float bf2f(bf16_t h) { return __uint_as_float((unsigned)h << 16); }
__device__ __forceinline__ float fexp(float x) { return __builtin_amdgcn_exp2f(x * 1.4426950408889634f); }
__device__ __forceinline__ float fsigmoid(float x) { return __builtin_amdgcn_rcpf(1.0f + fexp(-x)); }
__device__ __forceinline__ float fsilu(float x) { return x * fsigmoid(x); }
__device__ __forceinline__ float fgelu(float x) { return x * fsigmoid(1.5957691216057308f * (x + 0.044715f * x * x * x)); }
__device__ __forceinline__ float wave_sum(float v) {
#pragma unroll
    for (int o = 1; o < 64; o <<= 1) v += __shfl_xor(v, o);
    return v;
}
__device__ __forceinline__ int row_batch(int row) { return row < TP ? (row >> 11) : 16 + ((row - TP) >> 12); }
__device__ __forceinline__ int row_pos(int row) { return row < TP ? (row & (SP - 1)) : ((row - TP) & (SS - 1)); }

namespace pg8 {
constexpr int BM = 256, BK = 64, HALF = 128, HTB = HALF * BK * 2, STAGE_BYTES = 8 * HTB, NXCD = 8, WGM = 8;
__host__ __device__ __forceinline__ int lds_byte(int r, int c) { const int st = (r >> 4) * 2 + (c >> 5), rr = r & 15, cc = c & 31, ob = rr * 64 + cc * 2; return st * 1024 + (ob ^ (((ob >> 9) & 1) << 5)); }
__host__ __device__ __forceinline__ void stage_rc(int b, int& R, int& C) { const int st = b / 1024, sb = b % 1024, swz = sb ^ (((sb >> 9) & 1) << 5); R = (st >> 1) * 16 + swz / 64; C = (st & 1) * 32 + (swz % 64) / 2; }
__host__ __device__ __forceinline__ int perm32(int rho) { const int n = rho >> 4, i = rho & 15; return 8 * (i >> 2) + 4 * n + (i & 3); }

struct Unit { int pm, pn; };
struct Gemm { const bf16_t* A; const bf16_t* Bt; int lda, K; };

struct StaticOrder {
    int nM, nN, nwg, G, c;
    __device__ void init(int M, int N, int G_, int c_) { nM = M / BM; nN = N / BM; nwg = nM * nN; G = G_; c = c_; }
    __device__ bool next(int i, Unit& u) const {
        const long L = (long)i * G + c; if (L >= nwg) return false;
        int wgid = (int)L; { const int q = nwg / NXCD, r = nwg % NXCD, xcd = wgid % NXCD, off = wgid / NXCD; wgid = (xcd < r ? xcd * (q + 1) : r * (q + 1) + (xcd - r) * q) + off; }
        const int nig = WGM * nN, gid = wgid / nig, fm = gid * WGM, gsz = (nM - fm) < WGM ? (nM - fm) : WGM;
        u.pm = fm + ((wgid % nig) % gsz); u.pn = (wgid % nig) / gsz; return true;
    }
};

template <class Epi, bool SP2 = false>
__device__ __forceinline__ void gemm_phase(LAS unsigned char* lds, const Gemm g, const StaticOrder& S, const Epi& E) {
    const int tid = threadIdx.x, wid = __builtin_amdgcn_readfirstlane(tid >> 6), lane = tid & 63, wr = wid >> 2, wc = wid & 3, fr = lane & 15, fq = lane >> 4;
    const int K = g.K, nt = K / BK, lda = g.lda;
    unsigned voffA[2], voffB[2];
#pragma unroll
    for (int i = 0; i < 2; ++i) { int R, C; stage_rc(tid * 16 + i * 8192, R, C); const int Rb = Epi::PERM ? ((R & ~31) + perm32(R & 31)) : R;
        voffA[i] = (unsigned)(R * lda + C) * 2u; voffB[i] = (unsigned)(Rb * K + C) * 2u; }
    const size_t kstep = (size_t)(BK * 2);
    const size_t hstepA = (size_t)HALF * lda * 2, hstepB = (size_t)HALF * K * 2;
    const size_t tstepA = 2 * hstepA, tstepB = 2 * hstepB;
    const unsigned ldsw = (unsigned)wid * 1024u;
    const int aoff = lds_byte(wr * 64 + fr, fq * 8), boff = lds_byte(wc * 32 + fr, fq * 8);
#define PG8_SA(b, h) (((b) * 2 + (h)) * HTB)
#define PG8_SB(b, h) ((4 + (b) * 2 + (h)) * HTB)
#define PG8_STAGE(bufoff, gbase, voff) do { _Pragma("unroll") for (int _i = 0; _i < 2; ++_i) \
        __builtin_amdgcn_global_load_lds((const unsigned*)((const char*)(gbase) + (voff)[_i]), (LAS unsigned*)(lds + (bufoff) + ldsw + _i * 8192), 16, 0, 0); } while (0)
#define PG8_LDA(dst, b, h) do { _Pragma("unroll") for (int m = 0; m < 4; ++m) _Pragma("unroll") for (int k = 0; k < 2; ++k) dst[m][k] = *(const LAS bf16x8*)(lds + PG8_SA(b, h) + aoff + m * 2048 + k * 1024); } while (0)
#define PG8_LDB(dst, b, h) do { _Pragma("unroll") for (int n = 0; n < 2; ++n) _Pragma("unroll") for (int k = 0; k < 2; ++k) dst[n][k] = *(const LAS bf16x8*)(lds + PG8_SB(b, h) + boff + n * 2048 + k * 1024); } while (0)
#define PG8_MMA(ai, bj, At, Bt) do { __builtin_amdgcn_s_setprio(1); _Pragma("unroll") for (int m = 0; m < 4; ++m) _Pragma("unroll") for (int n = 0; n < 2; ++n) _Pragma("unroll") for (int k = 0; k < 2; ++k) \
        acc[ai][bj][m][n] = __builtin_amdgcn_mfma_f32_16x16x32_bf16(Bt[n][k], At[m][k], acc[ai][bj][m][n], 0, 0, 0); __builtin_amdgcn_s_setprio(0); } while (0)
#define PG8_WAIT_V(n) asm volatile("s_waitcnt vmcnt(" #n ")" ::: "memory")
#define PG8_WAIT_L(n) asm volatile("s_waitcnt lgkmcnt(" #n ")" ::: "memory")
#define PG8_BAR __builtin_amdgcn_s_barrier()
#define PG8_SCHED __builtin_amdgcn_sched_barrier(0)
    Unit cur, nxt; int ui = 0;
    if (!S.next(0, cur)) return;
    f32x4 acc[2][2][4][2];
#pragma unroll
    for (int a = 0; a < 2; ++a)
#pragma unroll
        for (int b = 0; b < 2; ++b)
#pragma unroll
            for (int m = 0; m < 4; ++m)
#pragma unroll
                for (int n = 0; n < 2; ++n) acc[a][b][m][n] = (f32x4){0.f, 0.f, 0.f, 0.f};
    bf16x8 At[4][2], B0[2][2], B1[2][2];
    const char* cA = (const char*)g.A + (size_t)cur.pm * tstepA; const char* cB = (const char*)g.Bt + (size_t)cur.pn * tstepB;
    if constexpr (SP2) {
        PG8_STAGE(PG8_SB(0, 0), cB, voffB); PG8_STAGE(PG8_SB(0, 1), cB + hstepB, voffB); PG8_STAGE(PG8_SA(0, 0), cA, voffA); PG8_STAGE(PG8_SA(0, 1), cA + hstepA, voffA);
        if (wr == 1) PG8_BAR;
        PG8_WAIT_V(2); PG8_BAR;
        PG8_STAGE(PG8_SB(1, 0), cB + kstep, voffB); PG8_STAGE(PG8_SA(1, 0), cA + kstep, voffA); PG8_STAGE(PG8_SB(1, 1), cB + hstepB + kstep, voffB);
        PG8_WAIT_V(6); PG8_BAR;
    } else {
    PG8_STAGE(PG8_SB(0, 0), cB, voffB); PG8_STAGE(PG8_SA(0, 0), cA, voffA); PG8_STAGE(PG8_SB(0, 1), cB + hstepB, voffB); PG8_STAGE(PG8_SA(0, 1), cA + hstepA, voffA);
    if (wr == 1) PG8_BAR;
    PG8_WAIT_V(4); PG8_BAR;
    PG8_STAGE(PG8_SB(1, 0), cB + kstep, voffB); PG8_STAGE(PG8_SA(1, 0), cA + kstep, voffA); PG8_STAGE(PG8_SB(1, 1), cB + hstepB + kstep, voffB);
    PG8_WAIT_V(6); PG8_BAR;
    }
    for (;;) {
        const bool has_next = S.next(ui + 1, nxt);
        const char* nA = has_next ? (const char*)g.A + (size_t)nxt.pm * tstepA : cA; const char* nB = has_next ? (const char*)g.Bt + (size_t)nxt.pn * tstepB : cB;
        for (int t = 0; t < nt; t += 2) {
            const bool last = (t == nt - 2);
            const char* a1 = cA + (size_t)(t + 1) * kstep;
            const char* a2 = last ? nA : cA + (size_t)(t + 2) * kstep; const char* b2 = last ? nB : cB + (size_t)(t + 2) * kstep;
            const char* a3 = a2 + kstep; const char* b3 = b2 + kstep;
            if constexpr (SP2) {
            PG8_LDB(B0, 0, 0); PG8_LDB(B1, 0, 1); PG8_SCHED; PG8_LDA(At, 0, 0); PG8_STAGE(PG8_SA(1, 1), a1 + hstepA, voffA);
            PG8_WAIT_V(8); PG8_WAIT_L(0); PG8_BAR; PG8_MMA(0, 0, At, B0); PG8_MMA(0, 1, At, B1); PG8_BAR; PG8_SCHED;
            PG8_LDA(At, 0, 1); PG8_STAGE(PG8_SB(0, 0), b2, voffB); PG8_STAGE(PG8_SB(0, 1), b2 + hstepB, voffB); PG8_STAGE(PG8_SA(0, 0), a2, voffA);
            PG8_WAIT_V(8); PG8_WAIT_L(0); PG8_BAR; PG8_MMA(1, 0, At, B0); PG8_MMA(1, 1, At, B1); PG8_BAR; PG8_SCHED;
            PG8_LDB(B0, 1, 0); PG8_LDB(B1, 1, 1); PG8_SCHED; PG8_LDA(At, 1, 0); PG8_STAGE(PG8_SA(0, 1), a2 + hstepA, voffA);
            PG8_WAIT_V(8); PG8_WAIT_L(0); PG8_BAR; PG8_MMA(0, 0, At, B0); PG8_MMA(0, 1, At, B1); PG8_BAR; PG8_SCHED;
            PG8_LDA(At, 1, 1); PG8_STAGE(PG8_SB(1, 0), b3, voffB); PG8_STAGE(PG8_SB(1, 1), b3 + hstepB, voffB); PG8_STAGE(PG8_SA(1, 0), a3, voffA);
            PG8_WAIT_V(8); PG8_WAIT_L(0); PG8_BAR; PG8_MMA(1, 0, At, B0); PG8_MMA(1, 1, At, B1); PG8_BAR; PG8_SCHED;
            } else {
            PG8_LDB(B0, 0, 0); PG8_SCHED; PG8_LDA(At, 0, 0); PG8_STAGE(PG8_SA(1, 1), a1 + hstepA, voffA);
            PG8_WAIT_L(8); PG8_BAR; PG8_WAIT_L(0); PG8_MMA(0, 0, At, B0); PG8_BAR; PG8_SCHED;
            PG8_LDB(B1, 0, 1); PG8_STAGE(PG8_SB(0, 0), b2, voffB);
            PG8_BAR; PG8_WAIT_L(0); PG8_MMA(0, 1, At, B1); PG8_BAR;
            PG8_LDA(At, 0, 1); PG8_STAGE(PG8_SA(0, 0), a2, voffA);
            PG8_BAR; PG8_WAIT_L(0); PG8_MMA(1, 0, At, B0); PG8_BAR; PG8_SCHED;
            PG8_STAGE(PG8_SB(0, 1), b2 + hstepB, voffB);
            PG8_WAIT_V(6); PG8_BAR; PG8_MMA(1, 1, At, B1); PG8_BAR;
            PG8_LDB(B0, 1, 0); PG8_SCHED; PG8_LDA(At, 1, 0); PG8_STAGE(PG8_SA(0, 1), a2 + hstepA, voffA);
            PG8_WAIT_L(8); PG8_BAR; PG8_WAIT_L(0); PG8_MMA(0, 0, At, B0); PG8_BAR; PG8_SCHED;
            PG8_LDB(B1, 1, 1); PG8_STAGE(PG8_SB(1, 0), b3, voffB);
            PG8_BAR; PG8_WAIT_L(0); PG8_MMA(0, 1, At, B1); PG8_BAR;
            PG8_LDA(At, 1, 1); PG8_STAGE(PG8_SA(1, 0), a3, voffA);
            PG8_BAR; PG8_WAIT_L(0); PG8_MMA(1, 0, At, B0); PG8_BAR; PG8_SCHED;
            PG8_STAGE(PG8_SB(1, 1), b3 + hstepB, voffB);
            PG8_WAIT_V(6); PG8_BAR; PG8_MMA(1, 1, At, B1); PG8_BAR;
            }
        }
        if constexpr (SP2) { if (wr == 0) PG8_BAR; }
        { int el; asm volatile("v_mbcnt_lo_u32_b32 %0, -1, 0\n\tv_mbcnt_hi_u32_b32 %0, -1, %0" : "=v"(el)); E(acc, cur, wr, wc, el & 15, el >> 4); }
        if (!has_next) break;
#pragma unroll
        for (int a = 0; a < 2; ++a)
#pragma unroll
            for (int b = 0; b < 2; ++b)
#pragma unroll
                for (int m = 0; m < 4; ++m)
#pragma unroll
                    for (int n = 0; n < 2; ++n) acc[a][b][m][n] = (f32x4){0.f, 0.f, 0.f, 0.f};
        cur = nxt; cA = nA; cB = nB; ++ui;
        if constexpr (SP2) { if (wr == 1) PG8_BAR; }
    }
    PG8_WAIT_V(0);
    if constexpr (!SP2) { if (wr == 0) PG8_BAR; }
    PG8_BAR;
#undef PG8_SA
#undef PG8_SB
#undef PG8_STAGE
#undef PG8_LDA
#undef PG8_LDB
#undef PG8_MMA
#undef PG8_WAIT_V
#undef PG8_WAIT_L
#undef PG8_BAR
#undef PG8_SCHED
}

#if defined(MK_SIMPLE_GEMM)
template <class Epi>
__device__ __forceinline__ void gemm_phase_simple(const Gemm g, const StaticOrder& S, const Epi& E) {
    const int tid = threadIdx.x, wid = __builtin_amdgcn_readfirstlane(tid >> 6), lane = tid & 63, wr = wid >> 2, wc = wid & 3, fr = lane & 15, fq = lane >> 4;
    Unit cur;
    for (int ui = 0; S.next(ui, cur); ++ui) {
        f32x4 acc[2][2][4][2];
#pragma unroll
        for (int a = 0; a < 2; ++a)
#pragma unroll
            for (int b = 0; b < 2; ++b)
#pragma unroll
                for (int m = 0; m < 4; ++m)
#pragma unroll
                    for (int n = 0; n < 2; ++n) acc[a][b][m][n] = (f32x4){0.f, 0.f, 0.f, 0.f};
        for (int k0 = 0; k0 < g.K; k0 += 32) {
            bf16x8 bf[2][2];
#pragma unroll
            for (int bj = 0; bj < 2; ++bj)
#pragma unroll
                for (int n = 0; n < 2; ++n) { const int slot = 16 * n + fr; const int wrow = cur.pn * BM + bj * HALF + wc * 32 + (Epi::PERM ? perm32(slot) : slot);
                    bf[bj][n] = *(const bf16x8*)(g.Bt + (size_t)wrow * g.K + k0 + 8 * fq); }
#pragma unroll
            for (int ai = 0; ai < 2; ++ai)
#pragma unroll
                for (int m = 0; m < 4; ++m) { const int arow = cur.pm * BM + ai * HALF + wr * 64 + m * 16 + fr;
                    const bf16x8 af = *(const bf16x8*)(g.A + (size_t)arow * g.lda + k0 + 8 * fq);
#pragma unroll
                    for (int bj = 0; bj < 2; ++bj)
#pragma unroll
                        for (int n = 0; n < 2; ++n) acc[ai][bj][m][n] = __builtin_amdgcn_mfma_f32_16x16x32_bf16(bf[bj][n], af, acc[ai][bj][m][n], 0, 0, 0); }
        }
        E(acc, cur, wr, wc, fr, fq);
    }
}
#define GEMM_PHASE(EPI, lds, g, S, E) pg8::gemm_phase_simple<EPI>(g, S, E)
#define GEMM_PHASE2(EPI, lds, g, S, E) pg8::gemm_phase_simple<EPI>(g, S, E)
#else
#define GEMM_PHASE(EPI, lds, g, S, E) pg8::gemm_phase<EPI, true>(lds, g, S, E)
#define GEMM_PHASE2(EPI, lds, g, S, E) pg8::gemm_phase<EPI, false>(lds, g, S, E)
#endif
struct EpiSwiglu {
    static constexpr bool PERM = true;
    bf16_t* O; int ldc;
    __device__ __forceinline__ void operator()(const f32x4 (&acc)[2][2][4][2], const Unit& u, int wr, int wc, int fr, int fq) const {
        const int row0 = u.pm * BM + wr * 64 + fr, col0 = u.pn * 128 + wc * 32 + 8 * fq;
#pragma unroll
        for (int ai = 0; ai < 2; ++ai)
#pragma unroll
            for (int m = 0; m < 4; ++m) {
                bf16_t* rowp = O + (size_t)(row0 + ai * HALF + m * 16) * ldc + col0;
                const f32x4 g0 = acc[ai][0][m][0], g1 = acc[ai][0][m][1], u0 = acc[ai][1][m][0], u1 = acc[ai][1][m][1];
                float v[8];
#pragma unroll
                for (int j = 0; j < 4; ++j) { v[j] = fsilu(g0[j]) * u0[j]; v[4 + j] = fsilu(g1[j]) * u1[j]; }
                u32x4 w; w.x = pk_bf16(v[0], v[1]); w.y = pk_bf16(v[2], v[3]); w.z = pk_bf16(v[4], v[5]); w.w = pk_bf16(v[6], v[7]);
                *(u32x4*)rowp = w;
                asm volatile("" ::: "memory");
            }
    }
};
__device__ __forceinline__ void store_tile_bf16(const f32x4 (&acc)[2][2][4][2], bf16_t* base, int ld, int row0, int col0, int act) {
#pragma unroll
    for (int ai = 0; ai < 2; ++ai)
#pragma unroll
        for (int m = 0; m < 4; ++m) {
            bf16_t* rowp = base + (size_t)(row0 + ai * HALF + m * 16) * ld + col0;
#pragma unroll
            for (int bj = 0; bj < 2; ++bj) {
                f32x4 v0 = acc[ai][bj][m][0], v1 = acc[ai][bj][m][1];
                if (act == 1) {
#pragma unroll
                    for (int j = 0; j < 4; ++j) { v0[j] = fgelu(v0[j]); v1[j] = fgelu(v1[j]); }
                } else if (act == 2) {
#pragma unroll
                    for (int j = 0; j < 4; ++j) { v0[j] = fsigmoid(v0[j]); v1[j] = fsigmoid(v1[j]); }
                }
                u32x4 w; w.x = pk_bf16(v0[0], v0[1]); w.y = pk_bf16(v0[2], v0[3]); w.z = pk_bf16(v1[0], v1[1]); w.w = pk_bf16(v1[2], v1[3]);
                *(u32x4*)(rowp + bj * HALF) = w;
            }
            asm volatile("" ::: "memory");
        }
}
template <int ACT> struct EpiAct {
    static constexpr bool PERM = true;
    bf16_t* p; int ld, pn0;
    __device__ __forceinline__ void operator()(const f32x4 (&acc)[2][2][4][2], const Unit& u, int wr, int wc, int fr, int fq) const {
        store_tile_bf16(acc, p, ld, u.pm * BM + wr * 64 + fr, (u.pn - pn0) * BM + wc * 32 + 8 * fq, ACT);
    }
};
struct EpiWinA {
    static constexpr bool PERM = true;
    bf16_t* zq; bf16_t* xl; bf16_t* gy;
    __device__ __forceinline__ void operator()(const f32x4 (&acc)[2][2][4][2], const Unit& u, int wr, int wc, int fr, int fq) const {
        size_t boff = 0; if (u.pn >= 2) boff += (size_t)((const char*)xl - (const char*)zq); if (u.pn >= 6) boff += (size_t)((const char*)gy - (const char*)xl);
        bf16_t* base = (bf16_t*)((char*)zq + boff);
        int ld = 512, pn0 = 0; if (u.pn >= 2) { ld = D; pn0 = 2; } if (u.pn >= 6) pn0 = 6;
        store_tile_bf16(acc, base, ld, u.pm * BM + wr * 64 + fr, (u.pn - pn0) * BM + wc * 32 + 8 * fq, u.pn < 6 ? 0 : 1);
    }
};
struct EpiWinB {
    static constexpr bool PERM = true;
    bf16_t* ga; bf16_t* gl;
    __device__ __forceinline__ void operator()(const f32x4 (&acc)[2][2][4][2], const Unit& u, int wr, int wc, int fr, int fq) const {
        store_tile_bf16(acc, u.pn < 4 ? ga : gl, D, u.pm * BM + wr * 64 + fr, (u.pn & 3) * BM + wc * 32 + 8 * fq, 2);
    }
};
template <bool ADD> struct EpiGate {
    static constexpr bool PERM = true;
    const bf16_t* gate; const bf16_t* add; bf16_t* out;
    __device__ __forceinline__ void operator()(const f32x4 (&acc)[2][2][4][2], const Unit& u, int wr, int wc, int fr, int fq) const {
        const int row0 = u.pm * BM + wr * 64 + fr, col0 = u.pn * BM + wc * 32 + 8 * fq;
#pragma unroll
        for (int ai = 0; ai < 2; ++ai)
#pragma unroll
            for (int m = 0; m < 4; ++m) {
                const size_t off = (size_t)(row0 + ai * HALF + m * 16) * D + col0;
#pragma unroll
                for (int bj = 0; bj < 2; ++bj) {
                    const u32x4 gw = *(const u32x4*)(gate + off + bj * HALF);
                    const f32x4 v0 = acc[ai][bj][m][0], v1 = acc[ai][bj][m][1];
                    float r[8];
                    r[0] = lo_bf(gw.x) * v0[0]; r[1] = hi_bf(gw.x) * v0[1]; r[2] = lo_bf(gw.y) * v0[2]; r[3] = hi_bf(gw.y) * v0[3];
                    r[4] = lo_bf(gw.z) * v1[0]; r[5] = hi_bf(gw.z) * v1[1]; r[6] = lo_bf(gw.w) * v1[2]; r[7] = hi_bf(gw.w) * v1[3];
                    if (ADD) {
                        const u32x4 aw = *(const u32x4*)(add + off + bj * HALF);
                        r[0] += lo_bf(aw.x); r[1] += hi_bf(aw.x); r[2] += lo_bf(aw.y); r[3] += hi_bf(aw.y);
                        r[4] += lo_bf(aw.z); r[5] += hi_bf(aw.z); r[6] += lo_bf(aw.w); r[7] += hi_bf(aw.w);
                    }
                    u32x4 w; w.x = pk_bf16(r[0], r[1]); w.y = pk_bf16(r[2], r[3]); w.z = pk_bf16(r[4], r[5]); w.w = pk_bf16(r[6], r[7]);
                    *(u32x4*)(out + off + bj * HALF) = w;
                }
                asm volatile("" ::: "memory");
            }
    }
};
struct EpiQKV {
    static constexpr bool PERM = true;
    bf16_t* Q; bf16_t* Kn;
    __device__ __forceinline__ void operator()(const f32x4 (&acc)[2][2][4][2], const Unit& u, int wr, int wc, int fr, int fq) const {
        size_t boff = 0; if (u.pn >= 3) boff += (size_t)((const char*)Kn - (const char*)Q); if (u.pn >= 5) boff += (size_t)T * NKV * 2;
        bf16_t* dst = (bf16_t*)((char*)Q + boff);
        int ld = NQ, ctile = u.pn * BM; if (u.pn >= 3) { ld = NKV; ctile = ((u.pn - 3) & 1) * BM; }
        store_tile_bf16(acc, dst, ld, u.pm * BM + wr * 64 + fr, ctile + wc * 32 + 8 * fq, 0);
    }
};
}

struct TJob { const float* src; const float* scale; bf16_t* dst; int ldsrc, K, lddst, dstk0, nrb, map, nbatch, sbs, dbs; };
__device__ __forceinline__ int srccol(int map, int rb) {
    const int r = rb * 32;
    switch (map) {
        case 1: { const int pn = r >> 8, w = r & 255; return w < 128 ? 128 * pn + w : DFF + 128 * pn + (w - 128); }
        case 2: { if (r < 416) return r; if (r < 512) return -1; return r - 96; }
        case 3: return 2464 + r;
        case 4: { const int v = r >= 512 ? 1 : 0; const int rr = r & 511; return (rr >> 6) * 128 + (rr & 63) + 64 * v; }
        default: return r;
    }
}
constexpr int NJOBS = 15;
__device__ __forceinline__ TJob get_job(const Params& p, int j) {
    TJob t; t.scale = nullptr; t.dstk0 = 0; t.map = 0; t.nbatch = 1; t.sbs = 0; t.dbs = 0;
    unsigned char* ws = p.ws;
    switch (j) {
        case 0:  t.src = p.in[8];  t.dst = (bf16_t*)(ws + WS_WGU1); t.ldsrc = 2 * DFF; t.K = D; t.lddst = D; t.nrb = 176; t.map = 1; break;
        case 1:  t.src = p.in[9];  t.dst = (bf16_t*)(ws + WS_WDN1); t.ldsrc = D; t.K = DFF; t.lddst = DFF; t.nrb = 32; break;
        case 2:  t.src = p.in[10]; t.dst = (bf16_t*)(ws + WS_WINA); t.ldsrc = 4512; t.K = D; t.lddst = D; t.nrb = 80; t.map = 2; break;
        case 3:  t.src = p.in[10]; t.dst = (bf16_t*)(ws + WS_WINB); t.ldsrc = 4512; t.K = D; t.lddst = D; t.nrb = 64; t.map = 3; break;
        case 4:  t.src = p.in[13]; t.scale = p.in[11]; t.dst = (bf16_t*)(ws + WS_WQKV); t.ldsrc = 768; t.K = 256; t.lddst = 384; t.nrb = 24; break;
        case 5:  t.src = nullptr;  t.dst = (bf16_t*)(ws + WS_WQKV); t.ldsrc = 0; t.K = 128; t.lddst = 384; t.dstk0 = 256; t.nrb = 24; break;
        case 6:  t.src = p.in[14]; t.scale = p.in[12]; t.dst = (bf16_t*)(ws + WS_WQKV) + 768 * 384; t.ldsrc = 1024; t.K = 128; t.lddst = 384; t.dstk0 = 256; t.nrb = 32; t.map = 4; break;
        case 7:  t.src = nullptr;  t.dst = (bf16_t*)(ws + WS_WQKV) + 768 * 384; t.ldsrc = 0; t.K = 256; t.lddst = 384; t.nrb = 32; break;
        case 8:  t.src = p.in[15]; t.dst = (bf16_t*)(ws + WS_WAO); t.ldsrc = D; t.K = 512; t.lddst = 512; t.nrb = 32; break;
        case 9:  t.src = p.in[23]; t.dst = (bf16_t*)(ws + WS_WLO); t.ldsrc = D; t.K = D; t.lddst = D; t.nrb = 32; break;
        case 10: t.src = p.in[24]; t.dst = (bf16_t*)(ws + WS_WOUT); t.ldsrc = D; t.K = D; t.lddst = D; t.nrb = 32; break;
        case 11: t.src = p.in[25]; t.dst = (bf16_t*)(ws + WS_WGU2); t.ldsrc = 2 * DFF; t.K = D; t.lddst = D; t.nrb = 176; t.map = 1; break;
        case 12: t.src = p.in[26]; t.dst = (bf16_t*)(ws + WS_WDN2); t.ldsrc = D; t.K = DFF; t.lddst = DFF; t.nrb = 32; break;
        case 13: t.src = p.in[18]; t.dst = (bf16_t*)(ws + WS_WG); t.ldsrc = 128; t.K = 128; t.lddst = 128; t.nrb = 4; t.nbatch = 16; t.sbs = 16384; t.dbs = 32768; break;
        default: t.src = p.in[20]; t.dst = (bf16_t*)(ws + WS_WG) + 16384; t.ldsrc = 128; t.K = 128; t.lddst = 128; t.nrb = 4; t.nbatch = 16; t.sbs = 16384; t.dbs = 32768; break;
    }
    return t;
}
__device__ __forceinline__ int job_items(const TJob& t) { return t.nbatch * t.nrb * (t.K >> 6); }

__device__ __forceinline__ void tr_item(const TJob& jb, int item, LAS float* scr, int lane) {
    const int nkb = jb.K >> 6, per_batch = jb.nrb * nkb;
    const int bt = item / per_batch, r = item - bt * per_batch, rb = r / nkb, kb = r - rb * nkb;
    const int sc = srccol(jb.map, rb), k0 = 64 * kb;
    if (jb.src != nullptr && sc >= 0) {
        const float* src = jb.src + (size_t)bt * jb.sbs;
#pragma unroll 8
        for (int i = 0; i < 32; ++i) { const int kk = 2 * i + (lane >> 5);
            float v = src[(size_t)(k0 + kk) * jb.ldsrc + sc + (lane & 31)];
            if (jb.scale) v *= jb.scale[k0 + kk];
            scr[kk * 33 + (lane & 31)] = v; }
    } else {
#pragma unroll 8
        for (int i = 0; i < 32; ++i) { const int kk = 2 * i + (lane >> 5); scr[kk * 33 + (lane & 31)] = 0.f; }
    }
    asm volatile("s_waitcnt lgkmcnt(0)" ::: "memory");
    bf16_t* dst = jb.dst + (size_t)bt * jb.dbs;
    const int c = lane & 7;
#pragma unroll
    for (int j = 0; j < 4; ++j) { const int n = (lane >> 3) + 8 * j; const LAS float* s = scr + (8 * c) * 33 + n;
        u32x4 o; o.x = pk_bf16(s[0 * 33], s[1 * 33]); o.y = pk_bf16(s[2 * 33], s[3 * 33]); o.z = pk_bf16(s[4 * 33], s[5 * 33]); o.w = pk_bf16(s[6 * 33], s[7 * 33]);
        *(u32x4*)(dst + (size_t)(32 * rb + n) * jb.lddst + jb.dstk0 + k0 + 8 * c) = o; }
    asm volatile("s_waitcnt lgkmcnt(0)" ::: "memory");
}

__device__ __forceinline__ void phase_prep(const Params& p, LAS unsigned char* lds) {
    const int tid = threadIdx.x, lane = tid & 63, wave = tid >> 6;
    const int gw = blockIdx.x * NWAVES + wave, NGW = gridDim.x * NWAVES;
    {
        LAS float* scr = (LAS float*)(lds + wave * 8704);
        int base = 0;
        for (int j = 0; j < NJOBS; ++j) {
            const TJob jb = get_job(p, j); const int n = job_items(jb);
            int first = gw - (base % NGW); if (first < 0) first += NGW;
            for (int i = first; i < n; i += NGW) tr_item(jb, i, scr, lane);
            base += n;
        }
    }
    {
        const int gt = blockIdx.x * NTHREADS + tid;
        if (gt < SS * 16) {
            const int pos = gt >> 4, i = gt & 15;
            double inv = 1.0; for (int q = 0; q < i; ++q) inv *= 0.5623413251903491;
            const float ang = (float)pos * (float)inv;
            const double rev = (double)ang * 0.15915494309189535; const float fr = (float)(rev - rint(rev));
            ((float*)(p.ws + WS_ROPE))[gt] = __builtin_amdgcn_cosf(fr);
            ((float*)(p.ws + WS_ROPE))[SS * 16 + gt] = __builtin_amdgcn_sinf(fr);
        }
    }
    __syncthreads();
    for (int item = blockIdx.x; item < 144; item += gridDim.x) {
        LAS float* sc = (LAS float*)(lds) + wave * (128 * 33);
        for (int i = 0; i < 64; ++i) { const int idx = lane + 64 * i, kl = idx & 127, b = idx >> 7;
            const float cv = (b < 16 ? p.in[2] : p.in[3])[(b & 15) * D + 128 * wave + kl];
            sc[kl * 33 + b] = fsilu(cv); }
        asm volatile("s_waitcnt lgkmcnt(0)" ::: "memory");
        float acc[32];
#pragma unroll
        for (int b = 0; b < 32; ++b) acc[b] = 0.f;
        const float* W = p.in[4] + (size_t)(128 * wave) * 9216 + item * 64 + lane;
        for (int k = 0; k < 128; ++k) { const float wv = W[(size_t)k * 9216];
#pragma unroll
            for (int b = 0; b < 32; ++b) acc[b] += sc[k * 33 + b] * wv; }
        __syncthreads();
        LAS float* red = (LAS float*)(lds);
#pragma unroll
        for (int b = 0; b < 32; ++b) red[(wave * 32 + b) * 64 + lane] = acc[b];
        __syncthreads();
        for (int o = tid; o < 2048; o += NTHREADS) { const int b = o >> 6, col = o & 63; float s = 0.f;
#pragma unroll
            for (int w = 0; w < 8; ++w) s += red[(w * 32 + b) * 64 + col];
            const int j = item * 64 + col;
            ((float*)(p.ws + WS_MOD))[b * 9216 + j] = s + p.in[5][j]; }
        __syncthreads();
    }
}

template <bool HAS_F, bool HAS_H>
__device__ __forceinline__ void phase_rows(const Params& p, int sp, int sn, float resw, bool from_input) {
    const int tid = threadIdx.x, lane = tid & 63, wave = tid >> 6;
    const int gw = blockIdx.x * NWAVES + wave, NGW = gridDim.x * NWAVES;
    const float* mod = (const float*)(p.ws + WS_MOD);
    const bf16_t* F = (const bf16_t*)(p.ws + WS_F);
    bf16_t* H = (bf16_t*)(p.ws + WS_H);
    for (int row = gw; row < T; row += NGW) {
        const int b = row_batch(row);
        const float* xin = !from_input ? p.out + (size_t)row * D : (row < TP ? p.in[0] + (size_t)row * D : p.in[1] + (size_t)(row - TP) * D);
        f32x4 v[4];
#pragma unroll
        for (int j = 0; j < 4; ++j) v[j] = *(const f32x4*)(xin + 4 * lane + 256 * j);
        if (HAS_F) {
            f32x4 f[4]; float ss = 0.f;
#pragma unroll
            for (int j = 0; j < 4; ++j) { const u32x2 w = *(const u32x2*)(F + (size_t)row * D + 4 * lane + 256 * j);
                f[j] = (f32x4){lo_bf(w.x), hi_bf(w.x), lo_bf(w.y), hi_bf(w.y)}; ss += (f[j].x * f[j].x + f[j].y * f[j].y) + (f[j].z * f[j].z + f[j].w * f[j].w); }
            const float rs = 1.0f / sqrtf(wave_sum(ss) * (1.0f / D) + EPS) * resw;
            const float* gate = mod + b * 9216 + sp * 3072 + 2048; const float* gp = p.in[7] + sp * D;
#pragma unroll
            for (int j = 0; j < 4; ++j) { const f32x4 g = *(const f32x4*)(gate + 4 * lane + 256 * j), q = *(const f32x4*)(gp + 4 * lane + 256 * j);
                v[j] = v[j] + g * (f[j] * rs * q);
                *(f32x4*)(p.out + (size_t)row * D + 4 * lane + 256 * j) = v[j]; }
        }
        if (HAS_H) {
            float ss = 0.f;
#pragma unroll
            for (int j = 0; j < 4; ++j) ss += (v[j].x * v[j].x + v[j].y * v[j].y) + (v[j].z * v[j].z + v[j].w * v[j].w);
            const float rs = 1.0f / sqrtf(wave_sum(ss) * (1.0f / D) + EPS);
            const float* sh = mod + b * 9216 + sn * 3072; const float* scl = sh + 1024; const float* gq = p.in[6] + sn * D;
#pragma unroll
            for (int j = 0; j < 4; ++j) { const f32x4 a = *(const f32x4*)(sh + 4 * lane + 256 * j), s = *(const f32x4*)(scl + 4 * lane + 256 * j), q = *(const f32x4*)(gq + 4 * lane + 256 * j);
                const f32x4 h = (v[j] * rs * q) * (s + 1.0f) + a;
                u32x2 w; w.x = pk_bf16(h.x, h.y); w.y = pk_bf16(h.z, h.w);
                *(u32x2*)(H + (size_t)row * D + 4 * lane + 256 * j) = w; }
        }
    }
}

__device__ __forceinline__ void phase_stats(const Params& p, const int wg0, const int nwg) {
    const int tid = threadIdx.x, lane = tid & 63, wave = tid >> 6;
    const int gw = ((int)blockIdx.x - wg0) * NWAVES + wave, NGW = nwg * NWAVES;
    bf16_t* ZQ = (bf16_t*)(p.ws + WS_ZQ);
    bf16_t* KR = (bf16_t*)(p.ws + WS_KR);
    const float* rc = (const float*)(p.ws + WS_ROPE); const float* rsn = rc + SS * 16;
    for (int row = gw; row < T; row += NGW) {
        const u32x4 w = *(const u32x4*)(ZQ + (size_t)row * 512 + 8 * lane);
        float x[8] = {lo_bf(w.x), hi_bf(w.x), lo_bf(w.y), hi_bf(w.y), lo_bf(w.z), hi_bf(w.z), lo_bf(w.w), hi_bf(w.w)};
        float ss = 0.f;
#pragma unroll
        for (int e = 0; e < 8; ++e) ss += x[e] * x[e];
        const float sq = wave_sum(lane < 32 ? ss : 0.f), skv = wave_sum((lane >= 32 && lane < 48) ? ss : 0.f);
        {
            const float rq = 1.0f / sqrtf(sq * (1.0f / 256.0f) + EPS), rkv = 1.0f / sqrtf(skv * (1.0f / 128.0f) + EPS);
            if (lane < 48) { const float r = lane < 32 ? rq : rkv;
                u32x4 o; o.x = pk_bf16(x[0] * r, x[1] * r); o.y = pk_bf16(x[2] * r, x[3] * r); o.z = pk_bf16(x[4] * r, x[5] * r); o.w = pk_bf16(x[6] * r, x[7] * r);
                *(u32x4*)(ZQ + (size_t)row * 512 + 8 * lane) = o; }
        }
        float y[8];
#pragma unroll
        for (int e = 0; e < 8; ++e) y[e] = __shfl_xor(x[e], 2);
        if (lane >= 48 && lane < 52) {
            const int pos = row_pos(row), i0 = 8 * (lane & 1);
            const f32x4 c0 = *(const f32x4*)(rc + pos * 16 + i0), c1 = *(const f32x4*)(rc + pos * 16 + i0 + 4);
            const f32x4 s0 = *(const f32x4*)(rsn + pos * 16 + i0), s1 = *(const f32x4*)(rsn + pos * 16 + i0 + 4);
            const float c[8] = {c0.x, c0.y, c0.z, c0.w, c1.x, c1.y, c1.z, c1.w}, s[8] = {s0.x, s0.y, s0.z, s0.w, s1.x, s1.y, s1.z, s1.w};
            float o[8];
            const bool first = lane < 50;
#pragma unroll
            for (int e = 0; e < 8; ++e) o[e] = first ? (x[e] * c[e] - y[e] * s[e]) : (x[e] * c[e] + y[e] * s[e]);
            u32x4 ow; ow.x = pk_bf16(o[0], o[1]); ow.y = pk_bf16(o[2], o[3]); ow.z = pk_bf16(o[4], o[5]); ow.w = pk_bf16(o[6], o[7]);
            *(u32x4*)(KR + (size_t)row * 32 + 8 * (lane - 48)) = ow;
        }
    }
}

constexpr int XC_PITCH = 272;
__device__ __forceinline__ void phase_lru(const Params& p, LAS unsigned char* lds) {
    const int tid = threadIdx.x, lane = tid & 63, wave = __builtin_amdgcn_readfirstlane(tid >> 6), g = lane >> 4, lc = lane & 15;
    const bf16_t* XL = (const bf16_t*)(p.ws + WS_XL); bf16_t* GY = (bf16_t*)(p.ws + WS_GY); bf16_t* HF = (bf16_t*)(p.ws + WS_F);
    const bf16_t* WG = (const bf16_t*)(p.ws + WS_WG);
    for (int item = blockIdx.x; item < 256; item += gridDim.x) {
        int gb, n;
        if (item < 128) { gb = 16 + (item >> 3); n = item & 7; } else { gb = (item - 128) >> 3; n = item & 7; }
        const int S = gb < 16 ? SP : SS; const int row0 = gb < 16 ? gb * SP : TP + (gb - 16) * SS;
        const int nch = S >> 6;
        const int tr = tid >> 4, cgp = (tid & 15) * 8, c0 = 128 * n + cgp;
        float cw[4][8], cb[8];
#pragma unroll
        for (int j = 0; j < 4; ++j) { const f32x4 a = *(const f32x4*)(p.in[16] + j * D + c0), b = *(const f32x4*)(p.in[16] + j * D + c0 + 4);
            cw[j][0] = a.x; cw[j][1] = a.y; cw[j][2] = a.z; cw[j][3] = a.w; cw[j][4] = b.x; cw[j][5] = b.y; cw[j][6] = b.z; cw[j][7] = b.w; }
        { const f32x4 a = *(const f32x4*)(p.in[17] + c0), b = *(const f32x4*)(p.in[17] + c0 + 4);
            cb[0] = a.x; cb[1] = a.y; cb[2] = a.z; cb[3] = a.w; cb[4] = b.x; cb[5] = b.y; cb[6] = b.z; cb[7] = b.w; }
        const int ch = 128 * n + 16 * wave + lc;
        for (int d = 0; d < 2; ++d) {
            bf16x8 Ba[4], Bi[4];
            { const bf16_t* wa = WG + (size_t)((d * 8 + n) * 2 + 0) * 16384 + (size_t)(16 * wave + lc) * 128 + 8 * g; const bf16_t* wi = wa + 16384;
#pragma unroll
              for (int ks = 0; ks < 4; ++ks) { Ba[ks] = *(const bf16x8*)(wa + 32 * ks); Bi[ks] = *(const bf16x8*)(wi + 32 * ks); } }
            const float ba = p.in[19][d * D + ch], bi = p.in[21][d * D + ch];
            const float lam = p.in[22][d * D + ch];
            const float c8 = -8.0f * log1pf(expf(-lam));
            const float nba = -1.4426950408889634f * ba, nbi = -1.4426950408889634f * bi, c8l = 1.4426950408889634f * c8;
#define BPERM(addr, v) __builtin_bit_cast(float, __builtin_amdgcn_ds_bpermute((addr), __builtin_bit_cast(int, (v))))
            const int bx16 = (lane ^ 16) << 2, bx32 = (lane ^ 32) << 2;
            const bool s1 = d ? !(g & 1) : (g & 1), s2 = d ? !(g >> 1) : (g >> 1);
            float carry = 0.f;
            u32x4 pw[2][4];
#define LRU_PREFETCH(CI) do { const int _cc = d ? (nch - 1 - (CI)) : (CI); _Pragma("unroll") for (int hf = 0; hf < 2; ++hf) _Pragma("unroll") for (int j = 0; j < 4; ++j) { \
                const int tt = _cc * 64 + tr + 32 * hf + j - 1; pw[hf][j] = (tt >= 0 && tt < S) ? *(const u32x4*)(XL + (size_t)(row0 + tt) * D + c0) : (u32x4){0u, 0u, 0u, 0u}; } } while (0)
            LRU_PREFETCH(0);
            for (int ci = 0; ci < nch; ++ci) {
                const int cc = d ? (nch - 1 - ci) : ci, t0 = cc * 64;
                __syncthreads();
#pragma unroll
                for (int hf = 0; hf < 2; ++hf) {
                    const int tl = tr + 32 * hf;
                    float a[8];
#pragma unroll
                    for (int e = 0; e < 8; ++e) a[e] = cb[e];
#pragma unroll
                    for (int j = 0; j < 4; ++j) { const u32x4 w = pw[hf][j];
                        a[0] += cw[j][0] * lo_bf(w.x); a[1] += cw[j][1] * hi_bf(w.x); a[2] += cw[j][2] * lo_bf(w.y); a[3] += cw[j][3] * hi_bf(w.y);
                        a[4] += cw[j][4] * lo_bf(w.z); a[5] += cw[j][5] * hi_bf(w.z); a[6] += cw[j][6] * lo_bf(w.w); a[7] += cw[j][7] * hi_bf(w.w); }
                    u32x4 o; o.x = pk_bf16(a[0], a[1]); o.y = pk_bf16(a[2], a[3]); o.z = pk_bf16(a[4], a[5]); o.w = pk_bf16(a[6], a[7]);
                    *(LAS u32x4*)(lds + tl * XC_PITCH + cgp * 2) = o;
                }
                __syncthreads();
                if (ci + 1 < nch) LRU_PREFETCH(ci + 1);
                float hfv[4][4], gyv[4][4];
                if (d == 1) {
                    const bf16_t* const hfi = HF + (size_t)(row0 + t0 + 4 * g) * D + ch; const bf16_t* const gyi = GY + (size_t)(row0 + t0 + 4 * g) * D + ch;
#pragma unroll
                    for (int mt = 0; mt < 4; ++mt)
#pragma unroll
                        for (int j = 0; j < 4; ++j) { hfv[mt][j] = bf2f(hfi[(16 * mt + j) * D]); gyv[mt][j] = bf2f(gyi[(16 * mt + j) * D]); }
                }
                f32x4 aa[4], ai[4];
#pragma unroll
                for (int mt = 0; mt < 4; ++mt) { aa[mt] = (f32x4){0.f, 0.f, 0.f, 0.f}; ai[mt] = (f32x4){0.f, 0.f, 0.f, 0.f}; }
#pragma unroll
                for (int ks = 0; ks < 4; ++ks)
#pragma unroll
                    for (int mt = 0; mt < 4; ++mt) { const bf16x8 A = *(const LAS bf16x8*)(lds + (16 * mt + lc) * XC_PITCH + (32 * ks + 8 * g) * 2);
                        aa[mt] = __builtin_amdgcn_mfma_f32_16x16x32_bf16(A, Ba[ks], aa[mt], 0, 0, 0);
                        ai[mt] = __builtin_amdgcn_mfma_f32_16x16x32_bf16(A, Bi[ks], ai[mt], 0, 0, 0); }
#pragma unroll
                for (int mt = 0; mt < 4; ++mt)
#pragma unroll
                    for (int j = 0; j < 4; ++j) {
                        const float xcv = bf2f(*(const LAS bf16_t*)(lds + (16 * mt + 4 * g + j) * XC_PITCH + (16 * wave + lc) * 2));
                        const float r = __builtin_amdgcn_rcpf(1.0f + __builtin_amdgcn_exp2f(__builtin_fmaf(aa[mt][j], -1.4426950408889634f, nba)));
                        const float ig = __builtin_amdgcn_rcpf(1.0f + __builtin_amdgcn_exp2f(__builtin_fmaf(ai[mt][j], -1.4426950408889634f, nbi)));
                        const float av = __builtin_amdgcn_exp2f(c8l * r), om = __builtin_fmaf(-av, av, 1.0f);
                        aa[mt][j] = av; ai[mt][j] = __builtin_amdgcn_sqrtf(om) * (ig * xcv);
                    }
#define LRU_COMBINE() \
                        const float A1 = BPERM(bx16, A), H1 = BPERM(bx16, Hs); \
                        const float PA = A * A1, PH = s1 ? (A * H1 + Hs) : (A1 * Hs + H1); \
                        const float exA = s1 ? A1 : 1.f, exH = s1 ? H1 : 0.f; \
                        const float A2 = BPERM(bx32, PA), H2 = BPERM(bx32, PH); \
                        const float TA = PA * A2, TH = s2 ? (PA * H2 + PH) : (A2 * PH + H2); \
                        const float Aex = s2 ? A2 * exA : exA, Hex = s2 ? (exA * H2 + exH) : exH; \
                        const float cin = Aex * carry + Hex; \
                        carry = TA * carry + TH;
                bf16_t* const hfo = HF + (size_t)(row0 + t0 + 4 * g) * D + ch;
                if (d == 0) {
#pragma unroll
                    for (int mt = 0; mt < 4; ++mt) {
                        float P = 1.f, Hh = 0.f, pl[4], hl[4];
#pragma unroll
                        for (int j = 0; j < 4; ++j) { Hh = aa[mt][j] * Hh + ai[mt][j]; P *= aa[mt][j]; hl[j] = Hh; pl[j] = P; }
                        const float A = P, Hs = Hh;
                        LRU_COMBINE()
#pragma unroll
                        for (int j = 0; j < 4; ++j) { const float h = hl[j] + pl[j] * cin;
                            hfo[(16 * mt + j) * D] = (bf16_t)(pk_bf16(h, 0.f) & 0xffffu); }
                    }
                } else {
                    bf16_t* const gyo = GY + (size_t)(row0 + t0 + 4 * g) * D + ch;
#pragma unroll
                    for (int mt = 3; mt >= 0; --mt) {
                        float P = 1.f, Hh = 0.f, pl[4], hl[4];
#pragma unroll
                        for (int j = 3; j >= 0; --j) { Hh = aa[mt][j] * Hh + ai[mt][j]; P *= aa[mt][j]; hl[j] = Hh; pl[j] = P; }
                        const float A = P, Hs = Hh;
                        LRU_COMBINE()
#pragma unroll
                        for (int j = 0; j < 4; ++j) { const float h = hl[j] + pl[j] * cin;
                            const float o = (hfv[mt][j] + h) * gyv[mt][j];
                            gyo[(16 * mt + j) * D] = (bf16_t)(pk_bf16(o, 0.f) & 0xffffu); }
                    }
                }
            }
        }
        __syncthreads();
    }
}

constexpr int AK_PITCH = 208, AV_PITCH = 160, AK_BYTES = 64 * AK_PITCH, AV_BYTES = 64 * AV_PITCH, ABUF = AK_BYTES + AV_BYTES;
__device__ __forceinline__ void phase_attn(const Params& p, LAS unsigned char* lds) {
    const int tid = threadIdx.x, lane = tid & 63, wave = __builtin_amdgcn_readfirstlane(tid >> 6), g = lane >> 4, lc = lane & 15;
    const bf16_t* Q = (const bf16_t*)(p.ws + WS_F); const bf16_t* KN = (const bf16_t*)(p.ws + WS_XL); const bf16_t* V = KN + (size_t)T * NKV;
    const bf16_t* KR = (const bf16_t*)(p.ws + WS_KR); bf16_t* O = (bf16_t*)(p.ws + WS_ZQ);
    const float csc = 0.10206207261596577f * 1.4426950408889634f;
    const int srow = tid >> 3, sch = tid & 7;
    const int rrow = (tid & 255) >> 2, rch = tid & 3;
    const int vtr = (4 * g + (lc >> 2)) * AV_PITCH + (4 * (lc & 3)) * 2;
    const int vwg = (gridDim.x % 8 == 0) ? (int)(blockIdx.x % 8) * (int)(gridDim.x / 8) + (int)(blockIdx.x / 8) : (int)blockIdx.x;
    for (int unit = vwg; unit < 3072; unit += gridDim.x) {
        int gb, h, qt, S, row0;
        if (unit < 2048) { gb = 16 + (unit >> 7); h = (unit & 127) >> 4; qt = unit & 15; S = SS; row0 = TP + (gb - 16) * SS; }
        else { const int u2 = unit - 2048; gb = u2 >> 6; h = (u2 & 63) >> 3; qt = u2 & 7; S = SP; row0 = gb * SP; }
        const int nkt = S >> 6;
        const int qrow = row0 + 256 * qt + 32 * wave;
        bf16x8 qf[2][3];
#pragma unroll
        for (int q2 = 0; q2 < 2; ++q2)
#pragma unroll
            for (int ks = 0; ks < 3; ++ks) qf[q2][ks] = *(const bf16x8*)(Q + (size_t)(qrow + 16 * q2 + lc) * NQ + 96 * h + 32 * ks + 8 * g);
#pragma unroll
        for (int q2 = 0; q2 < 2; ++q2) {
            const int pos = row_pos(qrow + 16 * q2 + lc), i0 = 8 * (g & 1);
            const float* rc = (const float*)(p.ws + WS_ROPE) + pos * 16 + i0; const float* rsn = rc + SS * 16;
            const f32x4 c0 = *(const f32x4*)rc, c1 = *(const f32x4*)(rc + 4), s0 = *(const f32x4*)rsn, s1 = *(const f32x4*)(rsn + 4);
            const float cc[8] = {c0.x, c0.y, c0.z, c0.w, c1.x, c1.y, c1.z, c1.w}, sn[8] = {s0.x, s0.y, s0.z, s0.w, s1.x, s1.y, s1.z, s1.w};
            const u32x4 mine = __builtin_bit_cast(u32x4, qf[q2][2]);
            u32x4 oth; oth.x = __shfl_xor(mine.x, 32); oth.y = __shfl_xor(mine.y, 32); oth.z = __shfl_xor(mine.z, 32); oth.w = __shfl_xor(mine.w, 32);
            const float xm[8] = {lo_bf(mine.x), hi_bf(mine.x), lo_bf(mine.y), hi_bf(mine.y), lo_bf(mine.z), hi_bf(mine.z), lo_bf(mine.w), hi_bf(mine.w)};
            const float xo[8] = {lo_bf(oth.x), hi_bf(oth.x), lo_bf(oth.y), hi_bf(oth.y), lo_bf(oth.z), hi_bf(oth.z), lo_bf(oth.w), hi_bf(oth.w)};
            float o[8];
#pragma unroll
            for (int e = 0; e < 8; ++e) o[e] = g < 2 ? (xm[e] * cc[e] - xo[e] * sn[e]) : (xm[e] * cc[e] + xo[e] * sn[e]);
            u32x4 w; w.x = pk_bf16(o[0], o[1]); w.y = pk_bf16(o[2], o[3]); w.z = pk_bf16(o[4], o[5]); w.w = pk_bf16(o[6], o[7]);
            qf[q2][2] = __builtin_bit_cast(bf16x8, w);
        }
        f32x4 oacc[4][2];
#pragma unroll
        for (int dt = 0; dt < 4; ++dt) { oacc[dt][0] = (f32x4){0.f, 0.f, 0.f, 0.f}; oacc[dt][1] = (f32x4){0.f, 0.f, 0.f, 0.f}; }
        float mrun[2] = {-1e30f, -1e30f}, lrun[2] = {0.f, 0.f};
        u32x4 gk, gr, gv;
        gk = *(const u32x4*)(KN + (size_t)(row0 + srow) * NKV + 64 * h + 8 * sch);
        gv = *(const u32x4*)(V + (size_t)(row0 + srow) * NKV + 64 * h + 8 * sch);
        gr = *(const u32x4*)(KR + (size_t)(row0 + rrow) * 32 + 8 * rch);
        __syncthreads();
        *(LAS u32x4*)(lds + srow * AK_PITCH + sch * 16) = gk;
        *(LAS u32x4*)(lds + AK_BYTES + srow * AV_PITCH + sch * 16) = gv;
        if (tid < 256) *(LAS u32x4*)(lds + rrow * AK_PITCH + 128 + rch * 16) = gr;
        u32x4 gk2, gr2, gv2;
        gk = *(const u32x4*)(KN + (size_t)(row0 + 64 + srow) * NKV + 64 * h + 8 * sch);
        gv = *(const u32x4*)(V + (size_t)(row0 + 64 + srow) * NKV + 64 * h + 8 * sch);
        gr = *(const u32x4*)(KR + (size_t)(row0 + 64 + rrow) * 32 + 8 * rch);
        gk2 = *(const u32x4*)(KN + (size_t)(row0 + 128 + srow) * NKV + 64 * h + 8 * sch);
        gv2 = *(const u32x4*)(V + (size_t)(row0 + 128 + srow) * NKV + 64 * h + 8 * sch);
        gr2 = *(const u32x4*)(KR + (size_t)(row0 + 128 + rrow) * 32 + 8 * rch);
        __syncthreads();
#define ATT_BODY(kt, GK, GR, GV) do { \
            LAS unsigned char* kb = lds + ((kt) & 1) * ABUF; LAS unsigned char* vb = kb + AK_BYTES; \
            LAS unsigned char* nb = lds + (((kt) + 1) & 1) * ABUF; \
            const bool more = (kt) + 1 < nkt; \
 \
            f32x4 sacc[4][2]; \
            _Pragma("unroll") \
            for (int k4 = 0; k4 < 4; ++k4) { sacc[k4][0] = (f32x4){0.f, 0.f, 0.f, 0.f}; sacc[k4][1] = (f32x4){0.f, 0.f, 0.f, 0.f}; } \
            _Pragma("unroll") \
            for (int ks = 0; ks < 3; ++ks) \
            _Pragma("unroll") \
                for (int k4 = 0; k4 < 4; ++k4) { const bf16x8 kf = *(const LAS bf16x8*)(kb + (16 * k4 + lc) * AK_PITCH + (32 * ks + 8 * g) * 2); \
                    sacc[k4][0] = __builtin_amdgcn_mfma_f32_16x16x32_bf16(kf, qf[0][ks], sacc[k4][0], 0, 0, 0); \
                    sacc[k4][1] = __builtin_amdgcn_mfma_f32_16x16x32_bf16(kf, qf[1][ks], sacc[k4][1], 0, 0, 0); } \
            bf16x8 pf[2][2]; \
            _Pragma("unroll") \
            for (int q2 = 0; q2 < 2; ++q2) { \
                float mx = sacc[0][q2][0]; \
            _Pragma("unroll") \
                for (int k4 = 0; k4 < 4; ++k4) \
            _Pragma("unroll") \
                    for (int j = 0; j < 4; ++j) mx = fmaxf(mx, sacc[k4][q2][j]); \
                mx = fmaxf(mx, __shfl_xor(mx, 16)); mx = fmaxf(mx, __shfl_xor(mx, 32)); \
                const float mnew = fmaxf(mrun[q2], mx * csc); \
                const float alpha = __builtin_amdgcn_exp2f(mrun[q2] - mnew); \
                mrun[q2] = mnew; \
                float ps = 0.f; float pv[4][4]; \
            _Pragma("unroll") \
                for (int k4 = 0; k4 < 4; ++k4) \
            _Pragma("unroll") \
                    for (int j = 0; j < 4; ++j) { const float e = __builtin_amdgcn_exp2f(sacc[k4][q2][j] * csc - mnew); pv[k4][j] = e; ps += e; } \
                lrun[q2] = lrun[q2] * alpha + ps; \
            _Pragma("unroll") \
                for (int dt = 0; dt < 4; ++dt) oacc[dt][q2] *= alpha; \
            _Pragma("unroll") \
                for (int kk = 0; kk < 2; ++kk) { \
                    u32x4 w; w.x = pk_bf16(pv[2 * kk][0], pv[2 * kk][1]); w.y = pk_bf16(pv[2 * kk][2], pv[2 * kk][3]); \
                    w.z = pk_bf16(pv[2 * kk + 1][0], pv[2 * kk + 1][1]); w.w = pk_bf16(pv[2 * kk + 1][2], pv[2 * kk + 1][3]); \
                    pf[q2][kk] = __builtin_bit_cast(bf16x8, w); \
                } \
            } \
 \
            _Pragma("unroll") \
            for (int kk = 0; kk < 2; ++kk) \
            _Pragma("unroll") \
                for (int dt = 0; dt < 4; ++dt) { \
                    const v4i16_t lo = __builtin_amdgcn_ds_read_tr16_b64_v4i16((LAS v4i16_t*)(vb + vtr + (32 * kk) * AV_PITCH + 32 * dt)); \
                    const v4i16_t hi = __builtin_amdgcn_ds_read_tr16_b64_v4i16((LAS v4i16_t*)(vb + vtr + (32 * kk + 16) * AV_PITCH + 32 * dt)); \
                    const bf16x8 vf = {lo[0], lo[1], lo[2], lo[3], hi[0], hi[1], hi[2], hi[3]}; \
                    oacc[dt][0] = __builtin_amdgcn_mfma_f32_16x16x32_bf16(vf, pf[0][kk], oacc[dt][0], 0, 0, 0); \
                    oacc[dt][1] = __builtin_amdgcn_mfma_f32_16x16x32_bf16(vf, pf[1][kk], oacc[dt][1], 0, 0, 0); \
                } \
            if (more) { \
                *(LAS u32x4*)(nb + srow * AK_PITCH + sch * 16) = GK; \
                *(LAS u32x4*)(nb + AK_BYTES + srow * AV_PITCH + sch * 16) = GV; \
                if (tid < 256) *(LAS u32x4*)(nb + rrow * AK_PITCH + 128 + rch * 16) = GR; \
            } \
            if ((kt) + 3 < nkt) { const int kr0 = row0 + 64 * ((kt) + 3); \
                GK = *(const u32x4*)(KN + (size_t)(kr0 + srow) * NKV + 64 * h + 8 * sch); \
                GV = *(const u32x4*)(V + (size_t)(kr0 + srow) * NKV + 64 * h + 8 * sch); \
                GR = *(const u32x4*)(KR + (size_t)(kr0 + rrow) * 32 + 8 * rch); } \
            __syncthreads(); \
        } while (0)
        for (int kt2 = 0; kt2 < nkt; kt2 += 2) { ATT_BODY(kt2, gk, gr, gv); ATT_BODY(kt2 + 1, gk2, gr2, gv2); }
#undef ATT_BODY
#pragma unroll
        for (int q2 = 0; q2 < 2; ++q2) {
            float l = lrun[q2]; l += __shfl_xor(l, 16); l += __shfl_xor(l, 32);
            const float inv = 1.0f / l;
#pragma unroll
            for (int dt = 0; dt < 4; ++dt) { const f32x4 o = oacc[dt][q2] * inv;
                u32x2 w; w.x = pk_bf16(o[0], o[1]); w.y = pk_bf16(o[2], o[3]);
                *(u32x2*)(O + (size_t)(qrow + 16 * q2 + lc) * 512 + 64 * h + 16 * dt + 4 * g) = w; }
        }
    }
    __syncthreads();
}

#define XB_TMO      128
#define XB_XCNT(j)  (256  + 64 * (j))
#define XB_XSUB(j)  (1280 + 64 * (j))
#define XB_XGEN(j)  (2304 + 64 * (j))
#define XB_TOP      3328
#define XB_TOPGEN   3392
#define XCD_BAR_WORDS 3456
#define XB_SPIN_CAP (1u << 18)

__device__ __forceinline__ unsigned xb_ld(unsigned* p)              { return __hip_atomic_load(p, __ATOMIC_RELAXED, __HIP_MEMORY_SCOPE_AGENT); }
__device__ __forceinline__ unsigned xb_add(unsigned* p, unsigned v) { return __hip_atomic_fetch_add(p, v, __ATOMIC_RELAXED, __HIP_MEMORY_SCOPE_AGENT); }
__device__ __forceinline__ unsigned xb_xcc_id() { return (unsigned)__builtin_amdgcn_s_getreg((3 << 11) | 20) & 0xFu; }
#define XB_SPIN(cond, bar) do { unsigned _sp = 0; while (cond) { __builtin_amdgcn_s_sleep(1); \
    if ((++_sp & 255u) == 0u) { if (xb_ld(&(bar)[XB_TMO])) break; if (_sp > XB_SPIN_CAP) { atomicAdd(&(bar)[XB_TMO], 1u); break; } } } } while (0)

struct XcdBarrier {
    unsigned* bar; unsigned x;
    volatile LAS unsigned* st;
};

__device__ __forceinline__ XcdBarrier xcd_barrier_post(unsigned* bar, volatile LAS unsigned* st) {
    XcdBarrier b; b.bar = bar; b.x = xb_xcc_id(); b.st = st;
    if (threadIdx.x == 0) (void)xb_add(&bar[XB_XCNT(b.x)], 1u);
    return b;
}
__device__ __forceinline__ void xcd_barrier_complete(unsigned* bar, unsigned x, unsigned& nloc, unsigned& nx) {
    const unsigned G = gridDim.x * gridDim.y * gridDim.z;
    unsigned sum, cnt, mine, sp = 0u;
    for (;;) {
        sum = 0u; cnt = 0u; mine = 0u;
#pragma unroll
        for (unsigned j = 0; j < 16; ++j) { const unsigned c = xb_ld(&bar[XB_XCNT(j)]); sum += c; cnt += (c > 0u) ? 1u : 0u; mine = (j == x) ? c : mine; }
        if (sum == G) break;
        __builtin_amdgcn_s_sleep(1);
        if ((++sp & 255u) == 0u) { if (xb_ld(&bar[XB_TMO])) break; if (sp > XB_SPIN_CAP) { atomicAdd(&bar[XB_TMO], 1u); break; } }
    }
    nloc = mine > 0u ? mine : 1u; nx = cnt > 0u ? cnt : 1u;
}

__device__ __forceinline__ void xcd_barrier(const XcdBarrier& b) {
    asm volatile("s_waitcnt vmcnt(0)" ::: "memory");
    __syncthreads();
    if (threadIdx.x == 0) {
        unsigned* bar = b.bar;
        __builtin_amdgcn_s_waitcnt(0);
        unsigned nloc = b.st[0], nx = b.st[1];
        if (nloc == 0u) { xcd_barrier_complete(bar, b.x, nloc, nx); b.st[0] = nloc; b.st[1] = nx; }
        const unsigned old = xb_add(&bar[XB_XSUB(b.x)], 1u);
        const unsigned gen = old / nloc;
        if (old + 1u == (gen + 1u) * nloc) {
            __builtin_amdgcn_fence(__ATOMIC_RELEASE, "agent");
            asm volatile("s_waitcnt vmcnt(0)" ::: "memory");
            const unsigned og = xb_add(&bar[XB_TOP], 1u);
            const unsigned tg = og / nx;
            if (og + 1u == (tg + 1u) * nx) xb_add(&bar[XB_TOPGEN], 1u);
            else XB_SPIN(xb_ld(&bar[XB_TOPGEN]) == tg, bar);
            __builtin_amdgcn_fence(__ATOMIC_ACQUIRE, "agent");
            xb_add(&bar[XB_XGEN(b.x)], 1u);
            asm volatile("s_waitcnt vmcnt(0)" ::: "memory");
        } else {
            XB_SPIN(xb_ld(&bar[XB_XGEN(b.x)]) == gen, bar);
            __builtin_amdgcn_fence(__ATOMIC_ACQUIRE, "agent");
            asm volatile("s_waitcnt vmcnt(0)" ::: "memory");
        }
    }
    __syncthreads();
}


constexpr int NPHASES = 16;
__global__ void __launch_bounds__(NTHREADS, 2) mega_fwd(Params p) {
    extern __shared__ __attribute__((aligned(16))) unsigned char lds_raw[];
    LAS unsigned char* lds = (LAS unsigned char*)lds_raw;
    cg::grid_group grid = cg::this_grid();
    unsigned char* ws = p.ws;
    const int G = gridDim.x, bid = blockIdx.x;
    bf16_t* Hb = (bf16_t*)(ws + WS_H); bf16_t* Fb = (bf16_t*)(ws + WS_F); bf16_t* ACT = (bf16_t*)(ws + WS_ACT);
    bf16_t* ZQ = (bf16_t*)(ws + WS_ZQ); bf16_t* XL = (bf16_t*)(ws + WS_XL); bf16_t* GY = (bf16_t*)(ws + WS_GY);
#ifndef TESTPH
#define TESTPH -1
#endif
#define IN(k) ((TESTPH < 0 || (k) == TESTPH) && p.ph_lo <= (k) && (k) < p.ph_hi)
#define SEAM0() do { if (IN(0) && IN(1)) { __builtin_amdgcn_fence(__ATOMIC_RELEASE, "agent"); asm volatile("s_waitcnt vmcnt(0) lgkmcnt(0)" ::: "memory"); \
        grid.sync(); __builtin_amdgcn_fence(__ATOMIC_ACQUIRE, "agent"); asm volatile("s_waitcnt vmcnt(0) lgkmcnt(0)" ::: "memory"); \
        xb = xcd_barrier_post((unsigned*)(p.ws + WS_XBAR), xbst); } } while (0)
#define SEAM(k) do { if (IN(k) && IN((k) + 1)) xcd_barrier(xb); } while (0)
    volatile LAS unsigned* xbst = (volatile LAS unsigned*)(lds + LDS_BYTES - 16);
    if (threadIdx.x < 4) xbst[threadIdx.x] = 0u;
    __syncthreads();
    XcdBarrier xb; xb.bar = (unsigned*)(p.ws + WS_XBAR); xb.x = 0; xb.st = xbst;
    if (IN(0) && bid == 0) { unsigned* xw = (unsigned*)(p.ws + WS_XBAR); for (int i = threadIdx.x; i < XCD_BAR_WORDS; i += NTHREADS) xw[i] = 0u; }
    SEAM0();
    if (IN(0)) phase_prep(p, lds);
    SEAM(0);
    if (IN(1)) phase_rows<false, true>(p, 0, 0, 0.f, true);
    SEAM(1);
#define FFN_PHASES(ffn, pb) do { \
        if (IN(pb)) { \
            pg8::Gemm g{Hb, (const bf16_t*)(ws + ((ffn) ? WS_WGU2 : WS_WGU1)), D, D}; pg8::StaticOrder S; S.init(T, 2 * DFF, G, bid); \
            pg8::EpiSwiglu E{ACT, DFF}; \
            GEMM_PHASE(pg8::EpiSwiglu, lds, g, S, E); \
        } \
        SEAM(pb); \
        if (IN((pb) + 1)) { \
            pg8::Gemm g{ACT, (const bf16_t*)(ws + ((ffn) ? WS_WDN2 : WS_WDN1)), DFF, DFF}; pg8::StaticOrder S; S.init(T, D, G, bid); \
            pg8::EpiAct<0> E{Fb, D, 0}; \
            GEMM_PHASE(pg8::EpiAct<0>, lds, g, S, E); \
        } \
        SEAM((pb) + 1); } while (0)
    FFN_PHASES(0, 2);
        if (IN(4)) phase_rows<true, true>(p, 0, 1, 0.5f, true);
        SEAM(4);
        if (IN(5)) {
            pg8::Gemm g{Hb, (const bf16_t*)(ws + WS_WINA), D, D}; pg8::StaticOrder S; S.init(T, 2560, G, bid);
            pg8::EpiWinA E{ZQ, XL, GY};
            GEMM_PHASE(pg8::EpiWinA, lds, g, S, E);
        }
        SEAM(5);
        if (IN(6)) { phase_lru(p, lds); if (bid >= G / 2) phase_stats(p, G / 2, G - G / 2);     }
        SEAM(6);
        if (IN(7)) {
            pg8::Gemm g{ZQ, (const bf16_t*)(ws + WS_WQKV), 512, 384}; pg8::StaticOrder S; S.init(T, 1792, G, bid);
            pg8::EpiQKV E{Fb, XL};
            GEMM_PHASE2(pg8::EpiQKV, lds, g, S, E);
        }
        SEAM(7);
        if (IN(8)) phase_attn(p, lds);
        SEAM(8);
        if (IN(9)) {
            pg8::Gemm g{Hb, (const bf16_t*)(ws + WS_WINB), D, D}; pg8::StaticOrder S; S.init(T, 2048, G, bid);
            pg8::EpiWinB E{Fb, XL};
            GEMM_PHASE(pg8::EpiWinB, lds, g, S, E);
        }
        SEAM(9);
        if (IN(10)) {
            { pg8::Gemm g{ZQ, (const bf16_t*)(ws + WS_WAO), 512, 512}; pg8::StaticOrder S; S.init(T, D, G, bid);
              pg8::EpiGate<false> E{Fb, nullptr, Fb};
              GEMM_PHASE(pg8::EpiGate<false>, lds, g, S, E); }
            { pg8::Gemm g{GY, (const bf16_t*)(ws + WS_WLO), D, D}; pg8::StaticOrder S; S.init(T, D, G, bid);
              pg8::EpiGate<true> E{XL, Fb, XL};
              GEMM_PHASE(pg8::EpiGate<true>, lds, g, S, E); }
        }
        SEAM(10);
        if (IN(11)) {
            pg8::Gemm g{XL, (const bf16_t*)(ws + WS_WOUT), D, D}; pg8::StaticOrder S; S.init(T, D, G, bid);
            pg8::EpiAct<0> E{Fb, D, 0};
            GEMM_PHASE(pg8::EpiAct<0>, lds, g, S, E);
        }
        SEAM(11);
        if (IN(12)) phase_rows<true, true>(p, 1, 2, 1.0f, false);
        SEAM(12);
    FFN_PHASES(1, 13);
    if (IN(15)) phase_rows<true, false>(p, 2, 0, 0.5f, false);
#undef IN
#undef SEAM
}

extern "C" void kernel_launch(void* const* d_in, const int* in_sizes, int n_in, void* d_out, int out_size, void* d_ws, size_t ws_size, hipStream_t stream) {
    static int grid = 0;
    if (grid == 0) {
        if (n_in != 27 || out_size != T * D || ws_size < WS_END) { fprintf(stderr, "kernel_launch: unexpected shapes: n_in %d out %d ws %zu (need >= %zu)\n", n_in, out_size, ws_size, (size_t)WS_END); grid = -1; return; }
        int dev = 0, cus = 0, per_cu = 0;
        (void)hipGetDevice(&dev);
        (void)hipDeviceGetAttribute(&cus, hipDeviceAttributeMultiprocessorCount, dev);
        if (hipFuncSetAttribute((const void*)mega_fwd, hipFuncAttributeMaxDynamicSharedMemorySize, LDS_BYTES) != hipSuccess) { fprintf(stderr, "kernel_launch: hipFuncSetAttribute failed\n"); grid = -1; return; }
        if (hipOccupancyMaxActiveBlocksPerMultiprocessor(&per_cu, (const void*)mega_fwd, NTHREADS, LDS_BYTES) != hipSuccess || per_cu < 1) { fprintf(stderr, "kernel_launch: occupancy query failed (%d)\n", per_cu); per_cu = 1; }
        (void)hipGetLastError();
        grid = cus;
        fprintf(stderr, "kernel_launch: grid %d (per_cu %d)\n", grid, per_cu);
    }
    if (grid < 0) return;
    Params p{};
    for (int i = 0; i < 27; ++i) p.in[i] = (const float*)d_in[i];
    p.out = (float*)d_out; p.ws = (unsigned char*)d_ws;
#if defined(MK_SPLIT)
    for (int ph = 0; ph < NPHASES; ++ph) { p.ph_lo = ph; p.ph_hi = ph + 1;
        hipLaunchKernelGGL(mega_fwd, dim3(grid), dim3(NTHREADS), LDS_BYTES, stream, p); }
#else
    p.ph_lo = 0; p.ph_hi = NPHASES;
    void* args[] = {&p};
    hipError_t e = hipLaunchCooperativeKernel((const void*)mega_fwd, dim3(grid), dim3(NTHREADS), args, LDS_BYTES, stream);
    if (e != hipSuccess) fprintf(stderr, "kernel_launch: cooperative launch failed: %s (grid %d)\n", hipGetErrorString(e), grid);
#endif
}
```

```cpp
#include <hip/hip_runtime.h>
#include <hip/hip_cooperative_groups.h>
#include <cstdio>
#include <cstdint>
namespace cg = cooperative_groups;
#ifndef MK_SP2_ALL
#define MK_SP2_ALL false
#endif

#define LAS __attribute__((address_space(3)))
typedef unsigned short bf16_t;
typedef short bf16x8 __attribute__((ext_vector_type(8)));
typedef short v4i16_t __attribute__((ext_vector_type(4)));
typedef float f32x4 __attribute__((ext_vector_type(4)));
typedef float f32x2 __attribute__((ext_vector_type(2)));
typedef unsigned u32x4 __attribute__((ext_vector_type(4)));
typedef unsigned u32x2 __attribute__((ext_vector_type(2)));

constexpr int D = 1024, DFF = 2816, TP = 32768, TS = 65536, T = TP + TS, SP = 2048, SS = 4096;
constexpr int NQ = 768, NKV = 512;
constexpr float EPS = 1e-6f;
constexpr int NTHREADS = 512, NWAVES = 8;

constexpr size_t KiB = 1024, MiB = 1024 * 1024;
constexpr size_t WS_WGU1 = 0, WS_WDN1 = 11 * MiB, WS_WINA = 16 * MiB + 512 * KiB, WS_WINB = 21 * MiB + 512 * KiB, WS_WQKV = 25 * MiB + 512 * KiB,
                 WS_WAO = 27 * MiB, WS_WLO = 28 * MiB, WS_WOUT = 30 * MiB, WS_WGU2 = 32 * MiB, WS_WDN2 = 43 * MiB, WS_WG = 48 * MiB + 512 * KiB,
                 WS_MOD = 49 * MiB + 512 * KiB, WS_ROPE = 50 * MiB + 768 * KiB, WS_STATS = 51 * MiB + 256 * KiB, WS_KR = 52 * MiB;
constexpr size_t WS_XBAR = 50 * MiB + 640 * KiB;
constexpr size_t WS_H = 64 * MiB, WS_F = 256 * MiB, WS_BIG = 448 * MiB;
constexpr size_t WS_ZQ = WS_BIG, WS_XL = WS_BIG + 96 * MiB, WS_GY = WS_BIG + 288 * MiB, WS_ACT = WS_BIG, WS_END = 976 * MiB;
constexpr int LDS_BYTES = 139264;

struct Params { const float* in[27]; float* out; unsigned char* ws; int ph_lo, ph_hi; };

typedef __bf16 bf16x2_t __attribute__((ext_vector_type(2)));
__device__ __forceinline__ unsigned pk_bf16(float lo, float hi) { const f32x2 v = {lo, hi}; const bf16x2_t b = __builtin_convertvector(v, bf16x2_t); return __builtin_bit_cast(unsigned, b); }
__device__ __forceinline__ float lo_bf(unsigned w) { return __uint_as_float(w << 16); }
__device__ __forceinline__ float hi_bf(unsigned w) { return __uint_as_float(w & 0xffff0000u); }
__device__ __forceinline__ float bf2f(bf16_t h) { return __uint_as_float((unsigned)h << 16); }
__device__ __forceinline__ float fexp(float x) { return __builtin_amdgcn_exp2f(x * 1.4426950408889634f); }
__device__ __forceinline__ float fsigmoid(float x) { return __builtin_amdgcn_rcpf(1.0f + fexp(-x)); }
__device__ __forceinline__ float fsilu(float x) { return x * fsigmoid(x); }
__device__ __forceinline__ float fgelu(float x) { return x * fsigmoid(1.5957691216057308f * (x + 0.044715f * x * x * x)); }
__device__ __forceinline__ float wave_sum(float v) {
#pragma unroll
    for (int o = 1; o < 64; o <<= 1) v += __shfl_xor(v, o);
    return v;
}
__device__ __forceinline__ int row_batch(int row) { return row < TP ? (row >> 11) : 16 + ((row - TP) >> 12); }
__device__ __forceinline__ int row_pos(int row) { return row < TP ? (row & (SP - 1)) : ((row - TP) & (SS - 1)); }

namespace pg8 {
constexpr int BM = 256, BK = 64, HALF = 128, HTB = HALF * BK * 2, STAGE_BYTES = 8 * HTB, NXCD = 8, WGM = 8;
__host__ __device__ __forceinline__ int lds_byte(int r, int c) { const int st = (r >> 4) * 2 + (c >> 5), rr = r & 15, cc = c & 31, ob = rr * 64 + cc * 2; return st * 1024 + (ob ^ (((ob >> 9) & 1) << 5)); }
__host__ __device__ __forceinline__ void stage_rc(int b, int& R, int& C) { const int st = b / 1024, sb = b % 1024, swz = sb ^ (((sb >> 9) & 1) << 5); R = (st >> 1) * 16 + swz / 64; C = (st & 1) * 32 + (swz % 64) / 2; }
__host__ __device__ __forceinline__ int perm32(int rho) { const int n = rho >> 4, i = rho & 15; return 8 * (i >> 2) + 4 * n + (i & 3); }

struct Unit { int pm, pn; };
struct Gemm { const bf16_t* A; const bf16_t* Bt; int lda, K; };

struct StaticOrder {
    int nM, nN, nwg, G, c;
    __device__ void init(int M, int N, int G_, int c_) { nM = M / BM; nN = N / BM; nwg = nM * nN; G = G_; c = c_; }
    __device__ bool next(int i, Unit& u) const {
        const long L = (long)i * G + c; if (L >= nwg) return false;
        int wgid = (int)L; { const int q = nwg / NXCD, r = nwg % NXCD, xcd = wgid % NXCD, off = wgid / NXCD; wgid = (xcd < r ? xcd * (q + 1) : r * (q + 1) + (xcd - r) * q) + off; }
        const int nig = WGM * nN, gid = wgid / nig, fm = gid * WGM, gsz = (nM - fm) < WGM ? (nM - fm) : WGM;
        u.pm = fm + ((wgid % nig) % gsz); u.pn = (wgid % nig) / gsz; return true;
    }
};

template <class Epi, bool SP2 = false>
__device__ __forceinline__ void gemm_phase(LAS unsigned char* lds, const Gemm g, const StaticOrder& S, const Epi& E) {
    const int tid = threadIdx.x, wid = __builtin_amdgcn_readfirstlane(tid >> 6), lane = tid & 63, wr = wid >> 2, wc = wid & 3, fr = lane & 15, fq = lane >> 4;
    const int K = g.K, nt = K / BK, lda = g.lda;
    unsigned voffA[2], voffB[2];
#pragma unroll
    for (int i = 0; i < 2; ++i) { int R, C; stage_rc(tid * 16 + i * 8192, R, C); const int Rb = Epi::PERM ? ((R & ~31) + perm32(R & 31)) : R;
        voffA[i] = (unsigned)(R * lda + C) * 2u; voffB[i] = (unsigned)(Rb * K + C) * 2u; }
    const size_t kstep = (size_t)(BK * 2);
    const size_t hstepA = (size_t)HALF * lda * 2, hstepB = (size_t)HALF * K * 2;
    const size_t tstepA = 2 * hstepA, tstepB = 2 * hstepB;
    const unsigned ldsw = (unsigned)wid * 1024u;
    const int aoff = lds_byte(wr * 64 + fr, fq * 8), boff = lds_byte(wc * 32 + fr, fq * 8);
#define PG8_SA(b, h) (((b) * 2 + (h)) * HTB)
#define PG8_SB(b, h) ((4 + (b) * 2 + (h)) * HTB)
#define PG8_STAGE(bufoff, gbase, voff) do { _Pragma("unroll") for (int _i = 0; _i < 2; ++_i) \
        __builtin_amdgcn_global_load_lds((const unsigned*)((const char*)(gbase) + (voff)[_i]), (LAS unsigned*)(lds + (bufoff) + ldsw + _i * 8192), 16, 0, 0); } while (0)
#define PG8_LDA(dst, b, h) do { _Pragma("unroll") for (int m = 0; m < 4; ++m) _Pragma("unroll") for (int k = 0; k < 2; ++k) dst[m][k] = *(const LAS bf16x8*)(lds + PG8_SA(b, h) + aoff + m * 2048 + k * 1024); } while (0)
#define PG8_LDB(dst, b, h) do { _Pragma("unroll") for (int n = 0; n < 2; ++n) _Pragma("unroll") for (int k = 0; k < 2; ++k) dst[n][k] = *(const LAS bf16x8*)(lds + PG8_SB(b, h) + boff + n * 2048 + k * 1024); } while (0)
#define PG8_MMA(ai, bj, At, Bt) do { __builtin_amdgcn_s_setprio(1); _Pragma("unroll") for (int m = 0; m < 4; ++m) _Pragma("unroll") for (int n = 0; n < 2; ++n) _Pragma("unroll") for (int k = 0; k < 2; ++k) \
        acc[ai][bj][m][n] = __builtin_amdgcn_mfma_f32_16x16x32_bf16(Bt[n][k], At[m][k], acc[ai][bj][m][n], 0, 0, 0); __builtin_amdgcn_s_setprio(0); } while (0)
#define PG8_WAIT_V(n) asm volatile("s_waitcnt vmcnt(" #n ")" ::: "memory")
#define PG8_WAIT_L(n) asm volatile("s_waitcnt lgkmcnt(" #n ")" ::: "memory")
#define PG8_BAR __builtin_amdgcn_s_barrier()
#define PG8_SCHED __builtin_amdgcn_sched_barrier(0)
    Unit cur, nxt; int ui = 0;
    if (!S.next(0, cur)) return;
    f32x4 acc[2][2][4][2];
#pragma unroll
    for (int a = 0; a < 2; ++a)
#pragma unroll
        for (int b = 0; b < 2; ++b)
#pragma unroll
            for (int m = 0; m < 4; ++m)
#pragma unroll
                for (int n = 0; n < 2; ++n) acc[a][b][m][n] = (f32x4){0.f, 0.f, 0.f, 0.f};
    bf16x8 At[4][2], B0[2][2], B1[2][2];
    const char* cA = (const char*)g.A + (size_t)cur.pm * tstepA; const char* cB = (const char*)g.Bt + (size_t)cur.pn * tstepB;
    if constexpr (SP2) {
        PG8_STAGE(PG8_SB(0, 0), cB, voffB); PG8_STAGE(PG8_SB(0, 1), cB + hstepB, voffB); PG8_STAGE(PG8_SA(0, 0), cA, voffA); PG8_STAGE(PG8_SA(0, 1), cA + hstepA, voffA);
        if (wr == 1) PG8_BAR;
        PG8_WAIT_V(2); PG8_BAR;
        PG8_STAGE(PG8_SB(1, 0), cB + kstep, voffB); PG8_STAGE(PG8_SA(1, 0), cA + kstep, voffA); PG8_STAGE(PG8_SB(1, 1), cB + hstepB + kstep, voffB);
        PG8_WAIT_V(6); PG8_BAR;
    } else {
    PG8_STAGE(PG8_SB(0, 0), cB, voffB); PG8_STAGE(PG8_SA(0, 0), cA, voffA); PG8_STAGE(PG8_SB(0, 1), cB + hstepB, voffB); PG8_STAGE(PG8_SA(0, 1), cA + hstepA, voffA);
    if (wr == 1) PG8_BAR;
    PG8_WAIT_V(4); PG8_BAR;
    PG8_STAGE(PG8_SB(1, 0), cB + kstep, voffB); PG8_STAGE(PG8_SA(1, 0), cA + kstep, voffA); PG8_STAGE(PG8_SB(1, 1), cB + hstepB + kstep, voffB);
    PG8_WAIT_V(6); PG8_BAR;
    }
    for (;;) {
        const bool has_next = S.next(ui + 1, nxt);
        const char* nA = has_next ? (const char*)g.A + (size_t)nxt.pm * tstepA : cA; const char* nB = has_next ? (const char*)g.Bt + (size_t)nxt.pn * tstepB : cB;
        for (int t = 0; t < nt; t += 2) {
            const bool last = (t == nt - 2);
            const char* a1 = cA + (size_t)(t + 1) * kstep;
            const char* a2 = last ? nA : cA + (size_t)(t + 2) * kstep; const char* b2 = last ? nB : cB + (size_t)(t + 2) * kstep;
            const char* a3 = a2 + kstep; const char* b3 = b2 + kstep;
            if constexpr (SP2) {
            PG8_LDB(B0, 0, 0); PG8_LDB(B1, 0, 1); PG8_SCHED; PG8_LDA(At, 0, 0); PG8_STAGE(PG8_SA(1, 1), a1 + hstepA, voffA);
            PG8_WAIT_V(8); PG8_WAIT_L(0); PG8_BAR; PG8_MMA(0, 0, At, B0); PG8_MMA(0, 1, At, B1); PG8_BAR; PG8_SCHED;
            PG8_LDA(At, 0, 1); PG8_STAGE(PG8_SB(0, 0), b2, voffB); PG8_STAGE(PG8_SB(0, 1), b2 + hstepB, voffB); PG8_STAGE(PG8_SA(0, 0), a2, voffA);
            PG8_WAIT_V(8); PG8_WAIT_L(0); PG8_BAR; PG8_MMA(1, 0, At, B0); PG8_MMA(1, 1, At, B1); PG8_BAR; PG8_SCHED;
            PG8_LDB(B0, 1, 0); PG8_LDB(B1, 1, 1); PG8_SCHED; PG8_LDA(At, 1, 0); PG8_STAGE(PG8_SA(0, 1), a2 + hstepA, voffA);
            PG8_WAIT_V(8); PG8_WAIT_L(0); PG8_BAR; PG8_MMA(0, 0, At, B0); PG8_MMA(0, 1, At, B1); PG8_BAR; PG8_SCHED;
            PG8_LDA(At, 1, 1); PG8_STAGE(PG8_SB(1, 0), b3, voffB); PG8_STAGE(PG8_SB(1, 1), b3 + hstepB, voffB); PG8_STAGE(PG8_SA(1, 0), a3, voffA);
            PG8_WAIT_V(8); PG8_WAIT_L(0); PG8_BAR; PG8_MMA(1, 0, At, B0); PG8_MMA(1, 1, At, B1); PG8_BAR; PG8_SCHED;
            } else {
            PG8_LDB(B0, 0, 0); PG8_SCHED; PG8_LDA(At, 0, 0); PG8_STAGE(PG8_SA(1, 1), a1 + hstepA, voffA);
            PG8_WAIT_L(8); PG8_BAR; PG8_WAIT_L(0); PG8_MMA(0, 0, At, B0); PG8_BAR; PG8_SCHED;
            PG8_LDB(B1, 0, 1); PG8_STAGE(PG8_SB(0, 0), b2, voffB);
            PG8_BAR; PG8_WAIT_L(0); PG8_MMA(0, 1, At, B1); PG8_BAR;
            PG8_LDA(At, 0, 1); PG8_STAGE(PG8_SA(0, 0), a2, voffA);
            PG8_BAR; PG8_WAIT_L(0); PG8_MMA(1, 0, At, B0); PG8_BAR; PG8_SCHED;
            PG8_STAGE(PG8_SB(0, 1), b2 + hstepB, voffB);
            PG8_WAIT_V(6); PG8_BAR; PG8_MMA(1, 1, At, B1); PG8_BAR;
            PG8_LDB(B0, 1, 0); PG8_SCHED; PG8_LDA(At, 1, 0); PG8_STAGE(PG8_SA(0, 1), a2 + hstepA, voffA);
            PG8_WAIT_L(8); PG8_BAR; PG8_WAIT_L(0); PG8_MMA(0, 0, At, B0); PG8_BAR; PG8_SCHED;
            PG8_LDB(B1, 1, 1); PG8_STAGE(PG8_SB(1, 0), b3, voffB);
            PG8_BAR; PG8_WAIT_L(0); PG8_MMA(0, 1, At, B1); PG8_BAR;
            PG8_LDA(At, 1, 1); PG8_STAGE(PG8_SA(1, 0), a3, voffA);
            PG8_BAR; PG8_WAIT_L(0); PG8_MMA(1, 0, At, B0); PG8_BAR; PG8_SCHED;
            PG8_STAGE(PG8_SB(1, 1), b3 + hstepB, voffB);
            PG8_WAIT_V(6); PG8_BAR; PG8_MMA(1, 1, At, B1); PG8_BAR;
            }
        }
        if constexpr (SP2) { if (wr == 0) PG8_BAR; }
        { int el; asm volatile("v_mbcnt_lo_u32_b32 %0, -1, 0\n\tv_mbcnt_hi_u32_b32 %0, -1, %0" : "=v"(el)); E(acc, cur, wr, wc, el & 15, el >> 4); }
        if (!has_next) break;
#pragma unroll
        for (int a = 0; a < 2; ++a)
#pragma unroll
            for (int b = 0; b < 2; ++b)
#pragma unroll
                for (int m = 0; m < 4; ++m)
#pragma unroll
                    for (int n = 0; n < 2; ++n) acc[a][b][m][n] = (f32x4){0.f, 0.f, 0.f, 0.f};
        cur = nxt; cA = nA; cB = nB; ++ui;
        if constexpr (SP2) { if (wr == 1) PG8_BAR; }
    }
    PG8_WAIT_V(0);
    if constexpr (!SP2) { if (wr == 0) PG8_BAR; }
    PG8_BAR;
#undef PG8_SA
#undef PG8_SB
#undef PG8_STAGE
#undef PG8_LDA
#undef PG8_LDB
#undef PG8_MMA
#undef PG8_WAIT_V
#undef PG8_WAIT_L
#undef PG8_BAR
#undef PG8_SCHED
}

#if defined(MK_SIMPLE_GEMM)
template <class Epi>
__device__ __forceinline__ void gemm_phase_simple(const Gemm g, const StaticOrder& S, const Epi& E) {
    const int tid = threadIdx.x, wid = __builtin_amdgcn_readfirstlane(tid >> 6), lane = tid & 63, wr = wid >> 2, wc = wid & 3, fr = lane & 15, fq = lane >> 4;
    Unit cur;
    for (int ui = 0; S.next(ui, cur); ++ui) {
        f32x4 acc[2][2][4][2];
#pragma unroll
        for (int a = 0; a < 2; ++a)
#pragma unroll
            for (int b = 0; b < 2; ++b)
#pragma unroll
                for (int m = 0; m < 4; ++m)
#pragma unroll
                    for (int n = 0; n < 2; ++n) acc[a][b][m][n] = (f32x4){0.f, 0.f, 0.f, 0.f};
        for (int k0 = 0; k0 < g.K; k0 += 32) {
            bf16x8 bf[2][2];
#pragma unroll
            for (int bj = 0; bj < 2; ++bj)
#pragma unroll
                for (int n = 0; n < 2; ++n) { const int slot = 16 * n + fr; const int wrow = cur.pn * BM + bj * HALF + wc * 32 + (Epi::PERM ? perm32(slot) : slot);
                    bf[bj][n] = *(const bf16x8*)(g.Bt + (size_t)wrow * g.K + k0 + 8 * fq); }
#pragma unroll
            for (int ai = 0; ai < 2; ++ai)
#pragma unroll
                for (int m = 0; m < 4; ++m) { const int arow = cur.pm * BM + ai * HALF + wr * 64 + m * 16 + fr;
                    const bf16x8 af = *(const bf16x8*)(g.A + (size_t)arow * g.lda + k0 + 8 * fq);
#pragma unroll
                    for (int bj = 0; bj < 2; ++bj)
#pragma unroll
                        for (int n = 0; n < 2; ++n) acc[ai][bj][m][n] = __builtin_amdgcn_mfma_f32_16x16x32_bf16(bf[bj][n], af, acc[ai][bj][m][n], 0, 0, 0); }
        }
        E(acc, cur, wr, wc, fr, fq);
    }
}
#define GEMM_PHASE(EPI, lds, g, S, E) pg8::gemm_phase_simple<EPI>(g, S, E)
#define GEMM_PHASE2(EPI, lds, g, S, E) pg8::gemm_phase_simple<EPI>(g, S, E)
#else
#define GEMM_PHASE(EPI, lds, g, S, E) pg8::gemm_phase<EPI, true>(lds, g, S, E)
#define GEMM_PHASE2(EPI, lds, g, S, E) pg8::gemm_phase<EPI, false>(lds, g, S, E)
#endif
struct EpiSwiglu {
    static constexpr bool PERM = true;
    bf16_t* O; int ldc;
    __device__ __forceinline__ void operator()(const f32x4 (&acc)[2][2][4][2], const Unit& u, int wr, int wc, int fr, int fq) const {
        const int row0 = u.pm * BM + wr * 64 + fr, col0 = u.pn * 128 + wc * 32 + 8 * fq;
#pragma unroll
        for (int ai = 0; ai < 2; ++ai)
#pragma unroll
            for (int m = 0; m < 4; ++m) {
                bf16_t* rowp = O + (size_t)(row0 + ai * HALF + m * 16) * ldc + col0;
                const f32x4 g0 = acc[ai][0][m][0], g1 = acc[ai][0][m][1], u0 = acc[ai][1][m][0], u1 = acc[ai][1][m][1];
                float v[8];
#pragma unroll
                for (int j = 0; j < 4; ++j) { v[j] = fsilu(g0[j]) * u0[j]; v[4 + j] = fsilu(g1[j]) * u1[j]; }
                u32x4 w; w.x = pk_bf16(v[0], v[1]); w.y = pk_bf16(v[2], v[3]); w.z = pk_bf16(v[4], v[5]); w.w = pk_bf16(v[6], v[7]);
                *(u32x4*)rowp = w;
                asm volatile("" ::: "memory");
            }
    }
};
__device__ __forceinline__ void store_tile_bf16(const f32x4 (&acc)[2][2][4][2], bf16_t* base, int ld, int row0, int col0, int act) {
#pragma unroll
    for (int ai = 0; ai < 2; ++ai)
#pragma unroll
        for (int m = 0; m < 4; ++m) {
            bf16_t* rowp = base + (size_t)(row0 + ai * HALF + m * 16) * ld + col0;
#pragma unroll
            for (int bj = 0; bj < 2; ++bj) {
                f32x4 v0 = acc[ai][bj][m][0], v1 = acc[ai][bj][m][1];
                if (act == 1) {
#pragma unroll
                    for (int j = 0; j < 4; ++j) { v0[j] = fgelu(v0[j]); v1[j] = fgelu(v1[j]); }
                } else if (act == 2) {
#pragma unroll
                    for (int j = 0; j < 4; ++j) { v0[j] = fsigmoid(v0[j]); v1[j] = fsigmoid(v1[j]); }
                }
                u32x4 w; w.x = pk_bf16(v0[0], v0[1]); w.y = pk_bf16(v0[2], v0[3]); w.z = pk_bf16(v1[0], v1[1]); w.w = pk_bf16(v1[2], v1[3]);
                *(u32x4*)(rowp + bj * HALF) = w;
            }
            asm volatile("" ::: "memory");
        }
}
template <int ACT> struct EpiAct {
    static constexpr bool PERM = true;
    bf16_t* p; int ld, pn0;
    __device__ __forceinline__ void operator()(const f32x4 (&acc)[2][2][4][2], const Unit& u, int wr, int wc, int fr, int fq) const {
        store_tile_bf16(acc, p, ld, u.pm * BM + wr * 64 + fr, (u.pn - pn0) * BM + wc * 32 + 8 * fq, ACT);
    }
};
struct EpiWinA {
    static constexpr bool PERM = true;
    bf16_t* zq; bf16_t* xl; bf16_t* gy;
    __device__ __forceinline__ void operator()(const f32x4 (&acc)[2][2][4][2], const Unit& u, int wr, int wc, int fr, int fq) const {
        size_t boff = 0; if (u.pn >= 2) boff += (size_t)((const char*)xl - (const char*)zq); if (u.pn >= 6) boff += (size_t)((const char*)gy - (const char*)xl);
        bf16_t* base = (bf16_t*)((char*)zq + boff);
        int ld = 512, pn0 = 0; if (u.pn >= 2) { ld = D; pn0 = 2; } if (u.pn >= 6) pn0 = 6;
        store_tile_bf16(acc, base, ld, u.pm * BM + wr * 64 + fr, (u.pn - pn0) * BM + wc * 32 + 8 * fq, u.pn < 6 ? 0 : 1);
    }
};
struct EpiWinB {
    static constexpr bool PERM = true;
    bf16_t* ga; bf16_t* gl;
    __device__ __forceinline__ void operator()(const f32x4 (&acc)[2][2][4][2], const Unit& u, int wr, int wc, int fr, int fq) const {
        store_tile_bf16(acc, u.pn < 4 ? ga : gl, D, u.pm * BM + wr * 64 + fr, (u.pn & 3) * BM + wc * 32 + 8 * fq, 2);
    }
};
template <bool ADD> struct EpiGate {
    static constexpr bool PERM = true;
    const bf16_t* gate; const bf16_t* add; bf16_t* out;
    __device__ __forceinline__ void operator()(const f32x4 (&acc)[2][2][4][2], const Unit& u, int wr, int wc, int fr, int fq) const {
        const int row0 = u.pm * BM + wr * 64 + fr, col0 = u.pn * BM + wc * 32 + 8 * fq;
#pragma unroll
        for (int ai = 0; ai < 2; ++ai)
#pragma unroll
            for (int m = 0; m < 4; ++m) {
                const size_t off = (size_t)(row0 + ai * HALF + m * 16) * D + col0;
#pragma unroll
                for (int bj = 0; bj < 2; ++bj) {
                    const u32x4 gw = *(const u32x4*)(gate + off + bj * HALF);
                    const f32x4 v0 = acc[ai][bj][m][0], v1 = acc[ai][bj][m][1];
                    float r[8];
                    r[0] = lo_bf(gw.x) * v0[0]; r[1] = hi_bf(gw.x) * v0[1]; r[2] = lo_bf(gw.y) * v0[2]; r[3] = hi_bf(gw.y) * v0[3];
                    r[4] = lo_bf(gw.z) * v1[0]; r[5] = hi_bf(gw.z) * v1[1]; r[6] = lo_bf(gw.w) * v1[2]; r[7] = hi_bf(gw.w) * v1[3];
                    if (ADD) {
                        const u32x4 aw = *(const u32x4*)(add + off + bj * HALF);
                        r[0] += lo_bf(aw.x); r[1] += hi_bf(aw.x); r[2] += lo_bf(aw.y); r[3] += hi_bf(aw.y);
                        r[4] += lo_bf(aw.z); r[5] += hi_bf(aw.z); r[6] += lo_bf(aw.w); r[7] += hi_bf(aw.w);
                    }
                    u32x4 w; w.x = pk_bf16(r[0], r[1]); w.y = pk_bf16(r[2], r[3]); w.z = pk_bf16(r[4], r[5]); w.w = pk_bf16(r[6], r[7]);
                    *(u32x4*)(out + off + bj * HALF) = w;
                }
                asm volatile("" ::: "memory");
            }
    }
};
struct EpiQKV {
    static constexpr bool PERM = true;
    bf16_t* Q; bf16_t* Kn;
    __device__ __forceinline__ void operator()(const f32x4 (&acc)[2][2][4][2], const Unit& u, int wr, int wc, int fr, int fq) const {
        size_t boff = 0; if (u.pn >= 3) boff += (size_t)((const char*)Kn - (const char*)Q); if (u.pn >= 5) boff += (size_t)T * NKV * 2;
        bf16_t* dst = (bf16_t*)((char*)Q + boff);
        int ld = NQ, ctile = u.pn * BM; if (u.pn >= 3) { ld = NKV; ctile = ((u.pn - 3) & 1) * BM; }
        store_tile_bf16(acc, dst, ld, u.pm * BM + wr * 64 + fr, ctile + wc * 32 + 8 * fq, 0);
    }
};
}

struct TJob { const float* src; const float* scale; bf16_t* dst; int ldsrc, K, lddst, dstk0, nrb, map, nbatch, sbs, dbs; };
__device__ __forceinline__ int srccol(int map, int rb) {
    const int r = rb * 32;
    switch (map) {
        case 1: { const int pn = r >> 8, w = r & 255; return w < 128 ? 128 * pn + w : DFF + 128 * pn + (w - 128); }
        case 2: { if (r < 416) return r; if (r < 512) return -1; return r - 96; }
        case 3: return 2464 + r;
        case 4: { const int v = r >= 512 ? 1 : 0; const int rr = r & 511; return (rr >> 6) * 128 + (rr & 63) + 64 * v; }
        default: return r;
    }
}
constexpr int NJOBS = 15;
__device__ __forceinline__ TJob get_job(const Params& p, int j) {
    TJob t; t.scale = nullptr; t.dstk0 = 0; t.map = 0; t.nbatch = 1; t.sbs = 0; t.dbs = 0;
    unsigned char* ws = p.ws;
    switch (j) {
        case 0:  t.src = p.in[8];  t.dst = (bf16_t*)(ws + WS_WGU1); t.ldsrc = 2 * DFF; t.K = D; t.lddst = D; t.nrb = 176; t.map = 1; break;
        case 1:  t.src = p.in[9];  t.dst = (bf16_t*)(ws + WS_WDN1); t.ldsrc = D; t.K = DFF; t.lddst = DFF; t.nrb = 32; break;
        case 2:  t.src = p.in[10]; t.dst = (bf16_t*)(ws + WS_WINA); t.ldsrc = 4512; t.K = D; t.lddst = D; t.nrb = 80; t.map = 2; break;
        case 3:  t.src = p.in[10]; t.dst = (bf16_t*)(ws + WS_WINB); t.ldsrc = 4512; t.K = D; t.lddst = D; t.nrb = 64; t.map = 3; break;
        case 4:  t.src = p.in[13]; t.scale = p.in[11]; t.dst = (bf16_t*)(ws + WS_WQKV); t.ldsrc = 768; t.K = 256; t.lddst = 384; t.nrb = 24; break;
        case 5:  t.src = nullptr;  t.dst = (bf16_t*)(ws + WS_WQKV); t.ldsrc = 0; t.K = 128; t.lddst = 384; t.dstk0 = 256; t.nrb = 24; break;
        case 6:  t.src = p.in[14]; t.scale = p.in[12]; t.dst = (bf16_t*)(ws + WS_WQKV) + 768 * 384; t.ldsrc = 1024; t.K = 128; t.lddst = 384; t.dstk0 = 256; t.nrb = 32; t.map = 4; break;
        case 7:  t.src = nullptr;  t.dst = (bf16_t*)(ws + WS_WQKV) + 768 * 384; t.ldsrc = 0; t.K = 256; t.lddst = 384; t.nrb = 32; break;
        case 8:  t.src = p.in[15]; t.dst = (bf16_t*)(ws + WS_WAO); t.ldsrc = D; t.K = 512; t.lddst = 512; t.nrb = 32; break;
        case 9:  t.src = p.in[23]; t.dst = (bf16_t*)(ws + WS_WLO); t.ldsrc = D; t.K = D; t.lddst = D; t.nrb = 32; break;
        case 10: t.src = p.in[24]; t.dst = (bf16_t*)(ws + WS_WOUT); t.ldsrc = D; t.K = D; t.lddst = D; t.nrb = 32; break;
        case 11: t.src = p.in[25]; t.dst = (bf16_t*)(ws + WS_WGU2); t.ldsrc = 2 * DFF; t.K = D; t.lddst = D; t.nrb = 176; t.map = 1; break;
        case 12: t.src = p.in[26]; t.dst = (bf16_t*)(ws + WS_WDN2); t.ldsrc = D; t.K = DFF; t.lddst = DFF; t.nrb = 32; break;
        case 13: t.src = p.in[18]; t.dst = (bf16_t*)(ws + WS_WG); t.ldsrc = 128; t.K = 128; t.lddst = 128; t.nrb = 4; t.nbatch = 16; t.sbs = 16384; t.dbs = 32768; break;
        default: t.src = p.in[20]; t.dst = (bf16_t*)(ws + WS_WG) + 16384; t.ldsrc = 128; t.K = 128; t.lddst = 128; t.nrb = 4; t.nbatch = 16; t.sbs = 16384; t.dbs = 32768; break;
    }
    return t;
}
__device__ __forceinline__ int job_items(const TJob& t) { return t.nbatch * t.nrb * (t.K >> 6); }

__device__ __forceinline__ void tr_item(const TJob& jb, int item, LAS float* scr, int lane) {
    const int nkb = jb.K >> 6, per_batch = jb.nrb * nkb;
    const int bt = item / per_batch, r = item - bt * per_batch, rb = r / nkb, kb = r - rb * nkb;
    const int sc = srccol(jb.map, rb), k0 = 64 * kb;
    if (jb.src != nullptr && sc >= 0) {
        const float* src = jb.src + (size_t)bt * jb.sbs;
#pragma unroll 8
        for (int i = 0; i < 32; ++i) { const int kk = 2 * i + (lane >> 5);
            float v = src[(size_t)(k0 + kk) * jb.ldsrc + sc + (lane & 31)];
            if (jb.scale) v *= jb.scale[k0 + kk];
            scr[kk * 33 + (lane & 31)] = v; }
    } else {
#pragma unroll 8
        for (int i = 0; i < 32; ++i) { const int kk = 2 * i + (lane >> 5); scr[kk * 33 + (lane & 31)] = 0.f; }
    }
    asm volatile("s_waitcnt lgkmcnt(0)" ::: "memory");
    bf16_t* dst = jb.dst + (size_t)bt * jb.dbs;
    const int c = lane & 7;
#pragma unroll
    for (int j = 0; j < 4; ++j) { const int n = (lane >> 3) + 8 * j; const LAS float* s = scr + (8 * c) * 33 + n;
        u32x4 o; o.x = pk_bf16(s[0 * 33], s[1 * 33]); o.y = pk_bf16(s[2 * 33], s[3 * 33]); o.z = pk_bf16(s[4 * 33], s[5 * 33]); o.w = pk_bf16(s[6 * 33], s[7 * 33]);
        *(u32x4*)(dst + (size_t)(32 * rb + n) * jb.lddst + jb.dstk0 + k0 + 8 * c) = o; }
    asm volatile("s_waitcnt lgkmcnt(0)" ::: "memory");
}

__device__ __forceinline__ void phase_prep(const Params& p, LAS unsigned char* lds) {
    const int tid = threadIdx.x, lane = tid & 63, wave = tid >> 6;
    const int gw = blockIdx.x * NWAVES + wave, NGW = gridDim.x * NWAVES;
    {
        LAS float* scr = (LAS float*)(lds + wave * 8704);
        int base = 0;
        for (int j = 0; j < NJOBS; ++j) {
            const TJob jb = get_job(p, j); const int n = job_items(jb);
            int first = gw - (base % NGW); if (first < 0) first += NGW;
            for (int i = first; i < n; i += NGW) tr_item(jb, i, scr, lane);
            base += n;
        }
    }
    {
        const int gt = blockIdx.x * NTHREADS + tid;
        if (gt < SS * 16) {
            const int pos = gt >> 4, i = gt & 15;
            double inv = 1.0; for (int q = 0; q < i; ++q) inv *= 0.5623413251903491;
            const float ang = (float)pos * (float)inv;
            const double rev = (double)ang * 0.15915494309189535; const float fr = (float)(rev - rint(rev));
            ((float*)(p.ws + WS_ROPE))[gt] = __builtin_amdgcn_cosf(fr);
            ((float*)(p.ws + WS_ROPE))[SS * 16 + gt] = __builtin_amdgcn_sinf(fr);
        }
    }
    __syncthreads();
    for (int item = blockIdx.x; item < 144; item += gridDim.x) {
        LAS float* sc = (LAS float*)(lds) + wave * (128 * 33);
        for (int i = 0; i < 64; ++i) { const int idx = lane + 64 * i, kl = idx & 127, b = idx >> 7;
            const float cv = (b < 16 ? p.in[2] : p.in[3])[(b & 15) * D + 128 * wave + kl];
            sc[kl * 33 + b] = fsilu(cv); }
        asm volatile("s_waitcnt lgkmcnt(0)" ::: "memory");
        float acc[32];
#pragma unroll
        for (int b = 0; b < 32; ++b) acc[b] = 0.f;
        const float* W = p.in[4] + (size_t)(128 * wave) * 9216 + item * 64 + lane;
        for (int k = 0; k < 128; ++k) { const float wv = W[(size_t)k * 9216];
#pragma unroll
            for (int b = 0; b < 32; ++b) acc[b] += sc[k * 33 + b] * wv; }
        __syncthreads();
        LAS float* red = (LAS float*)(lds);
#pragma unroll
        for (int b = 0; b < 32; ++b) red[(wave * 32 + b) * 64 + lane] = acc[b];
        __syncthreads();
        for (int o = tid; o < 2048; o += NTHREADS) { const int b = o >> 6, col = o & 63; float s = 0.f;
#pragma unroll
            for (int w = 0; w < 8; ++w) s += red[(w * 32 + b) * 64 + col];
            const int j = item * 64 + col;
            ((float*)(p.ws + WS_MOD))[b * 9216 + j] = s + p.in[5][j]; }
        __syncthreads();
    }
}

template <bool HAS_F, bool HAS_H>
__device__ __forceinline__ void phase_rows(const Params& p, int sp, int sn, float resw, bool from_input, bool write_x = true) {
    const int tid = threadIdx.x, lane = tid & 63, wave = tid >> 6;
    const int gw = blockIdx.x * NWAVES + wave, NGW = gridDim.x * NWAVES;
    const float* mod = (const float*)(p.ws + WS_MOD);
    const bf16_t* F = (const bf16_t*)(p.ws + WS_F);
    bf16_t* H = (bf16_t*)(p.ws + WS_H);
    for (int row = gw; row < T; row += NGW) {
        const int b = row_batch(row);
        const float* xin = !from_input ? p.out + (size_t)row * D : (row < TP ? p.in[0] + (size_t)row * D : p.in[1] + (size_t)(row - TP) * D);
        f32x4 v[4];
#pragma unroll
        for (int j = 0; j < 4; ++j) v[j] = *(const f32x4*)(xin + 4 * lane + 256 * j);
        if (HAS_F) {
            f32x4 f[4]; float ss = 0.f;
#pragma unroll
            for (int j = 0; j < 4; ++j) { const u32x2 w = *(const u32x2*)(F + (size_t)row * D + 4 * lane + 256 * j);
                f[j] = (f32x4){lo_bf(w.x), hi_bf(w.x), lo_bf(w.y), hi_bf(w.y)}; ss += (f[j].x * f[j].x + f[j].y * f[j].y) + (f[j].z * f[j].z + f[j].w * f[j].w); }
            const float rs = 1.0f / sqrtf(wave_sum(ss) * (1.0f / D) + EPS) * resw;
            const float* gate = mod + b * 9216 + sp * 3072 + 2048; const float* gp = p.in[7] + sp * D;
#pragma unroll
            for (int j = 0; j < 4; ++j) { const f32x4 g = *(const f32x4*)(gate + 4 * lane + 256 * j), q = *(const f32x4*)(gp + 4 * lane + 256 * j);
                v[j] = v[j] + g * (f[j] * rs * q);
                if (write_x) *(f32x4*)(p.out + (size_t)row * D + 4 * lane + 256 * j) = v[j]; }
        }
        if (HAS_H) {
            float ss = 0.f;
#pragma unroll
            for (int j = 0; j < 4; ++j) ss += (v[j].x * v[j].x + v[j].y * v[j].y) + (v[j].z * v[j].z + v[j].w * v[j].w);
            const float rs = 1.0f / sqrtf(wave_sum(ss) * (1.0f / D) + EPS);
            const float* sh = mod + b * 9216 + sn * 3072; const float* scl = sh + 1024; const float* gq = p.in[6] + sn * D;
#pragma unroll
            for (int j = 0; j < 4; ++j) { const f32x4 a = *(const f32x4*)(sh + 4 * lane + 256 * j), s = *(const f32x4*)(scl + 4 * lane + 256 * j), q = *(const f32x4*)(gq + 4 * lane + 256 * j);
                const f32x4 h = (v[j] * rs * q) * (s + 1.0f) + a;
                u32x2 w; w.x = pk_bf16(h.x, h.y); w.y = pk_bf16(h.z, h.w);
                *(u32x2*)(H + (size_t)row * D + 4 * lane + 256 * j) = w; }
        }
    }
}

__device__ __forceinline__ void phase_final(const Params& p) {
    const int tid = threadIdx.x, lane = tid & 63, wave = tid >> 6;
    const int gw = blockIdx.x * NWAVES + wave, NGW = gridDim.x * NWAVES;
    const float* mod = (const float*)(p.ws + WS_MOD);
    const bf16_t* Fm = (const bf16_t*)(p.ws + WS_F); const bf16_t* F2 = (const bf16_t*)(p.ws + WS_H);
    for (int row = gw; row < T; row += NGW) {
        const int b = row_batch(row);
        f32x4 v[4], m[4], f[4]; float sm = 0.f, sf = 0.f;
#pragma unroll
        for (int j = 0; j < 4; ++j) { v[j] = *(const f32x4*)(p.out + (size_t)row * D + 4 * lane + 256 * j);
            const u32x2 wm = *(const u32x2*)(Fm + (size_t)row * D + 4 * lane + 256 * j), wf = *(const u32x2*)(F2 + (size_t)row * D + 4 * lane + 256 * j);
            m[j] = (f32x4){lo_bf(wm.x), hi_bf(wm.x), lo_bf(wm.y), hi_bf(wm.y)}; f[j] = (f32x4){lo_bf(wf.x), hi_bf(wf.x), lo_bf(wf.y), hi_bf(wf.y)};
            sm += (m[j].x * m[j].x + m[j].y * m[j].y) + (m[j].z * m[j].z + m[j].w * m[j].w); sf += (f[j].x * f[j].x + f[j].y * f[j].y) + (f[j].z * f[j].z + f[j].w * f[j].w); }
        const float rm = 1.0f / sqrtf(wave_sum(sm) * (1.0f / D) + EPS), rf = 1.0f / sqrtf(wave_sum(sf) * (1.0f / D) + EPS) * 0.5f;
        const float* g1 = mod + b * 9216 + 1 * 3072 + 2048; const float* g2 = mod + b * 9216 + 2 * 3072 + 2048;
        const float* q1 = p.in[7] + 1 * D; const float* q2 = p.in[7] + 2 * D;
#pragma unroll
        for (int j = 0; j < 4; ++j) { const int c = 4 * lane + 256 * j;
            const f32x4 x2 = v[j] + *(const f32x4*)(g1 + c) * (m[j] * rm * *(const f32x4*)(q1 + c));
            *(f32x4*)(p.out + (size_t)row * D + c) = x2 + *(const f32x4*)(g2 + c) * (f[j] * rf * *(const f32x4*)(q2 + c)); }
    }
}

__device__ __forceinline__ void phase_stats(const Params& p, const int wg0, const int nwg) {
    const int tid = threadIdx.x, lane = tid & 63, wave = tid >> 6;
    const int gw = ((int)blockIdx.x - wg0) * NWAVES + wave, NGW = nwg * NWAVES;
    bf16_t* ZQ = (bf16_t*)(p.ws + WS_ZQ);
    bf16_t* KR = (bf16_t*)(p.ws + WS_KR);
    const float* rc = (const float*)(p.ws + WS_ROPE); const float* rsn = rc + SS * 16;
    for (int row = gw; row < T; row += NGW) {
        const u32x4 w = *(const u32x4*)(ZQ + (size_t)row * 512 + 8 * lane);
        float x[8] = {lo_bf(w.x), hi_bf(w.x), lo_bf(w.y), hi_bf(w.y), lo_bf(w.z), hi_bf(w.z), lo_bf(w.w), hi_bf(w.w)};
        float ss = 0.f;
#pragma unroll
        for (int e = 0; e < 8; ++e) ss += x[e] * x[e];
        const float sq = wave_sum(lane < 32 ? ss : 0.f), skv = wave_sum((lane >= 32 && lane < 48) ? ss : 0.f);
        {
            const float rq = 1.0f / sqrtf(sq * (1.0f / 256.0f) + EPS), rkv = 1.0f / sqrtf(skv * (1.0f / 128.0f) + EPS);
            if (lane < 48) { const float r = lane < 32 ? rq : rkv;
                u32x4 o; o.x = pk_bf16(x[0] * r, x[1] * r); o.y = pk_bf16(x[2] * r, x[3] * r); o.z = pk_bf16(x[4] * r, x[5] * r); o.w = pk_bf16(x[6] * r, x[7] * r);
                *(u32x4*)(ZQ + (size_t)row * 512 + 8 * lane) = o; }
        }
        float y[8];
#pragma unroll
        for (int e = 0; e < 8; ++e) y[e] = __shfl_xor(x[e], 2);
        if (lane >= 48 && lane < 52) {
            const int pos = row_pos(row), i0 = 8 * (lane & 1);
            const f32x4 c0 = *(const f32x4*)(rc + pos * 16 + i0), c1 = *(const f32x4*)(rc + pos * 16 + i0 + 4);
            const f32x4 s0 = *(const f32x4*)(rsn + pos * 16 + i0), s1 = *(const f32x4*)(rsn + pos * 16 + i0 + 4);
            const float c[8] = {c0.x, c0.y, c0.z, c0.w, c1.x, c1.y, c1.z, c1.w}, s[8] = {s0.x, s0.y, s0.z, s0.w, s1.x, s1.y, s1.z, s1.w};
            float o[8];
            const bool first = lane < 50;
#pragma unroll
            for (int e = 0; e < 8; ++e) o[e] = first ? (x[e] * c[e] - y[e] * s[e]) : (x[e] * c[e] + y[e] * s[e]);
            u32x4 ow; ow.x = pk_bf16(o[0], o[1]); ow.y = pk_bf16(o[2], o[3]); ow.z = pk_bf16(o[4], o[5]); ow.w = pk_bf16(o[6], o[7]);
            *(u32x4*)(KR + (size_t)row * 32 + 8 * (lane - 48)) = ow;
        }
    }
}

constexpr int XC_PITCH = 272;
__device__ __forceinline__ void phase_lru(const Params& p, LAS unsigned char* lds) {
    const int tid = threadIdx.x, lane = tid & 63, wave = __builtin_amdgcn_readfirstlane(tid >> 6), g = lane >> 4, lc = lane & 15;
    const bf16_t* XL = (const bf16_t*)(p.ws + WS_XL); bf16_t* GY = (bf16_t*)(p.ws + WS_GY); bf16_t* HF = (bf16_t*)(p.ws + WS_F);
    const bf16_t* WG = (const bf16_t*)(p.ws + WS_WG);
    for (int item = blockIdx.x; item < 256; item += gridDim.x) {
        int gb, n;
        if (item < 128) { gb = 16 + (item >> 3); n = item & 7; } else { gb = (item - 128) >> 3; n = item & 7; }
        const int S = gb < 16 ? SP : SS; const int row0 = gb < 16 ? gb * SP : TP + (gb - 16) * SS;
        const int nch = S >> 6;
        const int tr = tid >> 4, cgp = (tid & 15) * 8, c0 = 128 * n + cgp;
        float cw[4][8], cb[8];
#pragma unroll
        for (int j = 0; j < 4; ++j) { const f32x4 a = *(const f32x4*)(p.in[16] + j * D + c0), b = *(const f32x4*)(p.in[16] + j * D + c0 + 4);
            cw[j][0] = a.x; cw[j][1] = a.y; cw[j][2] = a.z; cw[j][3] = a.w; cw[j][4] = b.x; cw[j][5] = b.y; cw[j][6] = b.z; cw[j][7] = b.w; }
        { const f32x4 a = *(const f32x4*)(p.in[17] + c0), b = *(const f32x4*)(p.in[17] + c0 + 4);
            cb[0] = a.x; cb[1] = a.y; cb[2] = a.z; cb[3] = a.w; cb[4] = b.x; cb[5] = b.y; cb[6] = b.z; cb[7] = b.w; }
        const int ch = 128 * n + 16 * wave + lc;
        for (int d = 0; d < 2; ++d) {
            bf16x8 Ba[4], Bi[4];
            { const bf16_t* wa = WG + (size_t)((d * 8 + n) * 2 + 0) * 16384 + (size_t)(16 * wave + lc) * 128 + 8 * g; const bf16_t* wi = wa + 16384;
#pragma unroll
              for (int ks = 0; ks < 4; ++ks) { Ba[ks] = *(const bf16x8*)(wa + 32 * ks); Bi[ks] = *(const bf16x8*)(wi + 32 * ks); } }
            const float ba = p.in[19][d * D + ch], bi = p.in[21][d * D + ch];
            const float lam = p.in[22][d * D + ch];
            const float c8 = -8.0f * log1pf(expf(-lam));
            const float nba = -1.4426950408889634f * ba, nbi = -1.4426950408889634f * bi, c8l = 1.4426950408889634f * c8;
#define BPERM(addr, v) __builtin_bit_cast(float, __builtin_amdgcn_ds_bpermute((addr), __builtin_bit_cast(int, (v))))
            const int bx16 = (lane ^ 16) << 2, bx32 = (lane ^ 32) << 2;
            const bool s1 = d ? !(g & 1) : (g & 1), s2 = d ? !(g >> 1) : (g >> 1);
            float carry = 0.f;
            u32x4 pw[2][4];
#define LRU_PREFETCH(CI) do { const int _cc = d ? (nch - 1 - (CI)) : (CI); _Pragma("unroll") for (int hf = 0; hf < 2; ++hf) _Pragma("unroll") for (int j = 0; j < 4; ++j) { \
                const int tt = _cc * 64 + tr + 32 * hf + j - 1; pw[hf][j] = (tt >= 0 && tt < S) ? *(const u32x4*)(XL + (size_t)(row0 + tt) * D + c0) : (u32x4){0u, 0u, 0u, 0u}; } } while (0)
            LRU_PREFETCH(0);
            for (int ci = 0; ci < nch; ++ci) {
                const int cc = d ? (nch - 1 - ci) : ci, t0 = cc * 64;
                __syncthreads();
#pragma unroll
                for (int hf = 0; hf < 2; ++hf) {
                    const int tl = tr + 32 * hf;
                    float a[8];
#pragma unroll
                    for (int e = 0; e < 8; ++e) a[e] = cb[e];
#pragma unroll
                    for (int j = 0; j < 4; ++j) { const u32x4 w = pw[hf][j];
                        a[0] += cw[j][0] * lo_bf(w.x); a[1] += cw[j][1] * hi_bf(w.x); a[2] += cw[j][2] * lo_bf(w.y); a[3] += cw[j][3] * hi_bf(w.y);
                        a[4] += cw[j][4] * lo_bf(w.z); a[5] += cw[j][5] * hi_bf(w.z); a[6] += cw[j][6] * lo_bf(w.w); a[7] += cw[j][7] * hi_bf(w.w); }
                    u32x4 o; o.x = pk_bf16(a[0], a[1]); o.y = pk_bf16(a[2], a[3]); o.z = pk_bf16(a[4], a[5]); o.w = pk_bf16(a[6], a[7]);
                    *(LAS u32x4*)(lds + tl * XC_PITCH + cgp * 2) = o;
                }
                __syncthreads();
                if (ci + 1 < nch) LRU_PREFETCH(ci + 1);
                float hfv[4][4], gyv[4][4];
                if (d == 1) {
                    const bf16_t* const hfi = HF + (size_t)(row0 + t0 + 4 * g) * D + ch; const bf16_t* const gyi = GY + (size_t)(row0 + t0 + 4 * g) * D + ch;
#pragma unroll
                    for (int mt = 0; mt < 4; ++mt)
#pragma unroll
                        for (int j = 0; j < 4; ++j) { hfv[mt][j] = bf2f(hfi[(16 * mt + j) * D]); gyv[mt][j] = bf2f(gyi[(16 * mt + j) * D]); }
                }
                f32x4 aa[4], ai[4];
#pragma unroll
                for (int mt = 0; mt < 4; ++mt) { aa[mt] = (f32x4){0.f, 0.f, 0.f, 0.f}; ai[mt] = (f32x4){0.f, 0.f, 0.f, 0.f}; }
#pragma unroll
                for (int ks = 0; ks < 4; ++ks)
#pragma unroll
                    for (int mt = 0; mt < 4; ++mt) { const bf16x8 A = *(const LAS bf16x8*)(lds + (16 * mt + lc) * XC_PITCH + (32 * ks + 8 * g) * 2);
                        aa[mt] = __builtin_amdgcn_mfma_f32_16x16x32_bf16(A, Ba[ks], aa[mt], 0, 0, 0);
                        ai[mt] = __builtin_amdgcn_mfma_f32_16x16x32_bf16(A, Bi[ks], ai[mt], 0, 0, 0); }
#pragma unroll
                for (int mt = 0; mt < 4; ++mt)
#pragma unroll
                    for (int j = 0; j < 4; ++j) {
                        const float xcv = bf2f(*(const LAS bf16_t*)(lds + (16 * mt + 4 * g + j) * XC_PITCH + (16 * wave + lc) * 2));
                        const float r = __builtin_amdgcn_rcpf(1.0f + __builtin_amdgcn_exp2f(__builtin_fmaf(aa[mt][j], -1.4426950408889634f, nba)));
                        const float ig = __builtin_amdgcn_rcpf(1.0f + __builtin_amdgcn_exp2f(__builtin_fmaf(ai[mt][j], -1.4426950408889634f, nbi)));
                        const float av = __builtin_amdgcn_exp2f(c8l * r), om = __builtin_fmaf(-av, av, 1.0f);
                        aa[mt][j] = av; ai[mt][j] = __builtin_amdgcn_sqrtf(om) * (ig * xcv);
                    }
#define LRU_COMBINE() \
                        const float A1 = BPERM(bx16, A), H1 = BPERM(bx16, Hs); \
                        const float PA = A * A1, PH = s1 ? (A * H1 + Hs) : (A1 * Hs + H1); \
                        const float exA = s1 ? A1 : 1.f, exH = s1 ? H1 : 0.f; \
                        const float A2 = BPERM(bx32, PA), H2 = BPERM(bx32, PH); \
                        const float TA = PA * A2, TH = s2 ? (PA * H2 + PH) : (A2 * PH + H2); \
                        const float Aex = s2 ? A2 * exA : exA, Hex = s2 ? (exA * H2 + exH) : exH; \
                        const float cin = Aex * carry + Hex; \
                        carry = TA * carry + TH;
                bf16_t* const hfo = HF + (size_t)(row0 + t0 + 4 * g) * D + ch;
                if (d == 0) {
#pragma unroll
                    for (int mt = 0; mt < 4; ++mt) {
                        float P = 1.f, Hh = 0.f, pl[4], hl[4];
#pragma unroll
                        for (int j = 0; j < 4; ++j) { Hh = aa[mt][j] * Hh + ai[mt][j]; P *= aa[mt][j]; hl[j] = Hh; pl[j] = P; }
                        const float A = P, Hs = Hh;
                        LRU_COMBINE()
#pragma unroll
                        for (int j = 0; j < 4; ++j) { const float h = hl[j] + pl[j] * cin;
                            hfo[(16 * mt + j) * D] = (bf16_t)(pk_bf16(h, 0.f) & 0xffffu); }
                    }
                } else {
                    bf16_t* const gyo = GY + (size_t)(row0 + t0 + 4 * g) * D + ch;
#pragma unroll
                    for (int mt = 3; mt >= 0; --mt) {
                        float P = 1.f, Hh = 0.f, pl[4], hl[4];
#pragma unroll
                        for (int j = 3; j >= 0; --j) { Hh = aa[mt][j] * Hh + ai[mt][j]; P *= aa[mt][j]; hl[j] = Hh; pl[j] = P; }
                        const float A = P, Hs = Hh;
                        LRU_COMBINE()
#pragma unroll
                        for (int j = 0; j < 4; ++j) { const float h = hl[j] + pl[j] * cin;
                            const float o = (hfv[mt][j] + h) * gyv[mt][j];
                            gyo[(16 * mt + j) * D] = (bf16_t)(pk_bf16(o, 0.f) & 0xffffu); }
                    }
                }
            }
        }
        __syncthreads();
    }
}

constexpr int AK_PITCH = 208, AV_PITCH = 160, AK_BYTES = 64 * AK_PITCH, AV_BYTES = 64 * AV_PITCH, ABUF = AK_BYTES + AV_BYTES;
__device__ __forceinline__ void phase_attn(const Params& p, LAS unsigned char* lds) {
    const int tid = threadIdx.x, lane = tid & 63, wave = __builtin_amdgcn_readfirstlane(tid >> 6), g = lane >> 4, lc = lane & 15;
    const bf16_t* Q = (const bf16_t*)(p.ws + WS_F); const bf16_t* KN = (const bf16_t*)(p.ws + WS_XL); const bf16_t* V = KN + (size_t)T * NKV;
    const bf16_t* KR = (const bf16_t*)(p.ws + WS_KR); bf16_t* O = (bf16_t*)(p.ws + WS_ZQ);
    const float csc = 0.10206207261596577f * 1.4426950408889634f;
    const int srow = tid >> 3, sch = tid & 7;
    const int rrow = (tid & 255) >> 2, rch = tid & 3;
    const int vtr = (4 * g + (lc >> 2)) * AV_PITCH + (4 * (lc & 3)) * 2;
    const int vwg = (gridDim.x % 8 == 0) ? (int)(blockIdx.x % 8) * (int)(gridDim.x / 8) + (int)(blockIdx.x / 8) : (int)blockIdx.x;
    for (int unit = vwg; unit < 3072; unit += gridDim.x) {
        int gb, h, qt, S, row0;
        if (unit < 2048) { gb = 16 + (unit >> 7); h = (unit & 127) >> 4; qt = unit & 15; S = SS; row0 = TP + (gb - 16) * SS; }
        else { const int u2 = unit - 2048; gb = u2 >> 6; h = (u2 & 63) >> 3; qt = u2 & 7; S = SP; row0 = gb * SP; }
        const int nkt = S >> 6;
        const int qrow = row0 + 256 * qt + 32 * wave;
        bf16x8 qf[2][3];
#pragma unroll
        for (int q2 = 0; q2 < 2; ++q2)
#pragma unroll
            for (int ks = 0; ks < 3; ++ks) qf[q2][ks] = *(const bf16x8*)(Q + (size_t)(qrow + 16 * q2 + lc) * NQ + 96 * h + 32 * ks + 8 * g);
#pragma unroll
        for (int q2 = 0; q2 < 2; ++q2) {
            const int pos = row_pos(qrow + 16 * q2 + lc), i0 = 8 * (g & 1);
            const float* rc = (const float*)(p.ws + WS_ROPE) + pos * 16 + i0; const float* rsn = rc + SS * 16;
            const f32x4 c0 = *(const f32x4*)rc, c1 = *(const f32x4*)(rc + 4), s0 = *(const f32x4*)rsn, s1 = *(const f32x4*)(rsn + 4);
            const float cc[8] = {c0.x, c0.y, c0.z, c0.w, c1.x, c1.y, c1.z, c1.w}, sn[8] = {s0.x, s0.y, s0.z, s0.w, s1.x, s1.y, s1.z, s1.w};
            const u32x4 mine = __builtin_bit_cast(u32x4, qf[q2][2]);
            u32x4 oth; oth.x = __shfl_xor(mine.x, 32); oth.y = __shfl_xor(mine.y, 32); oth.z = __shfl_xor(mine.z, 32); oth.w = __shfl_xor(mine.w, 32);
            const float xm[8] = {lo_bf(mine.x), hi_bf(mine.x), lo_bf(mine.y), hi_bf(mine.y), lo_bf(mine.z), hi_bf(mine.z), lo_bf(mine.w), hi_bf(mine.w)};
            const float xo[8] = {lo_bf(oth.x), hi_bf(oth.x), lo_bf(oth.y), hi_bf(oth.y), lo_bf(oth.z), hi_bf(oth.z), lo_bf(oth.w), hi_bf(oth.w)};
            float o[8];
#pragma unroll
            for (int e = 0; e < 8; ++e) o[e] = g < 2 ? (xm[e] * cc[e] - xo[e] * sn[e]) : (xm[e] * cc[e] + xo[e] * sn[e]);
            u32x4 w; w.x = pk_bf16(o[0], o[1]); w.y = pk_bf16(o[2], o[3]); w.z = pk_bf16(o[4], o[5]); w.w = pk_bf16(o[6], o[7]);
            qf[q2][2] = __builtin_bit_cast(bf16x8, w);
        }
        f32x4 oacc[4][2];
#pragma unroll
        for (int dt = 0; dt < 4; ++dt) { oacc[dt][0] = (f32x4){0.f, 0.f, 0.f, 0.f}; oacc[dt][1] = (f32x4){0.f, 0.f, 0.f, 0.f}; }
        float mrun[2] = {-1e30f, -1e30f}, lrun[2] = {0.f, 0.f};
        u32x4 gk, gr, gv;
        gk = *(const u32x4*)(KN + (size_t)(row0 + srow) * NKV + 64 * h + 8 * sch);
        gv = *(const u32x4*)(V + (size_t)(row0 + srow) * NKV + 64 * h + 8 * sch);
        gr = *(const u32x4*)(KR + (size_t)(row0 + rrow) * 32 + 8 * rch);
        __syncthreads();
        *(LAS u32x4*)(lds + srow * AK_PITCH + sch * 16) = gk;
        *(LAS u32x4*)(lds + AK_BYTES + srow * AV_PITCH + sch * 16) = gv;
        if (tid < 256) *(LAS u32x4*)(lds + rrow * AK_PITCH + 128 + rch * 16) = gr;
        u32x4 gk2, gr2, gv2;
        gk = *(const u32x4*)(KN + (size_t)(row0 + 64 + srow) * NKV + 64 * h + 8 * sch);
        gv = *(const u32x4*)(V + (size_t)(row0 + 64 + srow) * NKV + 64 * h + 8 * sch);
        gr = *(const u32x4*)(KR + (size_t)(row0 + 64 + rrow) * 32 + 8 * rch);
        gk2 = *(const u32x4*)(KN + (size_t)(row0 + 128 + srow) * NKV + 64 * h + 8 * sch);
        gv2 = *(const u32x4*)(V + (size_t)(row0 + 128 + srow) * NKV + 64 * h + 8 * sch);
        gr2 = *(const u32x4*)(KR + (size_t)(row0 + 128 + rrow) * 32 + 8 * rch);
        __syncthreads();
#define ATT_BODY(kt, GK, GR, GV) do { \
            LAS unsigned char* kb = lds + ((kt) & 1) * ABUF; LAS unsigned char* vb = kb + AK_BYTES; \
            LAS unsigned char* nb = lds + (((kt) + 1) & 1) * ABUF; \
            const bool more = (kt) + 1 < nkt; \
 \
            f32x4 sacc[4][2]; \
            _Pragma("unroll") \
            for (int k4 = 0; k4 < 4; ++k4) { sacc[k4][0] = (f32x4){0.f, 0.f, 0.f, 0.f}; sacc[k4][1] = (f32x4){0.f, 0.f, 0.f, 0.f}; } \
            _Pragma("unroll") \
            for (int ks = 0; ks < 3; ++ks) \
            _Pragma("unroll") \
                for (int k4 = 0; k4 < 4; ++k4) { const bf16x8 kf = *(const LAS bf16x8*)(kb + (16 * k4 + lc) * AK_PITCH + (32 * ks + 8 * g) * 2); \
                    sacc[k4][0] = __builtin_amdgcn_mfma_f32_16x16x32_bf16(kf, qf[0][ks], sacc[k4][0], 0, 0, 0); \
                    sacc[k4][1] = __builtin_amdgcn_mfma_f32_16x16x32_bf16(kf, qf[1][ks], sacc[k4][1], 0, 0, 0); } \
            bf16x8 pf[2][2]; \
            _Pragma("unroll") \
            for (int q2 = 0; q2 < 2; ++q2) { \
                float mx = sacc[0][q2][0]; \
            _Pragma("unroll") \
                for (int k4 = 0; k4 < 4; ++k4) \
            _Pragma("unroll") \
                    for (int j = 0; j < 4; ++j) mx = fmaxf(mx, sacc[k4][q2][j]); \
                mx = fmaxf(mx, __shfl_xor(mx, 16)); mx = fmaxf(mx, __shfl_xor(mx, 32)); \
                const float mnew = fmaxf(mrun[q2], mx * csc); \
                const float alpha = __builtin_amdgcn_exp2f(mrun[q2] - mnew); \
                mrun[q2] = mnew; \
                float ps = 0.f; float pv[4][4]; \
            _Pragma("unroll") \
                for (int k4 = 0; k4 < 4; ++k4) \
            _Pragma("unroll") \
                    for (int j = 0; j < 4; ++j) { const float e = __builtin_amdgcn_exp2f(sacc[k4][q2][j] * csc - mnew); pv[k4][j] = e; ps += e; } \
                lrun[q2] = lrun[q2] * alpha + ps; \
            _Pragma("unroll") \
                for (int dt = 0; dt < 4; ++dt) oacc[dt][q2] *= alpha; \
            _Pragma("unroll") \
                for (int kk = 0; kk < 2; ++kk) { \
                    u32x4 w; w.x = pk_bf16(pv[2 * kk][0], pv[2 * kk][1]); w.y = pk_bf16(pv[2 * kk][2], pv[2 * kk][3]); \
                    w.z = pk_bf16(pv[2 * kk + 1][0], pv[2 * kk + 1][1]); w.w = pk_bf16(pv[2 * kk + 1][2], pv[2 * kk + 1][3]); \
                    pf[q2][kk] = __builtin_bit_cast(bf16x8, w); \
                } \
            } \
 \
            _Pragma("unroll") \
            for (int kk = 0; kk < 2; ++kk) \
            _Pragma("unroll") \
                for (int dt = 0; dt < 4; ++dt) { \
                    const v4i16_t lo = __builtin_amdgcn_ds_read_tr16_b64_v4i16((LAS v4i16_t*)(vb + vtr + (32 * kk) * AV_PITCH + 32 * dt)); \
                    const v4i16_t hi = __builtin_amdgcn_ds_read_tr16_b64_v4i16((LAS v4i16_t*)(vb + vtr + (32 * kk + 16) * AV_PITCH + 32 * dt)); \
                    const bf16x8 vf = {lo[0], lo[1], lo[2], lo[3], hi[0], hi[1], hi[2], hi[3]}; \
                    oacc[dt][0] = __builtin_amdgcn_mfma_f32_16x16x32_bf16(vf, pf[0][kk], oacc[dt][0], 0, 0, 0); \
                    oacc[dt][1] = __builtin_amdgcn_mfma_f32_16x16x32_bf16(vf, pf[1][kk], oacc[dt][1], 0, 0, 0); \
                } \
            if (more) { \
                *(LAS u32x4*)(nb + srow * AK_PITCH + sch * 16) = GK; \
                *(LAS u32x4*)(nb + AK_BYTES + srow * AV_PITCH + sch * 16) = GV; \
                if (tid < 256) *(LAS u32x4*)(nb + rrow * AK_PITCH + 128 + rch * 16) = GR; \
            } \
            if ((kt) + 3 < nkt) { const int kr0 = row0 + 64 * ((kt) + 3); \
                GK = *(const u32x4*)(KN + (size_t)(kr0 + srow) * NKV + 64 * h + 8 * sch); \
                GV = *(const u32x4*)(V + (size_t)(kr0 + srow) * NKV + 64 * h + 8 * sch); \
                GR = *(const u32x4*)(KR + (size_t)(kr0 + rrow) * 32 + 8 * rch); } \
            __syncthreads(); \
        } while (0)
        for (int kt2 = 0; kt2 < nkt; kt2 += 2) { ATT_BODY(kt2, gk, gr, gv); ATT_BODY(kt2 + 1, gk2, gr2, gv2); }
#undef ATT_BODY
#pragma unroll
        for (int q2 = 0; q2 < 2; ++q2) {
            float l = lrun[q2]; l += __shfl_xor(l, 16); l += __shfl_xor(l, 32);
            const float inv = 1.0f / l;
#pragma unroll
            for (int dt = 0; dt < 4; ++dt) { const f32x4 o = oacc[dt][q2] * inv;
                u32x2 w; w.x = pk_bf16(o[0], o[1]); w.y = pk_bf16(o[2], o[3]);
                *(u32x2*)(O + (size_t)(qrow + 16 * q2 + lc) * 512 + 64 * h + 16 * dt + 4 * g) = w; }
        }
    }
    __syncthreads();
}

#define XB_TMO      128
#define XB_XCNT(j)  (256  + 64 * (j))
#define XB_XSUB(j)  (1280 + 64 * (j))
#define XB_XGEN(j)  (2304 + 64 * (j))
#define XB_TOP      3328
#define XB_TOPGEN   3392
#define XCD_BAR_WORDS 3456
#define XB_SPIN_CAP (1u << 18)

__device__ __forceinline__ unsigned xb_ld(unsigned* p)              { return __hip_atomic_load(p, __ATOMIC_RELAXED, __HIP_MEMORY_SCOPE_AGENT); }
__device__ __forceinline__ unsigned xb_add(unsigned* p, unsigned v) { return __hip_atomic_fetch_add(p, v, __ATOMIC_RELAXED, __HIP_MEMORY_SCOPE_AGENT); }
__device__ __forceinline__ unsigned xb_xcc_id() { return (unsigned)__builtin_amdgcn_s_getreg((3 << 11) | 20) & 0xFu; }
#define XB_SPIN(cond, bar) do { unsigned _sp = 0; while (cond) { __builtin_amdgcn_s_sleep(1); \
    if ((++_sp & 255u) == 0u) { if (xb_ld(&(bar)[XB_TMO])) break; if (_sp > XB_SPIN_CAP) { atomicAdd(&(bar)[XB_TMO], 1u); break; } } } } while (0)

struct XcdBarrier {
    unsigned* bar; unsigned x;
    volatile LAS unsigned* st;
};

__device__ __forceinline__ XcdBarrier xcd_barrier_post(unsigned* bar, volatile LAS unsigned* st) {
    XcdBarrier b; b.bar = bar; b.x = xb_xcc_id(); b.st = st;
    if (threadIdx.x == 0) (void)xb_add(&bar[XB_XCNT(b.x)], 1u);
    return b;
}
__device__ __forceinline__ void xcd_barrier_complete(unsigned* bar, unsigned x, unsigned& nloc, unsigned& nx) {
    const unsigned G = gridDim.x * gridDim.y * gridDim.z;
    unsigned sum, cnt, mine, sp = 0u;
    for (;;) {
        sum = 0u; cnt = 0u; mine = 0u;
#pragma unroll
        for (unsigned j = 0; j < 16; ++j) { const unsigned c = xb_ld(&bar[XB_XCNT(j)]); sum += c; cnt += (c > 0u) ? 1u : 0u; mine = (j == x) ? c : mine; }
        if (sum == G) break;
        __builtin_amdgcn_s_sleep(1);
        if ((++sp & 255u) == 0u) { if (xb_ld(&bar[XB_TMO])) break; if (sp > XB_SPIN_CAP) { atomicAdd(&bar[XB_TMO], 1u); break; } }
    }
    nloc = mine > 0u ? mine : 1u; nx = cnt > 0u ? cnt : 1u;
}

__device__ __forceinline__ void xcd_barrier(const XcdBarrier& b) {
    asm volatile("s_waitcnt vmcnt(0)" ::: "memory");
    __syncthreads();
    if (threadIdx.x == 0) {
        unsigned* bar = b.bar;
        __builtin_amdgcn_s_waitcnt(0);
        unsigned nloc = b.st[0], nx = b.st[1];
        if (nloc == 0u) { xcd_barrier_complete(bar, b.x, nloc, nx); b.st[0] = nloc; b.st[1] = nx; }
        const unsigned old = xb_add(&bar[XB_XSUB(b.x)], 1u);
        const unsigned gen = old / nloc;
        if (old + 1u == (gen + 1u) * nloc) {
            __builtin_amdgcn_fence(__ATOMIC_RELEASE, "agent");
            asm volatile("s_waitcnt vmcnt(0)" ::: "memory");
            const unsigned og = xb_add(&bar[XB_TOP], 1u);
            const unsigned tg = og / nx;
            if (og + 1u == (tg + 1u) * nx) xb_add(&bar[XB_TOPGEN], 1u);
            else XB_SPIN(xb_ld(&bar[XB_TOPGEN]) == tg, bar);
            __builtin_amdgcn_fence(__ATOMIC_ACQUIRE, "agent");
            xb_add(&bar[XB_XGEN(b.x)], 1u);
            asm volatile("s_waitcnt vmcnt(0)" ::: "memory");
        } else {
            XB_SPIN(xb_ld(&bar[XB_XGEN(b.x)]) == gen, bar);
            __builtin_amdgcn_fence(__ATOMIC_ACQUIRE, "agent");
            asm volatile("s_waitcnt vmcnt(0)" ::: "memory");
        }
    }
    __syncthreads();
}


constexpr int NPHASES = 16;
__global__ void __launch_bounds__(NTHREADS, 2) mega_fwd(Params p) {
    extern __shared__ __attribute__((aligned(16))) unsigned char lds_raw[];
    LAS unsigned char* lds = (LAS unsigned char*)lds_raw;
    cg::grid_group grid = cg::this_grid();
    unsigned char* ws = p.ws;
    const int G = gridDim.x, bid = blockIdx.x;
    bf16_t* Hb = (bf16_t*)(ws + WS_H); bf16_t* Fb = (bf16_t*)(ws + WS_F); bf16_t* ACT = (bf16_t*)(ws + WS_ACT);
    bf16_t* ZQ = (bf16_t*)(ws + WS_ZQ); bf16_t* XL = (bf16_t*)(ws + WS_XL); bf16_t* GY = (bf16_t*)(ws + WS_GY);
#ifndef TESTPH
#define TESTPH -1
#endif
#define IN(k) ((TESTPH < 0 || (k) == TESTPH) && p.ph_lo <= (k) && (k) < p.ph_hi)
#define SEAM0() do { if (IN(0) && IN(1)) { __builtin_amdgcn_fence(__ATOMIC_RELEASE, "agent"); asm volatile("s_waitcnt vmcnt(0) lgkmcnt(0)" ::: "memory"); \
        grid.sync(); __builtin_amdgcn_fence(__ATOMIC_ACQUIRE, "agent"); asm volatile("s_waitcnt vmcnt(0) lgkmcnt(0)" ::: "memory"); \
        xb = xcd_barrier_post((unsigned*)(p.ws + WS_XBAR), xbst); } } while (0)
#define SEAM(k) do { if (IN(k) && IN((k) + 1)) xcd_barrier(xb); } while (0)
    volatile LAS unsigned* xbst = (volatile LAS unsigned*)(lds + LDS_BYTES - 16);
    if (threadIdx.x < 4) xbst[threadIdx.x] = 0u;
    __syncthreads();
    XcdBarrier xb; xb.bar = (unsigned*)(p.ws + WS_XBAR); xb.x = 0; xb.st = xbst;
    if (IN(0) && bid == 0) { unsigned* xw = (unsigned*)(p.ws + WS_XBAR); for (int i = threadIdx.x; i < XCD_BAR_WORDS; i += NTHREADS) xw[i] = 0u; }
    SEAM0();
    if (IN(0)) phase_prep(p, lds);
    SEAM(0);
    if (IN(1)) phase_rows<false, true>(p, 0, 0, 0.f, true);
    SEAM(1);
#define FFN_PHASES(ffn, pb) do { \
        if (IN(pb)) { \
            pg8::Gemm g{Hb, (const bf16_t*)(ws + ((ffn) ? WS_WGU2 : WS_WGU1)), D, D}; pg8::StaticOrder S; S.init(T, 2 * DFF, G, bid); \
            pg8::EpiSwiglu E{ACT, DFF}; \
            GEMM_PHASE(pg8::EpiSwiglu, lds, g, S, E); \
        } \
        SEAM(pb); \
        if (IN((pb) + 1)) { \
            pg8::Gemm g{ACT, (const bf16_t*)(ws + ((ffn) ? WS_WDN2 : WS_WDN1)), DFF, DFF}; pg8::StaticOrder S; S.init(T, D, G, bid); \
            pg8::EpiAct<0> E{(ffn) ? Hb : Fb, D, 0}; \
            GEMM_PHASE(pg8::EpiAct<0>, lds, g, S, E); \
        } \
        SEAM((pb) + 1); } while (0)
    FFN_PHASES(0, 2);
        if (IN(4)) phase_rows<true, true>(p, 0, 1, 0.5f, true);
        SEAM(4);
        if (IN(5)) {
            pg8::Gemm g{Hb, (const bf16_t*)(ws + WS_WINA), D, D}; pg8::StaticOrder S; S.init(T, 2560, G, bid);
            pg8::EpiWinA E{ZQ, XL, GY};
            GEMM_PHASE(pg8::EpiWinA, lds, g, S, E);
        }
        SEAM(5);
        if (IN(6)) { phase_lru(p, lds); if (bid >= G / 2) phase_stats(p, G / 2, G - G / 2);     }
        SEAM(6);
        if (IN(7)) {
            pg8::Gemm g{ZQ, (const bf16_t*)(ws + WS_WQKV), 512, 384}; pg8::StaticOrder S; S.init(T, 1792, G, bid);
            pg8::EpiQKV E{Fb, XL};
            GEMM_PHASE2(pg8::EpiQKV, lds, g, S, E);
        }
        SEAM(7);
        if (IN(8)) phase_attn(p, lds);
        SEAM(8);
        if (IN(9)) {
            pg8::Gemm g{Hb, (const bf16_t*)(ws + WS_WINB), D, D}; pg8::StaticOrder S; S.init(T, 2048, G, bid);
            pg8::EpiWinB E{Fb, XL};
            GEMM_PHASE(pg8::EpiWinB, lds, g, S, E);
        }
        SEAM(9);
        if (IN(10)) {
            { pg8::Gemm g{ZQ, (const bf16_t*)(ws + WS_WAO), 512, 512}; pg8::StaticOrder S; S.init(T, D, G, bid);
              pg8::EpiGate<false> E{Fb, nullptr, Fb};
              GEMM_PHASE(pg8::EpiGate<false>, lds, g, S, E); }
            { pg8::Gemm g{GY, (const bf16_t*)(ws + WS_WLO), D, D}; pg8::StaticOrder S; S.init(T, D, G, bid);
              pg8::EpiGate<true> E{XL, Fb, XL};
              GEMM_PHASE(pg8::EpiGate<true>, lds, g, S, E); }
        }
        SEAM(10);
        if (IN(11)) {
            pg8::Gemm g{XL, (const bf16_t*)(ws + WS_WOUT), D, D}; pg8::StaticOrder S; S.init(T, D, G, bid);
            pg8::EpiAct<0> E{Fb, D, 0};
            GEMM_PHASE(pg8::EpiAct<0>, lds, g, S, E);
        }
        SEAM(11);
        if (IN(12)) phase_rows<true, true>(p, 1, 2, 1.0f, false, false);
        SEAM(12);
    FFN_PHASES(1, 13);
    if (IN(15)) phase_final(p);
#undef IN
#undef SEAM
}

extern "C" void kernel_launch(void* const* d_in, const int* in_sizes, int n_in, void* d_out, int out_size, void* d_ws, size_t ws_size, hipStream_t stream) {
    static int grid = 0;
    if (grid == 0) {
        if (n_in != 27 || out_size != T * D || ws_size < WS_END) { fprintf(stderr, "kernel_launch: unexpected shapes: n_in %d out %d ws %zu (need >= %zu)\n", n_in, out_size, ws_size, (size_t)WS_END); grid = -1; return; }
        int dev = 0, cus = 0, per_cu = 0;
        (void)hipGetDevice(&dev);
        (void)hipDeviceGetAttribute(&cus, hipDeviceAttributeMultiprocessorCount, dev);
        if (hipFuncSetAttribute((const void*)mega_fwd, hipFuncAttributeMaxDynamicSharedMemorySize, LDS_BYTES) != hipSuccess) { fprintf(stderr, "kernel_launch: hipFuncSetAttribute failed\n"); grid = -1; return; }
        if (hipOccupancyMaxActiveBlocksPerMultiprocessor(&per_cu, (const void*)mega_fwd, NTHREADS, LDS_BYTES) != hipSuccess || per_cu < 1) { fprintf(stderr, "kernel_launch: occupancy query failed (%d)\n", per_cu); per_cu = 1; }
        (void)hipGetLastError();
        grid = cus;
        fprintf(stderr, "kernel_launch: grid %d (per_cu %d)\n", grid, per_cu);
    }
    if (grid < 0) return;
    Params p{};
    for (int i = 0; i < 27; ++i) p.in[i] = (const float*)d_in[i];
    p.out = (float*)d_out; p.ws = (unsigned char*)d_ws;
#if defined(MK_SPLIT)
    for (int ph = 0; ph < NPHASES; ++ph) { p.ph_lo = ph; p.ph_hi = ph + 1;
        hipLaunchKernelGGL(mega_fwd, dim3(grid), dim3(NTHREADS), LDS_BYTES, stream, p); }
#else
    p.ph_lo = 0; p.ph_hi = NPHASES;
    void* args[] = {&p};
    hipError_t e = hipLaunchCooperativeKernel((const void*)mega_fwd, dim3(grid), dim3(NTHREADS), args, LDS_BYTES, stream);
    if (e != hipSuccess) fprintf(stderr, "kernel_launch: cooperative launch failed: %s (grid %d)\n", hipGetErrorString(e), grid);
#endif
}
```

```cpp
#include <hip/hip_runtime.h>
#include <hip/hip_cooperative_groups.h>
#include <cstdio>
#include <cstdint>
namespace cg = cooperative_groups;
#ifndef MK_SP2_ALL
#define MK_SP2_ALL false
#endif

#define LAS __attribute__((address_space(3)))
typedef unsigned short bf16_t;
typedef short bf16x8 __attribute__((ext_vector_type(8)));
typedef short v4i16_t __attribute__((ext_vector_type(4)));
typedef float f32x4 __attribute__((ext_vector_type(4)));
typedef float f32x2 __attribute__((ext_vector_type(2)));
typedef unsigned u32x4 __attribute__((ext_vector_type(4)));
typedef unsigned u32x2 __attribute__((ext_vector_type(2)));

constexpr int D = 1024, DFF = 2816, TP = 32768, TS = 65536, T = TP + TS, SP = 2048, SS = 4096;
constexpr int NQ = 768, NKV = 512;
constexpr float EPS = 1e-6f;
constexpr int NTHREADS = 512, NWAVES = 8;

constexpr size_t KiB = 1024, MiB = 1024 * 1024;
constexpr size_t WS_WGU1 = 0, WS_WDN1 = 11 * MiB, WS_WINA = 16 * MiB + 512 * KiB, WS_WINB = 21 * MiB + 512 * KiB, WS_WQKV = 25 * MiB + 512 * KiB,
                 WS_WAO = 27 * MiB, WS_WLO = 28 * MiB, WS_WOUT = 30 * MiB, WS_WGU2 = 32 * MiB, WS_WDN2 = 43 * MiB, WS_WG = 48 * MiB + 512 * KiB,
                 WS_MOD = 49 * MiB + 512 * KiB, WS_ROPE = 50 * MiB + 768 * KiB, WS_STATS = 51 * MiB + 256 * KiB, WS_KR = 52 * MiB;
constexpr size_t WS_XBAR = 50 * MiB + 640 * KiB;
constexpr size_t WS_H = 64 * MiB, WS_F = 256 * MiB, WS_BIG = 448 * MiB;
constexpr size_t WS_ZQ = WS_BIG, WS_XL = WS_BIG + 96 * MiB, WS_GY = WS_BIG + 288 * MiB, WS_ACT = WS_BIG, WS_END = 976 * MiB;
constexpr int LDS_BYTES = 139264;

struct Params { const float* in[27]; float* out; unsigned char* ws; int ph_lo, ph_hi; };

typedef __bf16 bf16x2_t __attribute__((ext_vector_type(2)));
__device__ __forceinline__ unsigned pk_bf16(float lo, float hi) { const f32x2 v = {lo, hi}; const bf16x2_t b = __builtin_convertvector(v, bf16x2_t); return __builtin_bit_cast(unsigned, b); }
__device__ __forceinline__ float lo_bf(unsigned w) { return __uint_as_float(w << 16); }
__device__ __forceinline__ float hi_bf(unsigned w) { return __uint_as_float(w & 0xffff0000u); }
__device__ __forceinline__ float bf2f(bf16_t h) { return __uint_as_float((unsigned)h << 16); }
__device__ __forceinline__ float fexp(float x) { return __builtin_amdgcn_exp2f(x * 1.4426950408889634f); }
__device__ __forceinline__ float fsigmoid(float x) { return __builtin_amdgcn_rcpf(1.0f + fexp(-x)); }
__device__ __forceinline__ float fsilu(float x) { return x * fsigmoid(x); }
__device__ __forceinline__ float fgelu(float x) { return x * fsigmoid(1.5957691216057308f * (x + 0.044715f * x * x * x)); }
__device__ __forceinline__ float wave_sum(float v) {
#pragma unroll
    for (int o = 1; o < 64; o <<= 1) v += __shfl_xor(v, o);
    return v;
}
__device__ __forceinline__ int row_batch(int row) { return row < TP ? (row >> 11) : 16 + ((row - TP) >> 12); }
__device__ __forceinline__ int row_pos(int row) { return row < TP ? (row & (SP - 1)) : ((row - TP) & (SS - 1)); }

namespace pg8 {
constexpr int BM = 256, BK = 64, HALF = 128, HTB = HALF * BK * 2, STAGE_BYTES = 8 * HTB, NXCD = 8, WGM = 8;
__host__ __device__ __forceinline__ int lds_byte(int r, int c) { const int st = (r >> 4) * 2 + (c >> 5), rr = r & 15, cc = c & 31, ob = rr * 64 + cc * 2; return st * 1024 + (ob ^ (((ob >> 9) & 1) << 5)); }
__host__ __device__ __forceinline__ void stage_rc(int b, int& R, int& C) { const int st = b / 1024, sb = b % 1024, swz = sb ^ (((sb >> 9) & 1) << 5); R = (st >> 1) * 16 + swz / 64; C = (st & 1) * 32 + (swz % 64) / 2; }
__host__ __device__ __forceinline__ int perm32(int rho) { const int n = rho >> 4, i = rho & 15; return 8 * (i >> 2) + 4 * n + (i & 3); }

struct Unit { int pm, pn; };
struct Gemm { const bf16_t* A; const bf16_t* Bt; int lda, K; };

struct StaticOrder {
    int nM, nN, nwg, G, c, rev;
    __device__ void init(int M, int N, int G_, int c_, int rev_ = 0) { nM = M / BM; nN = N / BM; nwg = nM * nN; G = G_; c = c_; rev = rev_; }
    __device__ bool next(int i, Unit& u) const {
        const long L = (long)i * G + c; if (L >= nwg) return false;
        int wgid = (int)L; { const int q = nwg / NXCD, r = nwg % NXCD, xcd = wgid % NXCD, off = wgid / NXCD; wgid = (xcd < r ? xcd * (q + 1) : r * (q + 1) + (xcd - r) * q) + off; }
        const int nig = WGM * nN, gid = wgid / nig, fm = gid * WGM, gsz = (nM - fm) < WGM ? (nM - fm) : WGM;
        u.pm = fm + ((wgid % nig) % gsz); u.pn = (wgid % nig) / gsz; if (rev) u.pm = nM - 1 - u.pm; return true;
    }
};

template <class Epi, bool SP2 = false>
__device__ __forceinline__ void gemm_phase(LAS unsigned char* lds, const Gemm g, const StaticOrder& S, const Epi& E) {
    const int tid = threadIdx.x, wid = __builtin_amdgcn_readfirstlane(tid >> 6), lane = tid & 63, wr = wid >> 2, wc = wid & 3, fr = lane & 15, fq = lane >> 4;
    const int K = g.K, nt = K / BK, lda = g.lda;
    unsigned voffA[2], voffB[2];
#pragma unroll
    for (int i = 0; i < 2; ++i) { int R, C; stage_rc(tid * 16 + i * 8192, R, C); const int Rb = Epi::PERM ? ((R & ~31) + perm32(R & 31)) : R;
        voffA[i] = (unsigned)(R * lda + C) * 2u; voffB[i] = (unsigned)(Rb * K + C) * 2u; }
    const size_t kstep = (size_t)(BK * 2);
    const size_t hstepA = (size_t)HALF * lda * 2, hstepB = (size_t)HALF * K * 2;
    const size_t tstepA = 2 * hstepA, tstepB = 2 * hstepB;
    const unsigned ldsw = (unsigned)wid * 1024u;
    const int aoff = lds_byte(wr * 64 + fr, fq * 8), boff = lds_byte(wc * 32 + fr, fq * 8);
#define PG8_SA(b, h) (((b) * 2 + (h)) * HTB)
#define PG8_SB(b, h) ((4 + (b) * 2 + (h)) * HTB)
#define PG8_STAGE(bufoff, gbase, voff) do { _Pragma("unroll") for (int _i = 0; _i < 2; ++_i) \
        __builtin_amdgcn_global_load_lds((const unsigned*)((const char*)(gbase) + (voff)[_i]), (LAS unsigned*)(lds + (bufoff) + ldsw + _i * 8192), 16, 0, 0); } while (0)
#define PG8_LDA(dst, b, h) do { _Pragma("unroll") for (int m = 0; m < 4; ++m) _Pragma("unroll") for (int k = 0; k < 2; ++k) dst[m][k] = *(const LAS bf16x8*)(lds + PG8_SA(b, h) + aoff + m * 2048 + k * 1024); } while (0)
#define PG8_LDB(dst, b, h) do { _Pragma("unroll") for (int n = 0; n < 2; ++n) _Pragma("unroll") for (int k = 0; k < 2; ++k) dst[n][k] = *(const LAS bf16x8*)(lds + PG8_SB(b, h) + boff + n * 2048 + k * 1024); } while (0)
#define PG8_MMA(ai, bj, At, Bt) do { __builtin_amdgcn_s_setprio(1); _Pragma("unroll") for (int m = 0; m < 4; ++m) _Pragma("unroll") for (int n = 0; n < 2; ++n) _Pragma("unroll") for (int k = 0; k < 2; ++k) \
        acc[ai][bj][m][n] = __builtin_amdgcn_mfma_f32_16x16x32_bf16(Bt[n][k], At[m][k], acc[ai][bj][m][n], 0, 0, 0); __builtin_amdgcn_s_setprio(0); } while (0)
#define PG8_WAIT_V(n) asm volatile("s_waitcnt vmcnt(" #n ")" ::: "memory")
#define PG8_WAIT_L(n) asm volatile("s_waitcnt lgkmcnt(" #n ")" ::: "memory")
#define PG8_BAR __builtin_amdgcn_s_barrier()
#define PG8_SCHED __builtin_amdgcn_sched_barrier(0)
    Unit cur, nxt; int ui = 0;
    if (!S.next(0, cur)) return;
    f32x4 acc[2][2][4][2];
#pragma unroll
    for (int a = 0; a < 2; ++a)
#pragma unroll
        for (int b = 0; b < 2; ++b)
#pragma unroll
            for (int m = 0; m < 4; ++m)
#pragma unroll
                for (int n = 0; n < 2; ++n) acc[a][b][m][n] = (f32x4){0.f, 0.f, 0.f, 0.f};
    bf16x8 At[4][2], B0[2][2], B1[2][2];
    const char* cA = (const char*)g.A + (size_t)cur.pm * tstepA; const char* cB = (const char*)g.Bt + (size_t)cur.pn * tstepB;
    if constexpr (SP2) {
        PG8_STAGE(PG8_SB(0, 0), cB, voffB); PG8_STAGE(PG8_SB(0, 1), cB + hstepB, voffB); PG8_STAGE(PG8_SA(0, 0), cA, voffA); PG8_STAGE(PG8_SA(0, 1), cA + hstepA, voffA);
        if (wr == 1) PG8_BAR;
        PG8_WAIT_V(2); PG8_BAR;
        PG8_STAGE(PG8_SB(1, 0), cB + kstep, voffB); PG8_STAGE(PG8_SA(1, 0), cA + kstep, voffA); PG8_STAGE(PG8_SB(1, 1), cB + hstepB + kstep, voffB);
        PG8_WAIT_V(6); PG8_BAR;
    } else {
    PG8_STAGE(PG8_SB(0, 0), cB, voffB); PG8_STAGE(PG8_SA(0, 0), cA, voffA); PG8_STAGE(PG8_SB(0, 1), cB + hstepB, voffB); PG8_STAGE(PG8_SA(0, 1), cA + hstepA, voffA);
    if (wr == 1) PG8_BAR;
    PG8_WAIT_V(4); PG8_BAR;
    PG8_STAGE(PG8_SB(1, 0), cB + kstep, voffB); PG8_STAGE(PG8_SA(1, 0), cA + kstep, voffA); PG8_STAGE(PG8_SB(1, 1), cB + hstepB + kstep, voffB);
    PG8_WAIT_V(6); PG8_BAR;
    }
    for (;;) {
        const bool has_next = S.next(ui + 1, nxt);
        const char* nA = has_next ? (const char*)g.A + (size_t)nxt.pm * tstepA : cA; const char* nB = has_next ? (const char*)g.Bt + (size_t)nxt.pn * tstepB : cB;
        for (int t = 0; t < nt; t += 2) {
            const bool last = (t == nt - 2);
            const char* a1 = cA + (size_t)(t + 1) * kstep;
            const char* a2 = last ? nA : cA + (size_t)(t + 2) * kstep; const char* b2 = last ? nB : cB + (size_t)(t + 2) * kstep;
            const char* a3 = a2 + kstep; const char* b3 = b2 + kstep;
            if constexpr (SP2) {
            PG8_LDB(B0, 0, 0); PG8_LDB(B1, 0, 1); PG8_SCHED; PG8_LDA(At, 0, 0); PG8_STAGE(PG8_SA(1, 1), a1 + hstepA, voffA);
            PG8_WAIT_V(8); PG8_WAIT_L(0); PG8_BAR; PG8_MMA(0, 0, At, B0); PG8_MMA(0, 1, At, B1); PG8_BAR; PG8_SCHED;
            PG8_LDA(At, 0, 1); PG8_STAGE(PG8_SB(0, 0), b2, voffB); PG8_STAGE(PG8_SB(0, 1), b2 + hstepB, voffB); PG8_STAGE(PG8_SA(0, 0), a2, voffA);
            PG8_WAIT_V(8); PG8_WAIT_L(0); PG8_BAR; PG8_MMA(1, 0, At, B0); PG8_MMA(1, 1, At, B1); PG8_BAR; PG8_SCHED;
            PG8_LDB(B0, 1, 0); PG8_LDB(B1, 1, 1); PG8_SCHED; PG8_LDA(At, 1, 0); PG8_STAGE(PG8_SA(0, 1), a2 + hstepA, voffA);
            PG8_WAIT_V(8); PG8_WAIT_L(0); PG8_BAR; PG8_MMA(0, 0, At, B0); PG8_MMA(0, 1, At, B1); PG8_BAR; PG8_SCHED;
            PG8_LDA(At, 1, 1); PG8_STAGE(PG8_SB(1, 0), b3, voffB); PG8_STAGE(PG8_SB(1, 1), b3 + hstepB, voffB); PG8_STAGE(PG8_SA(1, 0), a3, voffA);
            PG8_WAIT_V(8); PG8_WAIT_L(0); PG8_BAR; PG8_MMA(1, 0, At, B0); PG8_MMA(1, 1, At, B1); PG8_BAR; PG8_SCHED;
            } else {
            PG8_LDB(B0, 0, 0); PG8_SCHED; PG8_LDA(At, 0, 0); PG8_STAGE(PG8_SA(1, 1), a1 + hstepA, voffA);
            PG8_WAIT_L(8); PG8_BAR; PG8_WAIT_L(0); PG8_MMA(0, 0, At, B0); PG8_BAR; PG8_SCHED;
            PG8_LDB(B1, 0, 1); PG8_STAGE(PG8_SB(0, 0), b2, voffB);
            PG8_BAR; PG8_WAIT_L(0); PG8_MMA(0, 1, At, B1); PG8_BAR;
            PG8_LDA(At, 0, 1); PG8_STAGE(PG8_SA(0, 0), a2, voffA);
            PG8_BAR; PG8_WAIT_L(0); PG8_MMA(1, 0, At, B0); PG8_BAR; PG8_SCHED;
            PG8_STAGE(PG8_SB(0, 1), b2 + hstepB, voffB);
            PG8_WAIT_V(6); PG8_BAR; PG8_MMA(1, 1, At, B1); PG8_BAR;
            PG8_LDB(B0, 1, 0); PG8_SCHED; PG8_LDA(At, 1, 0); PG8_STAGE(PG8_SA(0, 1), a2 + hstepA, voffA);
            PG8_WAIT_L(8); PG8_BAR; PG8_WAIT_L(0); PG8_MMA(0, 0, At, B0); PG8_BAR; PG8_SCHED;
            PG8_LDB(B1, 1, 1); PG8_STAGE(PG8_SB(1, 0), b3, voffB);
            PG8_BAR; PG8_WAIT_L(0); PG8_MMA(0, 1, At, B1); PG8_BAR;
            PG8_LDA(At, 1, 1); PG8_STAGE(PG8_SA(1, 0), a3, voffA);
            PG8_BAR; PG8_WAIT_L(0); PG8_MMA(1, 0, At, B0); PG8_BAR; PG8_SCHED;
            PG8_STAGE(PG8_SB(1, 1), b3 + hstepB, voffB);
            PG8_WAIT_V(6); PG8_BAR; PG8_MMA(1, 1, At, B1); PG8_BAR;
            }
        }
        if constexpr (SP2) { if (wr == 0) PG8_BAR; }
        { int el; asm volatile("v_mbcnt_lo_u32_b32 %0, -1, 0\n\tv_mbcnt_hi_u32_b32 %0, -1, %0" : "=v"(el)); E(acc, cur, wr, wc, el & 15, el >> 4); }
        if (!has_next) break;
#pragma unroll
        for (int a = 0; a < 2; ++a)
#pragma unroll
            for (int b = 0; b < 2; ++b)
#pragma unroll
                for (int m = 0; m < 4; ++m)
#pragma unroll
                    for (int n = 0; n < 2; ++n) acc[a][b][m][n] = (f32x4){0.f, 0.f, 0.f, 0.f};
        cur = nxt; cA = nA; cB = nB; ++ui;
        if constexpr (SP2) { if (wr == 1) PG8_BAR; }
    }
    PG8_WAIT_V(0);
    if constexpr (!SP2) { if (wr == 0) PG8_BAR; }
    PG8_BAR;
#undef PG8_SA
#undef PG8_SB
#undef PG8_STAGE
#undef PG8_LDA
#undef PG8_LDB
#undef PG8_MMA
#undef PG8_WAIT_V
#undef PG8_WAIT_L
#undef PG8_BAR
#undef PG8_SCHED
}

#if defined(MK_SIMPLE_GEMM)
template <class Epi>
__device__ __forceinline__ void gemm_phase_simple(const Gemm g, const StaticOrder& S, const Epi& E) {
    const int tid = threadIdx.x, wid = __builtin_amdgcn_readfirstlane(tid >> 6), lane = tid & 63, wr = wid >> 2, wc = wid & 3, fr = lane & 15, fq = lane >> 4;
    Unit cur;
    for (int ui = 0; S.next(ui, cur); ++ui) {
        f32x4 acc[2][2][4][2];
#pragma unroll
        for (int a = 0; a < 2; ++a)
#pragma unroll
            for (int b = 0; b < 2; ++b)
#pragma unroll
                for (int m = 0; m < 4; ++m)
#pragma unroll
                    for (int n = 0; n < 2; ++n) acc[a][b][m][n] = (f32x4){0.f, 0.f, 0.f, 0.f};
        for (int k0 = 0; k0 < g.K; k0 += 32) {
            bf16x8 bf[2][2];
#pragma unroll
            for (int bj = 0; bj < 2; ++bj)
#pragma unroll
                for (int n = 0; n < 2; ++n) { const int slot = 16 * n + fr; const int wrow = cur.pn * BM + bj * HALF + wc * 32 + (Epi::PERM ? perm32(slot) : slot);
                    bf[bj][n] = *(const bf16x8*)(g.Bt + (size_t)wrow * g.K + k0 + 8 * fq); }
#pragma unroll
            for (int ai = 0; ai < 2; ++ai)
#pragma unroll
                for (int m = 0; m < 4; ++m) { const int arow = cur.pm * BM + ai * HALF + wr * 64 + m * 16 + fr;
                    const bf16x8 af = *(const bf16x8*)(g.A + (size_t)arow * g.lda + k0 + 8 * fq);
#pragma unroll
                    for (int bj = 0; bj < 2; ++bj)
#pragma unroll
                        for (int n = 0; n < 2; ++n) acc[ai][bj][m][n] = __builtin_amdgcn_mfma_f32_16x16x32_bf16(bf[bj][n], af, acc[ai][bj][m][n], 0, 0, 0); }
        }
        E(acc, cur, wr, wc, fr, fq);
    }
}
#define GEMM_PHASE(EPI, lds, g, S, E) pg8::gemm_phase_simple<EPI>(g, S, E)
#define GEMM_PHASE2(EPI, lds, g, S, E) pg8::gemm_phase_simple<EPI>(g, S, E)
#else
#define GEMM_PHASE(EPI, lds, g, S, E) pg8::gemm_phase<EPI, true>(lds, g, S, E)
#define GEMM_PHASE2(EPI, lds, g, S, E) pg8::gemm_phase<EPI, false>(lds, g, S, E)
#endif
struct EpiSwiglu {
    static constexpr bool PERM = true;
    bf16_t* O; int ldc;
    __device__ __forceinline__ void operator()(const f32x4 (&acc)[2][2][4][2], const Unit& u, int wr, int wc, int fr, int fq) const {
        const int row0 = u.pm * BM + wr * 64 + fr, col0 = u.pn * 128 + wc * 32 + 8 * fq;
#pragma unroll
        for (int ai = 0; ai < 2; ++ai)
#pragma unroll
            for (int m = 0; m < 4; ++m) {
                bf16_t* rowp = O + (size_t)(row0 + ai * HALF + m * 16) * ldc + col0;
                const f32x4 g0 = acc[ai][0][m][0], g1 = acc[ai][0][m][1], u0 = acc[ai][1][m][0], u1 = acc[ai][1][m][1];
                float v[8];
#pragma unroll
                for (int j = 0; j < 4; ++j) { v[j] = fsilu(g0[j]) * u0[j]; v[4 + j] = fsilu(g1[j]) * u1[j]; }
                u32x4 w; w.x = pk_bf16(v[0], v[1]); w.y = pk_bf16(v[2], v[3]); w.z = pk_bf16(v[4], v[5]); w.w = pk_bf16(v[6], v[7]);
                *(u32x4*)rowp = w;
                asm volatile("" ::: "memory");
            }
    }
};
__device__ __forceinline__ void store_tile_bf16(const f32x4 (&acc)[2][2][4][2], bf16_t* base, int ld, int row0, int col0, int act) {
#pragma unroll
    for (int ai = 0; ai < 2; ++ai)
#pragma unroll
        for (int m = 0; m < 4; ++m) {
            bf16_t* rowp = base + (size_t)(row0 + ai * HALF + m * 16) * ld + col0;
#pragma unroll
            for (int bj = 0; bj < 2; ++bj) {
                f32x4 v0 = acc[ai][bj][m][0], v1 = acc[ai][bj][m][1];
                if (act == 1) {
#pragma unroll
                    for (int j = 0; j < 4; ++j) { v0[j] = fgelu(v0[j]); v1[j] = fgelu(v1[j]); }
                } else if (act == 2) {
#pragma unroll
                    for (int j = 0; j < 4; ++j) { v0[j] = fsigmoid(v0[j]); v1[j] = fsigmoid(v1[j]); }
                }
                u32x4 w; w.x = pk_bf16(v0[0], v0[1]); w.y = pk_bf16(v0[2], v0[3]); w.z = pk_bf16(v1[0], v1[1]); w.w = pk_bf16(v1[2], v1[3]);
                *(u32x4*)(rowp + bj * HALF) = w;
            }
            asm volatile("" ::: "memory");
        }
}
template <int ACT> struct EpiAct {
    static constexpr bool PERM = true;
    bf16_t* p; int ld, pn0;
    __device__ __forceinline__ void operator()(const f32x4 (&acc)[2][2][4][2], const Unit& u, int wr, int wc, int fr, int fq) const {
        store_tile_bf16(acc, p, ld, u.pm * BM + wr * 64 + fr, (u.pn - pn0) * BM + wc * 32 + 8 * fq, ACT);
    }
};
struct EpiWinA {
    static constexpr bool PERM = true;
    bf16_t* zq; bf16_t* xl; bf16_t* gy;
    __device__ __forceinline__ void operator()(const f32x4 (&acc)[2][2][4][2], const Unit& u, int wr, int wc, int fr, int fq) const {
        size_t boff = 0; if (u.pn >= 2) boff += (size_t)((const char*)xl - (const char*)zq); if (u.pn >= 6) boff += (size_t)((const char*)gy - (const char*)xl);
        bf16_t* base = (bf16_t*)((char*)zq + boff);
        int ld = 512, pn0 = 0; if (u.pn >= 2) { ld = D; pn0 = 2; } if (u.pn >= 6) pn0 = 6;
        store_tile_bf16(acc, base, ld, u.pm * BM + wr * 64 + fr, (u.pn - pn0) * BM + wc * 32 + 8 * fq, u.pn < 6 ? 0 : 1);
    }
};
struct EpiWinB {
    static constexpr bool PERM = true;
    bf16_t* ga; bf16_t* gl;
    __device__ __forceinline__ void operator()(const f32x4 (&acc)[2][2][4][2], const Unit& u, int wr, int wc, int fr, int fq) const {
        store_tile_bf16(acc, u.pn < 4 ? ga : gl, D, u.pm * BM + wr * 64 + fr, (u.pn & 3) * BM + wc * 32 + 8 * fq, 2);
    }
};
template <bool ADD> struct EpiGate {
    static constexpr bool PERM = true;
    const bf16_t* gate; const bf16_t* add; bf16_t* out;
    __device__ __forceinline__ void operator()(const f32x4 (&acc)[2][2][4][2], const Unit& u, int wr, int wc, int fr, int fq) const {
        const int row0 = u.pm * BM + wr * 64 + fr, col0 = u.pn * BM + wc * 32 + 8 * fq;
#pragma unroll
        for (int ai = 0; ai < 2; ++ai)
#pragma unroll
            for (int m = 0; m < 4; ++m) {
                const size_t off = (size_t)(row0 + ai * HALF + m * 16) * D + col0;
#pragma unroll
                for (int bj = 0; bj < 2; ++bj) {
                    const u32x4 gw = *(const u32x4*)(gate + off + bj * HALF);
                    const f32x4 v0 = acc[ai][bj][m][0], v1 = acc[ai][bj][m][1];
                    float r[8];
                    r[0] = lo_bf(gw.x) * v0[0]; r[1] = hi_bf(gw.x) * v0[1]; r[2] = lo_bf(gw.y) * v0[2]; r[3] = hi_bf(gw.y) * v0[3];
                    r[4] = lo_bf(gw.z) * v1[0]; r[5] = hi_bf(gw.z) * v1[1]; r[6] = lo_bf(gw.w) * v1[2]; r[7] = hi_bf(gw.w) * v1[3];
                    if (ADD) {
                        const u32x4 aw = *(const u32x4*)(add + off + bj * HALF);
                        r[0] += lo_bf(aw.x); r[1] += hi_bf(aw.x); r[2] += lo_bf(aw.y); r[3] += hi_bf(aw.y);
                        r[4] += lo_bf(aw.z); r[5] += hi_bf(aw.z); r[6] += lo_bf(aw.w); r[7] += hi_bf(aw.w);
                    }
                    u32x4 w; w.x = pk_bf16(r[0], r[1]); w.y = pk_bf16(r[2], r[3]); w.z = pk_bf16(r[4], r[5]); w.w = pk_bf16(r[6], r[7]);
                    *(u32x4*)(out + off + bj * HALF) = w;
                }
                asm volatile("" ::: "memory");
            }
    }
};
struct EpiQKV {
    static constexpr bool PERM = true;
    bf16_t* Q; bf16_t* Kn;
    __device__ __forceinline__ void operator()(const f32x4 (&acc)[2][2][4][2], const Unit& u, int wr, int wc, int fr, int fq) const {
        size_t boff = 0; if (u.pn >= 3) boff += (size_t)((const char*)Kn - (const char*)Q); if (u.pn >= 5) boff += (size_t)T * NKV * 2;
        bf16_t* dst = (bf16_t*)((char*)Q + boff);
        int ld = NQ, ctile = u.pn * BM; if (u.pn >= 3) { ld = NKV; ctile = ((u.pn - 3) & 1) * BM; }
        store_tile_bf16(acc, dst, ld, u.pm * BM + wr * 64 + fr, ctile + wc * 32 + 8 * fq, 0);
    }
};
}

struct TJob { const float* src; const float* scale; bf16_t* dst; int ldsrc, K, lddst, dstk0, nrb, map, nbatch, sbs, dbs; };
__device__ __forceinline__ int srccol(int map, int rb) {
    const int r = rb * 32;
    switch (map) {
        case 1: { const int pn = r >> 8, w = r & 255; return w < 128 ? 128 * pn + w : DFF + 128 * pn + (w - 128); }
        case 2: { if (r < 416) return r; if (r < 512) return -1; return r - 96; }
        case 3: return 2464 + r;
        case 4: { const int v = r >= 512 ? 1 : 0; const int rr = r & 511; return (rr >> 6) * 128 + (rr & 63) + 64 * v; }
        default: return r;
    }
}
constexpr int NJOBS = 15;
__device__ __forceinline__ TJob get_job(const Params& p, int j) {
    TJob t; t.scale = nullptr; t.dstk0 = 0; t.map = 0; t.nbatch = 1; t.sbs = 0; t.dbs = 0;
    unsigned char* ws = p.ws;
    switch (j) {
        case 0:  t.src = p.in[8];  t.dst = (bf16_t*)(ws + WS_WGU1); t.ldsrc = 2 * DFF; t.K = D; t.lddst = D; t.nrb = 176; t.map = 1; break;
        case 1:  t.src = p.in[9];  t.dst = (bf16_t*)(ws + WS_WDN1); t.ldsrc = D; t.K = DFF; t.lddst = DFF; t.nrb = 32; break;
        case 2:  t.src = p.in[10]; t.dst = (bf16_t*)(ws + WS_WINA); t.ldsrc = 4512; t.K = D; t.lddst = D; t.nrb = 80; t.map = 2; break;
        case 3:  t.src = p.in[10]; t.dst = (bf16_t*)(ws + WS_WINB); t.ldsrc = 4512; t.K = D; t.lddst = D; t.nrb = 64; t.map = 3; break;
        case 4:  t.src = p.in[13]; t.scale = p.in[11]; t.dst = (bf16_t*)(ws + WS_WQKV); t.ldsrc = 768; t.K = 256; t.lddst = 384; t.nrb = 24; break;
        case 5:  t.src = nullptr;  t.dst = (bf16_t*)(ws + WS_WQKV); t.ldsrc = 0; t.K = 128; t.lddst = 384; t.dstk0 = 256; t.nrb = 24; break;
        case 6:  t.src = p.in[14]; t.scale = p.in[12]; t.dst = (bf16_t*)(ws + WS_WQKV) + 768 * 384; t.ldsrc = 1024; t.K = 128; t.lddst = 384; t.dstk0 = 256; t.nrb = 32; t.map = 4; break;
        case 7:  t.src = nullptr;  t.dst = (bf16_t*)(ws + WS_WQKV) + 768 * 384; t.ldsrc = 0; t.K = 256; t.lddst = 384; t.nrb = 32; break;
        case 8:  t.src = p.in[15]; t.dst = (bf16_t*)(ws + WS_WAO); t.ldsrc = D; t.K = 512; t.lddst = 512; t.nrb = 32; break;
        case 9:  t.src = p.in[23]; t.dst = (bf16_t*)(ws + WS_WLO); t.ldsrc = D; t.K = D; t.lddst = D; t.nrb = 32; break;
        case 10: t.src = p.in[24]; t.dst = (bf16_t*)(ws + WS_WOUT); t.ldsrc = D; t.K = D; t.lddst = D; t.nrb = 32; break;
        case 11: t.src = p.in[25]; t.dst = (bf16_t*)(ws + WS_WGU2); t.ldsrc = 2 * DFF; t.K = D; t.lddst = D; t.nrb = 176; t.map = 1; break;
        case 12: t.src = p.in[26]; t.dst = (bf16_t*)(ws + WS_WDN2); t.ldsrc = D; t.K = DFF; t.lddst = DFF; t.nrb = 32; break;
        case 13: t.src = p.in[18]; t.dst = (bf16_t*)(ws + WS_WG); t.ldsrc = 128; t.K = 128; t.lddst = 128; t.nrb = 4; t.nbatch = 16; t.sbs = 16384; t.dbs = 32768; break;
        default: t.src = p.in[20]; t.dst = (bf16_t*)(ws + WS_WG) + 16384; t.ldsrc = 128; t.K = 128; t.lddst = 128; t.nrb = 4; t.nbatch = 16; t.sbs = 16384; t.dbs = 32768; break;
    }
    return t;
}
__device__ __forceinline__ int job_items(const TJob& t) { return t.nbatch * t.nrb * (t.K >> 6); }

__device__ __forceinline__ void tr_item(const TJob& jb, int item, LAS float* scr, int lane) {
    const int nkb = jb.K >> 6, per_batch = jb.nrb * nkb;
    const int bt = item / per_batch, r = item - bt * per_batch, rb = r / nkb, kb = r - rb * nkb;
    const int sc = srccol(jb.map, rb), k0 = 64 * kb;
    if (jb.src != nullptr && sc >= 0) {
        const float* src = jb.src + (size_t)bt * jb.sbs;
#pragma unroll 8
        for (int i = 0; i < 32; ++i) { const int kk = 2 * i + (lane >> 5);
            float v = src[(size_t)(k0 + kk) * jb.ldsrc + sc + (lane & 31)];
            if (jb.scale) v *= jb.scale[k0 + kk];
            scr[kk * 33 + (lane & 31)] = v; }
    } else {
#pragma unroll 8
        for (int i = 0; i < 32; ++i) { const int kk = 2 * i + (lane >> 5); scr[kk * 33 + (lane & 31)] = 0.f; }
    }
    asm volatile("s_waitcnt lgkmcnt(0)" ::: "memory");
    bf16_t* dst = jb.dst + (size_t)bt * jb.dbs;
    const int c = lane & 7;
#pragma unroll
    for (int j = 0; j < 4; ++j) { const int n = (lane >> 3) + 8 * j; const LAS float* s = scr + (8 * c) * 33 + n;
        u32x4 o; o.x = pk_bf16(s[0 * 33], s[1 * 33]); o.y = pk_bf16(s[2 * 33], s[3 * 33]); o.z = pk_bf16(s[4 * 33], s[5 * 33]); o.w = pk_bf16(s[6 * 33], s[7 * 33]);
        *(u32x4*)(dst + (size_t)(32 * rb + n) * jb.lddst + jb.dstk0 + k0 + 8 * c) = o; }
    asm volatile("s_waitcnt lgkmcnt(0)" ::: "memory");
}

__device__ __forceinline__ void phase_prep(const Params& p, LAS unsigned char* lds) {
    const int tid = threadIdx.x, lane = tid & 63, wave = tid >> 6;
    const int gw = blockIdx.x * NWAVES + wave, NGW = gridDim.x * NWAVES;
    {
        LAS float* scr = (LAS float*)(lds + wave * 8704);
        int base = 0;
        for (int j = 0; j < NJOBS; ++j) {
            const TJob jb = get_job(p, j); const int n = job_items(jb);
            int first = gw - (base % NGW); if (first < 0) first += NGW;
            for (int i = first; i < n; i += NGW) tr_item(jb, i, scr, lane);
            base += n;
        }
    }
    {
        const int gt = blockIdx.x * NTHREADS + tid;
        if (gt < SS * 16) {
            const int pos = gt >> 4, i = gt & 15;
            double inv = 1.0; for (int q = 0; q < i; ++q) inv *= 0.5623413251903491;
            const float ang = (float)pos * (float)inv;
            const double rev = (double)ang * 0.15915494309189535; const float fr = (float)(rev - rint(rev));
            ((float*)(p.ws + WS_ROPE))[gt] = __builtin_amdgcn_cosf(fr);
            ((float*)(p.ws + WS_ROPE))[SS * 16 + gt] = __builtin_amdgcn_sinf(fr);
        }
    }
    __syncthreads();
    for (int item = blockIdx.x; item < 144; item += gridDim.x) {
        LAS float* sc = (LAS float*)(lds) + wave * (128 * 33);
        for (int i = 0; i < 64; ++i) { const int idx = lane + 64 * i, kl = idx & 127, b = idx >> 7;
            const float cv = (b < 16 ? p.in[2] : p.in[3])[(b & 15) * D + 128 * wave + kl];
            sc[kl * 33 + b] = fsilu(cv); }
        asm volatile("s_waitcnt lgkmcnt(0)" ::: "memory");
        float acc[32];
#pragma unroll
        for (int b = 0; b < 32; ++b) acc[b] = 0.f;
        const float* W = p.in[4] + (size_t)(128 * wave) * 9216 + item * 64 + lane;
        for (int k = 0; k < 128; ++k) { const float wv = W[(size_t)k * 9216];
#pragma unroll
            for (int b = 0; b < 32; ++b) acc[b] += sc[k * 33 + b] * wv; }
        __syncthreads();
        LAS float* red = (LAS float*)(lds);
#pragma unroll
        for (int b = 0; b < 32; ++b) red[(wave * 32 + b) * 64 + lane] = acc[b];
        __syncthreads();
        for (int o = tid; o < 2048; o += NTHREADS) { const int b = o >> 6, col = o & 63; float s = 0.f;
#pragma unroll
            for (int w = 0; w < 8; ++w) s += red[(w * 32 + b) * 64 + col];
            const int j = item * 64 + col;
            ((float*)(p.ws + WS_MOD))[b * 9216 + j] = s + p.in[5][j]; }
        __syncthreads();
    }
}

template <bool HAS_F, bool HAS_H>
__device__ __forceinline__ void phase_rows(const Params& p, int sp, int sn, float resw, bool from_input, bool write_x = true) {
    const int tid = threadIdx.x, lane = tid & 63, wave = tid >> 6;
    const int gw = blockIdx.x * NWAVES + wave, NGW = gridDim.x * NWAVES;
    const float* mod = (const float*)(p.ws + WS_MOD);
    const bf16_t* F = (const bf16_t*)(p.ws + WS_F);
    bf16_t* H = (bf16_t*)(p.ws + WS_H);
    for (int row = gw; row < T; row += NGW) {
        const int b = row_batch(row);
        const float* xin = !from_input ? p.out + (size_t)row * D : (row < TP ? p.in[0] + (size_t)row * D : p.in[1] + (size_t)(row - TP) * D);
        f32x4 v[4];
#pragma unroll
        for (int j = 0; j < 4; ++j) v[j] = *(const f32x4*)(xin + 4 * lane + 256 * j);
        if (HAS_F) {
            f32x4 f[4]; float ss = 0.f;
#pragma unroll
            for (int j = 0; j < 4; ++j) { const u32x2 w = *(const u32x2*)(F + (size_t)row * D + 4 * lane + 256 * j);
                f[j] = (f32x4){lo_bf(w.x), hi_bf(w.x), lo_bf(w.y), hi_bf(w.y)}; ss += (f[j].x * f[j].x + f[j].y * f[j].y) + (f[j].z * f[j].z + f[j].w * f[j].w); }
            const float rs = 1.0f / sqrtf(wave_sum(ss) * (1.0f / D) + EPS) * resw;
            const float* gate = mod + b * 9216 + sp * 3072 + 2048; const float* gp = p.in[7] + sp * D;
#pragma unroll
            for (int j = 0; j < 4; ++j) { const f32x4 g = *(const f32x4*)(gate + 4 * lane + 256 * j), q = *(const f32x4*)(gp + 4 * lane + 256 * j);
                v[j] = v[j] + g * (f[j] * rs * q);
                if (write_x) *(f32x4*)(p.out + (size_t)row * D + 4 * lane + 256 * j) = v[j]; }
        }
        if (HAS_H) {
            float ss = 0.f;
#pragma unroll
            for (int j = 0; j < 4; ++j) ss += (v[j].x * v[j].x + v[j].y * v[j].y) + (v[j].z * v[j].z + v[j].w * v[j].w);
            const float rs = 1.0f / sqrtf(wave_sum(ss) * (1.0f / D) + EPS);
            const float* sh = mod + b * 9216 + sn * 3072; const float* scl = sh + 1024; const float* gq = p.in[6] + sn * D;
#pragma unroll
            for (int j = 0; j < 4; ++j) { const f32x4 a = *(const f32x4*)(sh + 4 * lane + 256 * j), s = *(const f32x4*)(scl + 4 * lane + 256 * j), q = *(const f32x4*)(gq + 4 * lane + 256 * j);
                const f32x4 h = (v[j] * rs * q) * (s + 1.0f) + a;
                u32x2 w; w.x = pk_bf16(h.x, h.y); w.y = pk_bf16(h.z, h.w);
                *(u32x2*)(H + (size_t)row * D + 4 * lane + 256 * j) = w; }
        }
    }
}

__device__ __forceinline__ void phase_final(const Params& p) {
    const int tid = threadIdx.x, lane = tid & 63, wave = tid >> 6;
    const int gw = blockIdx.x * NWAVES + wave, NGW = gridDim.x * NWAVES;
    const float* mod = (const float*)(p.ws + WS_MOD);
    const bf16_t* Fm = (const bf16_t*)(p.ws + WS_F); const bf16_t* F2 = (const bf16_t*)(p.ws + WS_H);
    for (int row = gw; row < T; row += NGW) {
        const int b = row_batch(row);
        f32x4 v[4], m[4], f[4]; float sm = 0.f, sf = 0.f;
#pragma unroll
        for (int j = 0; j < 4; ++j) { v[j] = *(const f32x4*)(p.out + (size_t)row * D + 4 * lane + 256 * j);
            const u32x2 wm = *(const u32x2*)(Fm + (size_t)row * D + 4 * lane + 256 * j), wf = *(const u32x2*)(F2 + (size_t)row * D + 4 * lane + 256 * j);
            m[j] = (f32x4){lo_bf(wm.x), hi_bf(wm.x), lo_bf(wm.y), hi_bf(wm.y)}; f[j] = (f32x4){lo_bf(wf.x), hi_bf(wf.x), lo_bf(wf.y), hi_bf(wf.y)};
            sm += (m[j].x * m[j].x + m[j].y * m[j].y) + (m[j].z * m[j].z + m[j].w * m[j].w); sf += (f[j].x * f[j].x + f[j].y * f[j].y) + (f[j].z * f[j].z + f[j].w * f[j].w); }
        const float rm = 1.0f / sqrtf(wave_sum(sm) * (1.0f / D) + EPS), rf = 1.0f / sqrtf(wave_sum(sf) * (1.0f / D) + EPS) * 0.5f;
        const float* g1 = mod + b * 9216 + 1 * 3072 + 2048; const float* g2 = mod + b * 9216 + 2 * 3072 + 2048;
        const float* q1 = p.in[7] + 1 * D; const float* q2 = p.in[7] + 2 * D;
#pragma unroll
        for (int j = 0; j < 4; ++j) { const int c = 4 * lane + 256 * j;
            const f32x4 x2 = v[j] + *(const f32x4*)(g1 + c) * (m[j] * rm * *(const f32x4*)(q1 + c));
            *(f32x4*)(p.out + (size_t)row * D + c) = x2 + *(const f32x4*)(g2 + c) * (f[j] * rf * *(const f32x4*)(q2 + c)); }
    }
}

__device__ __forceinline__ void phase_stats(const Params& p, const int wg0, const int nwg) {
    const int tid = threadIdx.x, lane = tid & 63, wave = tid >> 6;
    const int gw = ((int)blockIdx.x - wg0) * NWAVES + wave, NGW = nwg * NWAVES;
    bf16_t* ZQ = (bf16_t*)(p.ws + WS_ZQ);
    bf16_t* KR = (bf16_t*)(p.ws + WS_KR);
    const float* rc = (const float*)(p.ws + WS_ROPE); const float* rsn = rc + SS * 16;
    for (int row = gw; row < T; row += NGW) {
        const u32x4 w = *(const u32x4*)(ZQ + (size_t)row * 512 + 8 * lane);
        float x[8] = {lo_bf(w.x), hi_bf(w.x), lo_bf(w.y), hi_bf(w.y), lo_bf(w.z), hi_bf(w.z), lo_bf(w.w), hi_bf(w.w)};
        float ss = 0.f;
#pragma unroll
        for (int e = 0; e < 8; ++e) ss += x[e] * x[e];
        const float sq = wave_sum(lane < 32 ? ss : 0.f), skv = wave_sum((lane >= 32 && lane < 48) ? ss : 0.f);
        {
            const float rq = 1.0f / sqrtf(sq * (1.0f / 256.0f) + EPS), rkv = 1.0f / sqrtf(skv * (1.0f / 128.0f) + EPS);
            if (lane < 48) { const float r = lane < 32 ? rq : rkv;
                u32x4 o; o.x = pk_bf16(x[0] * r, x[1] * r); o.y = pk_bf16(x[2] * r, x[3] * r); o.z = pk_bf16(x[4] * r, x[5] * r); o.w = pk_bf16(x[6] * r, x[7] * r);
                *(u32x4*)(ZQ + (size_t)row * 512 + 8 * lane) = o; }
        }
        float y[8];
#pragma unroll
        for (int e = 0; e < 8; ++e) y[e] = __shfl_xor(x[e], 2);
        if (lane >= 48 && lane < 52) {
            const int pos = row_pos(row), i0 = 8 * (lane & 1);
            const f32x4 c0 = *(const f32x4*)(rc + pos * 16 + i0), c1 = *(const f32x4*)(rc + pos * 16 + i0 + 4);
            const f32x4 s0 = *(const f32x4*)(rsn + pos * 16 + i0), s1 = *(const f32x4*)(rsn + pos * 16 + i0 + 4);
            const float c[8] = {c0.x, c0.y, c0.z, c0.w, c1.x, c1.y, c1.z, c1.w}, s[8] = {s0.x, s0.y, s0.z, s0.w, s1.x, s1.y, s1.z, s1.w};
            float o[8];
            const bool first = lane < 50;
#pragma unroll
            for (int e = 0; e < 8; ++e) o[e] = first ? (x[e] * c[e] - y[e] * s[e]) : (x[e] * c[e] + y[e] * s[e]);
            u32x4 ow; ow.x = pk_bf16(o[0], o[1]); ow.y = pk_bf16(o[2], o[3]); ow.z = pk_bf16(o[4], o[5]); ow.w = pk_bf16(o[6], o[7]);
            *(u32x4*)(KR + (size_t)row * 32 + 8 * (lane - 48)) = ow;
        }
    }
}

constexpr int XC_PITCH = 272;
__device__ __forceinline__ void phase_lru(const Params& p, LAS unsigned char* lds) {
    const int tid = threadIdx.x, lane = tid & 63, wave = __builtin_amdgcn_readfirstlane(tid >> 6), g = lane >> 4, lc = lane & 15;
    const bf16_t* XL = (const bf16_t*)(p.ws + WS_XL); bf16_t* GY = (bf16_t*)(p.ws + WS_GY); bf16_t* HF = (bf16_t*)(p.ws + WS_F);
    const bf16_t* WG = (const bf16_t*)(p.ws + WS_WG);
    for (int item = blockIdx.x; item < 256; item += gridDim.x) {
        int gb, n;
        if (item < 128) { gb = 16 + (item >> 3); n = item & 7; } else { gb = (item - 128) >> 3; n = item & 7; }
        const int S = gb < 16 ? SP : SS; const int row0 = gb < 16 ? gb * SP : TP + (gb - 16) * SS;
        const int nch = S >> 6;
        const int tr = tid >> 4, cgp = (tid & 15) * 8, c0 = 128 * n + cgp;
        float cw[4][8], cb[8];
#pragma unroll
        for (int j = 0; j < 4; ++j) { const f32x4 a = *(const f32x4*)(p.in[16] + j * D + c0), b = *(const f32x4*)(p.in[16] + j * D + c0 + 4);
            cw[j][0] = a.x; cw[j][1] = a.y; cw[j][2] = a.z; cw[j][3] = a.w; cw[j][4] = b.x; cw[j][5] = b.y; cw[j][6] = b.z; cw[j][7] = b.w; }
        { const f32x4 a = *(const f32x4*)(p.in[17] + c0), b = *(const f32x4*)(p.in[17] + c0 + 4);
            cb[0] = a.x; cb[1] = a.y; cb[2] = a.z; cb[3] = a.w; cb[4] = b.x; cb[5] = b.y; cb[6] = b.z; cb[7] = b.w; }
        const int ch = 128 * n + 16 * wave + lc;
        for (int d = 0; d < 2; ++d) {
            bf16x8 Ba[4], Bi[4];
            { const bf16_t* wa = WG + (size_t)((d * 8 + n) * 2 + 0) * 16384 + (size_t)(16 * wave + lc) * 128 + 8 * g; const bf16_t* wi = wa + 16384;
#pragma unroll
              for (int ks = 0; ks < 4; ++ks) { Ba[ks] = *(const bf16x8*)(wa + 32 * ks); Bi[ks] = *(const bf16x8*)(wi + 32 * ks); } }
            const float ba = p.in[19][d * D + ch], bi = p.in[21][d * D + ch];
            const float lam = p.in[22][d * D + ch];
            const float c8 = -8.0f * log1pf(expf(-lam));
            const float nba = -1.4426950408889634f * ba, nbi = -1.4426950408889634f * bi, c8l = 1.4426950408889634f * c8;
#define BPERM(addr, v) __builtin_bit_cast(float, __builtin_amdgcn_ds_bpermute((addr), __builtin_bit_cast(int, (v))))
            const int bx16 = (lane ^ 16) << 2, bx32 = (lane ^ 32) << 2;
            const bool s1 = d ? !(g & 1) : (g & 1), s2 = d ? !(g >> 1) : (g >> 1);
            float carry = 0.f;
            u32x4 pw[2][4];
#define LRU_PREFETCH(CI) do { const int _cc = d ? (nch - 1 - (CI)) : (CI); _Pragma("unroll") for (int hf = 0; hf < 2; ++hf) _Pragma("unroll") for (int j = 0; j < 4; ++j) { \
                const int tt = _cc * 64 + tr + 32 * hf + j - 1; pw[hf][j] = (tt >= 0 && tt < S) ? *(const u32x4*)(XL + (size_t)(row0 + tt) * D + c0) : (u32x4){0u, 0u, 0u, 0u}; } } while (0)
            LRU_PREFETCH(0);
            for (int ci = 0; ci < nch; ++ci) {
                const int cc = d ? (nch - 1 - ci) : ci, t0 = cc * 64;
                __syncthreads();
#pragma unroll
                for (int hf = 0; hf < 2; ++hf) {
                    const int tl = tr + 32 * hf;
                    float a[8];
#pragma unroll
                    for (int e = 0; e < 8; ++e) a[e] = cb[e];
#pragma unroll
                    for (int j = 0; j < 4; ++j) { const u32x4 w = pw[hf][j];
                        a[0] += cw[j][0] * lo_bf(w.x); a[1] += cw[j][1] * hi_bf(w.x); a[2] += cw[j][2] * lo_bf(w.y); a[3] += cw[j][3] * hi_bf(w.y);
                        a[4] += cw[j][4] * lo_bf(w.z); a[5] += cw[j][5] * hi_bf(w.z); a[6] += cw[j][6] * lo_bf(w.w); a[7] += cw[j][7] * hi_bf(w.w); }
                    u32x4 o; o.x = pk_bf16(a[0], a[1]); o.y = pk_bf16(a[2], a[3]); o.z = pk_bf16(a[4], a[5]); o.w = pk_bf16(a[6], a[7]);
                    *(LAS u32x4*)(lds + tl * XC_PITCH + cgp * 2) = o;
                }
                __syncthreads();
                if (ci + 1 < nch) LRU_PREFETCH(ci + 1);
                float hfv[4][4], gyv[4][4];
                if (d == 1) {
                    const bf16_t* const hfi = HF + (size_t)(row0 + t0 + 4 * g) * D + ch; const bf16_t* const gyi = GY + (size_t)(row0 + t0 + 4 * g) * D + ch;
#pragma unroll
                    for (int mt = 0; mt < 4; ++mt)
#pragma unroll
                        for (int j = 0; j < 4; ++j) { hfv[mt][j] = bf2f(hfi[(16 * mt + j) * D]); gyv[mt][j] = bf2f(gyi[(16 * mt + j) * D]); }
                }
                f32x4 aa[4], ai[4];
#pragma unroll
                for (int mt = 0; mt < 4; ++mt) { aa[mt] = (f32x4){0.f, 0.f, 0.f, 0.f}; ai[mt] = (f32x4){0.f, 0.f, 0.f, 0.f}; }
#pragma unroll
                for (int ks = 0; ks < 4; ++ks)
#pragma unroll
                    for (int mt = 0; mt < 4; ++mt) { const bf16x8 A = *(const LAS bf16x8*)(lds + (16 * mt + lc) * XC_PITCH + (32 * ks + 8 * g) * 2);
                        aa[mt] = __builtin_amdgcn_mfma_f32_16x16x32_bf16(A, Ba[ks], aa[mt], 0, 0, 0);
                        ai[mt] = __builtin_amdgcn_mfma_f32_16x16x32_bf16(A, Bi[ks], ai[mt], 0, 0, 0); }
#pragma unroll
                for (int mt = 0; mt < 4; ++mt)
#pragma unroll
                    for (int j = 0; j < 4; ++j) {
                        const float xcv = bf2f(*(const LAS bf16_t*)(lds + (16 * mt + 4 * g + j) * XC_PITCH + (16 * wave + lc) * 2));
                        const float r = __builtin_amdgcn_rcpf(1.0f + __builtin_amdgcn_exp2f(__builtin_fmaf(aa[mt][j], -1.4426950408889634f, nba)));
                        const float ig = __builtin_amdgcn_rcpf(1.0f + __builtin_amdgcn_exp2f(__builtin_fmaf(ai[mt][j], -1.4426950408889634f, nbi)));
                        const float av = __builtin_amdgcn_exp2f(c8l * r), om = __builtin_fmaf(-av, av, 1.0f);
                        aa[mt][j] = av; ai[mt][j] = __builtin_amdgcn_sqrtf(om) * (ig * xcv);
                    }
#define LRU_COMBINE() \
                        const float A1 = BPERM(bx16, A), H1 = BPERM(bx16, Hs); \
                        const float PA = A * A1, PH = s1 ? (A * H1 + Hs) : (A1 * Hs + H1); \
                        const float exA = s1 ? A1 : 1.f, exH = s1 ? H1 : 0.f; \
                        const float A2 = BPERM(bx32, PA), H2 = BPERM(bx32, PH); \
                        const float TA = PA * A2, TH = s2 ? (PA * H2 + PH) : (A2 * PH + H2); \
                        const float Aex = s2 ? A2 * exA : exA, Hex = s2 ? (exA * H2 + exH) : exH; \
                        const float cin = Aex * carry + Hex; \
                        carry = TA * carry + TH;
                bf16_t* const hfo = HF + (size_t)(row0 + t0 + 4 * g) * D + ch;
                if (d == 0) {
#pragma unroll
                    for (int mt = 0; mt < 4; ++mt) {
                        float P = 1.f, Hh = 0.f, pl[4], hl[4];
#pragma unroll
                        for (int j = 0; j < 4; ++j) { Hh = aa[mt][j] * Hh + ai[mt][j]; P *= aa[mt][j]; hl[j] = Hh; pl[j] = P; }
                        const float A = P, Hs = Hh;
                        LRU_COMBINE()
#pragma unroll
                        for (int j = 0; j < 4; ++j) { const float h = hl[j] + pl[j] * cin;
                            hfo[(16 * mt + j) * D] = (bf16_t)(pk_bf16(h, 0.f) & 0xffffu); }
                    }
                } else {
                    bf16_t* const gyo = GY + (size_t)(row0 + t0 + 4 * g) * D + ch;
#pragma unroll
                    for (int mt = 3; mt >= 0; --mt) {
                        float P = 1.f, Hh = 0.f, pl[4], hl[4];
#pragma unroll
                        for (int j = 3; j >= 0; --j) { Hh = aa[mt][j] * Hh + ai[mt][j]; P *= aa[mt][j]; hl[j] = Hh; pl[j] = P; }
                        const float A = P, Hs = Hh;
                        LRU_COMBINE()
#pragma unroll
                        for (int j = 0; j < 4; ++j) { const float h = hl[j] + pl[j] * cin;
                            const float o = (hfv[mt][j] + h) * gyv[mt][j];
                            gyo[(16 * mt + j) * D] = (bf16_t)(pk_bf16(o, 0.f) & 0xffffu); }
                    }
                }
            }
        }
        __syncthreads();
    }
}

constexpr int AK_PITCH = 208, AV_PITCH = 160, AK_BYTES = 64 * AK_PITCH, AV_BYTES = 64 * AV_PITCH, ABUF = AK_BYTES + AV_BYTES;
__device__ __forceinline__ void phase_attn(const Params& p, LAS unsigned char* lds) {
    const int tid = threadIdx.x, lane = tid & 63, wave = __builtin_amdgcn_readfirstlane(tid >> 6), g = lane >> 4, lc = lane & 15;
    const bf16_t* Q = (const bf16_t*)(p.ws + WS_F); const bf16_t* KN = (const bf16_t*)(p.ws + WS_XL); const bf16_t* V = KN + (size_t)T * NKV;
    const bf16_t* KR = (const bf16_t*)(p.ws + WS_KR); bf16_t* O = (bf16_t*)(p.ws + WS_ZQ);
    const float csc = 0.10206207261596577f * 1.4426950408889634f;
    const int srow = tid >> 3, sch = tid & 7;
    const int rrow = (tid & 255) >> 2, rch = tid & 3;
    const int vtr = (4 * g + (lc >> 2)) * AV_PITCH + (4 * (lc & 3)) * 2;
    const int vwg = (gridDim.x % 8 == 0) ? (int)(blockIdx.x % 8) * (int)(gridDim.x / 8) + (int)(blockIdx.x / 8) : (int)blockIdx.x;
    for (int unit = vwg; unit < 3072; unit += gridDim.x) {
        int gb, h, qt, S, row0;
        if (unit < 2048) { gb = 16 + (unit >> 7); h = (unit & 127) >> 4; qt = unit & 15; S = SS; row0 = TP + (gb - 16) * SS; }
        else { const int u2 = unit - 2048; gb = u2 >> 6; h = (u2 & 63) >> 3; qt = u2 & 7; S = SP; row0 = gb * SP; }
        const int nkt = S >> 6;
        const int qrow = row0 + 256 * qt + 32 * wave;
        bf16x8 qf[2][3];
#pragma unroll
        for (int q2 = 0; q2 < 2; ++q2)
#pragma unroll
            for (int ks = 0; ks < 3; ++ks) qf[q2][ks] = *(const bf16x8*)(Q + (size_t)(qrow + 16 * q2 + lc) * NQ + 96 * h + 32 * ks + 8 * g);
#pragma unroll
        for (int q2 = 0; q2 < 2; ++q2) {
            const int pos = row_pos(qrow + 16 * q2 + lc), i0 = 8 * (g & 1);
            const float* rc = (const float*)(p.ws + WS_ROPE) + pos * 16 + i0; const float* rsn = rc + SS * 16;
            const f32x4 c0 = *(const f32x4*)rc, c1 = *(const f32x4*)(rc + 4), s0 = *(const f32x4*)rsn, s1 = *(const f32x4*)(rsn + 4);
            const float cc[8] = {c0.x, c0.y, c0.z, c0.w, c1.x, c1.y, c1.z, c1.w}, sn[8] = {s0.x, s0.y, s0.z, s0.w, s1.x, s1.y, s1.z, s1.w};
            const u32x4 mine = __builtin_bit_cast(u32x4, qf[q2][2]);
            u32x4 oth; oth.x = __shfl_xor(mine.x, 32); oth.y = __shfl_xor(mine.y, 32); oth.z = __shfl_xor(mine.z, 32); oth.w = __shfl_xor(mine.w, 32);
            const float xm[8] = {lo_bf(mine.x), hi_bf(mine.x), lo_bf(mine.y), hi_bf(mine.y), lo_bf(mine.z), hi_bf(mine.z), lo_bf(mine.w), hi_bf(mine.w)};
            const float xo[8] = {lo_bf(oth.x), hi_bf(oth.x), lo_bf(oth.y), hi_bf(oth.y), lo_bf(oth.z), hi_bf(oth.z), lo_bf(oth.w), hi_bf(oth.w)};
            float o[8];
#pragma unroll
            for (int e = 0; e < 8; ++e) o[e] = g < 2 ? (xm[e] * cc[e] - xo[e] * sn[e]) : (xm[e] * cc[e] + xo[e] * sn[e]);
            u32x4 w; w.x = pk_bf16(o[0], o[1]); w.y = pk_bf16(o[2], o[3]); w.z = pk_bf16(o[4], o[5]); w.w = pk_bf16(o[6], o[7]);
            qf[q2][2] = __builtin_bit_cast(bf16x8, w);
        }
        f32x4 oacc[4][2];
#pragma unroll
        for (int dt = 0; dt < 4; ++dt) { oacc[dt][0] = (f32x4){0.f, 0.f, 0.f, 0.f}; oacc[dt][1] = (f32x4){0.f, 0.f, 0.f, 0.f}; }
        float mrun[2] = {-1e30f, -1e30f}, lrun[2] = {0.f, 0.f};
        u32x4 gk, gr, gv;
        gk = *(const u32x4*)(KN + (size_t)(row0 + srow) * NKV + 64 * h + 8 * sch);
        gv = *(const u32x4*)(V + (size_t)(row0 + srow) * NKV + 64 * h + 8 * sch);
        gr = *(const u32x4*)(KR + (size_t)(row0 + rrow) * 32 + 8 * rch);
        __syncthreads();
        *(LAS u32x4*)(lds + srow * AK_PITCH + sch * 16) = gk;
        *(LAS u32x4*)(lds + AK_BYTES + srow * AV_PITCH + sch * 16) = gv;
        if (tid < 256) *(LAS u32x4*)(lds + rrow * AK_PITCH + 128 + rch * 16) = gr;
        u32x4 gk2, gr2, gv2;
        gk = *(const u32x4*)(KN + (size_t)(row0 + 64 + srow) * NKV + 64 * h + 8 * sch);
        gv = *(const u32x4*)(V + (size_t)(row0 + 64 + srow) * NKV + 64 * h + 8 * sch);
        gr = *(const u32x4*)(KR + (size_t)(row0 + 64 + rrow) * 32 + 8 * rch);
        gk2 = *(const u32x4*)(KN + (size_t)(row0 + 128 + srow) * NKV + 64 * h + 8 * sch);
        gv2 = *(const u32x4*)(V + (size_t)(row0 + 128 + srow) * NKV + 64 * h + 8 * sch);
        gr2 = *(const u32x4*)(KR + (size_t)(row0 + 128 + rrow) * 32 + 8 * rch);
        __syncthreads();
#define ATT_BODY(kt, GK, GR, GV) do { \
            LAS unsigned char* kb = lds + ((kt) & 1) * ABUF; LAS unsigned char* vb = kb + AK_BYTES; \
            LAS unsigned char* nb = lds + (((kt) + 1) & 1) * ABUF; \
            const bool more = (kt) + 1 < nkt; \
 \
            f32x4 sacc[4][2]; \
            _Pragma("unroll") \
            for (int k4 = 0; k4 < 4; ++k4) { sacc[k4][0] = (f32x4){0.f, 0.f, 0.f, 0.f}; sacc[k4][1] = (f32x4){0.f, 0.f, 0.f, 0.f}; } \
            _Pragma("unroll") \
            for (int ks = 0; ks < 3; ++ks) \
            _Pragma("unroll") \
                for (int k4 = 0; k4 < 4; ++k4) { const bf16x8 kf = *(const LAS bf16x8*)(kb + (16 * k4 + lc) * AK_PITCH + (32 * ks + 8 * g) * 2); \
                    sacc[k4][0] = __builtin_amdgcn_mfma_f32_16x16x32_bf16(kf, qf[0][ks], sacc[k4][0], 0, 0, 0); \
                    sacc[k4][1] = __builtin_amdgcn_mfma_f32_16x16x32_bf16(kf, qf[1][ks], sacc[k4][1], 0, 0, 0); } \
            bf16x8 pf[2][2]; \
            _Pragma("unroll") \
            for (int q2 = 0; q2 < 2; ++q2) { \
                float mx = sacc[0][q2][0]; \
            _Pragma("unroll") \
                for (int k4 = 0; k4 < 4; ++k4) \
            _Pragma("unroll") \
                    for (int j = 0; j < 4; ++j) mx = fmaxf(mx, sacc[k4][q2][j]); \
                mx = fmaxf(mx, __shfl_xor(mx, 16)); mx = fmaxf(mx, __shfl_xor(mx, 32)); \
                const float mnew = fmaxf(mrun[q2], mx * csc); \
                const float alpha = __builtin_amdgcn_exp2f(mrun[q2] - mnew); \
                mrun[q2] = mnew; \
                float ps = 0.f; float pv[4][4]; \
            _Pragma("unroll") \
                for (int k4 = 0; k4 < 4; ++k4) \
            _Pragma("unroll") \
                    for (int j = 0; j < 4; ++j) { const float e = __builtin_amdgcn_exp2f(sacc[k4][q2][j] * csc - mnew); pv[k4][j] = e; ps += e; } \
                lrun[q2] = lrun[q2] * alpha + ps; \
            _Pragma("unroll") \
                for (int dt = 0; dt < 4; ++dt) oacc[dt][q2] *= alpha; \
            _Pragma("unroll") \
                for (int kk = 0; kk < 2; ++kk) { \
                    u32x4 w; w.x = pk_bf16(pv[2 * kk][0], pv[2 * kk][1]); w.y = pk_bf16(pv[2 * kk][2], pv[2 * kk][3]); \
                    w.z = pk_bf16(pv[2 * kk + 1][0], pv[2 * kk + 1][1]); w.w = pk_bf16(pv[2 * kk + 1][2], pv[2 * kk + 1][3]); \
                    pf[q2][kk] = __builtin_bit_cast(bf16x8, w); \
                } \
            } \
 \
            _Pragma("unroll") \
            for (int kk = 0; kk < 2; ++kk) \
            _Pragma("unroll") \
                for (int dt = 0; dt < 4; ++dt) { \
                    const v4i16_t lo = __builtin_amdgcn_ds_read_tr16_b64_v4i16((LAS v4i16_t*)(vb + vtr + (32 * kk) * AV_PITCH + 32 * dt)); \
                    const v4i16_t hi = __builtin_amdgcn_ds_read_tr16_b64_v4i16((LAS v4i16_t*)(vb + vtr + (32 * kk + 16) * AV_PITCH + 32 * dt)); \
                    const bf16x8 vf = {lo[0], lo[1], lo[2], lo[3], hi[0], hi[1], hi[2], hi[3]}; \
                    oacc[dt][0] = __builtin_amdgcn_mfma_f32_16x16x32_bf16(vf, pf[0][kk], oacc[dt][0], 0, 0, 0); \
                    oacc[dt][1] = __builtin_amdgcn_mfma_f32_16x16x32_bf16(vf, pf[1][kk], oacc[dt][1], 0, 0, 0); \
                } \
            if (more) { \
                *(LAS u32x4*)(nb + srow * AK_PITCH + sch * 16) = GK; \
                *(LAS u32x4*)(nb + AK_BYTES + srow * AV_PITCH + sch * 16) = GV; \
                if (tid < 256) *(LAS u32x4*)(nb + rrow * AK_PITCH + 128 + rch * 16) = GR; \
            } \
            if ((kt) + 3 < nkt) { const int kr0 = row0 + 64 * ((kt) + 3); \
                GK = *(const u32x4*)(KN + (size_t)(kr0 + srow) * NKV + 64 * h + 8 * sch); \
                GV = *(const u32x4*)(V + (size_t)(kr0 + srow) * NKV + 64 * h + 8 * sch); \
                GR = *(const u32x4*)(KR + (size_t)(kr0 + rrow) * 32 + 8 * rch); } \
            __syncthreads(); \
        } while (0)
        for (int kt2 = 0; kt2 < nkt; kt2 += 2) { ATT_BODY(kt2, gk, gr, gv); ATT_BODY(kt2 + 1, gk2, gr2, gv2); }
#undef ATT_BODY
#pragma unroll
        for (int q2 = 0; q2 < 2; ++q2) {
            float l = lrun[q2]; l += __shfl_xor(l, 16); l += __shfl_xor(l, 32);
            const float inv = 1.0f / l;
#pragma unroll
            for (int dt = 0; dt < 4; ++dt) { const f32x4 o = oacc[dt][q2] * inv;
                u32x2 w; w.x = pk_bf16(o[0], o[1]); w.y = pk_bf16(o[2], o[3]);
                *(u32x2*)(O + (size_t)(qrow + 16 * q2 + lc) * 512 + 64 * h + 16 * dt + 4 * g) = w; }
        }
    }
    __syncthreads();
}

#define XB_TMO      128
#define XB_XCNT(j)  (256  + 64 * (j))
#define XB_XSUB(j)  (1280 + 64 * (j))
#define XB_XGEN(j)  (2304 + 64 * (j))
#define XB_TOP      3328
#define XB_TOPGEN   3392
#define XCD_BAR_WORDS 3456
#define XB_SPIN_CAP (1u << 18)

__device__ __forceinline__ unsigned xb_ld(unsigned* p)              { return __hip_atomic_load(p, __ATOMIC_RELAXED, __HIP_MEMORY_SCOPE_AGENT); }
__device__ __forceinline__ unsigned xb_add(unsigned* p, unsigned v) { return __hip_atomic_fetch_add(p, v, __ATOMIC_RELAXED, __HIP_MEMORY_SCOPE_AGENT); }
__device__ __forceinline__ unsigned xb_xcc_id() { return (unsigned)__builtin_amdgcn_s_getreg((3 << 11) | 20) & 0xFu; }
#define XB_SPIN(cond, bar) do { unsigned _sp = 0; while (cond) { __builtin_amdgcn_s_sleep(1); \
    if ((++_sp & 255u) == 0u) { if (xb_ld(&(bar)[XB_TMO])) break; if (_sp > XB_SPIN_CAP) { atomicAdd(&(bar)[XB_TMO], 1u); break; } } } } while (0)

struct XcdBarrier {
    unsigned* bar; unsigned x;
    volatile LAS unsigned* st;
};

__device__ __forceinline__ XcdBarrier xcd_barrier_post(unsigned* bar, volatile LAS unsigned* st) {
    XcdBarrier b; b.bar = bar; b.x = xb_xcc_id(); b.st = st;
    if (threadIdx.x == 0) (void)xb_add(&bar[XB_XCNT(b.x)], 1u);
    return b;
}
__device__ __forceinline__ void xcd_barrier_complete(unsigned* bar, unsigned x, unsigned& nloc, unsigned& nx) {
    const unsigned G = gridDim.x * gridDim.y * gridDim.z;
    unsigned sum, cnt, mine, sp = 0u;
    for (;;) {
        sum = 0u; cnt = 0u; mine = 0u;
#pragma unroll
        for (unsigned j = 0; j < 16; ++j) { const unsigned c = xb_ld(&bar[XB_XCNT(j)]); sum += c; cnt += (c > 0u) ? 1u : 0u; mine = (j == x) ? c : mine; }
        if (sum == G) break;
        __builtin_amdgcn_s_sleep(1);
        if ((++sp & 255u) == 0u) { if (xb_ld(&bar[XB_TMO])) break; if (sp > XB_SPIN_CAP) { atomicAdd(&bar[XB_TMO], 1u); break; } }
    }
    nloc = mine > 0u ? mine : 1u; nx = cnt > 0u ? cnt : 1u;
}

__device__ __forceinline__ void xcd_barrier(const XcdBarrier& b) {
    asm volatile("s_waitcnt vmcnt(0)" ::: "memory");
    __syncthreads();
    if (threadIdx.x == 0) {
        unsigned* bar = b.bar;
        __builtin_amdgcn_s_waitcnt(0);
        unsigned nloc = b.st[0], nx = b.st[1];
        if (nloc == 0u) { xcd_barrier_complete(bar, b.x, nloc, nx); b.st[0] = nloc; b.st[1] = nx; }
        const unsigned old = xb_add(&bar[XB_XSUB(b.x)], 1u);
        const unsigned gen = old / nloc;
        if (old + 1u == (gen + 1u) * nloc) {
            __builtin_amdgcn_fence(__ATOMIC_RELEASE, "agent");
            asm volatile("s_waitcnt vmcnt(0)" ::: "memory");
            const unsigned og = xb_add(&bar[XB_TOP], 1u);
            const unsigned tg = og / nx;
            if (og + 1u == (tg + 1u) * nx) xb_add(&bar[XB_TOPGEN], 1u);
            else XB_SPIN(xb_ld(&bar[XB_TOPGEN]) == tg, bar);
            __builtin_amdgcn_fence(__ATOMIC_ACQUIRE, "agent");
            xb_add(&bar[XB_XGEN(b.x)], 1u);
            asm volatile("s_waitcnt vmcnt(0)" ::: "memory");
        } else {
            XB_SPIN(xb_ld(&bar[XB_XGEN(b.x)]) == gen, bar);
            __builtin_amdgcn_fence(__ATOMIC_ACQUIRE, "agent");
            asm volatile("s_waitcnt vmcnt(0)" ::: "memory");
        }
    }
    __syncthreads();
}


constexpr int NPHASES = 16;
__global__ void __launch_bounds__(NTHREADS, 2) mega_fwd(Params p) {
    extern __shared__ __attribute__((aligned(16))) unsigned char lds_raw[];
    LAS unsigned char* lds = (LAS unsigned char*)lds_raw;
    cg::grid_group grid = cg::this_grid();
    unsigned char* ws = p.ws;
    const int G = gridDim.x, bid = blockIdx.x;
    bf16_t* Hb = (bf16_t*)(ws + WS_H); bf16_t* Fb = (bf16_t*)(ws + WS_F); bf16_t* ACT = (bf16_t*)(ws + WS_ACT);
    bf16_t* ZQ = (bf16_t*)(ws + WS_ZQ); bf16_t* XL = (bf16_t*)(ws + WS_XL); bf16_t* GY = (bf16_t*)(ws + WS_GY);
#ifndef TESTPH
#define TESTPH -1
#endif
#define IN(k) ((TESTPH < 0 || (k) == TESTPH) && p.ph_lo <= (k) && (k) < p.ph_hi)
#define SEAM0() do { if (IN(0) && IN(1)) { __builtin_amdgcn_fence(__ATOMIC_RELEASE, "agent"); asm volatile("s_waitcnt vmcnt(0) lgkmcnt(0)" ::: "memory"); \
        grid.sync(); __builtin_amdgcn_fence(__ATOMIC_ACQUIRE, "agent"); asm volatile("s_waitcnt vmcnt(0) lgkmcnt(0)" ::: "memory"); \
        xb = xcd_barrier_post((unsigned*)(p.ws + WS_XBAR), xbst); } } while (0)
#define SEAM(k) do { if (IN(k) && IN((k) + 1)) xcd_barrier(xb); } while (0)
    volatile LAS unsigned* xbst = (volatile LAS unsigned*)(lds + LDS_BYTES - 16);
    if (threadIdx.x < 4) xbst[threadIdx.x] = 0u;
    __syncthreads();
    XcdBarrier xb; xb.bar = (unsigned*)(p.ws + WS_XBAR); xb.x = 0; xb.st = xbst;
    if (IN(0) && bid == 0) { unsigned* xw = (unsigned*)(p.ws + WS_XBAR); for (int i = threadIdx.x; i < XCD_BAR_WORDS; i += NTHREADS) xw[i] = 0u; }
    SEAM0();
    if (IN(0)) phase_prep(p, lds);
    SEAM(0);
    if (IN(1)) phase_rows<false, true>(p, 0, 0, 0.f, true);
    SEAM(1);
#define FFN_PHASES(ffn, pb) do { \
        if (IN(pb)) { \
            pg8::Gemm g{Hb, (const bf16_t*)(ws + ((ffn) ? WS_WGU2 : WS_WGU1)), D, D}; pg8::StaticOrder S; S.init(T, 2 * DFF, G, bid); \
            pg8::EpiSwiglu E{ACT, DFF}; \
            GEMM_PHASE(pg8::EpiSwiglu, lds, g, S, E); \
        } \
        SEAM(pb); \
        if (IN((pb) + 1)) { \
            pg8::Gemm g{ACT, (const bf16_t*)(ws + ((ffn) ? WS_WDN2 : WS_WDN1)), DFF, DFF}; pg8::StaticOrder S; S.init(T, D, G, bid, 1); \
            pg8::EpiAct<0> E{(ffn) ? Hb : Fb, D, 0}; \
            GEMM_PHASE(pg8::EpiAct<0>, lds, g, S, E); \
        } \
        SEAM((pb) + 1); } while (0)
    FFN_PHASES(0, 2);
        if (IN(4)) phase_rows<true, true>(p, 0, 1, 0.5f, true);
        SEAM(4);
        if (IN(5)) {
            pg8::Gemm g{Hb, (const bf16_t*)(ws + WS_WINA), D, D}; pg8::StaticOrder S; S.init(T, 2560, G, bid);
            pg8::EpiWinA E{ZQ, XL, GY};
            GEMM_PHASE(pg8::EpiWinA, lds, g, S, E);
        }
        SEAM(5);
        if (IN(6)) { phase_lru(p, lds); if (bid >= G / 2) phase_stats(p, G / 2, G - G / 2);     }
        SEAM(6);
        if (IN(7)) {
            pg8::Gemm g{ZQ, (const bf16_t*)(ws + WS_WQKV), 512, 384}; pg8::StaticOrder S; S.init(T, 1792, G, bid);
            pg8::EpiQKV E{Fb, XL};
            GEMM_PHASE2(pg8::EpiQKV, lds, g, S, E);
        }
        SEAM(7);
        if (IN(8)) phase_attn(p, lds);
        SEAM(8);
        if (IN(9)) {
            pg8::Gemm g{Hb, (const bf16_t*)(ws + WS_WINB), D, D}; pg8::StaticOrder S; S.init(T, 2048, G, bid);
            pg8::EpiWinB E{Fb, XL};
            GEMM_PHASE(pg8::EpiWinB, lds, g, S, E);
        }
        SEAM(9);
        if (IN(10)) {
            { pg8::Gemm g{ZQ, (const bf16_t*)(ws + WS_WAO), 512, 512}; pg8::StaticOrder S; S.init(T, D, G, bid);
              pg8::EpiGate<false> E{Fb, nullptr, Fb};
              GEMM_PHASE(pg8::EpiGate<false>, lds, g, S, E); }
            { pg8::Gemm g{GY, (const bf16_t*)(ws + WS_WLO), D, D}; pg8::StaticOrder S; S.init(T, D, G, bid);
              pg8::EpiGate<true> E{XL, Fb, XL};
              GEMM_PHASE(pg8::EpiGate<true>, lds, g, S, E); }
        }
        SEAM(10);
        if (IN(11)) {
            pg8::Gemm g{XL, (const bf16_t*)(ws + WS_WOUT), D, D}; pg8::StaticOrder S; S.init(T, D, G, bid);
            pg8::EpiAct<0> E{Fb, D, 0};
            GEMM_PHASE(pg8::EpiAct<0>, lds, g, S, E);
        }
        SEAM(11);
        if (IN(12)) phase_rows<true, true>(p, 1, 2, 1.0f, false, false);
        SEAM(12);
    FFN_PHASES(1, 13);
    if (IN(15)) phase_final(p);
#undef IN
#undef SEAM
}

extern "C" void kernel_launch(void* const* d_in, const int* in_sizes, int n_in, void* d_out, int out_size, void* d_ws, size_t ws_size, hipStream_t stream) {
    static int grid = 0;
    if (grid == 0) {
        if (n_in != 27 || out_size != T * D || ws_size < WS_END) { fprintf(stderr, "kernel_launch: unexpected shapes: n_in %d out %d ws %zu (need >= %zu)\n", n_in, out_size, ws_size, (size_t)WS_END); grid = -1; return; }
        int dev = 0, cus = 0, per_cu = 0;
        (void)hipGetDevice(&dev);
        (void)hipDeviceGetAttribute(&cus, hipDeviceAttributeMultiprocessorCount, dev);
        if (hipFuncSetAttribute((const void*)mega_fwd, hipFuncAttributeMaxDynamicSharedMemorySize, LDS_BYTES) != hipSuccess) { fprintf(stderr, "kernel_launch: hipFuncSetAttribute failed\n"); grid = -1; return; }
        if (hipOccupancyMaxActiveBlocksPerMultiprocessor(&per_cu, (const void*)mega_fwd, NTHREADS, LDS_BYTES) != hipSuccess || per_cu < 1) { fprintf(stderr, "kernel_launch: occupancy query failed (%d)\n", per_cu); per_cu = 1; }
        (void)hipGetLastError();
        grid = cus;
        fprintf(stderr, "kernel_launch: grid %d (per_cu %d)\n", grid, per_cu);
    }
    if (grid < 0) return;
    Params p{};
    for (int i = 0; i < 27; ++i) p.in[i] = (const float*)d_in[i];
    p.out = (float*)d_out; p.ws = (unsigned char*)d_ws;
#if defined(MK_SPLIT)
    for (int ph = 0; ph < NPHASES; ++ph) { p.ph_lo = ph; p.ph_hi = ph + 1;
        hipLaunchKernelGGL(mega_fwd, dim3(grid), dim3(NTHREADS), LDS_BYTES, stream, p); }
#else
    p.ph_lo = 0; p.ph_hi = NPHASES;
    void* args[] = {&p};
    hipError_t e = hipLaunchCooperativeKernel((const void*)mega_fwd, dim3(grid), dim3(NTHREADS), args, LDS_BYTES, stream);
    if (e != hipSuccess) fprintf(stderr, "kernel_launch: cooperative launch failed: %s (grid %d)\n", hipGetErrorString(e), grid);
#endif
}
```
